# Optimizing an MI355X kernel written in HIP

```python
import jax, jax.numpy as jnp
from jax import lax
import numpy as np

D_MODEL = 2048
BATCH = 8
SEQ = 2048
DEPTH = 2

GRID_W = 64
CTX_LEN = 256
N_MOD = 9
D_FF = 5632
LN_EPS = 1e-5
DEEPNORM_ALPHA = (2 * DEPTH) ** 0.25
DEEPNORM_BETA = (8 * DEPTH) ** -0.25
FFN_RES = 0.5

A_HEADS = 8
A_KV_HEADS = 2
A_GROUP = A_HEADS // A_KV_HEADS
A_HEAD_DIM = 128
A_Q_DIM = A_HEADS * A_HEAD_DIM
A_KV_DIM = A_KV_HEADS * A_HEAD_DIM
WINDOW = 128
A_BLOCK = 128
N_SIDE = -(-WINDOW // A_BLOCK)
ROPE_BASE = 10000.0
MASK_VALUE = -1e30

R_HEAD_DIM = 64
R_DIM = D_MODEL // 2
R_HEADS = R_DIM // R_HEAD_DIM
DECAY_LORA = 96
ICLR_LORA = 96
GATE_LORA = 256
CONV_W = 3
R_GN_EPS = 64e-5

G_HEADS = 4
G_KEY_DIM = D_MODEL // 2
G_VAL_DIM = D_MODEL
G_DK = G_KEY_DIM // G_HEADS
G_DV = G_VAL_DIM // G_HEADS
G_GATE_RANK = 16
G_GATE_NORM = 16.0
G_CHUNK = 64
G_EPS = 1e-5

ATT_SPLIT = (A_Q_DIM, A_KV_DIM, A_KV_DIM)
RWKV_SPLIT = (R_DIM, R_DIM, R_DIM, 2 * DECAY_LORA, 2 * ICLR_LORA, GATE_LORA)
GLA_SPLIT = (G_KEY_DIM, G_KEY_DIM, G_VAL_DIM, G_VAL_DIM, 2 * G_GATE_RANK)
GATE_SPLIT = (D_MODEL, D_MODEL, D_MODEL)
ATT_COLS = sum(ATT_SPLIT)
RWKV_COLS = sum(RWKV_SPLIT)
GLA_COLS = sum(GLA_SPLIT)
GATE_COLS = sum(GATE_SPLIT)
GROUP_SPLIT = (ATT_COLS, RWKV_COLS, GLA_COLS, GATE_COLS)
IN_COLS = sum(GROUP_SPLIT)

kernel_name = "hybrid_dit_swa_rwkv7_gla_block"


def _split(z, sizes):
    idx = [int(i) for i in np.cumsum(sizes)[:-1]]
    return jnp.split(z, idx, axis=-1)


def _heads(t, n_heads):
    return t.reshape(*t.shape[:-1], n_heads, t.shape[-1] // n_heads)


def _layer_norm(x):
    xf = x.astype(jnp.float32)
    mu = jnp.mean(xf, -1, keepdims=True)
    var = jnp.mean(jnp.square(xf - mu), -1, keepdims=True)
    return ((xf - mu) * lax.rsqrt(var + LN_EPS)).astype(x.dtype)


def _post_norm(x_res, y, g, b):
    return _layer_norm(DEEPNORM_ALPHA * x_res + y) * g + b


def _modulate(x, shift, scale):
    return _layer_norm(x) * (1 + scale) + shift


def _swiglu(h, w_gu, w_down):
    gate, up = jnp.split(h @ w_gu, 2, axis=-1)
    return (jax.nn.silu(gate) * up) @ w_down


def _ffn_sublayer(x, shift, scale, gate, w_gu, w_down, g, b):
    y = _swiglu(_modulate(x, shift, scale), w_gu, w_down)
    return _post_norm(x, FFN_RES * gate * y, g, b)


def _axial_rope(n, dtype):
    rows = n // GRID_W
    row = jnp.repeat(jnp.arange(rows, dtype=jnp.float32), GRID_W)
    col = jnp.tile(jnp.arange(GRID_W, dtype=jnp.float32), rows)
    n_freq = A_HEAD_DIM // 4
    inv_freq = ROPE_BASE ** (-jnp.arange(n_freq, dtype=jnp.float32) / n_freq)
    ang = jnp.stack([row, col], -1)[:, :, None] * inv_freq
    return jnp.cos(ang)[:, None].astype(dtype), jnp.sin(ang)[:, None].astype(dtype)


def _apply_rope(x, cos, sin):
    xr = x.reshape(*x.shape[:-1], 2, 2, A_HEAD_DIM // 4)
    x1, x2 = xr[..., 0, :], xr[..., 1, :]
    out = jnp.stack([x1 * cos - x2 * sin, x2 * cos + x1 * sin], axis=-2)
    return out.reshape(x.shape)


def _window_attention_latent(q, q_plain, k, v, k_ctx, v_ctx, sink):
    B, S = q.shape[:2]
    C = k_ctx.shape[1]
    nb = S // A_BLOCK
    n_band = 2 * N_SIDE + 1
    band = n_band * A_BLOCK
    scale = A_HEAD_DIM ** -0.5
    qb = q.reshape(B, nb, A_BLOCK, A_KV_HEADS, A_GROUP, A_HEAD_DIM)
    qpb = q_plain.reshape(B, nb, A_BLOCK, A_KV_HEADS, A_GROUP, A_HEAD_DIM)
    pad = ((0, 0), (N_SIDE * A_BLOCK, N_SIDE * A_BLOCK), (0, 0), (0, 0))
    kp = jnp.pad(k, pad).reshape(B, nb + 2 * N_SIDE, A_BLOCK, A_KV_HEADS, A_HEAD_DIM)
    vp = jnp.pad(v, pad).reshape(B, nb + 2 * N_SIDE, A_BLOCK, A_KV_HEADS, A_HEAD_DIM)
    kband = jnp.concatenate([kp[:, j:j + nb] for j in range(n_band)], axis=2)
    vband = jnp.concatenate([vp[:, j:j + nb] for j in range(n_band)], axis=2)
    s_loc = jnp.einsum('bnqhgd,bnkhd->bnhgqk', qb, kband).astype(jnp.float32) * scale
    blk = jnp.arange(nb)[:, None, None]
    qpos = blk * A_BLOCK + jnp.arange(A_BLOCK)[None, :, None]
    kpos = (blk - N_SIDE) * A_BLOCK + jnp.arange(band)[None, None, :]
    valid = (jnp.abs(qpos - kpos) <= WINDOW) & (kpos >= 0) & (kpos < S)
    s_loc = jnp.where(valid[None, :, None, None], s_loc, MASK_VALUE)
    s_ctx = jnp.einsum('bnqhgd,bchd->bnhgqc', qpb, k_ctx).astype(jnp.float32) * scale
    s_sink = jnp.broadcast_to(sink.reshape(A_KV_HEADS, A_GROUP, 1, 1).astype(jnp.float32),
                              s_loc.shape[:-1] + (1,))
    p = jax.nn.softmax(jnp.concatenate([s_loc, s_ctx, s_sink], axis=-1), axis=-1)
    p_loc = p[..., :band].astype(v.dtype)
    p_ctx = p[..., band:band + C].astype(v.dtype)
    o = (jnp.einsum('bnhgqk,bnkhd->bnqhgd', p_loc, vband)
         + jnp.einsum('bnhgqc,bchd->bnqhgd', p_ctx, v_ctx))
    return o.reshape(B, S, A_Q_DIM)


def _context_attention(q, k, v, sink):
    B, C = q.shape[:2]
    qg = q.reshape(B, C, A_KV_HEADS, A_GROUP, A_HEAD_DIM)
    s = jnp.einsum('bqhgd,bkhd->bhgqk', qg, k).astype(jnp.float32) * (A_HEAD_DIM ** -0.5)
    s_sink = jnp.broadcast_to(sink.reshape(A_KV_HEADS, A_GROUP, 1, 1).astype(jnp.float32),
                              s.shape[:-1] + (1,))
    p = jax.nn.softmax(jnp.concatenate([s, s_sink], axis=-1), axis=-1)
    o = jnp.einsum('bhgqk,bkhd->bqhgd', p[..., :C].astype(v.dtype), v)
    return o.reshape(B, C, A_Q_DIM)


def _centred_dwconv(z, w):
    L = z.shape[1]
    pad = CONV_W // 2
    zp = jnp.pad(z, ((0, 0), (pad, pad), (0, 0)))
    out = zp[:, 0:L] * w[0]
    for i in range(1, CONV_W):
        out = out + zp[:, i:i + L] * w[i]
    return out


def _rwkv_inputs(z, p):
    z = _centred_dwconv(z, p['rwkv_conv'])
    r, k, v, wc, ac, gc = _split(z, RWKV_SPLIT)
    wc = jnp.split(wc, 2, axis=-1)
    ac = jnp.split(ac, 2, axis=-1)
    g = jax.nn.sigmoid(gc) @ p['rwkv_g2']
    kk = _heads((k * p['rwkv_k_k']).astype(jnp.float32), R_HEADS)
    kk = kk / jnp.maximum(jnp.linalg.norm(kk, axis=-1, keepdims=True), 1e-12)
    dirs = []
    for d in range(2):
        w = -jax.nn.softplus(-(p['rwkv_w0'][d] + jnp.tanh(wc[d]) @ p['rwkv_w2'][d])) - 0.5
        decay = jnp.exp(-jnp.exp(w.astype(jnp.float32)))
        a = jax.nn.sigmoid(p['rwkv_a0'][d] + ac[d] @ p['rwkv_a2'][d])
        kd = k * (1 + (a - 1) * p['rwkv_k_a'])
        dirs.append((_heads(decay, R_HEADS), _heads(kd, R_HEADS), _heads(a, R_HEADS)))
    return _heads(r, R_HEADS), _heads(v, R_HEADS), kk, g, dirs


def _rwkv7_scan(r, decay, k, v, kk, a, s0, reverse):
    dt = r.dtype
    xs = tuple(jnp.moveaxis(t.astype(jnp.float32), 1, 0) for t in (r, decay, k, v, kk, a))

    def step(s, inp):
        r_t, w_t, k_t, v_t, kk_t, a_t = inp
        sa = jnp.einsum('bhij,bhj->bhi', s, -kk_t)
        s = (s * w_t[:, :, None, :] + sa[..., None] * (kk_t * a_t)[:, :, None, :]
             + v_t[..., None] * k_t[:, :, None, :])
        return s, jnp.einsum('bhij,bhj->bhi', s, r_t)

    s_fin, ys = lax.scan(step, s0, xs, reverse=reverse)
    return jnp.moveaxis(ys, 0, 1).astype(dt), s_fin


def _rwkv_output(ys, r, v, kds, g, p, dtype):
    o = (ys[0] + ys[1]).astype(jnp.float32)
    mu = jnp.mean(o, -1, keepdims=True)
    var = jnp.mean(jnp.square(o - mu), -1, keepdims=True)
    o = (o - mu) * lax.rsqrt(var + R_GN_EPS)
    o = o * p['rwkv_ln_w'].reshape(R_HEADS, R_HEAD_DIM) + p['rwkv_ln_b'].reshape(R_HEADS, R_HEAD_DIM)
    bonus = sum(jnp.sum(r * kd * p['rwkv_r_k'], axis=-1, keepdims=True) * v for kd in kds)
    B, L = o.shape[:2]
    return ((o + bonus).reshape(B, L, R_DIM) * g).astype(dtype)


def _rwkv_mixer(z_lat, z_ctx, p, with_ctx_out):
    r_c, v_c, kk_c, g_c, dirs_c = _rwkv_inputs(z_ctx, p)
    r_l, v_l, kk_l, g_l, dirs_l = _rwkv_inputs(z_lat, p)
    s0 = jnp.zeros((z_lat.shape[0], R_HEADS, R_HEAD_DIM, R_HEAD_DIM), jnp.float32)
    ys_l, ys_c = [], []
    for d in range(2):
        rev = d == 1
        dec_c, k_c, a_c = dirs_c[d]
        y_c, s_c = _rwkv7_scan(r_c, dec_c, k_c, v_c, kk_c, a_c, s0, rev)
        dec_l, k_l, a_l = dirs_l[d]
        y_l, _ = _rwkv7_scan(r_l, dec_l, k_l, v_l, kk_l, a_l, s_c, rev)
        ys_c.append(y_c)
        ys_l.append(y_l)
    out_l = _rwkv_output(ys_l, r_l, v_l, [dl[1] for dl in dirs_l], g_l, p, z_lat.dtype)
    out_c = _rwkv_output(ys_c, r_c, v_c, [dc[1] for dc in dirs_c], g_c, p, z_ctx.dtype) if with_ctx_out else None
    return out_l, out_c


def _gla_inputs(z, p):
    q, k, v, g, ac = _split(z, GLA_SPLIT)
    ac = jnp.split(ac, 2, axis=-1)
    q = _heads(q, G_HEADS) * (G_DK ** -0.5)
    log_a = [_heads(jax.nn.log_sigmoid((ac[d] @ p['gla_wa2'][d] + p['gla_ba'][d]).astype(jnp.float32))
                    / G_GATE_NORM, G_HEADS) for d in range(2)]
    return q, _heads(k, G_HEADS), _heads(v, G_HEADS), g, log_a


def _gla_chunked(q, k, v, log_a, s0):
    dt = v.dtype
    B, L, H, _ = q.shape
    Dv = v.shape[-1]
    nc = L // G_CHUNK

    def chunks(t):
        return t.reshape(B, nc, G_CHUNK, H, t.shape[-1]).astype(jnp.float32)

    qc, kc, vc, lac = chunks(q), chunks(k), chunks(v), chunks(log_a)
    b = jnp.cumsum(lac, axis=2)
    b_last = b[:, :, -1]
    q_dec = qc * jnp.exp(b)
    k_inv = kc * jnp.exp(-b)
    k_end = kc * jnp.exp(b_last[:, :, None] - b)
    causal = jnp.tril(jnp.ones((G_CHUNK, G_CHUNK), bool))
    att = jnp.where(causal, jnp.einsum('bnihd,bnjhd->bnhij', q_dec, k_inv), 0.0)
    o_intra = jnp.einsum('bnhij,bnjhe->bnihe', att, vc)

    def step(s, inp):
        q_t, k_t, v_t, dl = inp
        o = jnp.einsum('bihd,bhde->bihe', q_t, s)
        s = s * dl[..., None] + jnp.einsum('bjhd,bjhe->bhde', k_t, v_t)
        return s, o

    xs = tuple(jnp.moveaxis(t, 1, 0) for t in (q_dec, k_end, vc, jnp.exp(b_last)))
    s_fin, o_inter = lax.scan(step, s0, xs)
    o = o_intra + jnp.moveaxis(o_inter, 0, 1)
    return o.reshape(B, L, H, Dv).astype(dt), s_fin


def _gla_output(o, g, p):
    of = o.astype(jnp.float32)
    of = of * lax.rsqrt(jnp.mean(jnp.square(of), -1, keepdims=True) + G_EPS) * p['gla_norm_w']
    B, L = o.shape[:2]
    return (of.reshape(B, L, G_VAL_DIM) * jax.nn.silu(g.astype(jnp.float32))).astype(g.dtype)


def _gla_mixer(z_lat, z_ctx, p, with_ctx_out):
    q_c, k_c, v_c, g_c, la_c = _gla_inputs(z_ctx, p)
    q_l, k_l, v_l, g_l, la_l = _gla_inputs(z_lat, p)
    s0 = jnp.zeros((z_lat.shape[0], G_HEADS, G_DK, G_DV), jnp.float32)

    def flip(t):
        return jnp.flip(t, axis=1)

    y_cf, s_cf = _gla_chunked(q_c, k_c, v_c, la_c[0], s0)
    y_lf, _ = _gla_chunked(q_l, k_l, v_l, la_l[0], s_cf)
    y_cb, s_cb = _gla_chunked(flip(q_c), flip(k_c), flip(v_c), flip(la_c[1]), s0)
    y_lb, _ = _gla_chunked(flip(q_l), flip(k_l), flip(v_l), flip(la_l[1]), s_cb)
    out_l = _gla_output(y_lf + flip(y_lb), g_l, p)
    out_c = _gla_output(y_cf + flip(y_cb), g_c, p) if with_ctx_out else None
    return out_l, out_c


def _merge(o_att, o_rwkv, o_gla, gate_cols, p):
    g_att, g_rwkv, g_gla = _split(jax.nn.sigmoid(gate_cols), GATE_SPLIT)
    merged = (g_att * (o_att @ p['w_branch_att']) + g_rwkv * (o_rwkv @ p['w_branch_rwkv'])
              + g_gla * (o_gla @ p['w_branch_gla']))
    return merged @ p['w_out']


def _token_mixing(h_lat, h_ctx, p, cos, sin, with_ctx_out):
    z_lat = h_lat @ p['w_in']
    z_ctx = h_ctx @ p['w_in']
    att_l, rwkv_l, gla_l, gate_l = _split(z_lat, GROUP_SPLIT)
    att_c, rwkv_c, gla_c, gate_c = _split(z_ctx, GROUP_SPLIT)
    q_l, k_l, v_l = _split(att_l, ATT_SPLIT)
    q_c, k_c, v_c = _split(att_c, ATT_SPLIT)
    q_l, k_l, v_l = _heads(q_l, A_HEADS), _heads(k_l, A_KV_HEADS), _heads(v_l, A_KV_HEADS)
    q_c, k_c, v_c = _heads(q_c, A_HEADS), _heads(k_c, A_KV_HEADS), _heads(v_c, A_KV_HEADS)
    o_att_l = _window_attention_latent(_apply_rope(q_l, cos, sin), q_l, _apply_rope(k_l, cos, sin), v_l,
                                       k_c, v_c, p['attn_sink'])
    o_rwkv_l, o_rwkv_c = _rwkv_mixer(rwkv_l, rwkv_c, p, with_ctx_out)
    o_gla_l, o_gla_c = _gla_mixer(gla_l, gla_c, p, with_ctx_out)
    y_lat = _merge(o_att_l, o_rwkv_l, o_gla_l, gate_l, p)
    y_ctx = None
    if with_ctx_out:
        o_att_c = _context_attention(q_c, k_c, v_c, p['attn_sink'])
        y_ctx = _merge(o_att_c, o_rwkv_c, o_gla_c, gate_c, p)
    return y_lat, y_ctx


def setup_inputs(seed: int = 0) -> dict:
    key = jax.random.key(seed)
    ks = jax.random.split(key, 32)
    D = D_MODEL

    def nrm(k, shape, s):
        return jax.random.normal(k, shape, jnp.float32) * s

    centre_tap = (jnp.arange(CONV_W) == CONV_W // 2).astype(jnp.float32)[:, None]
    return {
        "x": nrm(ks[0], (BATCH, SEQ, D), 1.0),
        "c": nrm(ks[1], (BATCH, D), 1.0),
        "ctx": nrm(ks[2], (BATCH, CTX_LEN, D), 1.0),
        "c_ctx": nrm(ks[3], (D,), 1.0),
        "ada_w": nrm(ks[4], (DEPTH, D, N_MOD * D), D ** -0.5),
        "ada_b": nrm(ks[5], (DEPTH, N_MOD * D), 0.02),
        "ln_g": 1.0 + nrm(ks[6], (DEPTH, 3, D), 0.02),
        "ln_b": nrm(ks[7], (DEPTH, 3, D), 0.02),
        "ffn_w_gu": nrm(ks[8], (DEPTH, 2, D, 2 * D_FF), D ** -0.5),
        "ffn_w_down": nrm(ks[9], (DEPTH, 2, D_FF, D), DEEPNORM_BETA * D_FF ** -0.5),
        "w_in": nrm(ks[10], (DEPTH, D, IN_COLS), D ** -0.5),
        "attn_sink": nrm(ks[11], (DEPTH, A_HEADS), 0.5),
        "rwkv_conv": centre_tap + nrm(ks[12], (DEPTH, CONV_W, RWKV_COLS), 0.1),
        "rwkv_w0": jax.random.uniform(ks[13], (DEPTH, 2, R_DIM), jnp.float32, -5.0, 0.0),
        "rwkv_w2": nrm(ks[14], (DEPTH, 2, DECAY_LORA, R_DIM), 0.1 * DECAY_LORA ** -0.5),
        "rwkv_a0": nrm(ks[15], (DEPTH, 2, R_DIM), 0.1),
        "rwkv_a2": nrm(ks[16], (DEPTH, 2, ICLR_LORA, R_DIM), ICLR_LORA ** -0.5),
        "rwkv_g2": nrm(ks[17], (DEPTH, GATE_LORA, R_DIM), GATE_LORA ** -0.5),
        "rwkv_k_k": 0.85 + nrm(ks[18], (DEPTH, R_DIM), 0.02),
        "rwkv_k_a": 1.0 + nrm(ks[19], (DEPTH, R_DIM), 0.02),
        "rwkv_r_k": nrm(ks[20], (DEPTH, R_HEADS, R_HEAD_DIM), 0.1),
        "rwkv_ln_w": 1.0 + nrm(ks[21], (DEPTH, R_DIM), 0.02),
        "rwkv_ln_b": nrm(ks[22], (DEPTH, R_DIM), 0.02),
        "gla_wa2": nrm(ks[23], (DEPTH, 2, G_GATE_RANK, G_KEY_DIM), G_GATE_RANK ** -0.5),
        "gla_ba": nrm(ks[24], (DEPTH, 2, G_KEY_DIM), 0.1),
        "gla_norm_w": 1.0 + nrm(ks[25], (DEPTH, G_DV), 0.02),
        "w_branch_att": nrm(ks[26], (DEPTH, A_Q_DIM, D), A_Q_DIM ** -0.5),
        "w_branch_rwkv": nrm(ks[27], (DEPTH, R_DIM, D), R_DIM ** -0.5),
        "w_branch_gla": nrm(ks[28], (DEPTH, G_VAL_DIM, D), G_VAL_DIM ** -0.5),
        "w_out": nrm(ks[29], (DEPTH, D, D), DEEPNORM_BETA * D ** -0.5),
    }


def reference(x, c, ctx, c_ctx, ada_w, ada_b, ln_g, ln_b, ffn_w_gu, ffn_w_down, w_in, attn_sink,
              rwkv_conv, rwkv_w0, rwkv_w2, rwkv_a0, rwkv_a2, rwkv_g2, rwkv_k_k, rwkv_k_a, rwkv_r_k,
              rwkv_ln_w, rwkv_ln_b, gla_wa2, gla_ba, gla_norm_w, w_branch_att, w_branch_rwkv,
              w_branch_gla, w_out):
    cos, sin = _axial_rope(x.shape[1], x.dtype)
    xc = ctx
    for l in range(DEPTH):
        last = l == DEPTH - 1
        p = {
            'w_in': w_in[l], 'attn_sink': attn_sink[l],
            'rwkv_conv': rwkv_conv[l], 'rwkv_w0': rwkv_w0[l], 'rwkv_w2': rwkv_w2[l],
            'rwkv_a0': rwkv_a0[l], 'rwkv_a2': rwkv_a2[l], 'rwkv_g2': rwkv_g2[l],
            'rwkv_k_k': rwkv_k_k[l], 'rwkv_k_a': rwkv_k_a[l], 'rwkv_r_k': rwkv_r_k[l],
            'rwkv_ln_w': rwkv_ln_w[l], 'rwkv_ln_b': rwkv_ln_b[l],
            'gla_wa2': gla_wa2[l], 'gla_ba': gla_ba[l], 'gla_norm_w': gla_norm_w[l],
            'w_branch_att': w_branch_att[l], 'w_branch_rwkv': w_branch_rwkv[l],
            'w_branch_gla': w_branch_gla[l], 'w_out': w_out[l],
        }
        ml = jnp.split((jax.nn.silu(c) @ ada_w[l] + ada_b[l])[:, None, :], N_MOD, axis=-1)
        mc = jnp.split(jax.nn.silu(c_ctx) @ ada_w[l] + ada_b[l], N_MOD, axis=-1)
        x = _ffn_sublayer(x, ml[0], ml[1], ml[2], ffn_w_gu[l, 0], ffn_w_down[l, 0], ln_g[l, 0], ln_b[l, 0])
        xc = _ffn_sublayer(xc, mc[0], mc[1], mc[2], ffn_w_gu[l, 0], ffn_w_down[l, 0], ln_g[l, 0], ln_b[l, 0])
        h_l = _modulate(x, ml[3], ml[4])
        h_c = _modulate(xc, mc[3], mc[4])
        y_l, y_c = _token_mixing(h_l, h_c, p, cos, sin, not last)
        x = _post_norm(x, ml[5] * y_l, ln_g[l, 1], ln_b[l, 1])
        x = _ffn_sublayer(x, ml[6], ml[7], ml[8], ffn_w_gu[l, 1], ffn_w_down[l, 1], ln_g[l, 2], ln_b[l, 2])
        if not last:
            xc = _post_norm(xc, mc[5] * y_c, ln_g[l, 1], ln_b[l, 1])
            xc = _ffn_sublayer(xc, mc[6], mc[7], mc[8], ffn_w_gu[l, 1], ffn_w_down[l, 1], ln_g[l, 2], ln_b[l, 2])
    return x
```

```cpp
#include <hip/hip_runtime.h>
#include <cstdio>
#include <cstdint>

#define GAS __attribute__((address_space(1)))
#define LAS __attribute__((address_space(3)))
typedef unsigned short bf16;
typedef unsigned v4u __attribute__((ext_vector_type(4)));
typedef unsigned v2u __attribute__((ext_vector_type(2)));
typedef float f32x4 __attribute__((ext_vector_type(4)));
typedef float f32x2 __attribute__((ext_vector_type(2)));
typedef short bf16x8 __attribute__((ext_vector_type(8)));

__device__ __forceinline__ float bf2f(unsigned short b) { return __builtin_bit_cast(float, ((unsigned)b) << 16); }
__device__ __forceinline__ float bflo(unsigned w) { return __builtin_bit_cast(float, w << 16); }
__device__ __forceinline__ float bfhi(unsigned w) { return __builtin_bit_cast(float, w & 0xffff0000u); }
__device__ __forceinline__ unsigned f2bf(float f) { unsigned u = __builtin_bit_cast(unsigned, f); return (u + 0x7fffu + ((u >> 16) & 1u)) >> 16; }
__device__ __forceinline__ unsigned pk2(float lo, float hi) { return f2bf(lo) | (f2bf(hi) << 16); }
__device__ __forceinline__ float wave_sum(float v) {
#pragma unroll
    for (int o = 1; o < 64; o <<= 1) v += __shfl_xor(v, o);
    return v;
}
__device__ __forceinline__ float fsigmoid(float x) { return 1.0f / (1.0f + __expf(-x)); }
__device__ __forceinline__ float fsilu(float x) { return x / (1.0f + __expf(-x)); }
__device__ __forceinline__ float fsoftplus(float x) { return fmaxf(x, 0.f) + __logf(1.0f + __expf(-fabsf(x))); }
__device__ __forceinline__ float ftanh(float x) { const float e = __expf(-2.0f * fabsf(x)); const float t = (1.0f - e) / (1.0f + e); return x < 0.f ? -t : t; }

namespace pg8 {
#define PG8_LAS __attribute__((address_space(3)))
typedef unsigned short bf16_t;
typedef short bf16x8 __attribute__((ext_vector_type(8)));
typedef float f32x4 __attribute__((ext_vector_type(4)));
typedef unsigned u32x4 __attribute__((ext_vector_type(4)));
constexpr int BM = 256, BK = 64, HALF = 128, HTB = HALF * BK * 2  , STAGE_BYTES = 8 * HTB, NXCD = 8, WGM = 8;

__host__ __device__ __forceinline__ int lds_byte(int r, int c) { const int st = (r >> 4) * 2 + (c >> 5), rr = r & 15, cc = c & 31, ob = rr * 64 + cc * 2; return st * 1024 + (ob ^ (((ob >> 9) & 1) << 5)); }
__host__ __device__ __forceinline__ void stage_rc(int b, int& R, int& C) { const int st = b / 1024, sb = b % 1024, swz = sb ^ (((sb >> 9) & 1) << 5); R = (st >> 1) * 16 + swz / 64; C = (st & 1) * 32 + (swz % 64) / 2; }
__host__ __device__ __forceinline__ int perm32(int rho) { const int n = rho >> 4, i = rho & 15; return 8 * (i >> 2) + 4 * n + (i & 3); }

struct Unit { int pm, pn; };
struct Gemm { const bf16_t* A; const bf16_t* Bt; int M, N, K, lda, ldb; };

struct StaticOrder {
    int nM, nN, nwg, G, c;
    __host__ __device__ void init(int M, int N, int G_, int c_) { nM = M / BM; nN = N / BM; nwg = nM * nN; G = G_; c = c_; }
    __host__ __device__ bool next(int i, Unit& u) const {
        const long L = (long)i * G + c; if (L >= nwg) return false;
        int wgid = (int)L; { const int q = nwg / NXCD, r = nwg % NXCD, xcd = wgid % NXCD, off = wgid / NXCD; wgid = (xcd < r ? xcd * (q + 1) : r * (q + 1) + (xcd - r) * q) + off; }
        const int nig = WGM * nN, gid = wgid / nig, fm = gid * WGM, gsz = (nM - fm) < WGM ? (nM - fm) : WGM;
        u.pm = fm + ((wgid % nig) % gsz); u.pn = (wgid % nig) / gsz; return true;
    }
    __device__ __forceinline__ void a_ready(const Unit&) const {}
    __device__ __forceinline__ void done(const Unit&) const {}
};

__device__ __forceinline__ unsigned cvt_pk_bf16(float lo, float hi) { unsigned r; asm volatile("v_cvt_pk_bf16_f32 %0, %1, %2" : "=v"(r) : "v"(lo), "v"(hi)); return r; }

#define EPI_ROWS_BEGIN \
    _Pragma("unroll") for (int ai = 0; ai < 2; ++ai) _Pragma("unroll") for (int m = 0; m < 4; ++m) { const int row = u.pm * BM + ai * HALF + wr * 64 + m * 16 + fr;
#define EPI_ROWS_END }

template <int ACT, size_t O0, size_t O1, size_t O2, int T1, int T2, int L0, int L1, int L2> struct EpiBf16Seg {
    static constexpr bool PERM = true, AFTER_DRAIN = false;
    unsigned char* ws;
    __device__ __forceinline__ void operator()(const f32x4 (&acc)[2][2][4][2], const Unit& u, int wr, int wc, int fr, int fq) const {
        const size_t off = u.pn >= T2 ? O2 : (u.pn >= T1 ? O1 : O0); const int l = u.pn >= T2 ? L2 : (u.pn >= T1 ? L1 : L0), tb = u.pn >= T2 ? T2 : (u.pn >= T1 ? T1 : 0);
        bf16_t* base = (bf16_t*)(ws + off);
        const int col0 = (u.pn - tb) * BM + wc * 32 + 8 * fq;
        EPI_ROWS_BEGIN
            bf16_t* rowp = base + (size_t)row * l + col0;
#pragma unroll
            for (int bj = 0; bj < 2; ++bj) { f32x4 v0 = acc[ai][bj][m][0], v1 = acc[ai][bj][m][1];
                if (ACT == 1) {
#pragma unroll
                    for (int j = 0; j < 4; ++j) { v0[j] = fsigmoid(v0[j]); v1[j] = fsigmoid(v1[j]); } }
                u32x4 w; w.x = cvt_pk_bf16(v0[0], v0[1]); w.y = cvt_pk_bf16(v0[2], v0[3]); w.z = cvt_pk_bf16(v1[0], v1[1]); w.w = cvt_pk_bf16(v1[2], v1[3]);
                *(u32x4*)(rowp + bj * HALF) = w; }
        EPI_ROWS_END
    }
};
struct EpiSwiglu {
    static constexpr bool PERM = true, AFTER_DRAIN = false;
    bf16_t* H; int ldh;
    __device__ __forceinline__ void operator()(const f32x4 (&acc)[2][2][4][2], const Unit& u, int wr, int wc, int fr, int fq) const {
        const int col0 = u.pn * HALF + wc * 32 + 8 * fq;
        EPI_ROWS_BEGIN
            f32x4 g0 = acc[ai][0][m][0], g1 = acc[ai][0][m][1]; const f32x4 u0 = acc[ai][1][m][0], u1 = acc[ai][1][m][1];
#pragma unroll
            for (int j = 0; j < 4; ++j) { g0[j] = fsilu(g0[j]) * u0[j]; g1[j] = fsilu(g1[j]) * u1[j]; }
            u32x4 w; w.x = cvt_pk_bf16(g0[0], g0[1]); w.y = cvt_pk_bf16(g0[2], g0[3]); w.z = cvt_pk_bf16(g1[0], g1[1]); w.w = cvt_pk_bf16(g1[2], g1[3]);
            *(u32x4*)(H + (size_t)row * ldh + col0) = w;
        EPI_ROWS_END
    }
};
struct EpiResid {
    static constexpr bool PERM = true, AFTER_DRAIN = false;
    float* xl; float* xc; const float* mods; int kmod; float alpha, coef;
    __device__ __forceinline__ void operator()(const f32x4 (&acc)[2][2][4][2], const Unit& u, int wr, int wc, int fr, int fq) const {
        const int bsel = u.pm < 64 ? (u.pm >> 3) : 8;
        const float* mp = mods + (size_t)bsel * (9 * 2048) + kmod * 2048;
        float* xb = u.pm < 64 ? xl : xc - (size_t)16384 * 2048;
        const int col0 = u.pn * BM + wc * 32 + 8 * fq;
        f32x4 mv[2][2];
#pragma unroll
        for (int bj = 0; bj < 2; ++bj)
#pragma unroll
            for (int n = 0; n < 2; ++n) mv[bj][n] = *(const f32x4*)(mp + col0 + bj * HALF + 4 * n) * coef;
        EPI_ROWS_BEGIN
            float* rowp = xb + (size_t)row * 2048 + col0;
#pragma unroll
            for (int bj = 0; bj < 2; ++bj)
#pragma unroll
                for (int n = 0; n < 2; ++n) { f32x4* p = (f32x4*)(rowp + bj * HALF + 4 * n); const f32x4 x = *p; *p = x * alpha + mv[bj][n] * acc[ai][bj][m][n]; }
        EPI_ROWS_END
    }
};
template <int MODE> struct EpiBranch {
    static constexpr bool PERM = true, AFTER_DRAIN = false;
    const bf16_t* GT; int ldg, goff; float* T; bf16_t* O;
    __device__ __forceinline__ void operator()(const f32x4 (&acc)[2][2][4][2], const Unit& u, int wr, int wc, int fr, int fq) const {
        const int col0 = u.pn * BM + wc * 32 + 8 * fq;
        EPI_ROWS_BEGIN
#pragma unroll
            for (int bj = 0; bj < 2; ++bj) {
                const u32x4 gw = *(const u32x4*)(GT + (size_t)row * ldg + goff + col0 + bj * HALF);
                f32x4 g0 = (f32x4){bflo(gw.x), bfhi(gw.x), bflo(gw.y), bfhi(gw.y)}, g1 = (f32x4){bflo(gw.z), bfhi(gw.z), bflo(gw.w), bfhi(gw.w)};
                f32x4 v0 = g0 * acc[ai][bj][m][0], v1 = g1 * acc[ai][bj][m][1];
                float* tp = T + (size_t)row * 2048 + col0 + bj * HALF;
                if (MODE >= 1) { v0 += *(const f32x4*)tp; v1 += *(const f32x4*)(tp + 4); }
                if (MODE <= 1) { *(f32x4*)tp = v0; *(f32x4*)(tp + 4) = v1; }
                else { u32x4 w; w.x = cvt_pk_bf16(v0[0], v0[1]); w.y = cvt_pk_bf16(v0[2], v0[3]); w.z = cvt_pk_bf16(v1[0], v1[1]); w.w = cvt_pk_bf16(v1[2], v1[3]);
                    *(u32x4*)(O + (size_t)row * 2048 + col0 + bj * HALF) = w; }
            }
        EPI_ROWS_END
    }
};
template <int MODE> struct EpiLora {
    static constexpr bool PERM = true, AFTER_DRAIN = false;
    float* WD; bf16_t* OB; const float* bias; size_t dstride;
    __device__ __forceinline__ void operator()(const f32x4 (&acc)[2][2][4][2], const Unit& u, int wr, int wc, int fr, int fq) const {
        const int colg = u.pn * BM + wc * 32 + 8 * fq;
        EPI_ROWS_BEGIN
#pragma unroll
            for (int bj = 0; bj < 2; ++bj) { const int cg = colg + bj * HALF; const int dir = (MODE == 2) ? 0 : (cg >> 10); const int c = (MODE == 2) ? cg : (cg & 1023);
                f32x4 v0 = acc[ai][bj][m][0], v1 = acc[ai][bj][m][1];
                if (MODE != 2) { v0 += *(const f32x4*)(bias + cg); v1 += *(const f32x4*)(bias + cg + 4); }
                if (MODE == 0) {
#pragma unroll
                    for (int j = 0; j < 4; ++j) { v0[j] = __expf(-__expf(-fsoftplus(-v0[j]) - 0.5f)); v1[j] = __expf(-__expf(-fsoftplus(-v1[j]) - 0.5f)); }
                    float* p = WD + (size_t)dir * dstride + (size_t)row * 1024 + c; *(f32x4*)p = v0; *(f32x4*)(p + 4) = v1;
                } else {
                    if (MODE == 1) {
#pragma unroll
                        for (int j = 0; j < 4; ++j) { v0[j] = fsigmoid(v0[j]); v1[j] = fsigmoid(v1[j]); } }
                    u32x4 w; w.x = cvt_pk_bf16(v0[0], v0[1]); w.y = cvt_pk_bf16(v0[2], v0[3]); w.z = cvt_pk_bf16(v1[0], v1[1]); w.w = cvt_pk_bf16(v1[2], v1[3]);
                    *(u32x4*)(OB + (size_t)dir * dstride + (size_t)row * 1024 + c) = w;
                }
            }
            asm volatile("" ::: "memory");
        EPI_ROWS_END
    }
};

template <class Epi, class Sched, bool ALIGN_EPI = false, bool SP2 = false>
__device__ __forceinline__ void gemm_phase(PG8_LAS unsigned char* lds, const Gemm g, const Sched& S, const Epi& E) {
    const int tid = threadIdx.x, wid = __builtin_amdgcn_readfirstlane(tid >> 6), lane = tid & 63, wr = wid >> 2, wc = wid & 3, fr = lane & 15, fq = lane >> 4;
    const int K = g.K, nt = K / BK, lda = g.lda, ldb = g.ldb;
    unsigned voffA[2], voffB[2];
#pragma unroll
    for (int i = 0; i < 2; ++i) { int R, C; stage_rc(tid * 16 + i * 8192, R, C); const int Rb = Epi::PERM ? ((R & ~31) + perm32(R & 31)) : R;
        voffA[i] = (unsigned)(R * lda + C) * 2u; voffB[i] = (unsigned)(Rb * ldb + C) * 2u; }
    const size_t kstep = (size_t)(BK * 2);
    const size_t hsA = (size_t)HALF * lda * 2, hsB = (size_t)HALF * ldb * 2;
    const size_t tsA = 2 * hsA, tsB = 2 * hsB;
    const unsigned ldsw = (unsigned)wid * 1024u;
    const int aoff = lds_byte(wr * 64 + fr, fq * 8), boff = lds_byte(wc * 32 + fr, fq * 8);
#define PG8_SA(b, h) (((b) * 2 + (h)) * HTB)
#define PG8_SB(b, h) ((4 + (b) * 2 + (h)) * HTB)
#define PG8_STAGE(bufoff, gbase, voff) do { _Pragma("unroll") for (int _i = 0; _i < 2; ++_i) \
        __builtin_amdgcn_global_load_lds((const unsigned*)((const char*)(gbase) + (voff)[_i]), (PG8_LAS unsigned*)(lds + (bufoff) + ldsw + _i * 8192), 16, 0, 0); } while (0)
#define PG8_LDA(dst, b, h) do { _Pragma("unroll") for (int m = 0; m < 4; ++m) _Pragma("unroll") for (int k = 0; k < 2; ++k) dst[m][k] = *(const PG8_LAS bf16x8*)(lds + PG8_SA(b, h) + aoff + m * 2048 + k * 1024); } while (0)
#define PG8_LDB(dst, b, h) do { _Pragma("unroll") for (int n = 0; n < 2; ++n) _Pragma("unroll") for (int k = 0; k < 2; ++k) dst[n][k] = *(const PG8_LAS bf16x8*)(lds + PG8_SB(b, h) + boff + n * 2048 + k * 1024); } while (0)
#define PG8_MMA(ai, bj, At, Bt) do { __builtin_amdgcn_s_setprio(1); _Pragma("unroll") for (int m = 0; m < 4; ++m) _Pragma("unroll") for (int n = 0; n < 2; ++n) _Pragma("unroll") for (int k = 0; k < 2; ++k) \
        acc[ai][bj][m][n] = __builtin_amdgcn_mfma_f32_16x16x32_bf16(Bt[n][k], At[m][k], acc[ai][bj][m][n], 0, 0, 0); __builtin_amdgcn_s_setprio(0); } while (0)
#define PG8_WAIT_V(n) asm volatile("s_waitcnt vmcnt(" #n ")" ::: "memory")
#define PG8_WAIT_L(n) asm volatile("s_waitcnt lgkmcnt(" #n ")" ::: "memory")
#define PG8_BAR __builtin_amdgcn_s_barrier()
#define PG8_SCHED __builtin_amdgcn_sched_barrier(0)
    Unit cur, nxt; int ui = 0;
    if (!S.next(0, cur)) return;
    f32x4 acc[2][2][4][2];
#pragma unroll
    for (int a = 0; a < 2; ++a)
#pragma unroll
        for (int b = 0; b < 2; ++b)
#pragma unroll
            for (int m = 0; m < 4; ++m)
#pragma unroll
                for (int n = 0; n < 2; ++n) acc[a][b][m][n] = (f32x4){0.f, 0.f, 0.f, 0.f};
    bf16x8 At[4][2], B0[2][2], B1[2][2];
    const char* cA = (const char*)g.A + (size_t)cur.pm * tsA; const char* cB = (const char*)g.Bt + (size_t)cur.pn * tsB;
    S.a_ready(cur);
    if constexpr (SP2) {
        PG8_STAGE(PG8_SB(0, 0), cB, voffB); PG8_STAGE(PG8_SB(0, 1), cB + hsB, voffB); PG8_STAGE(PG8_SA(0, 0), cA, voffA); PG8_STAGE(PG8_SA(0, 1), cA + hsA, voffA);
        if (wr == 1) PG8_BAR;
        PG8_WAIT_V(2); PG8_BAR;
        PG8_STAGE(PG8_SB(1, 0), cB + kstep, voffB); PG8_STAGE(PG8_SA(1, 0), cA + kstep, voffA); PG8_STAGE(PG8_SB(1, 1), cB + hsB + kstep, voffB);
        PG8_WAIT_V(6); PG8_BAR;
    } else {
        PG8_STAGE(PG8_SB(0, 0), cB, voffB); PG8_STAGE(PG8_SA(0, 0), cA, voffA); PG8_STAGE(PG8_SB(0, 1), cB + hsB, voffB); PG8_STAGE(PG8_SA(0, 1), cA + hsA, voffA);
        if (wr == 1) PG8_BAR;
        PG8_WAIT_V(4); PG8_BAR;
        PG8_STAGE(PG8_SB(1, 0), cB + kstep, voffB); PG8_STAGE(PG8_SA(1, 0), cA + kstep, voffA); PG8_STAGE(PG8_SB(1, 1), cB + hsB + kstep, voffB);
        PG8_WAIT_V(6); PG8_BAR;
    }
    for (;;) {
        const bool has_next = S.next(ui + 1, nxt);
        const char* nA = has_next ? (const char*)g.A + (size_t)nxt.pm * tsA : cA; const char* nB = has_next ? (const char*)g.Bt + (size_t)nxt.pn * tsB : cB;
        for (int t = 0; t < nt; t += 2) {
            const bool last = (t == nt - 2);
            const char* a1 = cA + (size_t)(t + 1) * kstep;
            const char* a2 = last ? nA : cA + (size_t)(t + 2) * kstep; const char* b2 = last ? nB : cB + (size_t)(t + 2) * kstep;
            const char* a3 = a2 + kstep; const char* b3 = b2 + kstep;
            if (last && has_next) S.a_ready(nxt);
            if constexpr (SP2) {
            PG8_LDB(B0, 0, 0); PG8_LDB(B1, 0, 1); PG8_SCHED; PG8_LDA(At, 0, 0); PG8_STAGE(PG8_SA(1, 1), a1 + hsA, voffA);
            PG8_WAIT_V(8); PG8_WAIT_L(0); PG8_BAR; PG8_MMA(0, 0, At, B0); PG8_MMA(0, 1, At, B1); PG8_BAR; PG8_SCHED;
            PG8_LDA(At, 0, 1); PG8_STAGE(PG8_SB(0, 0), b2, voffB); PG8_STAGE(PG8_SB(0, 1), b2 + hsB, voffB); PG8_STAGE(PG8_SA(0, 0), a2, voffA);
            PG8_WAIT_V(8); PG8_WAIT_L(0); PG8_BAR; PG8_MMA(1, 0, At, B0); PG8_MMA(1, 1, At, B1); PG8_BAR; PG8_SCHED;
            PG8_LDB(B0, 1, 0); PG8_LDB(B1, 1, 1); PG8_SCHED; PG8_LDA(At, 1, 0); PG8_STAGE(PG8_SA(0, 1), a2 + hsA, voffA);
            PG8_WAIT_V(8); PG8_WAIT_L(0); PG8_BAR; PG8_MMA(0, 0, At, B0); PG8_MMA(0, 1, At, B1); PG8_BAR; PG8_SCHED;
            PG8_LDA(At, 1, 1); PG8_STAGE(PG8_SB(1, 0), b3, voffB); PG8_STAGE(PG8_SB(1, 1), b3 + hsB, voffB); PG8_STAGE(PG8_SA(1, 0), a3, voffA);
            PG8_WAIT_V(8); PG8_WAIT_L(0); PG8_BAR; PG8_MMA(1, 0, At, B0); PG8_MMA(1, 1, At, B1); PG8_BAR; PG8_SCHED;
            } else {
            PG8_LDB(B0, 0, 0); PG8_SCHED; PG8_LDA(At, 0, 0); PG8_STAGE(PG8_SA(1, 1), a1 + hsA, voffA);
            PG8_WAIT_L(8); PG8_BAR; PG8_WAIT_L(0); PG8_MMA(0, 0, At, B0); PG8_BAR; PG8_SCHED;
            PG8_LDB(B1, 0, 1); PG8_STAGE(PG8_SB(0, 0), b2, voffB);
            PG8_BAR; PG8_WAIT_L(0); PG8_MMA(0, 1, At, B1); PG8_BAR;
            PG8_LDA(At, 0, 1); PG8_STAGE(PG8_SA(0, 0), a2, voffA);
            PG8_BAR; PG8_WAIT_L(0); PG8_MMA(1, 0, At, B0); PG8_BAR; PG8_SCHED;
            PG8_STAGE(PG8_SB(0, 1), b2 + hsB, voffB);
            PG8_WAIT_V(6); PG8_BAR; PG8_MMA(1, 1, At, B1); PG8_BAR;
            PG8_LDB(B0, 1, 0); PG8_SCHED; PG8_LDA(At, 1, 0); PG8_STAGE(PG8_SA(0, 1), a2 + hsA, voffA);
            PG8_WAIT_L(8); PG8_BAR; PG8_WAIT_L(0); PG8_MMA(0, 0, At, B0); PG8_BAR; PG8_SCHED;
            PG8_LDB(B1, 1, 1); PG8_STAGE(PG8_SB(1, 0), b3, voffB);
            PG8_BAR; PG8_WAIT_L(0); PG8_MMA(0, 1, At, B1); PG8_BAR;
            PG8_LDA(At, 1, 1); PG8_STAGE(PG8_SA(1, 0), a3, voffA);
            PG8_BAR; PG8_WAIT_L(0); PG8_MMA(1, 0, At, B0); PG8_BAR; PG8_SCHED;
            PG8_STAGE(PG8_SB(1, 1), b3 + hsB, voffB);
            PG8_WAIT_V(6); PG8_BAR; PG8_MMA(1, 1, At, B1); PG8_BAR;
            }
        }
        if constexpr (ALIGN_EPI) { if (wr == 0) PG8_BAR; }
        if constexpr (!Epi::AFTER_DRAIN) { E(acc, cur, wr, wc, fr, fq); S.done(cur); }
        if (!has_next) break;
#pragma unroll
        for (int a = 0; a < 2; ++a)
#pragma unroll
            for (int b = 0; b < 2; ++b)
#pragma unroll
                for (int m = 0; m < 4; ++m)
#pragma unroll
                    for (int n = 0; n < 2; ++n) acc[a][b][m][n] = (f32x4){0.f, 0.f, 0.f, 0.f};
        cur = nxt; cA = nA; cB = nB; ++ui;
        if constexpr (ALIGN_EPI) { if (wr == 1) PG8_BAR; }
    }
    PG8_WAIT_V(0);
    if constexpr (!ALIGN_EPI) { if (wr == 0) PG8_BAR; }
    PG8_BAR;
    if constexpr (Epi::AFTER_DRAIN) { E.fused(acc, cur, wr, wc, fr, fq, lds, wid, lane); S.done(cur); }
#undef PG8_SA
#undef PG8_SB
#undef PG8_STAGE
#undef PG8_LDA
#undef PG8_LDB
#undef PG8_MMA
#undef PG8_WAIT_V
#undef PG8_WAIT_L
#undef PG8_BAR
#undef PG8_SCHED
}
}

#undef EPI_ROWS_BEGIN
#undef EPI_ROWS_END

constexpr int D = 2048, NB = 8, SEQ = 2048, CL = 256, ML = NB * SEQ, MC = NB * CL, MT = ML + MC;
constexpr int FF = 5632, NMOD = 9, DEPTH = 2;
constexpr int NIN_SRC = 17568;
constexpr int ZA_W = 1536, ZR_W = 3840, ZG_W = 6144, GT_W = 6144, NMIX = ZA_W + ZR_W + ZG_W  , NIN = NMIX + GT_W  ;
constexpr int RW_COLS = 3712, LA_W = 768;
constexpr float LN_EPS = 1e-5f, ALPHA = 1.41421356237f;
constexpr int NWAVES = 8, NTHR = 512;

constexpr size_t MiB = 1u << 20;
constexpr size_t WS_CTL = 0, CTL_ZERO_BYTES = 1 * MiB;
constexpr size_t WS_MODS = 1 * MiB;
constexpr size_t WS_XC = 4 * MiB;
constexpr size_t WS_HB = 20 * MiB;
constexpr size_t WS_WM = 92 * MiB;
constexpr size_t WM_IN = 0, WM_BA = 69 * MiB, WM_BR = 73 * MiB, WM_BG = 77 * MiB, WM_OUT = 85 * MiB, WM_LW = 93 * MiB, WM_LA = 94 * MiB, WM_LG = 95 * MiB;
constexpr size_t WS_R = 188 * MiB;
constexpr size_t R_WGU = 0, R_WDN = 44 * MiB, R_H = 66 * MiB;
constexpr size_t R_ZA = 0;
constexpr size_t R_ORW = 54 * MiB;
constexpr size_t R_OGL = 90 * MiB;
constexpr size_t R_ZR = 162 * MiB;
constexpr size_t R_AA = 297 * MiB;
constexpr size_t R_Y = 369 * MiB;
constexpr size_t R_G = 513 * MiB;
constexpr size_t R_ZG = 549 * MiB;
constexpr size_t R_YG = 765 * MiB;
constexpr size_t R_QR = 909 * MiB;
constexpr size_t R_KR = 941 * MiB;
constexpr size_t R_LA = 949 * MiB;
constexpr size_t R_WDEC = 976 * MiB;
constexpr size_t R_GL = 1120 * MiB;
constexpr size_t R_GT = R_QR;
constexpr size_t R_MT = R_ZR;
constexpr size_t R_MG = R_Y;
constexpr size_t R_END = 1192 * MiB;
constexpr size_t WS_END = WS_R + R_END;
static_assert(R_GT + (size_t)MT * GT_W * 2 <= R_END, "GT overlay");
static_assert(WS_END <= (size_t)1408 * MiB, "workspace budget");
static_assert(R_H + (size_t)MT * FF * 2 <= R_END, "H fits");

#define XB_TMO      128
#define XB_XCNT(j)  (256  + 64 * (j))
#define XB_XSUB(j)  (1280 + 64 * (j))
#define XB_XGEN(j)  (2304 + 64 * (j))
#define XB_TOP      3328
#define XB_TOPGEN   3392
#define XCD_BAR_WORDS 3456
#define XB_SPIN_CAP (1u << 18)
__device__ __forceinline__ unsigned xb_ld(unsigned* p)              { return __hip_atomic_load(p, __ATOMIC_RELAXED, __HIP_MEMORY_SCOPE_AGENT); }
__device__ __forceinline__ unsigned xb_add(unsigned* p, unsigned v) { return __hip_atomic_fetch_add(p, v, __ATOMIC_RELAXED, __HIP_MEMORY_SCOPE_AGENT); }
__device__ __forceinline__ unsigned xb_xcc_id() { return (unsigned)__builtin_amdgcn_s_getreg((3 << 11) | 20) & 0xFu; }
#define XB_SPIN(cond, bar) do { unsigned _sp = 0; while (cond) { __builtin_amdgcn_s_sleep(1); \
    if ((++_sp & 255u) == 0u) { if (xb_ld(&(bar)[XB_TMO])) break; if (_sp > XB_SPIN_CAP) { atomicAdd(&(bar)[XB_TMO], 1u); break; } } } } while (0)
struct XcdBarrier { unsigned* bar; unsigned x; volatile LAS unsigned* st; };
__device__ __forceinline__ XcdBarrier xcd_barrier_post(unsigned* bar, volatile LAS unsigned* st) {
    XcdBarrier b; b.bar = bar; b.x = xb_xcc_id(); b.st = st;
    if (threadIdx.x == 0) (void)xb_add(&bar[XB_XCNT(b.x)], 1u);
    return b;
}
__device__ __forceinline__ void xcd_barrier_complete(unsigned* bar, unsigned x, unsigned& nloc, unsigned& nx) {
    const unsigned G = gridDim.x * gridDim.y * gridDim.z;
    unsigned sum, cnt, mine, sp = 0u;
    for (;;) {
        sum = 0u; cnt = 0u; mine = 0u;
#pragma unroll
        for (unsigned j = 0; j < 16; ++j) { const unsigned c = xb_ld(&bar[XB_XCNT(j)]); sum += c; cnt += (c > 0u) ? 1u : 0u; mine = (j == x) ? c : mine; }
        if (sum == G) break;
        __builtin_amdgcn_s_sleep(1);
        if ((++sp & 255u) == 0u) { if (xb_ld(&bar[XB_TMO])) break; if (sp > XB_SPIN_CAP) { atomicAdd(&bar[XB_TMO], 1u); break; } }
    }
    nloc = mine > 0u ? mine : 1u; nx = cnt > 0u ? cnt : 1u;
}
__device__ __forceinline__ void xcd_barrier(const XcdBarrier& b) {
    asm volatile("s_waitcnt vmcnt(0)" ::: "memory");
    __syncthreads();
    if (threadIdx.x == 0) {
        unsigned* bar = b.bar;
        __builtin_amdgcn_s_waitcnt(0);
        unsigned nloc = b.st[0], nx = b.st[1];
        if (nloc == 0u) { xcd_barrier_complete(bar, b.x, nloc, nx); b.st[0] = nloc; b.st[1] = nx; }
        const unsigned old = xb_add(&bar[XB_XSUB(b.x)], 1u);
        const unsigned gen = old / nloc;
        if (old + 1u == (gen + 1u) * nloc) {
            __builtin_amdgcn_fence(__ATOMIC_RELEASE, "agent");
            asm volatile("s_waitcnt vmcnt(0)" ::: "memory");
            const unsigned og = xb_add(&bar[XB_TOP], 1u);
            const unsigned tg = og / nx;
            if (og + 1u == (tg + 1u) * nx) xb_add(&bar[XB_TOPGEN], 1u);
            else XB_SPIN(xb_ld(&bar[XB_TOPGEN]) == tg, bar);
            __builtin_amdgcn_fence(__ATOMIC_ACQUIRE, "agent");
            xb_add(&bar[XB_XGEN(b.x)], 1u);
            asm volatile("s_waitcnt vmcnt(0)" ::: "memory");
        } else {
            XB_SPIN(xb_ld(&bar[XB_XGEN(b.x)]) == gen, bar);
            __builtin_amdgcn_fence(__ATOMIC_ACQUIRE, "agent");
            asm volatile("s_waitcnt vmcnt(0)" ::: "memory");
        }
    }
    __syncthreads();
}

constexpr int RING_BYTES = 131072;
constexpr int LDSCTL_OFF = RING_BYTES, MISC_OFF = LDSCTL_OFF + 320;
constexpr int LDS_BYTES = 147456;

struct Args { const float* in[30]; float* out; unsigned char* ws; int ph_lo, ph_hi; };

struct Frame {
    LAS unsigned char* lds;
    int tid, lane, wave, G, bid;
    const float* const* in;
    float* out; unsigned char* ws;
};
#define WSP(T, off) ((T*)(F.ws + (off)))
#define RGN(T, off) ((T*)(F.ws + WS_R + (off)))
__device__ __forceinline__ float* xrow(const Frame& F, int m) { return m < ML ? F.out + (size_t)m * D : WSP(float, WS_XC) + (size_t)(m - ML) * D; }

__device__ __forceinline__ void tr_item(const float* W, int N, bf16* WT, int ldk, int k0, int scol0, int drow0, LAS float* scr, int lane) {
    if (scol0 >= 0) {
#pragma unroll 8
        for (int i = 0; i < 32; ++i) { const int kk = 2 * i + (lane >> 5); scr[kk * 33 + (lane & 31)] = W[(size_t)(k0 + kk) * N + scol0 + (lane & 31)]; }
    } else {
#pragma unroll 8
        for (int i = 0; i < 32; ++i) { const int kk = 2 * i + (lane >> 5); scr[kk * 33 + (lane & 31)] = 0.f; }
    }
    asm volatile("s_waitcnt vmcnt(0) lgkmcnt(0)" ::: "memory");
    const int c = lane & 7;
#pragma unroll
    for (int j = 0; j < 4; ++j) { const int n = (lane >> 3) + 8 * j; const LAS float* s = scr + (8 * c) * 33 + n;
        v4u o; o.x = pk2(s[0 * 33], s[1 * 33]); o.y = pk2(s[2 * 33], s[3 * 33]); o.z = pk2(s[4 * 33], s[5 * 33]); o.w = pk2(s[6 * 33], s[7 * 33]);
        *(v4u*)(WT + (size_t)(drow0 + n) * ldk + k0 + 8 * c) = o; }
    asm volatile("s_waitcnt lgkmcnt(0)" ::: "memory");
}
struct MapIdent { __device__ __forceinline__ int operator()(int drow) const { return drow; } };
struct MapGU { __device__ __forceinline__ int operator()(int drow) const { const int pn = drow >> 8, bj = (drow >> 7) & 1, i = drow & 127; return bj * FF + pn * 128 + i; } };
struct MapWin { __device__ __forceinline__ int operator()(int drow) const {
    if (drow < 5248) return drow;
    if (drow < 5280) return 11392 + (drow - 5248);
    if (drow < 5376) return -1;
    if (drow < 11520) return 5248 + (drow - 5376);
    return 11424 + (drow - 11520);
} };
template <class MAP> __device__ __forceinline__ void conv_matrix(const Frame& F, const float* W, int K, int N, bf16* WT, int NT, const MAP& mp, int& item0, int gw, int NGW) {
    LAS float* scr = (LAS float*)(F.lds + F.wave * 16384);
    const int nblk = NT / 32, nitems = (K / 64) * nblk;
    int first = ((gw - item0) % NGW + NGW) % NGW;
    for (int it = first; it < nitems; it += NGW) { const int kb = it / nblk, nb = it % nblk; tr_item(W, N, WT, K, kb * 64, mp(nb * 32), nb * 32, scr, F.lane); }
    item0 += nitems;
}

__device__ __forceinline__ int seq_row(int b, int dir, int p, int& idx, int& len) {
    if (p < CL) { idx = dir ? (CL - 1 - p) : p; len = CL; return ML + b * CL + idx; }
    const int q = p - CL; idx = dir ? (SEQ - 1 - q) : q; len = SEQ; return b * SEQ + idx;
}

__device__ __forceinline__ void phase_init(const Frame& F, const Args& A) {
    {
        const size_t n4 = (size_t)ML * D / 4; const f32x4* s = (const f32x4*)A.in[0]; f32x4* d = (f32x4*)F.out;
        for (size_t i = (size_t)F.bid * NTHR + F.tid; i < n4; i += (size_t)F.G * NTHR) d[i] = s[i];
        const size_t m4 = (size_t)MC * D / 4; const f32x4* s2 = (const f32x4*)A.in[2]; f32x4* d2 = WSP(f32x4, WS_XC);
        for (size_t i = (size_t)F.bid * NTHR + F.tid; i < m4; i += (size_t)F.G * NTHR) d2[i] = s2[i];
    }
    const float* c = A.in[1]; const float* cctx = A.in[3]; const float* ada_w = A.in[4]; const float* ada_b = A.in[5];
    float* mods = WSP(float, WS_MODS);
    LAS float* sc = (LAS float*)F.lds;
    LAS float* red = sc + 9 * 2048;
    for (int i = F.tid; i < 9 * 2048; i += NTHR) { const int bs = i >> 11, k = i & 2047; const float v = bs < 8 ? c[bs * 2048 + k] : cctx[k]; sc[i] = fsilu(v); }
    __syncthreads();
    for (int item = F.bid; item < 2 * 144; item += F.G) {
        const int l = item / 144, cb = item % 144, col = cb * 128 + 2 * F.lane;
        float a0[9], a1[9];
#pragma unroll
        for (int bs = 0; bs < 9; ++bs) { a0[bs] = 0.f; a1[bs] = 0.f; }
        const float* wp = ada_w + ((size_t)l * 2048 + F.wave * 256) * 18432 + col;
        const LAS float* sp = sc + F.wave * 256;
#pragma unroll 8
        for (int k = 0; k < 256; ++k) { const f32x2 w = *(const f32x2*)(wp + (size_t)k * 18432);
#pragma unroll
            for (int bs = 0; bs < 9; ++bs) { const float s = sp[bs * 2048 + k]; a0[bs] += s * w.x; a1[bs] += s * w.y; } }
#pragma unroll
        for (int bs = 0; bs < 9; ++bs) { red[(F.wave * 9 + bs) * 128 + 2 * F.lane] = a0[bs]; red[(F.wave * 9 + bs) * 128 + 2 * F.lane + 1] = a1[bs]; }
        __syncthreads();
        for (int o = F.tid; o < 9 * 128; o += NTHR) { const int bs = o >> 7, cc = o & 127; float s = ada_b[l * 18432 + cb * 128 + cc];
#pragma unroll
            for (int w = 0; w < 8; ++w) s += red[(w * 9 + bs) * 128 + cc];
            mods[((size_t)l * 9 + bs) * 18432 + cb * 128 + cc] = s; }
        __syncthreads();
    }
}

template <bool POST, bool MODH>
__device__ __forceinline__ void phase_ln(const Frame& F, int nrows, const float* g, const float* b, const float* mods_l, int kshift, int kscale) {
    const int gw = F.bid * NWAVES + F.wave, NGW = F.G * NWAVES;
    bf16* HB = WSP(bf16, WS_HB);
    for (int m = gw; m < nrows; m += NGW) {
        float* xr = xrow(F, m);
        f32x4 v[8];
#pragma unroll
        for (int j = 0; j < 8; ++j) v[j] = ((const f32x4*)xr)[F.lane + 64 * j];
        if (POST) {
            float s = 0.f;
#pragma unroll
            for (int j = 0; j < 8; ++j) s += (v[j].x + v[j].y) + (v[j].z + v[j].w);
            const float mean = wave_sum(s) * (1.f / D); float s2 = 0.f;
#pragma unroll
            for (int j = 0; j < 8; ++j) { v[j] = v[j] - mean; s2 += (v[j].x * v[j].x + v[j].y * v[j].y) + (v[j].z * v[j].z + v[j].w * v[j].w); }
            const float rstd = 1.f / sqrtf(wave_sum(s2) * (1.f / D) + LN_EPS);
#pragma unroll
            for (int j = 0; j < 8; ++j) { const f32x4 gg = ((const f32x4*)g)[F.lane + 64 * j], bb = ((const f32x4*)b)[F.lane + 64 * j]; v[j] = v[j] * rstd * gg + bb; ((f32x4*)xr)[F.lane + 64 * j] = v[j]; }
        }
        if (MODH) {
            float s = 0.f;
#pragma unroll
            for (int j = 0; j < 8; ++j) s += (v[j].x + v[j].y) + (v[j].z + v[j].w);
            const float mean = wave_sum(s) * (1.f / D); float s2 = 0.f;
#pragma unroll
            for (int j = 0; j < 8; ++j) { v[j] = v[j] - mean; s2 += (v[j].x * v[j].x + v[j].y * v[j].y) + (v[j].z * v[j].z + v[j].w * v[j].w); }
            const float rstd = 1.f / sqrtf(wave_sum(s2) * (1.f / D) + LN_EPS);
            const int bsel = m < ML ? (m >> 11) : 8;
            const f32x4* shp = (const f32x4*)(mods_l + (size_t)bsel * 18432 + kshift * 2048);
            const f32x4* scp = (const f32x4*)(mods_l + (size_t)bsel * 18432 + kscale * 2048);
            v2u* hp = (v2u*)(HB + (size_t)m * D);
#pragma unroll
            for (int j = 0; j < 8; ++j) { const f32x4 sh = shp[F.lane + 64 * j], scl = scp[F.lane + 64 * j]; const f32x4 o = v[j] * rstd * (scl + 1.0f) + sh;
                v2u w; w.x = pk2(o.x, o.y); w.y = pk2(o.z, o.w); hp[F.lane + 64 * j] = w; }
        }
    }
}

__device__ __forceinline__ void phase_convert(const Frame& F, const Args& A, int l, int ffn_i, int which) {
    const int gw = F.bid * NWAVES + F.wave, NGW = F.G * NWAVES; int item0 = 0;
    if (which & 1) {
        conv_matrix(F, A.in[8] + ((size_t)l * 2 + ffn_i) * D * (2 * FF), D, 2 * FF, RGN(bf16, R_WGU), 2 * FF, MapGU(), item0, gw, NGW);
        conv_matrix(F, A.in[9] + ((size_t)l * 2 + ffn_i) * FF * D, FF, D, RGN(bf16, R_WDN), D, MapIdent(), item0, gw, NGW);
    }
    if (which & 2) {
        conv_matrix(F, A.in[10] + (size_t)l * D * NIN_SRC, D, NIN_SRC, WSP(bf16, WS_WM + WM_IN), NIN, MapWin(), item0, gw, NGW);
        conv_matrix(F, A.in[26] + (size_t)l * 1024 * D, 1024, D, WSP(bf16, WS_WM + WM_BA), D, MapIdent(), item0, gw, NGW);
        conv_matrix(F, A.in[27] + (size_t)l * 1024 * D, 1024, D, WSP(bf16, WS_WM + WM_BR), D, MapIdent(), item0, gw, NGW);
        conv_matrix(F, A.in[28] + (size_t)l * D * D, D, D, WSP(bf16, WS_WM + WM_BG), D, MapIdent(), item0, gw, NGW);
        conv_matrix(F, A.in[29] + (size_t)l * D * D, D, D, WSP(bf16, WS_WM + WM_OUT), D, MapIdent(), item0, gw, NGW);
        const float* w2 = A.in[14] + (size_t)l * 2 * 96 * 1024; const float* a2 = A.in[16] + (size_t)l * 2 * 96 * 1024; const float* g2 = A.in[17] + (size_t)l * 256 * 1024;
        bf16* LW = WSP(bf16, WS_WM + WM_LW); bf16* LAw = WSP(bf16, WS_WM + WM_LA); bf16* LG = WSP(bf16, WS_WM + WM_LG);
        for (int e = F.bid * NTHR + F.tid; e < 2048 * 256; e += F.G * NTHR) { const int n = e >> 8, k = e & 255, dir = n >> 10, cc = n & 1023;
            const int kk = k - dir * 96; const bool liv = kk >= 0 && kk < 96;
            LW[e] = liv ? (bf16)f2bf(w2[((size_t)dir * 96 + kk) * 1024 + cc]) : (bf16)0;
            LAw[e] = liv ? (bf16)f2bf(a2[((size_t)dir * 96 + kk) * 1024 + cc]) : (bf16)0;
            if (n < 1024) LG[e] = (bf16)f2bf(g2[(size_t)k * 1024 + n]); }
    }
    __syncthreads();
}

__device__ __forceinline__ void phase_prep(const Frame& F, const Args& A, int l) {
    const int gw = F.bid * NWAVES + F.wave, NGW = F.G * NWAVES, lane = F.lane;
    const bf16* ZA = RGN(bf16, R_ZA); bf16* QR = RGN(bf16, R_QR); bf16* KR = RGN(bf16, R_KR);
    const bf16* ZR = RGN(bf16, R_ZR); bf16* LA = RGN(bf16, R_LA); unsigned* GL = RGN(unsigned, R_GL);
    {
        const int axis = lane >> 5, f = lane & 31;
        const float invf = exp2f(-(float)f * (13.287712379549449f / 32.0f));
        for (int m = gw; m < ML; m += NGW) {
            const int t = m & (SEQ - 1);
            const float pos = axis == 0 ? (float)(t >> 6) : (float)(t & 63);
            const float ang = pos * invf; const float sn = __sinf(ang), cs = __cosf(ang);
            const bf16* zr = ZA + (size_t)m * ZA_W;
#pragma unroll
            for (int hh = 0; hh < 10; ++hh) {
                const int cb = hh * 128 + axis * 64 + f;
                const float x1 = bf2f(zr[cb]), x2 = bf2f(zr[cb + 32]);
                const float o1 = x1 * cs - x2 * sn, o2 = x2 * cs + x1 * sn;
                if (hh < 8) { QR[(size_t)m * 1024 + cb] = (bf16)f2bf(o1); QR[(size_t)m * 1024 + cb + 32] = (bf16)f2bf(o2); }
                else { KR[(size_t)m * 256 + cb - 1024] = (bf16)f2bf(o1); KR[(size_t)m * 256 + cb - 1024 + 32] = (bf16)f2bf(o2); }
            }
        }
    }
    {
        const float* cw = A.in[12] + (size_t)l * 3 * RW_COLS;
        for (int m = gw; m < MT; m += NGW) {
            int idx, len; if (m < ML) { idx = m & (SEQ - 1); len = SEQ; } else { idx = (m - ML) & (CL - 1); len = CL; }
            const bool hasL = idx > 0, hasR = idx < len - 1;
            const bf16* z0 = ZR + (size_t)m * ZR_W;
#pragma unroll
            for (int jj0 = 0; jj0 < LA_W; jj0 += 64) {
                const int j = jj0 + lane; const int sec = j >> 8, jj = j & 255;
                float o = 0.f;
                if (sec == 2 || jj < 192) {
                    const int scol = (sec == 0 ? 3072 : sec == 1 ? 3264 : 3456) + jj;
                    float zc = bf2f(z0[scol]) * cw[RW_COLS + scol];
                    if (hasL) zc += bf2f(z0[scol - ZR_W]) * cw[scol];
                    if (hasR) zc += bf2f(z0[scol + ZR_W]) * cw[2 * RW_COLS + scol];
                    o = sec == 0 ? ftanh(zc) : (sec == 1 ? zc : fsigmoid(zc));
                }
                LA[(size_t)m * LA_W + j] = (bf16)f2bf(o);
            }
        }
    }
    {
        const float* wa2 = A.in[23] + (size_t)l * 2 * 16 * 1024; const float* ba = A.in[24] + (size_t)l * 2 * 1024;
        for (int item = F.bid; item < 2 * (MT / 16); item += F.G) {
            const int dir = item / (MT / 16), m0 = (item % (MT / 16)) * 16, c0 = 2 * F.tid;
            float w0[16], w1[16];
#pragma unroll
            for (int r = 0; r < 16; ++r) { const f32x2 w = *(const f32x2*)(wa2 + ((size_t)dir * 16 + r) * 1024 + c0); w0[r] = w.x; w1[r] = w.y; }
            const f32x2 bb = *(const f32x2*)(ba + dir * 1024 + c0);
            for (int rr = 0; rr < 16; ++rr) {
                const int m = m0 + rr; const bf16* ac = ZR + (size_t)m * ZR_W + 3712 + dir * 16;
                float s0 = bb.x, s1 = bb.y;
#pragma unroll
                for (int r = 0; r < 16; ++r) { const float a = bf2f(ac[r]); s0 += a * w0[r]; s1 += a * w1[r]; }
                const float la0 = -fsoftplus(-s0) * 0.0625f, la1 = -fsoftplus(-s1) * 0.0625f;
                GL[(((size_t)dir * MT + m) * 1024 + c0) >> 1] = pk2(la0, la1);
            }
        }
    }
}

__device__ __forceinline__ float dpp_f(float v, const int ctrl_sel) {
    const int x = __builtin_bit_cast(int, v); int r;
    if (ctrl_sel == 0) r = __builtin_amdgcn_update_dpp(0, x, 0xB1, 0xF, 0xF, false);
    else if (ctrl_sel == 1) r = __builtin_amdgcn_update_dpp(0, x, 0x4E, 0xF, 0xF, false);
    else if (ctrl_sel == 2) r = __builtin_amdgcn_update_dpp(0, x, 0x141, 0xF, 0xF, false);
    else r = __builtin_amdgcn_update_dpp(0, x, 0x140, 0xF, 0xF, false);
    return __builtin_bit_cast(float, r);
}
__device__ __forceinline__ float red16(float v) { v += dpp_f(v, 0); v += dpp_f(v, 1); v += dpp_f(v, 2); v += dpp_f(v, 3); return v; }
__device__ __forceinline__ float red4(float v) { v += dpp_f(v, 0); v += dpp_f(v, 1); return v; }

__device__ __forceinline__ void rwkv_scan_item(const Frame& F, const Args& A, int l, int item, bool last) {
    const int b = item >> 5, h = (item >> 1) & 15, dir = item & 1, lane = F.lane;
    LAS float* V6 = (LAS float*)F.lds;
    LAS float* SC = V6 + 64 * 384;
    LAS float* YB = SC + 128;
    const bf16* ZR = RGN(bf16, R_ZR); const float* WDEC = RGN(float, R_WDEC); const bf16* AA = RGN(bf16, R_AA); float* Y = RGN(float, R_Y);
    const float* cw = A.in[12] + (size_t)l * 3 * RW_COLS;
    const int ch = h * 64 + lane;
    float cr[3], ck[3], cv[3];
#pragma unroll
    for (int tap = 0; tap < 3; ++tap) { cr[tap] = cw[tap * RW_COLS + ch]; ck[tap] = cw[tap * RW_COLS + 1024 + ch]; cv[tap] = cw[tap * RW_COLS + 2048 + ch]; }
    const float kkw = A.in[18][l * 1024 + ch], kaw = A.in[19][l * 1024 + ch];
    const int jq = lane & 15, si0 = (F.wave * 4 + (lane >> 4)) * 2;
    float s0[4] = {0.f, 0.f, 0.f, 0.f}, s1[4] = {0.f, 0.f, 0.f, 0.f};
    for (int chunk = 0; chunk < 36; ++chunk) {
#pragma unroll 2
        for (int q = 0; q < 8; ++q) {
            const int tt = F.wave * 8 + q; int idx, len; const int m = seq_row(b, dir, chunk * 64 + tt, idx, len);
            const bf16* z = ZR + (size_t)m * ZR_W + ch;
            float r = bf2f(z[0]) * cr[1], k = bf2f(z[1024]) * ck[1], v = bf2f(z[2048]) * cv[1];
            if (idx > 0) { r += bf2f(z[-ZR_W]) * cr[0]; k += bf2f(z[1024 - ZR_W]) * ck[0]; v += bf2f(z[2048 - ZR_W]) * cv[0]; }
            if (idx < len - 1) { r += bf2f(z[ZR_W]) * cr[2]; k += bf2f(z[1024 + ZR_W]) * ck[2]; v += bf2f(z[2048 + ZR_W]) * cv[2]; }
            const float kr = k * kkw; const float nrm = sqrtf(wave_sum(kr * kr)); const float kk = kr / fmaxf(nrm, 1e-12f);
            const float w = WDEC[((size_t)dir * MT + m) * 1024 + ch]; const float a = bf2f(AA[((size_t)dir * MT + m) * 1024 + ch]);
            const float kd = k * (1.f + (a - 1.f) * kaw), kka = kk * a;
            const float c1 = wave_sum(kka * r), c2 = wave_sum(kd * r);
            LAS float* o = V6 + tt * 384 + lane; o[0] = w; o[64] = kd; o[128] = kka; o[192] = -kk; o[256] = w * r; o[320] = v;
            if (lane == 0) { SC[tt * 2] = c1; SC[tt * 2 + 1] = c2; }
        }
        __syncthreads();
#pragma unroll 4
        for (int tt = 0; tt < 64; ++tt) {
            const LAS float* vb = V6 + tt * 384 + jq * 4;
            const f32x4 w4 = *(const LAS f32x4*)(vb), kd4 = *(const LAS f32x4*)(vb + 64), ka4 = *(const LAS f32x4*)(vb + 128), nk4 = *(const LAS f32x4*)(vb + 192), wr4 = *(const LAS f32x4*)(vb + 256);
            const f32x2 vi = *(const LAS f32x2*)(V6 + tt * 384 + 320 + si0); const f32x2 cc = *(const LAS f32x2*)(SC + tt * 2);
            float sa0 = 0.f, yp0 = 0.f, sa1 = 0.f, yp1 = 0.f;
#pragma unroll
            for (int q = 0; q < 4; ++q) { sa0 += s0[q] * nk4[q]; yp0 += s0[q] * wr4[q]; sa1 += s1[q] * nk4[q]; yp1 += s1[q] * wr4[q]; }
            sa0 = red16(sa0); yp0 = red16(yp0); sa1 = red16(sa1); yp1 = red16(yp1);
            const float y0 = yp0 + sa0 * cc.x + vi.x * cc.y, y1 = yp1 + sa1 * cc.x + vi.y * cc.y;
#pragma unroll
            for (int q = 0; q < 4; ++q) { s0[q] = s0[q] * w4[q] + sa0 * ka4[q] + vi.x * kd4[q]; s1[q] = s1[q] * w4[q] + sa1 * ka4[q] + vi.y * kd4[q]; }
            if (jq == 0) { *(LAS f32x2*)(YB + tt * 64 + si0) = (f32x2){y0, y1}; }
        }
        __syncthreads();
        if (!(last && chunk < 4)) {
            for (int e = F.tid; e < 4096; e += NTHR) { const int tt = e >> 6, i = e & 63; int idx, len; const int m = seq_row(b, dir, chunk * 64 + tt, idx, len);
                Y[((size_t)dir * MT + m) * 1024 + h * 64 + i] = YB[e]; }
        }
        __syncthreads();
    }
}

__device__ __forceinline__ void gla_scan_item(const Frame& F, int item, bool last) {
    const int b = item >> 5, h = (item >> 3) & 3, dvs = item & 7;
    LAS float* Aq = (LAS float*)F.lds;
    LAS float* Ak = Aq + 4096; LAS float* Aa = Ak + 4096; LAS float* Av = Aa + 4096  ; LAS float* OP = Av + 1024;
    const bf16* ZG = RGN(bf16, R_ZG); const bf16* GL = RGN(bf16, R_GL); float* YG = RGN(float, R_YG);
    const int dg = F.tid >> 5, ep = F.tid & 31;
    for (int dir = 0; dir < 2; ++dir) {
        float S0[16], S1[16];
#pragma unroll
        for (int i = 0; i < 16; ++i) { S0[i] = 0.f; S1[i] = 0.f; }
        for (int chunk = 0; chunk < 144; ++chunk) {
            for (int e = F.tid; e < 16 * 256; e += NTHR) { const int tt = e >> 8, d = e & 255; int idx, len; const int m = seq_row(b, dir, chunk * 16 + tt, idx, len);
                const bf16* z = ZG + (size_t)m * ZG_W + h * 256 + d;
                Aq[e] = bf2f(z[0]) * 0.0625f; Ak[e] = bf2f(z[1024]); Aa[e] = __expf(bf2f(GL[((size_t)dir * MT + m) * 1024 + h * 256 + d])); }
            for (int e = F.tid; e < 16 * 64; e += NTHR) { const int tt = e >> 6, ee = e & 63; int idx, len; const int m = seq_row(b, dir, chunk * 16 + tt, idx, len);
                Av[e] = bf2f(ZG[(size_t)m * ZG_W + 2048 + h * 512 + dvs * 64 + ee]); }
            __syncthreads();
#pragma unroll 2
            for (int tt = 0; tt < 16; ++tt) {
                const f32x2 v = *(const LAS f32x2*)(Av + tt * 64 + 2 * ep); float o0 = 0.f, o1 = 0.f;
                const LAS float* qa = Aq + tt * 256 + dg * 16; const LAS float* ka = Ak + tt * 256 + dg * 16; const LAS float* aa = Aa + tt * 256 + dg * 16;
#pragma unroll
                for (int i = 0; i < 16; i += 4) { const f32x4 a4 = *(const LAS f32x4*)(aa + i), k4 = *(const LAS f32x4*)(ka + i), q4 = *(const LAS f32x4*)(qa + i);
#pragma unroll
                    for (int j = 0; j < 4; ++j) { S0[i + j] = S0[i + j] * a4[j] + k4[j] * v.x; S1[i + j] = S1[i + j] * a4[j] + k4[j] * v.y; o0 += q4[j] * S0[i + j]; o1 += q4[j] * S1[i + j]; } }
                *(LAS f32x2*)(OP + (tt * 16 + dg) * 64 + 2 * ep) = (f32x2){o0, o1};
            }
            __syncthreads();
            if (!(last && chunk < 16)) {
                for (int e = F.tid; e < 16 * 64; e += NTHR) { const int tt = e >> 6, ee = e & 63; float s = 0.f;
#pragma unroll
                    for (int w = 0; w < 16; ++w) s += OP[(tt * 16 + w) * 64 + ee];
                    int idx, len; const int m = seq_row(b, dir, chunk * 16 + tt, idx, len);
                    float* yp = YG + (size_t)m * 2048 + h * 512 + dvs * 64 + ee; if (dir == 0) *yp = s; else *yp += s; }
            }
            __syncthreads();
        }
    }
}

__device__ __forceinline__ void ld32bf(const bf16* p, float (&d)[32], float sc) {
#pragma unroll
    for (int i = 0; i < 4; ++i) { const v4u w = ((const v4u*)p)[i];
        d[8 * i + 0] = bflo(w.x) * sc; d[8 * i + 1] = bfhi(w.x) * sc; d[8 * i + 2] = bflo(w.y) * sc; d[8 * i + 3] = bfhi(w.y) * sc;
        d[8 * i + 4] = bflo(w.z) * sc; d[8 * i + 5] = bfhi(w.z) * sc; d[8 * i + 6] = bflo(w.w) * sc; d[8 * i + 7] = bfhi(w.w) * sc; }
}
__device__ __forceinline__ float dot32bf(const bf16* p, const float (&q)[32]) {
    float s0 = 0.f, s1 = 0.f;
#pragma unroll
    for (int i = 0; i < 4; ++i) { const v4u w = ((const v4u*)p)[i];
        s0 += q[8 * i + 0] * bflo(w.x); s1 += q[8 * i + 1] * bfhi(w.x); s0 += q[8 * i + 2] * bflo(w.y); s1 += q[8 * i + 3] * bfhi(w.y);
        s0 += q[8 * i + 4] * bflo(w.z); s1 += q[8 * i + 5] * bfhi(w.z); s0 += q[8 * i + 6] * bflo(w.w); s1 += q[8 * i + 7] * bfhi(w.w); }
    return s0 + s1;
}
__device__ __forceinline__ void attn_key(float s, bool valid, const bf16* vp, float& mx, float& lsum, float (&o)[32]) {
    s = red4(s);
    s = valid ? s : -1e30f;
    const float mn = fmaxf(mx, s);
    const float corr = __expf(mx - mn), p = __expf(s - mn);
    lsum = lsum * corr + p; mx = mn;
    if (__builtin_amdgcn_ballot_w64(corr != 1.0f) != 0ull) {
#pragma unroll
        for (int i = 0; i < 32; ++i) o[i] *= corr; }
#pragma unroll
    for (int i = 0; i < 4; ++i) { const v4u w = ((const v4u*)vp)[i];
        o[8 * i + 0] += p * bflo(w.x); o[8 * i + 1] += p * bfhi(w.x); o[8 * i + 2] += p * bflo(w.y); o[8 * i + 3] += p * bfhi(w.y);
        o[8 * i + 4] += p * bflo(w.z); o[8 * i + 5] += p * bfhi(w.z); o[8 * i + 6] += p * bflo(w.w); o[8 * i + 7] += p * bfhi(w.w); }
}
__device__ __forceinline__ void attn_store(bf16* op, const float (&o)[32], float inv) {
#pragma unroll
    for (int i = 0; i < 4; ++i) { v4u w; w.x = pk2(o[8 * i] * inv, o[8 * i + 1] * inv); w.y = pk2(o[8 * i + 2] * inv, o[8 * i + 3] * inv); w.z = pk2(o[8 * i + 4] * inv, o[8 * i + 5] * inv); w.w = pk2(o[8 * i + 6] * inv, o[8 * i + 7] * inv);
        ((v4u*)op)[i] = w; }
}
__device__ __forceinline__ void attn_item(const Frame& F, const Args& A, int l, int item) {
    const int lane = F.lane, qi = lane >> 2, part = lane & 3;
    bf16* ZA = RGN(bf16, R_ZA); const bf16* QR = RGN(bf16, R_QR); const bf16* KR = RGN(bf16, R_KR);
    const float scale = 0.08838834764831845f;
    float o[32];
#pragma unroll
    for (int i = 0; i < 32; ++i) o[i] = 0.f;
    if (item < 8192) {
        const int qb = item & 127, hq = (item >> 7) & 7, b = item >> 10, hk = hq >> 2;
        const int t = qb * 16 + qi, m = b * SEQ + t;
        float mx = A.in[11][l * 8 + hq], lsum = 1.f;
        {
            float qr[32]; ld32bf(QR + (size_t)m * 1024 + hq * 128 + part * 32, qr, scale);
            const int j0 = (qb * 16 - 128) > 0 ? (qb * 16 - 128) : 0, j1 = (qb * 16 + 15 + 128) < (SEQ - 1) ? (qb * 16 + 15 + 128) : (SEQ - 1);
            for (int j = j0; j <= j1; ++j) {
                const float s = dot32bf(KR + (size_t)(b * SEQ + j) * 256 + hk * 128 + part * 32, qr);
                const int dlt = t - j; const bool valid = dlt <= 128 && dlt >= -128;
                attn_key(s, valid, ZA + (size_t)(b * SEQ + j) * ZA_W + 1280 + hk * 128 + part * 32, mx, lsum, o);
            }
        }
        {
            float qp[32]; ld32bf(ZA + (size_t)m * ZA_W + hq * 128 + part * 32, qp, scale);
            for (int c = 0; c < CL; ++c) {
                const bf16* kr = ZA + (size_t)(ML + b * CL + c) * ZA_W + 1024 + hk * 128 + part * 32;
                const float s = dot32bf(kr, qp);
                attn_key(s, true, kr + 256, mx, lsum, o);
            }
        }
        attn_store(ZA + (size_t)m * ZA_W + hq * 128 + part * 32, o, 1.0f / lsum);
    } else {
        const int it = item - 8192; const int qb = it & 15, hq = (it >> 4) & 7, b = it >> 7, hk = hq >> 2;
        const int m = ML + b * CL + qb * 16 + qi;
        float mx = A.in[11][l * 8 + hq], lsum = 1.f;
        float qp[32]; ld32bf(ZA + (size_t)m * ZA_W + hq * 128 + part * 32, qp, scale);
        for (int c = 0; c < CL; ++c) {
            const bf16* kr = ZA + (size_t)(ML + b * CL + c) * ZA_W + 1024 + hk * 128 + part * 32;
            const float s = dot32bf(kr, qp);
            attn_key(s, true, kr + 256, mx, lsum, o);
        }
        attn_store(ZA + (size_t)m * ZA_W + hq * 128 + part * 32, o, 1.0f / lsum);
    }
}

__device__ __forceinline__ void phase_mix(const Frame& F, const Args& A, int l, bool last) {
    for (int item = F.bid; item < 256; item += F.G) rwkv_scan_item(F, A, l, item, last);
    for (int item = F.bid; item < 256; item += F.G) gla_scan_item(F, item, last);
    const int gw = F.bid * NWAVES + F.wave, NGW = F.G * NWAVES;
    const int nitems = last ? 8192 : 8192 + 1024;
    for (int item = gw; item < nitems; item += NGW) attn_item(F, A, l, item);
}

__device__ __forceinline__ void phase_mixout(const Frame& F, const Args& A, int l, int nrows) {
    const int gw = F.bid * NWAVES + F.wave, NGW = F.G * NWAVES, lane = F.lane;
    {
        const bf16* ZR = RGN(bf16, R_ZR); const bf16* AA = RGN(bf16, R_AA); const float* Y = RGN(float, R_Y); const bf16* G = RGN(bf16, R_G); bf16* ORW = RGN(bf16, R_ORW);
        const float* cw = A.in[12] + (size_t)l * 3 * RW_COLS; const float* k_a = A.in[19] + l * 1024; const float* r_k = A.in[20] + l * 1024;
        const float* lnw = A.in[21] + l * 1024; const float* lnb = A.in[22] + l * 1024;
        for (int it = gw; it < nrows * 16; it += NGW) {
            const int m = it >> 4, h = it & 15, ch = h * 64 + lane;
            int idx, len; if (m < ML) { idx = m & (SEQ - 1); len = SEQ; } else { idx = (m - ML) & (CL - 1); len = CL; }
            const float o = Y[(size_t)m * 1024 + ch] + Y[((size_t)MT + m) * 1024 + ch];
            const float mean = wave_sum(o) * (1.f / 64.f); const float dv = o - mean; const float var = wave_sum(dv * dv) * (1.f / 64.f);
            const float on = dv * (1.f / sqrtf(var + 64e-5f)) * lnw[ch] + lnb[ch];
            const bf16* z = ZR + (size_t)m * ZR_W + ch;
            float r = bf2f(z[0]) * cw[RW_COLS + ch], k = bf2f(z[1024]) * cw[RW_COLS + 1024 + ch], v = bf2f(z[2048]) * cw[RW_COLS + 2048 + ch];
            if (idx > 0) { r += bf2f(z[-ZR_W]) * cw[ch]; k += bf2f(z[1024 - ZR_W]) * cw[1024 + ch]; v += bf2f(z[2048 - ZR_W]) * cw[2048 + ch]; }
            if (idx < len - 1) { r += bf2f(z[ZR_W]) * cw[2 * RW_COLS + ch]; k += bf2f(z[1024 + ZR_W]) * cw[2 * RW_COLS + 1024 + ch]; v += bf2f(z[2048 + ZR_W]) * cw[2 * RW_COLS + 2048 + ch]; }
            const float a0 = bf2f(AA[(size_t)m * 1024 + ch]), a1 = bf2f(AA[((size_t)MT + m) * 1024 + ch]);
            const float kaw = k_a[ch]; const float kd0 = k * (1.f + (a0 - 1.f) * kaw), kd1 = k * (1.f + (a1 - 1.f) * kaw);
            const float bs = wave_sum(r * (kd0 + kd1) * r_k[ch]);
            const float res = (on + bs * v) * bf2f(G[(size_t)m * 1024 + ch]);
            ORW[(size_t)m * 1024 + ch] = (bf16)f2bf(res);
        }
    }
    {
        const float* YG = RGN(float, R_YG); const bf16* ZG = RGN(bf16, R_ZG); bf16* OGL = RGN(bf16, R_OGL); const float* nw = A.in[25] + l * 512;
        const f32x4 nw0 = *(const f32x4*)(nw + lane * 8), nw1 = *(const f32x4*)(nw + lane * 8 + 4);
        for (int it = gw; it < nrows * 4; it += NGW) {
            const int m = it >> 2, h = it & 3;
            const float* yp = YG + (size_t)m * 2048 + h * 512 + lane * 8;
            f32x4 y0 = *(const f32x4*)yp, y1 = *(const f32x4*)(yp + 4);
            const float ss = wave_sum((y0.x * y0.x + y0.y * y0.y) + (y0.z * y0.z + y0.w * y0.w) + (y1.x * y1.x + y1.y * y1.y) + (y1.z * y1.z + y1.w * y1.w));
            const float rs = 1.f / sqrtf(ss * (1.f / 512.f) + 1e-5f);
            const v4u gw4 = *(const v4u*)(ZG + (size_t)m * ZG_W + 4096 + h * 512 + lane * 8);
            const f32x4 g0 = (f32x4){bflo(gw4.x), bfhi(gw4.x), bflo(gw4.y), bfhi(gw4.y)}, g1 = (f32x4){bflo(gw4.z), bfhi(gw4.z), bflo(gw4.w), bfhi(gw4.w)};
            y0 = y0 * rs * nw0; y1 = y1 * rs * nw1;
            v4u w; w.x = pk2(y0.x * fsilu(g0.x), y0.y * fsilu(g0.y)); w.y = pk2(y0.z * fsilu(g0.z), y0.w * fsilu(g0.w));
            w.z = pk2(y1.x * fsilu(g1.x), y1.y * fsilu(g1.y)); w.w = pk2(y1.z * fsilu(g1.z), y1.w * fsilu(g1.w));
            *(v4u*)(OGL + (size_t)m * 2048 + h * 512 + lane * 8) = w;
        }
    }
}


template <int K> __device__ __forceinline__ void run_phase(const Frame& F, const Args& A, int l) {
    const float* mods = WSP(float, WS_MODS);
    bf16* HB = WSP(bf16, WS_HB);
    const bool last = (l == DEPTH - 1);
    const float* mods_l = mods + (size_t)l * 9 * 18432;
    const float* lng = A.in[6] + (size_t)l * 3 * D; const float* lnb = A.in[7] + (size_t)l * 3 * D;
    const int nrows = last ? ML : MT;
    if constexpr (K == -1) phase_init(F, A);
    if constexpr (K == 0) {
        if (l > 0) phase_ln<true, true>(F, MT, lng - D, lnb - D, mods_l, 0, 1);
        else phase_ln<false, true>(F, MT, nullptr, nullptr, mods_l, 0, 1);
        phase_convert(F, A, l, 0, 3);
    }
    if constexpr (K == 1 || K == 12) { const int M = (K == 1) ? MT : nrows; pg8::Gemm g{HB, RGN(bf16, R_WGU), M, 2 * FF, D, D, D}; pg8::StaticOrder S; S.init(M, 2 * FF, F.G, F.bid);
        pg8::EpiSwiglu E{RGN(bf16, R_H), FF}; pg8::gemm_phase<pg8::EpiSwiglu, pg8::StaticOrder, true, true>(F.lds, g, S, E); }
    if constexpr (K == 2 || K == 13) { const int M = (K == 2) ? MT : nrows; pg8::Gemm g{RGN(bf16, R_H), RGN(bf16, R_WDN), M, D, FF, FF, FF}; pg8::StaticOrder S; S.init(M, D, F.G, F.bid);
        pg8::EpiResid E{F.out, WSP(float, WS_XC), mods_l, (K == 2) ? 2 : 8, ALPHA, 0.5f}; pg8::gemm_phase<pg8::EpiResid, pg8::StaticOrder, true, true>(F.lds, g, S, E); }
    if constexpr (K == 3) phase_ln<true, true>(F, MT, lng, lnb, mods_l, 3, 4);
    if constexpr (K == 4) { pg8::Gemm g{HB, WSP(bf16, WS_WM + WM_IN), MT, NMIX, D, D, D}; pg8::StaticOrder S; S.init(MT, NMIX, F.G, F.bid);
        typedef pg8::EpiBf16Seg<0, WS_R + R_ZA, WS_R + R_ZR, WS_R + R_ZG, 6, 21, ZA_W, ZR_W, ZG_W> EpiWin; EpiWin E{F.ws};
        pg8::gemm_phase<EpiWin, pg8::StaticOrder, true, true>(F.lds, g, S, E); }
    if constexpr (K == 5) phase_prep(F, A, l);
    if constexpr (K == 6) {
        { pg8::Gemm g{RGN(bf16, R_LA), WSP(bf16, WS_WM + WM_LW), MT, 2048, 256, LA_W, 256}; pg8::StaticOrder S; S.init(MT, 2048, F.G, F.bid);
          pg8::EpiLora<0> E{RGN(float, R_WDEC), nullptr, A.in[13] + (size_t)l * 2048, (size_t)MT * 1024}; pg8::gemm_phase<pg8::EpiLora<0>, pg8::StaticOrder, true, true>(F.lds, g, S, E); }
    }
    if constexpr (K == 15) {
        { pg8::Gemm g{RGN(bf16, R_LA) + 256, WSP(bf16, WS_WM + WM_LA), MT, 2048, 256, LA_W, 256}; pg8::StaticOrder S; S.init(MT, 2048, F.G, F.bid);
          pg8::EpiLora<1> E{nullptr, RGN(bf16, R_AA), A.in[15] + (size_t)l * 2048, (size_t)MT * 1024}; pg8::gemm_phase<pg8::EpiLora<1>, pg8::StaticOrder, true, true>(F.lds, g, S, E); }
    }
    if constexpr (K == 16) {
        { pg8::Gemm g{RGN(bf16, R_LA) + 512, WSP(bf16, WS_WM + WM_LG), MT, 1024, 256, LA_W, 256}; pg8::StaticOrder S; S.init(MT, 1024, F.G, F.bid);
          pg8::EpiLora<2> E{nullptr, RGN(bf16, R_G), nullptr, 0}; pg8::gemm_phase<pg8::EpiLora<2>, pg8::StaticOrder, true, true>(F.lds, g, S, E); }
    }
    if constexpr (K == 7) phase_mix(F, A, l, last);
    if constexpr (K == 8) {
        phase_mixout(F, A, l, nrows);
        __syncthreads();
        pg8::Gemm g{HB, WSP(bf16, WS_WM + WM_IN) + (size_t)NMIX * D, nrows, GT_W, D, D, D}; pg8::StaticOrder S; S.init(nrows, GT_W, F.G, F.bid);
        typedef pg8::EpiBf16Seg<1, WS_R + R_GT, WS_R + R_GT, WS_R + R_GT, 1 << 20, 1 << 20, GT_W, GT_W, GT_W> EpiGate; EpiGate E{F.ws};
        pg8::gemm_phase<EpiGate, pg8::StaticOrder, true, true>(F.lds, g, S, E);
    }
    if constexpr (K == 9) {
        { pg8::Gemm g{RGN(bf16, R_ZA), WSP(bf16, WS_WM + WM_BA), nrows, D, 1024, ZA_W, 1024}; pg8::StaticOrder S; S.init(nrows, D, F.G, F.bid);
          pg8::EpiBranch<0> E{RGN(bf16, R_GT), GT_W, 0, RGN(float, R_MT), nullptr}; pg8::gemm_phase<pg8::EpiBranch<0>, pg8::StaticOrder, true, true>(F.lds, g, S, E); }
        { pg8::Gemm g{RGN(bf16, R_ORW), WSP(bf16, WS_WM + WM_BR), nrows, D, 1024, 1024, 1024}; pg8::StaticOrder S; S.init(nrows, D, F.G, F.bid);
          pg8::EpiBranch<1> E{RGN(bf16, R_GT), GT_W, 2048, RGN(float, R_MT), nullptr}; pg8::gemm_phase<pg8::EpiBranch<1>, pg8::StaticOrder, true, true>(F.lds, g, S, E); }
        { pg8::Gemm g{RGN(bf16, R_OGL), WSP(bf16, WS_WM + WM_BG), nrows, D, D, D, D}; pg8::StaticOrder S; S.init(nrows, D, F.G, F.bid);
          pg8::EpiBranch<2> E{RGN(bf16, R_GT), GT_W, 4096, RGN(float, R_MT), RGN(bf16, R_MG)}; pg8::gemm_phase<pg8::EpiBranch<2>, pg8::StaticOrder, true, true>(F.lds, g, S, E); }
    }
    if constexpr (K == 10) { pg8::Gemm g{RGN(bf16, R_MG), WSP(bf16, WS_WM + WM_OUT), nrows, D, D, D, D}; pg8::StaticOrder S; S.init(nrows, D, F.G, F.bid);
        pg8::EpiResid E{F.out, WSP(float, WS_XC), mods_l, 5, ALPHA, 1.0f}; pg8::gemm_phase<pg8::EpiResid, pg8::StaticOrder, true, true>(F.lds, g, S, E); }
    if constexpr (K == 11) { phase_ln<true, true>(F, nrows, lng + D, lnb + D, mods_l, 6, 7); phase_convert(F, A, l, 1, 1); }
    if constexpr (K == 14) phase_ln<true, false>(F, ML, lng + 2 * D, lnb + 2 * D, nullptr, 0, 0);
}

__device__ __forceinline__ void frame_init(Frame& F, const Args& A, unsigned char* lds_raw) {
    F.lds = (LAS unsigned char*)lds_raw;
    F.tid = threadIdx.x; F.lane = F.tid & 63; F.wave = __builtin_amdgcn_readfirstlane(F.tid >> 6);
    F.G = gridDim.x; F.bid = blockIdx.x; F.out = A.out; F.ws = A.ws;
}

template <int K> __global__ void __launch_bounds__(NTHR, 2) fwd_phase(Args A) {
    extern __shared__ __attribute__((aligned(16))) unsigned char lds_raw[];
    Frame F; frame_init(F, A, lds_raw);
    run_phase<K>(F, A, A.ph_lo);
}

template <int K> static void launch_phase(const Args& a, int l, int grid, hipStream_t stream) {
    static bool attr_done = false;
    if (!attr_done) { (void)hipFuncSetAttribute((const void*)fwd_phase<K>, hipFuncAttributeMaxDynamicSharedMemorySize, LDS_BYTES); attr_done = true; }
    Args b = a; b.ph_lo = l; b.ph_hi = 0;
    hipLaunchKernelGGL(fwd_phase<K>, dim3(grid), dim3(NTHR), LDS_BYTES, stream, b);
}

extern "C" void kernel_launch(void* const* d_in, const int* in_sizes, int n_in, void* d_out, int out_size, void* d_ws, size_t ws_size, hipStream_t stream) {
    static int grid = 0;
    if (grid == 0) {
        if (n_in != 30 || out_size != ML * D || ws_size < WS_END) { fprintf(stderr, "kernel_launch: unexpected shapes (n_in %d, out %d, ws %zu < %zu)\n", n_in, out_size, ws_size, (size_t)WS_END); grid = -1; return; }
        int dev = 0, cus = 0;
        if (hipGetDevice(&dev) != hipSuccess || hipDeviceGetAttribute(&cus, hipDeviceAttributeMultiprocessorCount, dev) != hipSuccess) { grid = -1; return; }
        grid = cus;
    }
    if (grid < 0) return;
    (void)hipMemsetAsync((char*)d_ws + WS_CTL, 0, CTL_ZERO_BYTES, stream);
    Args a{};
    for (int i = 0; i < 30; ++i) a.in[i] = (const float*)d_in[i];
    a.out = (float*)d_out; a.ws = (unsigned char*)d_ws;
    launch_phase<-1>(a, 0, grid, stream);
    for (int l = 0; l < DEPTH; ++l) {
        launch_phase<0>(a, l, grid, stream); launch_phase<1>(a, l, grid, stream); launch_phase<2>(a, l, grid, stream); launch_phase<3>(a, l, grid, stream);
        launch_phase<4>(a, l, grid, stream); launch_phase<5>(a, l, grid, stream); launch_phase<6>(a, l, grid, stream); launch_phase<15>(a, l, grid, stream); launch_phase<16>(a, l, grid, stream); launch_phase<7>(a, l, grid, stream);
        launch_phase<8>(a, l, grid, stream); launch_phase<9>(a, l, grid, stream); launch_phase<10>(a, l, grid, stream); launch_phase<11>(a, l, grid, stream);
        launch_phase<12>(a, l, grid, stream); launch_phase<13>(a, l, grid, stream);
    }
    launch_phase<14>(a, DEPTH - 1, grid, stream);
}
```

```cpp
#include <hip/hip_runtime.h>
#include <cstdio>
#include <cstdint>

#define GAS __attribute__((address_space(1)))
#define LAS __attribute__((address_space(3)))
typedef unsigned short bf16;
typedef unsigned v4u __attribute__((ext_vector_type(4)));
typedef unsigned v2u __attribute__((ext_vector_type(2)));
typedef float f32x4 __attribute__((ext_vector_type(4)));
typedef float f32x2 __attribute__((ext_vector_type(2)));
typedef short bf16x8 __attribute__((ext_vector_type(8)));

__device__ __forceinline__ float bf2f(unsigned short b) { return __builtin_bit_cast(float, ((unsigned)b) << 16); }
__device__ __forceinline__ float bflo(unsigned w) { return __builtin_bit_cast(float, w << 16); }
__device__ __forceinline__ float bfhi(unsigned w) { return __builtin_bit_cast(float, w & 0xffff0000u); }
__device__ __forceinline__ unsigned f2bf(float f) { unsigned u = __builtin_bit_cast(unsigned, f); return (u + 0x7fffu + ((u >> 16) & 1u)) >> 16; }
__device__ __forceinline__ unsigned pk2(float lo, float hi) { return f2bf(lo) | (f2bf(hi) << 16); }
__device__ __forceinline__ float wave_sum(float v) {
#pragma unroll
    for (int o = 1; o < 64; o <<= 1) v += __shfl_xor(v, o);
    return v;
}
__device__ __forceinline__ float fsigmoid(float x) { return 1.0f / (1.0f + __expf(-x)); }
__device__ __forceinline__ float fsilu(float x) { return x / (1.0f + __expf(-x)); }
__device__ __forceinline__ float fsoftplus(float x) { return fmaxf(x, 0.f) + __logf(1.0f + __expf(-fabsf(x))); }
__device__ __forceinline__ float ftanh(float x) { const float e = __expf(-2.0f * fabsf(x)); const float t = (1.0f - e) / (1.0f + e); return x < 0.f ? -t : t; }

namespace pg8 {
#define PG8_LAS __attribute__((address_space(3)))
typedef unsigned short bf16_t;
typedef short bf16x8 __attribute__((ext_vector_type(8)));
typedef float f32x4 __attribute__((ext_vector_type(4)));
typedef unsigned u32x4 __attribute__((ext_vector_type(4)));
constexpr int BM = 256, BK = 64, HALF = 128, HTB = HALF * BK * 2  , STAGE_BYTES = 8 * HTB, NXCD = 8, WGM = 8;

__host__ __device__ __forceinline__ int lds_byte(int r, int c) { const int st = (r >> 4) * 2 + (c >> 5), rr = r & 15, cc = c & 31, ob = rr * 64 + cc * 2; return st * 1024 + (ob ^ (((ob >> 9) & 1) << 5)); }
__host__ __device__ __forceinline__ void stage_rc(int b, int& R, int& C) { const int st = b / 1024, sb = b % 1024, swz = sb ^ (((sb >> 9) & 1) << 5); R = (st >> 1) * 16 + swz / 64; C = (st & 1) * 32 + (swz % 64) / 2; }
__host__ __device__ __forceinline__ int perm32(int rho) { const int n = rho >> 4, i = rho & 15; return 8 * (i >> 2) + 4 * n + (i & 3); }

struct Unit { int pm, pn; };
struct Gemm { const bf16_t* A; const bf16_t* Bt; int M, N, K, lda, ldb; };

struct StaticOrder {
    int nM, nN, nwg, G, c;
    __host__ __device__ void init(int M, int N, int G_, int c_) { nM = M / BM; nN = N / BM; nwg = nM * nN; G = G_; c = c_; }
    __host__ __device__ bool next(int i, Unit& u) const {
        const long L = (long)i * G + c; if (L >= nwg) return false;
        int wgid = (int)L; { const int q = nwg / NXCD, r = nwg % NXCD, xcd = wgid % NXCD, off = wgid / NXCD; wgid = (xcd < r ? xcd * (q + 1) : r * (q + 1) + (xcd - r) * q) + off; }
        const int nig = WGM * nN, gid = wgid / nig, fm = gid * WGM, gsz = (nM - fm) < WGM ? (nM - fm) : WGM;
        u.pm = fm + ((wgid % nig) % gsz); u.pn = (wgid % nig) / gsz; return true;
    }
    __device__ __forceinline__ void a_ready(const Unit&) const {}
    __device__ __forceinline__ void done(const Unit&) const {}
};

__device__ __forceinline__ unsigned cvt_pk_bf16(float lo, float hi) { unsigned r; asm volatile("v_cvt_pk_bf16_f32 %0, %1, %2" : "=v"(r) : "v"(lo), "v"(hi)); return r; }

#define EPI_ROWS_BEGIN \
    _Pragma("unroll") for (int ai = 0; ai < 2; ++ai) _Pragma("unroll") for (int m = 0; m < 4; ++m) { const int row = u.pm * BM + ai * HALF + wr * 64 + m * 16 + fr;
#define EPI_ROWS_END }

template <int ACT, size_t O0, size_t O1, size_t O2, int T1, int T2, int L0, int L1, int L2> struct EpiBf16Seg {
    static constexpr bool PERM = true, AFTER_DRAIN = false;
    unsigned char* ws;
    __device__ __forceinline__ void operator()(const f32x4 (&acc)[2][2][4][2], const Unit& u, int wr, int wc, int fr, int fq) const {
        const size_t off = u.pn >= T2 ? O2 : (u.pn >= T1 ? O1 : O0); const int l = u.pn >= T2 ? L2 : (u.pn >= T1 ? L1 : L0), tb = u.pn >= T2 ? T2 : (u.pn >= T1 ? T1 : 0);
        bf16_t* base = (bf16_t*)(ws + off);
        const int col0 = (u.pn - tb) * BM + wc * 32 + 8 * fq;
        EPI_ROWS_BEGIN
            bf16_t* rowp = base + (size_t)row * l + col0;
#pragma unroll
            for (int bj = 0; bj < 2; ++bj) { f32x4 v0 = acc[ai][bj][m][0], v1 = acc[ai][bj][m][1];
                if (ACT == 1) {
#pragma unroll
                    for (int j = 0; j < 4; ++j) { v0[j] = fsigmoid(v0[j]); v1[j] = fsigmoid(v1[j]); } }
                u32x4 w; w.x = cvt_pk_bf16(v0[0], v0[1]); w.y = cvt_pk_bf16(v0[2], v0[3]); w.z = cvt_pk_bf16(v1[0], v1[1]); w.w = cvt_pk_bf16(v1[2], v1[3]);
                *(u32x4*)(rowp + bj * HALF) = w; }
        EPI_ROWS_END
    }
};
struct EpiSwiglu {
    static constexpr bool PERM = true, AFTER_DRAIN = false;
    bf16_t* H; int ldh;
    __device__ __forceinline__ void operator()(const f32x4 (&acc)[2][2][4][2], const Unit& u, int wr, int wc, int fr, int fq) const {
        const int col0 = u.pn * HALF + wc * 32 + 8 * fq;
        EPI_ROWS_BEGIN
            f32x4 g0 = acc[ai][0][m][0], g1 = acc[ai][0][m][1]; const f32x4 u0 = acc[ai][1][m][0], u1 = acc[ai][1][m][1];
#pragma unroll
            for (int j = 0; j < 4; ++j) { g0[j] = fsilu(g0[j]) * u0[j]; g1[j] = fsilu(g1[j]) * u1[j]; }
            u32x4 w; w.x = cvt_pk_bf16(g0[0], g0[1]); w.y = cvt_pk_bf16(g0[2], g0[3]); w.z = cvt_pk_bf16(g1[0], g1[1]); w.w = cvt_pk_bf16(g1[2], g1[3]);
            *(u32x4*)(H + (size_t)row * ldh + col0) = w;
        EPI_ROWS_END
    }
};
struct EpiResid {
    static constexpr bool PERM = true, AFTER_DRAIN = false;
    float* xl; float* xc; const float* mods; int kmod; float alpha, coef;
    __device__ __forceinline__ void operator()(const f32x4 (&acc)[2][2][4][2], const Unit& u, int wr, int wc, int fr, int fq) const {
        const int bsel = u.pm < 64 ? (u.pm >> 3) : 8;
        const float* mp = mods + (size_t)bsel * (9 * 2048) + kmod * 2048;
        float* xb = u.pm < 64 ? xl : xc - (size_t)16384 * 2048;
        const int col0 = u.pn * BM + wc * 32 + 8 * fq;
        f32x4 mv[2][2];
#pragma unroll
        for (int bj = 0; bj < 2; ++bj)
#pragma unroll
            for (int n = 0; n < 2; ++n) mv[bj][n] = *(const f32x4*)(mp + col0 + bj * HALF + 4 * n) * coef;
        EPI_ROWS_BEGIN
            float* rowp = xb + (size_t)row * 2048 + col0;
#pragma unroll
            for (int bj = 0; bj < 2; ++bj)
#pragma unroll
                for (int n = 0; n < 2; ++n) { f32x4* p = (f32x4*)(rowp + bj * HALF + 4 * n); const f32x4 x = *p; *p = x * alpha + mv[bj][n] * acc[ai][bj][m][n]; }
            asm volatile("" ::: "memory");
        EPI_ROWS_END
    }
};
template <int MODE> struct EpiBranch {
    static constexpr bool PERM = true, AFTER_DRAIN = false;
    const bf16_t* GT; int ldg, goff; float* T; bf16_t* O;
    __device__ __forceinline__ void operator()(const f32x4 (&acc)[2][2][4][2], const Unit& u, int wr, int wc, int fr, int fq) const {
        const int col0 = u.pn * BM + wc * 32 + 8 * fq;
        EPI_ROWS_BEGIN
#pragma unroll
            for (int bj = 0; bj < 2; ++bj) {
                const u32x4 gw = *(const u32x4*)(GT + (size_t)row * ldg + goff + col0 + bj * HALF);
                f32x4 g0 = (f32x4){bflo(gw.x), bfhi(gw.x), bflo(gw.y), bfhi(gw.y)}, g1 = (f32x4){bflo(gw.z), bfhi(gw.z), bflo(gw.w), bfhi(gw.w)};
                f32x4 v0 = g0 * acc[ai][bj][m][0], v1 = g1 * acc[ai][bj][m][1];
                float* tp = T + (size_t)row * 2048 + col0 + bj * HALF;
                if (MODE >= 1) { v0 += *(const f32x4*)tp; v1 += *(const f32x4*)(tp + 4); }
                if (MODE <= 1) { *(f32x4*)tp = v0; *(f32x4*)(tp + 4) = v1; }
                else { u32x4 w; w.x = cvt_pk_bf16(v0[0], v0[1]); w.y = cvt_pk_bf16(v0[2], v0[3]); w.z = cvt_pk_bf16(v1[0], v1[1]); w.w = cvt_pk_bf16(v1[2], v1[3]);
                    *(u32x4*)(O + (size_t)row * 2048 + col0 + bj * HALF) = w; }
            }
            asm volatile("" ::: "memory");
        EPI_ROWS_END
    }
};
template <int MODE> struct EpiLora {
    static constexpr bool PERM = true, AFTER_DRAIN = false;
    float* WD; bf16_t* OB; const float* bias; size_t dstride;
    __device__ __forceinline__ void operator()(const f32x4 (&acc)[2][2][4][2], const Unit& u, int wr, int wc, int fr, int fq) const {
        const int colg = u.pn * BM + wc * 32 + 8 * fq;
        EPI_ROWS_BEGIN
#pragma unroll
            for (int bj = 0; bj < 2; ++bj) { const int cg = colg + bj * HALF; const int dir = (MODE == 2) ? 0 : (cg >> 10); const int c = (MODE == 2) ? cg : (cg & 1023);
                f32x4 v0 = acc[ai][bj][m][0], v1 = acc[ai][bj][m][1];
                if (MODE != 2) { v0 += *(const f32x4*)(bias + cg); v1 += *(const f32x4*)(bias + cg + 4); }
                if (MODE == 0) {
#pragma unroll
                    for (int j = 0; j < 4; ++j) { v0[j] = __expf(-__expf(-fsoftplus(-v0[j]) - 0.5f)); v1[j] = __expf(-__expf(-fsoftplus(-v1[j]) - 0.5f)); }
                    float* p = WD + (size_t)dir * dstride + (size_t)row * 1024 + c; *(f32x4*)p = v0; *(f32x4*)(p + 4) = v1;
                } else {
                    if (MODE == 1) {
#pragma unroll
                        for (int j = 0; j < 4; ++j) { v0[j] = fsigmoid(v0[j]); v1[j] = fsigmoid(v1[j]); } }
                    u32x4 w; w.x = cvt_pk_bf16(v0[0], v0[1]); w.y = cvt_pk_bf16(v0[2], v0[3]); w.z = cvt_pk_bf16(v1[0], v1[1]); w.w = cvt_pk_bf16(v1[2], v1[3]);
                    *(u32x4*)(OB + (size_t)dir * dstride + (size_t)row * 1024 + c) = w;
                }
            }
            asm volatile("" ::: "memory");
        EPI_ROWS_END
    }
};

template <class Epi, class Sched, bool ALIGN_EPI = false, bool SP2 = false>
__device__ __forceinline__ void gemm_phase(PG8_LAS unsigned char* lds, const Gemm g, const Sched& S, const Epi& E) {
    int tid_ = threadIdx.x; asm volatile("" : "+v"(tid_));
    const int tid = tid_, wid = __builtin_amdgcn_readfirstlane(tid >> 6), lane = tid & 63, wr = wid >> 2, wc = wid & 3, fr = lane & 15, fq = lane >> 4;
    int K_ = g.K, lda_ = g.lda, ldb_ = g.ldb; asm volatile("" : "+s"(K_), "+s"(lda_), "+s"(ldb_));
    const int K = K_, nt = K / BK, lda = lda_, ldb = ldb_;
    unsigned voffA[2], voffB[2];
#pragma unroll
    for (int i = 0; i < 2; ++i) { int R, C; stage_rc(tid * 16 + i * 8192, R, C); const int Rb = Epi::PERM ? ((R & ~31) + perm32(R & 31)) : R;
        voffA[i] = (unsigned)(R * lda + C) * 2u; voffB[i] = (unsigned)(Rb * ldb + C) * 2u; }
    const size_t kstep = (size_t)(BK * 2);
    const size_t hsA = (size_t)HALF * lda * 2, hsB = (size_t)HALF * ldb * 2;
    const size_t tsA = 2 * hsA, tsB = 2 * hsB;
    const unsigned ldsw = (unsigned)wid * 1024u;
    const int aoff = lds_byte(wr * 64 + fr, fq * 8), boff = lds_byte(wc * 32 + fr, fq * 8);
#define PG8_SA(b, h) (((b) * 2 + (h)) * HTB)
#define PG8_SB(b, h) ((4 + (b) * 2 + (h)) * HTB)
#define PG8_STAGE(bufoff, gbase, voff) do { _Pragma("unroll") for (int _i = 0; _i < 2; ++_i) \
        __builtin_amdgcn_global_load_lds((const unsigned*)((const char*)(gbase) + (voff)[_i]), (PG8_LAS unsigned*)(lds + (bufoff) + ldsw + _i * 8192), 16, 0, 0); } while (0)
#define PG8_LDA(dst, b, h) do { _Pragma("unroll") for (int m = 0; m < 4; ++m) _Pragma("unroll") for (int k = 0; k < 2; ++k) dst[m][k] = *(const PG8_LAS bf16x8*)(lds + PG8_SA(b, h) + aoff + m * 2048 + k * 1024); } while (0)
#define PG8_LDB(dst, b, h) do { _Pragma("unroll") for (int n = 0; n < 2; ++n) _Pragma("unroll") for (int k = 0; k < 2; ++k) dst[n][k] = *(const PG8_LAS bf16x8*)(lds + PG8_SB(b, h) + boff + n * 2048 + k * 1024); } while (0)
#define PG8_MMA(ai, bj, At, Bt) do { __builtin_amdgcn_s_setprio(1); _Pragma("unroll") for (int m = 0; m < 4; ++m) _Pragma("unroll") for (int n = 0; n < 2; ++n) _Pragma("unroll") for (int k = 0; k < 2; ++k) \
        acc[ai][bj][m][n] = __builtin_amdgcn_mfma_f32_16x16x32_bf16(Bt[n][k], At[m][k], acc[ai][bj][m][n], 0, 0, 0); __builtin_amdgcn_s_setprio(0); } while (0)
#define PG8_WAIT_V(n) asm volatile("s_waitcnt vmcnt(" #n ")" ::: "memory")
#define PG8_WAIT_L(n) asm volatile("s_waitcnt lgkmcnt(" #n ")" ::: "memory")
#define PG8_BAR __builtin_amdgcn_s_barrier()
#define PG8_SCHED __builtin_amdgcn_sched_barrier(0)
    Unit cur, nxt; int ui = 0;
    if (!S.next(0, cur)) return;
    f32x4 acc[2][2][4][2];
#pragma unroll
    for (int a = 0; a < 2; ++a)
#pragma unroll
        for (int b = 0; b < 2; ++b)
#pragma unroll
            for (int m = 0; m < 4; ++m)
#pragma unroll
                for (int n = 0; n < 2; ++n) acc[a][b][m][n] = (f32x4){0.f, 0.f, 0.f, 0.f};
    bf16x8 At[4][2], B0[2][2], B1[2][2];
    const char* cA = (const char*)g.A + (size_t)cur.pm * tsA; const char* cB = (const char*)g.Bt + (size_t)cur.pn * tsB;
    S.a_ready(cur);
    if constexpr (SP2) {
        PG8_STAGE(PG8_SB(0, 0), cB, voffB); PG8_STAGE(PG8_SB(0, 1), cB + hsB, voffB); PG8_STAGE(PG8_SA(0, 0), cA, voffA); PG8_STAGE(PG8_SA(0, 1), cA + hsA, voffA);
        if (wr == 1) PG8_BAR;
        PG8_WAIT_V(2); PG8_BAR;
        PG8_STAGE(PG8_SB(1, 0), cB + kstep, voffB); PG8_STAGE(PG8_SA(1, 0), cA + kstep, voffA); PG8_STAGE(PG8_SB(1, 1), cB + hsB + kstep, voffB);
        PG8_WAIT_V(6); PG8_BAR;
    } else {
        PG8_STAGE(PG8_SB(0, 0), cB, voffB); PG8_STAGE(PG8_SA(0, 0), cA, voffA); PG8_STAGE(PG8_SB(0, 1), cB + hsB, voffB); PG8_STAGE(PG8_SA(0, 1), cA + hsA, voffA);
        if (wr == 1) PG8_BAR;
        PG8_WAIT_V(4); PG8_BAR;
        PG8_STAGE(PG8_SB(1, 0), cB + kstep, voffB); PG8_STAGE(PG8_SA(1, 0), cA + kstep, voffA); PG8_STAGE(PG8_SB(1, 1), cB + hsB + kstep, voffB);
        PG8_WAIT_V(6); PG8_BAR;
    }
    for (;;) {
        const bool has_next = S.next(ui + 1, nxt);
        const char* nA = has_next ? (const char*)g.A + (size_t)nxt.pm * tsA : cA; const char* nB = has_next ? (const char*)g.Bt + (size_t)nxt.pn * tsB : cB;
        for (int t = 0; t < nt; t += 2) {
            const bool last = (t == nt - 2);
            const char* a1 = cA + (size_t)(t + 1) * kstep;
            const char* a2 = last ? nA : cA + (size_t)(t + 2) * kstep; const char* b2 = last ? nB : cB + (size_t)(t + 2) * kstep;
            const char* a3 = a2 + kstep; const char* b3 = b2 + kstep;
            if (last && has_next) S.a_ready(nxt);
            if constexpr (SP2) {
            PG8_LDB(B0, 0, 0); PG8_LDB(B1, 0, 1); PG8_SCHED; PG8_LDA(At, 0, 0); PG8_STAGE(PG8_SA(1, 1), a1 + hsA, voffA);
            PG8_WAIT_V(8); PG8_WAIT_L(0); PG8_BAR; PG8_MMA(0, 0, At, B0); PG8_MMA(0, 1, At, B1); PG8_BAR; PG8_SCHED;
            PG8_LDA(At, 0, 1); PG8_STAGE(PG8_SB(0, 0), b2, voffB); PG8_STAGE(PG8_SB(0, 1), b2 + hsB, voffB); PG8_STAGE(PG8_SA(0, 0), a2, voffA);
            PG8_WAIT_V(8); PG8_WAIT_L(0); PG8_BAR; PG8_MMA(1, 0, At, B0); PG8_MMA(1, 1, At, B1); PG8_BAR; PG8_SCHED;
            PG8_LDB(B0, 1, 0); PG8_LDB(B1, 1, 1); PG8_SCHED; PG8_LDA(At, 1, 0); PG8_STAGE(PG8_SA(0, 1), a2 + hsA, voffA);
            PG8_WAIT_V(8); PG8_WAIT_L(0); PG8_BAR; PG8_MMA(0, 0, At, B0); PG8_MMA(0, 1, At, B1); PG8_BAR; PG8_SCHED;
            PG8_LDA(At, 1, 1); PG8_STAGE(PG8_SB(1, 0), b3, voffB); PG8_STAGE(PG8_SB(1, 1), b3 + hsB, voffB); PG8_STAGE(PG8_SA(1, 0), a3, voffA);
            PG8_WAIT_V(8); PG8_WAIT_L(0); PG8_BAR; PG8_MMA(1, 0, At, B0); PG8_MMA(1, 1, At, B1); PG8_BAR; PG8_SCHED;
            } else {
            PG8_LDB(B0, 0, 0); PG8_SCHED; PG8_LDA(At, 0, 0); PG8_STAGE(PG8_SA(1, 1), a1 + hsA, voffA);
            PG8_WAIT_L(8); PG8_BAR; PG8_WAIT_L(0); PG8_MMA(0, 0, At, B0); PG8_BAR; PG8_SCHED;
            PG8_LDB(B1, 0, 1); PG8_STAGE(PG8_SB(0, 0), b2, voffB);
            PG8_BAR; PG8_WAIT_L(0); PG8_MMA(0, 1, At, B1); PG8_BAR;
            PG8_LDA(At, 0, 1); PG8_STAGE(PG8_SA(0, 0), a2, voffA);
            PG8_BAR; PG8_WAIT_L(0); PG8_MMA(1, 0, At, B0); PG8_BAR; PG8_SCHED;
            PG8_STAGE(PG8_SB(0, 1), b2 + hsB, voffB);
            PG8_WAIT_V(6); PG8_BAR; PG8_MMA(1, 1, At, B1); PG8_BAR;
            PG8_LDB(B0, 1, 0); PG8_SCHED; PG8_LDA(At, 1, 0); PG8_STAGE(PG8_SA(0, 1), a2 + hsA, voffA);
            PG8_WAIT_L(8); PG8_BAR; PG8_WAIT_L(0); PG8_MMA(0, 0, At, B0); PG8_BAR; PG8_SCHED;
            PG8_LDB(B1, 1, 1); PG8_STAGE(PG8_SB(1, 0), b3, voffB);
            PG8_BAR; PG8_WAIT_L(0); PG8_MMA(0, 1, At, B1); PG8_BAR;
            PG8_LDA(At, 1, 1); PG8_STAGE(PG8_SA(1, 0), a3, voffA);
            PG8_BAR; PG8_WAIT_L(0); PG8_MMA(1, 0, At, B0); PG8_BAR; PG8_SCHED;
            PG8_STAGE(PG8_SB(1, 1), b3 + hsB, voffB);
            PG8_WAIT_V(6); PG8_BAR; PG8_MMA(1, 1, At, B1); PG8_BAR;
            }
        }
        if constexpr (ALIGN_EPI) { if (wr == 0) PG8_BAR; }
        if constexpr (!Epi::AFTER_DRAIN) { E(acc, cur, wr, wc, fr, fq); S.done(cur); }
        if (!has_next) break;
#pragma unroll
        for (int a = 0; a < 2; ++a)
#pragma unroll
            for (int b = 0; b < 2; ++b)
#pragma unroll
                for (int m = 0; m < 4; ++m)
#pragma unroll
                    for (int n = 0; n < 2; ++n) acc[a][b][m][n] = (f32x4){0.f, 0.f, 0.f, 0.f};
        cur = nxt; cA = nA; cB = nB; ++ui;
        if constexpr (ALIGN_EPI) { if (wr == 1) PG8_BAR; }
    }
    PG8_WAIT_V(0);
    if constexpr (!ALIGN_EPI) { if (wr == 0) PG8_BAR; }
    PG8_BAR;
    if constexpr (Epi::AFTER_DRAIN) { E.fused(acc, cur, wr, wc, fr, fq, lds, wid, lane); S.done(cur); }
#undef PG8_SA
#undef PG8_SB
#undef PG8_STAGE
#undef PG8_LDA
#undef PG8_LDB
#undef PG8_MMA
#undef PG8_WAIT_V
#undef PG8_WAIT_L
#undef PG8_BAR
#undef PG8_SCHED
}
}

#undef EPI_ROWS_BEGIN
#undef EPI_ROWS_END

constexpr int D = 2048, NB = 8, SEQ = 2048, CL = 256, ML = NB * SEQ, MC = NB * CL, MT = ML + MC;
constexpr int FF = 5632, NMOD = 9, DEPTH = 2;
constexpr int NIN_SRC = 17568;
constexpr int ZA_W = 1536, ZR_W = 3840, ZG_W = 6144, GT_W = 6144, NMIX = ZA_W + ZR_W + ZG_W  , NIN = NMIX + GT_W  ;
constexpr int RW_COLS = 3712, LA_W = 768;
constexpr float LN_EPS = 1e-5f, ALPHA = 1.41421356237f;
constexpr int NWAVES = 8, NTHR = 512;

constexpr size_t MiB = 1u << 20;
constexpr size_t WS_CTL = 0, CTL_ZERO_BYTES = 1 * MiB;
constexpr size_t WS_MODS = 1 * MiB;
constexpr size_t WS_XC = 4 * MiB;
constexpr size_t WS_HB = 20 * MiB;
constexpr size_t WS_WM = 92 * MiB;
constexpr size_t WM_IN = 0, WM_BA = 69 * MiB, WM_BR = 73 * MiB, WM_BG = 77 * MiB, WM_OUT = 85 * MiB, WM_LW = 93 * MiB, WM_LA = 94 * MiB, WM_LG = 95 * MiB;
constexpr size_t WS_R = 188 * MiB;
constexpr size_t R_WGU = 0, R_WDN = 44 * MiB, R_H = 66 * MiB;
constexpr size_t R_ZA = 0;
constexpr size_t R_ORW = 54 * MiB;
constexpr size_t R_OGL = 90 * MiB;
constexpr size_t R_ZR = 162 * MiB;
constexpr size_t R_AA = 297 * MiB;
constexpr size_t R_Y = 369 * MiB;
constexpr size_t R_G = 513 * MiB;
constexpr size_t R_ZG = 549 * MiB;
constexpr size_t R_YG = 765 * MiB;
constexpr size_t R_QR = 909 * MiB;
constexpr size_t R_KR = 941 * MiB;
constexpr size_t R_LA = 949 * MiB;
constexpr size_t R_WDEC = 976 * MiB;
constexpr size_t R_GL = 1120 * MiB;
constexpr size_t R_GT = R_QR;
constexpr size_t R_MT = R_ZR;
constexpr size_t R_MG = R_Y;
constexpr size_t R_END = 1192 * MiB;
constexpr size_t WS_END = WS_R + R_END;
static_assert(R_GT + (size_t)MT * GT_W * 2 <= R_END, "GT overlay");
static_assert(WS_END <= (size_t)1408 * MiB, "workspace budget");
static_assert(R_H + (size_t)MT * FF * 2 <= R_END, "H fits");

#define XB_TMO      128
#define XB_XCNT(j)  (256  + 64 * (j))
#define XB_XSUB(j)  (1280 + 64 * (j))
#define XB_XGEN(j)  (2304 + 64 * (j))
#define XB_TOP      3328
#define XB_TOPGEN   3392
#define XCD_BAR_WORDS 3456
#define XB_SPIN_CAP (1u << 18)
__device__ __forceinline__ unsigned xb_ld(unsigned* p)              { return __hip_atomic_load(p, __ATOMIC_RELAXED, __HIP_MEMORY_SCOPE_AGENT); }
__device__ __forceinline__ unsigned xb_add(unsigned* p, unsigned v) { return __hip_atomic_fetch_add(p, v, __ATOMIC_RELAXED, __HIP_MEMORY_SCOPE_AGENT); }
__device__ __forceinline__ unsigned xb_xcc_id() { return (unsigned)__builtin_amdgcn_s_getreg((3 << 11) | 20) & 0xFu; }
#define XB_SPIN(cond, bar) do { unsigned _sp = 0; while (cond) { __builtin_amdgcn_s_sleep(1); \
    if ((++_sp & 255u) == 0u) { if (xb_ld(&(bar)[XB_TMO])) break; if (_sp > XB_SPIN_CAP) { atomicAdd(&(bar)[XB_TMO], 1u); break; } } } } while (0)
struct XcdBarrier { unsigned* bar; unsigned x; volatile LAS unsigned* st; };
__device__ __forceinline__ XcdBarrier xcd_barrier_post(unsigned* bar, volatile LAS unsigned* st) {
    XcdBarrier b; b.bar = bar; b.x = xb_xcc_id(); b.st = st;
    if (threadIdx.x == 0) (void)xb_add(&bar[XB_XCNT(b.x)], 1u);
    return b;
}
__device__ __forceinline__ void xcd_barrier_complete(unsigned* bar, unsigned x, unsigned& nloc, unsigned& nx) {
    const unsigned G = gridDim.x * gridDim.y * gridDim.z;
    unsigned sum, cnt, mine, sp = 0u;
    for (;;) {
        sum = 0u; cnt = 0u; mine = 0u;
#pragma unroll
        for (unsigned j = 0; j < 16; ++j) { const unsigned c = xb_ld(&bar[XB_XCNT(j)]); sum += c; cnt += (c > 0u) ? 1u : 0u; mine = (j == x) ? c : mine; }
        if (sum == G) break;
        __builtin_amdgcn_s_sleep(1);
        if ((++sp & 255u) == 0u) { if (xb_ld(&bar[XB_TMO])) break; if (sp > XB_SPIN_CAP) { atomicAdd(&bar[XB_TMO], 1u); break; } }
    }
    nloc = mine > 0u ? mine : 1u; nx = cnt > 0u ? cnt : 1u;
}
__device__ __forceinline__ void xcd_barrier(const XcdBarrier& b) {
    asm volatile("s_waitcnt vmcnt(0)" ::: "memory");
    __syncthreads();
    if (threadIdx.x == 0) {
        unsigned* bar = b.bar;
        __builtin_amdgcn_s_waitcnt(0);
        unsigned nloc = b.st[0], nx = b.st[1];
        if (nloc == 0u) { xcd_barrier_complete(bar, b.x, nloc, nx); b.st[0] = nloc; b.st[1] = nx; }
        const unsigned old = xb_add(&bar[XB_XSUB(b.x)], 1u);
        const unsigned gen = old / nloc;
        if (old + 1u == (gen + 1u) * nloc) {
            __builtin_amdgcn_fence(__ATOMIC_RELEASE, "agent");
            asm volatile("s_waitcnt vmcnt(0)" ::: "memory");
            const unsigned og = xb_add(&bar[XB_TOP], 1u);
            const unsigned tg = og / nx;
            if (og + 1u == (tg + 1u) * nx) xb_add(&bar[XB_TOPGEN], 1u);
            else XB_SPIN(xb_ld(&bar[XB_TOPGEN]) == tg, bar);
            __builtin_amdgcn_fence(__ATOMIC_ACQUIRE, "agent");
            xb_add(&bar[XB_XGEN(b.x)], 1u);
            asm volatile("s_waitcnt vmcnt(0)" ::: "memory");
        } else {
            XB_SPIN(xb_ld(&bar[XB_XGEN(b.x)]) == gen, bar);
            __builtin_amdgcn_fence(__ATOMIC_ACQUIRE, "agent");
            asm volatile("s_waitcnt vmcnt(0)" ::: "memory");
        }
    }
    __syncthreads();
}

constexpr int RING_BYTES = 131072;
constexpr int LDSCTL_OFF = RING_BYTES, MISC_OFF = LDSCTL_OFF + 320;
constexpr int LDS_BYTES = 147456;

struct Args { const float* in[30]; float* out; unsigned char* ws; int ph_lo, ph_hi; };
#define CAS __attribute__((address_space(4)))
typedef const CAS Args& ArgsRef;

struct Frame {
    LAS unsigned char* lds;
    int tid, lane, wave, G, bid;
    const float* const* in;
    float* out; unsigned char* ws;
};
#define WSP(T, off) ((T*)(F.ws + (off)))
#define RGN(T, off) ((T*)(F.ws + WS_R + (off)))
__device__ __forceinline__ float* xrow(const Frame& F, int m) { return m < ML ? F.out + (size_t)m * D : WSP(float, WS_XC) + (size_t)(m - ML) * D; }

__device__ __forceinline__ void tr_item(const float* W, int N, bf16* WT, int ldk, int k0, int scol0, int drow0, LAS float* scr, int lane) {
    if (scol0 >= 0) {
#pragma unroll 8
        for (int i = 0; i < 32; ++i) { const int kk = 2 * i + (lane >> 5); scr[kk * 33 + (lane & 31)] = W[(size_t)(k0 + kk) * N + scol0 + (lane & 31)]; }
    } else {
#pragma unroll 8
        for (int i = 0; i < 32; ++i) { const int kk = 2 * i + (lane >> 5); scr[kk * 33 + (lane & 31)] = 0.f; }
    }
    asm volatile("s_waitcnt vmcnt(0) lgkmcnt(0)" ::: "memory");
    const int c = lane & 7;
#pragma unroll
    for (int j = 0; j < 4; ++j) { const int n = (lane >> 3) + 8 * j; const LAS float* s = scr + (8 * c) * 33 + n;
        v4u o; o.x = pk2(s[0 * 33], s[1 * 33]); o.y = pk2(s[2 * 33], s[3 * 33]); o.z = pk2(s[4 * 33], s[5 * 33]); o.w = pk2(s[6 * 33], s[7 * 33]);
        *(v4u*)(WT + (size_t)(drow0 + n) * ldk + k0 + 8 * c) = o; }
    asm volatile("s_waitcnt lgkmcnt(0)" ::: "memory");
}
struct MapIdent { __device__ __forceinline__ int operator()(int drow) const { return drow; } };
struct MapGU { __device__ __forceinline__ int operator()(int drow) const { const int pn = drow >> 8, bj = (drow >> 7) & 1, i = drow & 127; return bj * FF + pn * 128 + i; } };
struct MapWin { __device__ __forceinline__ int operator()(int drow) const {
    if (drow < 5248) return drow;
    if (drow < 5280) return 11392 + (drow - 5248);
    if (drow < 5376) return -1;
    if (drow < 11520) return 5248 + (drow - 5376);
    return 11424 + (drow - 11520);
} };
template <class MAP> __device__ __forceinline__ void conv_matrix(const Frame& F, const float* W, int K, int N, bf16* WT, int NT, const MAP& mp, int& item0, int gw, int NGW) {
    LAS float* scr = (LAS float*)(F.lds + F.wave * 16384);
    const int nblk = NT / 32, nitems = (K / 64) * nblk;
    int first = ((gw - item0) % NGW + NGW) % NGW;
    for (int it = first; it < nitems; it += NGW) { const int kb = it / nblk, nb = it % nblk; tr_item(W, N, WT, K, kb * 64, mp(nb * 32), nb * 32, scr, F.lane); }
    item0 += nitems;
}

__device__ __forceinline__ int seq_row(int b, int dir, int p, int& idx, int& len) {
    if (p < CL) { idx = dir ? (CL - 1 - p) : p; len = CL; return ML + b * CL + idx; }
    const int q = p - CL; idx = dir ? (SEQ - 1 - q) : q; len = SEQ; return b * SEQ + idx;
}

__device__ __forceinline__ void phase_init(const Frame& F, ArgsRef A) {
    {
        const size_t n4 = (size_t)ML * D / 4; const f32x4* s = (const f32x4*)A.in[0]; f32x4* d = (f32x4*)F.out;
        for (size_t i = (size_t)F.bid * NTHR + F.tid; i < n4; i += (size_t)F.G * NTHR) d[i] = s[i];
        const size_t m4 = (size_t)MC * D / 4; const f32x4* s2 = (const f32x4*)A.in[2]; f32x4* d2 = WSP(f32x4, WS_XC);
        for (size_t i = (size_t)F.bid * NTHR + F.tid; i < m4; i += (size_t)F.G * NTHR) d2[i] = s2[i];
    }
    const float* c = A.in[1]; const float* cctx = A.in[3]; const float* ada_w = A.in[4]; const float* ada_b = A.in[5];
    float* mods = WSP(float, WS_MODS);
    LAS float* sc = (LAS float*)F.lds;
    LAS float* red = sc + 9 * 2048;
    for (int i = F.tid; i < 9 * 2048; i += NTHR) { const int bs = i >> 11, k = i & 2047; const float v = bs < 8 ? c[bs * 2048 + k] : cctx[k]; sc[i] = fsilu(v); }
    __syncthreads();
    for (int item = F.bid; item < 2 * 144; item += F.G) {
        const int l = item / 144, cb = item % 144, col = cb * 128 + 2 * F.lane;
        float a0[9], a1[9];
#pragma unroll
        for (int bs = 0; bs < 9; ++bs) { a0[bs] = 0.f; a1[bs] = 0.f; }
        const float* wp = ada_w + ((size_t)l * 2048 + F.wave * 256) * 18432 + col;
        const LAS float* sp = sc + F.wave * 256;
#pragma unroll 8
        for (int k = 0; k < 256; ++k) { const f32x2 w = *(const f32x2*)(wp + (size_t)k * 18432);
#pragma unroll
            for (int bs = 0; bs < 9; ++bs) { const float s = sp[bs * 2048 + k]; a0[bs] += s * w.x; a1[bs] += s * w.y; } }
#pragma unroll
        for (int bs = 0; bs < 9; ++bs) { red[(F.wave * 9 + bs) * 128 + 2 * F.lane] = a0[bs]; red[(F.wave * 9 + bs) * 128 + 2 * F.lane + 1] = a1[bs]; }
        __syncthreads();
        for (int o = F.tid; o < 9 * 128; o += NTHR) { const int bs = o >> 7, cc = o & 127; float s = ada_b[l * 18432 + cb * 128 + cc];
#pragma unroll
            for (int w = 0; w < 8; ++w) s += red[(w * 9 + bs) * 128 + cc];
            mods[((size_t)l * 9 + bs) * 18432 + cb * 128 + cc] = s; }
        __syncthreads();
    }
}

template <bool POST, bool MODH>
__device__ __forceinline__ void phase_ln(const Frame& F, int nrows, const float* g, const float* b, const float* mods_l, int kshift, int kscale) {
    const int gw = F.bid * NWAVES + F.wave, NGW = F.G * NWAVES;
    bf16* HB = WSP(bf16, WS_HB);
    for (int m = gw; m < nrows; m += NGW) {
        float* xr = xrow(F, m);
        f32x4 v[8];
#pragma unroll
        for (int j = 0; j < 8; ++j) v[j] = ((const f32x4*)xr)[F.lane + 64 * j];
        if (POST) {
            float s = 0.f;
#pragma unroll
            for (int j = 0; j < 8; ++j) s += (v[j].x + v[j].y) + (v[j].z + v[j].w);
            const float mean = wave_sum(s) * (1.f / D); float s2 = 0.f;
#pragma unroll
            for (int j = 0; j < 8; ++j) { v[j] = v[j] - mean; s2 += (v[j].x * v[j].x + v[j].y * v[j].y) + (v[j].z * v[j].z + v[j].w * v[j].w); }
            const float rstd = 1.f / sqrtf(wave_sum(s2) * (1.f / D) + LN_EPS);
#pragma unroll
            for (int j = 0; j < 8; ++j) { const f32x4 gg = ((const f32x4*)g)[F.lane + 64 * j], bb = ((const f32x4*)b)[F.lane + 64 * j]; v[j] = v[j] * rstd * gg + bb; ((f32x4*)xr)[F.lane + 64 * j] = v[j]; }
        }
        if (MODH) {
            float s = 0.f;
#pragma unroll
            for (int j = 0; j < 8; ++j) s += (v[j].x + v[j].y) + (v[j].z + v[j].w);
            const float mean = wave_sum(s) * (1.f / D); float s2 = 0.f;
#pragma unroll
            for (int j = 0; j < 8; ++j) { v[j] = v[j] - mean; s2 += (v[j].x * v[j].x + v[j].y * v[j].y) + (v[j].z * v[j].z + v[j].w * v[j].w); }
            const float rstd = 1.f / sqrtf(wave_sum(s2) * (1.f / D) + LN_EPS);
            const int bsel = m < ML ? (m >> 11) : 8;
            const f32x4* shp = (const f32x4*)(mods_l + (size_t)bsel * 18432 + kshift * 2048);
            const f32x4* scp = (const f32x4*)(mods_l + (size_t)bsel * 18432 + kscale * 2048);
            v2u* hp = (v2u*)(HB + (size_t)m * D);
#pragma unroll
            for (int j = 0; j < 8; ++j) { const f32x4 sh = shp[F.lane + 64 * j], scl = scp[F.lane + 64 * j]; const f32x4 o = v[j] * rstd * (scl + 1.0f) + sh;
                v2u w; w.x = pk2(o.x, o.y); w.y = pk2(o.z, o.w); hp[F.lane + 64 * j] = w; }
        }
    }
}

__device__ __forceinline__ void phase_convert(const Frame& F, ArgsRef A, int l, int ffn_i, int which) {
    const int gw = F.bid * NWAVES + F.wave, NGW = F.G * NWAVES; int item0 = 0;
    if (which & 1) {
        conv_matrix(F, A.in[8] + ((size_t)l * 2 + ffn_i) * D * (2 * FF), D, 2 * FF, RGN(bf16, R_WGU), 2 * FF, MapGU(), item0, gw, NGW);
        conv_matrix(F, A.in[9] + ((size_t)l * 2 + ffn_i) * FF * D, FF, D, RGN(bf16, R_WDN), D, MapIdent(), item0, gw, NGW);
    }
    if (which & 2) {
        conv_matrix(F, A.in[10] + (size_t)l * D * NIN_SRC, D, NIN_SRC, WSP(bf16, WS_WM + WM_IN), NIN, MapWin(), item0, gw, NGW);
        conv_matrix(F, A.in[26] + (size_t)l * 1024 * D, 1024, D, WSP(bf16, WS_WM + WM_BA), D, MapIdent(), item0, gw, NGW);
        conv_matrix(F, A.in[27] + (size_t)l * 1024 * D, 1024, D, WSP(bf16, WS_WM + WM_BR), D, MapIdent(), item0, gw, NGW);
        conv_matrix(F, A.in[28] + (size_t)l * D * D, D, D, WSP(bf16, WS_WM + WM_BG), D, MapIdent(), item0, gw, NGW);
        conv_matrix(F, A.in[29] + (size_t)l * D * D, D, D, WSP(bf16, WS_WM + WM_OUT), D, MapIdent(), item0, gw, NGW);
        const float* w2 = A.in[14] + (size_t)l * 2 * 96 * 1024; const float* a2 = A.in[16] + (size_t)l * 2 * 96 * 1024; const float* g2 = A.in[17] + (size_t)l * 256 * 1024;
        bf16* LW = WSP(bf16, WS_WM + WM_LW); bf16* LAw = WSP(bf16, WS_WM + WM_LA); bf16* LG = WSP(bf16, WS_WM + WM_LG);
        for (int e = F.bid * NTHR + F.tid; e < 2048 * 256; e += F.G * NTHR) { const int n = e >> 8, k = e & 255, dir = n >> 10, cc = n & 1023;
            const int kk = k - dir * 96; const bool liv = kk >= 0 && kk < 96;
            LW[e] = liv ? (bf16)f2bf(w2[((size_t)dir * 96 + kk) * 1024 + cc]) : (bf16)0;
            LAw[e] = liv ? (bf16)f2bf(a2[((size_t)dir * 96 + kk) * 1024 + cc]) : (bf16)0;
            if (n < 1024) LG[e] = (bf16)f2bf(g2[(size_t)k * 1024 + n]); }
    }
    __syncthreads();
}

__device__ __forceinline__ void phase_prep(const Frame& F, ArgsRef A, int l) {
    const int gw = F.bid * NWAVES + F.wave, NGW = F.G * NWAVES, lane = F.lane;
    const bf16* ZA = RGN(bf16, R_ZA); bf16* QR = RGN(bf16, R_QR); bf16* KR = RGN(bf16, R_KR);
    const bf16* ZR = RGN(bf16, R_ZR); bf16* LA = RGN(bf16, R_LA); unsigned* GL = RGN(unsigned, R_GL);
    {
        const int axis = lane >> 5, f = lane & 31;
        const float invf = exp2f(-(float)f * (13.287712379549449f / 32.0f));
        for (int m = gw; m < ML; m += NGW) {
            const int t = m & (SEQ - 1);
            const float pos = axis == 0 ? (float)(t >> 6) : (float)(t & 63);
            const float ang = pos * invf; const float sn = __sinf(ang), cs = __cosf(ang);
            const bf16* zr = ZA + (size_t)m * ZA_W;
#pragma unroll
            for (int hh = 0; hh < 10; ++hh) {
                const int cb = hh * 128 + axis * 64 + f;
                const float x1 = bf2f(zr[cb]), x2 = bf2f(zr[cb + 32]);
                const float o1 = x1 * cs - x2 * sn, o2 = x2 * cs + x1 * sn;
                if (hh < 8) { QR[(size_t)m * 1024 + cb] = (bf16)f2bf(o1); QR[(size_t)m * 1024 + cb + 32] = (bf16)f2bf(o2); }
                else { KR[(size_t)m * 256 + cb - 1024] = (bf16)f2bf(o1); KR[(size_t)m * 256 + cb - 1024 + 32] = (bf16)f2bf(o2); }
            }
        }
    }
    {
        const float* cw = A.in[12] + (size_t)l * 3 * RW_COLS;
        for (int m = gw; m < MT; m += NGW) {
            int idx, len; if (m < ML) { idx = m & (SEQ - 1); len = SEQ; } else { idx = (m - ML) & (CL - 1); len = CL; }
            const bool hasL = idx > 0, hasR = idx < len - 1;
            const bf16* z0 = ZR + (size_t)m * ZR_W;
#pragma unroll
            for (int jj0 = 0; jj0 < LA_W; jj0 += 64) {
                const int j = jj0 + lane; const int sec = j >> 8, jj = j & 255;
                float o = 0.f;
                if (sec == 2 || jj < 192) {
                    const int scol = (sec == 0 ? 3072 : sec == 1 ? 3264 : 3456) + jj;
                    float zc = bf2f(z0[scol]) * cw[RW_COLS + scol];
                    if (hasL) zc += bf2f(z0[scol - ZR_W]) * cw[scol];
                    if (hasR) zc += bf2f(z0[scol + ZR_W]) * cw[2 * RW_COLS + scol];
                    o = sec == 0 ? ftanh(zc) : (sec == 1 ? zc : fsigmoid(zc));
                }
                LA[(size_t)m * LA_W + j] = (bf16)f2bf(o);
            }
        }
    }
    {
        const float* wa2 = A.in[23] + (size_t)l * 2 * 16 * 1024; const float* ba = A.in[24] + (size_t)l * 2 * 1024;
        for (int item = F.bid; item < 2 * (MT / 16); item += F.G) {
            const int dir = item / (MT / 16), m0 = (item % (MT / 16)) * 16, c0 = 2 * F.tid;
            float w0[16], w1[16];
#pragma unroll
            for (int r = 0; r < 16; ++r) { const f32x2 w = *(const f32x2*)(wa2 + ((size_t)dir * 16 + r) * 1024 + c0); w0[r] = w.x; w1[r] = w.y; }
            const f32x2 bb = *(const f32x2*)(ba + dir * 1024 + c0);
            for (int rr = 0; rr < 16; ++rr) {
                const int m = m0 + rr; const bf16* ac = ZR + (size_t)m * ZR_W + 3712 + dir * 16;
                float s0 = bb.x, s1 = bb.y;
#pragma unroll
                for (int r = 0; r < 16; ++r) { const float a = bf2f(ac[r]); s0 += a * w0[r]; s1 += a * w1[r]; }
                const float la0 = -fsoftplus(-s0) * 0.0625f, la1 = -fsoftplus(-s1) * 0.0625f;
                GL[(((size_t)dir * MT + m) * 1024 + c0) >> 1] = pk2(la0, la1);
            }
        }
    }
}

__device__ __forceinline__ float dpp_f(float v, const int ctrl_sel) {
    const int x = __builtin_bit_cast(int, v); int r;
    if (ctrl_sel == 0) r = __builtin_amdgcn_update_dpp(0, x, 0xB1, 0xF, 0xF, false);
    else if (ctrl_sel == 1) r = __builtin_amdgcn_update_dpp(0, x, 0x4E, 0xF, 0xF, false);
    else if (ctrl_sel == 2) r = __builtin_amdgcn_update_dpp(0, x, 0x141, 0xF, 0xF, false);
    else r = __builtin_amdgcn_update_dpp(0, x, 0x140, 0xF, 0xF, false);
    return __builtin_bit_cast(float, r);
}
__device__ __forceinline__ float red16(float v) { v += dpp_f(v, 0); v += dpp_f(v, 1); v += dpp_f(v, 2); v += dpp_f(v, 3); return v; }
__device__ __forceinline__ float red4(float v) { v += dpp_f(v, 0); v += dpp_f(v, 1); return v; }

__device__ __forceinline__ void rwkv_scan_item(const Frame& F, ArgsRef A, int l, int item, bool last) {
    const int b = item >> 5, h = (item >> 1) & 15, dir = item & 1, lane = F.lane;
    LAS float* V6 = (LAS float*)F.lds;
    LAS float* SC = V6 + 64 * 384;
    LAS float* YB = SC + 128;
    const bf16* ZR = RGN(bf16, R_ZR); const float* WDEC = RGN(float, R_WDEC); const bf16* AA = RGN(bf16, R_AA); float* Y = RGN(float, R_Y);
    const float* cw = A.in[12] + (size_t)l * 3 * RW_COLS;
    const int ch = h * 64 + lane;
    float cr[3], ck[3], cv[3];
#pragma unroll
    for (int tap = 0; tap < 3; ++tap) { cr[tap] = cw[tap * RW_COLS + ch]; ck[tap] = cw[tap * RW_COLS + 1024 + ch]; cv[tap] = cw[tap * RW_COLS + 2048 + ch]; }
    const float kkw = A.in[18][l * 1024 + ch], kaw = A.in[19][l * 1024 + ch];
    const int jq = lane & 15, si0 = (F.wave * 4 + (lane >> 4)) * 2;
    float s0[4] = {0.f, 0.f, 0.f, 0.f}, s1[4] = {0.f, 0.f, 0.f, 0.f};
    for (int chunk = 0; chunk < 36; ++chunk) {
#pragma unroll 2
        for (int q = 0; q < 8; ++q) {
            const int tt = F.wave * 8 + q; int idx, len; const int m = seq_row(b, dir, chunk * 64 + tt, idx, len);
            const bf16* z = ZR + (size_t)m * ZR_W + ch;
            float r = bf2f(z[0]) * cr[1], k = bf2f(z[1024]) * ck[1], v = bf2f(z[2048]) * cv[1];
            if (idx > 0) { r += bf2f(z[-ZR_W]) * cr[0]; k += bf2f(z[1024 - ZR_W]) * ck[0]; v += bf2f(z[2048 - ZR_W]) * cv[0]; }
            if (idx < len - 1) { r += bf2f(z[ZR_W]) * cr[2]; k += bf2f(z[1024 + ZR_W]) * ck[2]; v += bf2f(z[2048 + ZR_W]) * cv[2]; }
            const float kr = k * kkw; const float nrm = sqrtf(wave_sum(kr * kr)); const float kk = kr / fmaxf(nrm, 1e-12f);
            const float w = WDEC[((size_t)dir * MT + m) * 1024 + ch]; const float a = bf2f(AA[((size_t)dir * MT + m) * 1024 + ch]);
            const float kd = k * (1.f + (a - 1.f) * kaw), kka = kk * a;
            const float c1 = wave_sum(kka * r), c2 = wave_sum(kd * r);
            LAS float* o = V6 + tt * 384 + lane; o[0] = w; o[64] = kd; o[128] = kka; o[192] = -kk; o[256] = w * r; o[320] = v;
            if (lane == 0) { SC[tt * 2] = c1; SC[tt * 2 + 1] = c2; }
        }
        __syncthreads();
#pragma unroll 4
        for (int tt = 0; tt < 64; ++tt) {
            const LAS float* vb = V6 + tt * 384 + jq * 4;
            const f32x4 w4 = *(const LAS f32x4*)(vb), kd4 = *(const LAS f32x4*)(vb + 64), ka4 = *(const LAS f32x4*)(vb + 128), nk4 = *(const LAS f32x4*)(vb + 192), wr4 = *(const LAS f32x4*)(vb + 256);
            const f32x2 vi = *(const LAS f32x2*)(V6 + tt * 384 + 320 + si0); const f32x2 cc = *(const LAS f32x2*)(SC + tt * 2);
            float sa0 = 0.f, yp0 = 0.f, sa1 = 0.f, yp1 = 0.f;
#pragma unroll
            for (int q = 0; q < 4; ++q) { sa0 += s0[q] * nk4[q]; yp0 += s0[q] * wr4[q]; sa1 += s1[q] * nk4[q]; yp1 += s1[q] * wr4[q]; }
            sa0 = red16(sa0); yp0 = red16(yp0); sa1 = red16(sa1); yp1 = red16(yp1);
            const float y0 = yp0 + sa0 * cc.x + vi.x * cc.y, y1 = yp1 + sa1 * cc.x + vi.y * cc.y;
#pragma unroll
            for (int q = 0; q < 4; ++q) { s0[q] = s0[q] * w4[q] + sa0 * ka4[q] + vi.x * kd4[q]; s1[q] = s1[q] * w4[q] + sa1 * ka4[q] + vi.y * kd4[q]; }
            if (jq == 0) { *(LAS f32x2*)(YB + tt * 64 + si0) = (f32x2){y0, y1}; }
        }
        __syncthreads();
        if (!(last && chunk < 4)) {
            for (int e = F.tid; e < 4096; e += NTHR) { const int tt = e >> 6, i = e & 63; int idx, len; const int m = seq_row(b, dir, chunk * 64 + tt, idx, len);
                Y[((size_t)dir * MT + m) * 1024 + h * 64 + i] = YB[e]; }
        }
        __syncthreads();
    }
}

__device__ __forceinline__ void gla_scan_item(const Frame& F, int item, bool last) {
    const int b = item >> 5, h = (item >> 3) & 3, dvs = item & 7;
    LAS float* Aq = (LAS float*)F.lds;
    LAS float* Ak = Aq + 4096; LAS float* Aa = Ak + 4096; LAS float* Av = Aa + 4096  ; LAS float* OP = Av + 1024;
    const bf16* ZG = RGN(bf16, R_ZG); const bf16* GL = RGN(bf16, R_GL); float* YG = RGN(float, R_YG);
    const int dg = F.tid >> 5, ep = F.tid & 31;
    for (int dir = 0; dir < 2; ++dir) {
        float S0[16], S1[16];
#pragma unroll
        for (int i = 0; i < 16; ++i) { S0[i] = 0.f; S1[i] = 0.f; }
        for (int chunk = 0; chunk < 144; ++chunk) {
            for (int e = F.tid; e < 16 * 256; e += NTHR) { const int tt = e >> 8, d = e & 255; int idx, len; const int m = seq_row(b, dir, chunk * 16 + tt, idx, len);
                const bf16* z = ZG + (size_t)m * ZG_W + h * 256 + d;
                Aq[e] = bf2f(z[0]) * 0.0625f; Ak[e] = bf2f(z[1024]); Aa[e] = __expf(bf2f(GL[((size_t)dir * MT + m) * 1024 + h * 256 + d])); }
            for (int e = F.tid; e < 16 * 64; e += NTHR) { const int tt = e >> 6, ee = e & 63; int idx, len; const int m = seq_row(b, dir, chunk * 16 + tt, idx, len);
                Av[e] = bf2f(ZG[(size_t)m * ZG_W + 2048 + h * 512 + dvs * 64 + ee]); }
            __syncthreads();
#pragma unroll 2
            for (int tt = 0; tt < 16; ++tt) {
                const f32x2 v = *(const LAS f32x2*)(Av + tt * 64 + 2 * ep); float o0 = 0.f, o1 = 0.f;
                const LAS float* qa = Aq + tt * 256 + dg * 16; const LAS float* ka = Ak + tt * 256 + dg * 16; const LAS float* aa = Aa + tt * 256 + dg * 16;
#pragma unroll
                for (int i = 0; i < 16; i += 4) { const f32x4 a4 = *(const LAS f32x4*)(aa + i), k4 = *(const LAS f32x4*)(ka + i), q4 = *(const LAS f32x4*)(qa + i);
#pragma unroll
                    for (int j = 0; j < 4; ++j) { S0[i + j] = S0[i + j] * a4[j] + k4[j] * v.x; S1[i + j] = S1[i + j] * a4[j] + k4[j] * v.y; o0 += q4[j] * S0[i + j]; o1 += q4[j] * S1[i + j]; } }
                *(LAS f32x2*)(OP + (tt * 16 + dg) * 64 + 2 * ep) = (f32x2){o0, o1};
            }
            __syncthreads();
            if (!(last && chunk < 16)) {
                for (int e = F.tid; e < 16 * 64; e += NTHR) { const int tt = e >> 6, ee = e & 63; float s = 0.f;
#pragma unroll
                    for (int w = 0; w < 16; ++w) s += OP[(tt * 16 + w) * 64 + ee];
                    int idx, len; const int m = seq_row(b, dir, chunk * 16 + tt, idx, len);
                    float* yp = YG + (size_t)m * 2048 + h * 512 + dvs * 64 + ee; if (dir == 0) *yp = s; else *yp += s; }
            }
            __syncthreads();
        }
    }
}

__device__ __forceinline__ void ld32bf(const bf16* p, float (&d)[32], float sc) {
#pragma unroll
    for (int i = 0; i < 4; ++i) { const v4u w = ((const v4u*)p)[i];
        d[8 * i + 0] = bflo(w.x) * sc; d[8 * i + 1] = bfhi(w.x) * sc; d[8 * i + 2] = bflo(w.y) * sc; d[8 * i + 3] = bfhi(w.y) * sc;
        d[8 * i + 4] = bflo(w.z) * sc; d[8 * i + 5] = bfhi(w.z) * sc; d[8 * i + 6] = bflo(w.w) * sc; d[8 * i + 7] = bfhi(w.w) * sc; }
}
__device__ __forceinline__ float dot32bf(const bf16* p, const float (&q)[32]) {
    float s0 = 0.f, s1 = 0.f;
#pragma unroll
    for (int i = 0; i < 4; ++i) { const v4u w = ((const v4u*)p)[i];
        s0 += q[8 * i + 0] * bflo(w.x); s1 += q[8 * i + 1] * bfhi(w.x); s0 += q[8 * i + 2] * bflo(w.y); s1 += q[8 * i + 3] * bfhi(w.y);
        s0 += q[8 * i + 4] * bflo(w.z); s1 += q[8 * i + 5] * bfhi(w.z); s0 += q[8 * i + 6] * bflo(w.w); s1 += q[8 * i + 7] * bfhi(w.w); }
    return s0 + s1;
}
__device__ __forceinline__ void attn_key(float s, bool valid, const bf16* vp, float& mx, float& lsum, float (&o)[32]) {
    s = red4(s);
    s = valid ? s : -1e30f;
    const float mn = fmaxf(mx, s);
    const float corr = __expf(mx - mn), p = __expf(s - mn);
    lsum = lsum * corr + p; mx = mn;
    if (__builtin_amdgcn_ballot_w64(corr != 1.0f) != 0ull) {
#pragma unroll
        for (int i = 0; i < 32; ++i) o[i] *= corr; }
#pragma unroll
    for (int i = 0; i < 4; ++i) { const v4u w = ((const v4u*)vp)[i];
        o[8 * i + 0] += p * bflo(w.x); o[8 * i + 1] += p * bfhi(w.x); o[8 * i + 2] += p * bflo(w.y); o[8 * i + 3] += p * bfhi(w.y);
        o[8 * i + 4] += p * bflo(w.z); o[8 * i + 5] += p * bfhi(w.z); o[8 * i + 6] += p * bflo(w.w); o[8 * i + 7] += p * bfhi(w.w); }
}
__device__ __forceinline__ void attn_store(bf16* op, const float (&o)[32], float inv) {
#pragma unroll
    for (int i = 0; i < 4; ++i) { v4u w; w.x = pk2(o[8 * i] * inv, o[8 * i + 1] * inv); w.y = pk2(o[8 * i + 2] * inv, o[8 * i + 3] * inv); w.z = pk2(o[8 * i + 4] * inv, o[8 * i + 5] * inv); w.w = pk2(o[8 * i + 6] * inv, o[8 * i + 7] * inv);
        ((v4u*)op)[i] = w; }
}
__device__ __forceinline__ void attn_item(const Frame& F, ArgsRef A, int l, int item) {
    const int lane = F.lane, qi = lane >> 2, part = lane & 3;
    bf16* ZA = RGN(bf16, R_ZA); const bf16* QR = RGN(bf16, R_QR); const bf16* KR = RGN(bf16, R_KR);
    const float scale = 0.08838834764831845f;
    float o[32];
#pragma unroll
    for (int i = 0; i < 32; ++i) o[i] = 0.f;
    if (item < 8192) {
        const int qb = item & 127, hq = (item >> 7) & 7, b = item >> 10, hk = hq >> 2;
        const int t = qb * 16 + qi, m = b * SEQ + t;
        float mx = A.in[11][l * 8 + hq], lsum = 1.f;
        {
            float qr[32]; ld32bf(QR + (size_t)m * 1024 + hq * 128 + part * 32, qr, scale);
            const int j0 = (qb * 16 - 128) > 0 ? (qb * 16 - 128) : 0, j1 = (qb * 16 + 15 + 128) < (SEQ - 1) ? (qb * 16 + 15 + 128) : (SEQ - 1);
            for (int j = j0; j <= j1; ++j) {
                const float s = dot32bf(KR + (size_t)(b * SEQ + j) * 256 + hk * 128 + part * 32, qr);
                const int dlt = t - j; const bool valid = dlt <= 128 && dlt >= -128;
                attn_key(s, valid, ZA + (size_t)(b * SEQ + j) * ZA_W + 1280 + hk * 128 + part * 32, mx, lsum, o);
            }
        }
        {
            float qp[32]; ld32bf(ZA + (size_t)m * ZA_W + hq * 128 + part * 32, qp, scale);
            for (int c = 0; c < CL; ++c) {
                const bf16* kr = ZA + (size_t)(ML + b * CL + c) * ZA_W + 1024 + hk * 128 + part * 32;
                const float s = dot32bf(kr, qp);
                attn_key(s, true, kr + 256, mx, lsum, o);
            }
        }
        attn_store(ZA + (size_t)m * ZA_W + hq * 128 + part * 32, o, 1.0f / lsum);
    } else {
        const int it = item - 8192; const int qb = it & 15, hq = (it >> 4) & 7, b = it >> 7, hk = hq >> 2;
        const int m = ML + b * CL + qb * 16 + qi;
        float mx = A.in[11][l * 8 + hq], lsum = 1.f;
        float qp[32]; ld32bf(ZA + (size_t)m * ZA_W + hq * 128 + part * 32, qp, scale);
        for (int c = 0; c < CL; ++c) {
            const bf16* kr = ZA + (size_t)(ML + b * CL + c) * ZA_W + 1024 + hk * 128 + part * 32;
            const float s = dot32bf(kr, qp);
            attn_key(s, true, kr + 256, mx, lsum, o);
        }
        attn_store(ZA + (size_t)m * ZA_W + hq * 128 + part * 32, o, 1.0f / lsum);
    }
}

__device__ __forceinline__ void phase_mix(const Frame& F, ArgsRef A, int l, bool last) {
    for (int item = F.bid; item < 256; item += F.G) rwkv_scan_item(F, A, l, item, last);
    for (int item = F.bid; item < 256; item += F.G) gla_scan_item(F, item, last);
    const int gw = F.bid * NWAVES + F.wave, NGW = F.G * NWAVES;
    const int nitems = last ? 8192 : 8192 + 1024;
    for (int item = gw; item < nitems; item += NGW) attn_item(F, A, l, item);
}

__device__ __forceinline__ void phase_mixout(const Frame& F, ArgsRef A, int l, int nrows) {
    const int gw = F.bid * NWAVES + F.wave, NGW = F.G * NWAVES, lane = F.lane;
    {
        const bf16* ZR = RGN(bf16, R_ZR); const bf16* AA = RGN(bf16, R_AA); const float* Y = RGN(float, R_Y); const bf16* G = RGN(bf16, R_G); bf16* ORW = RGN(bf16, R_ORW);
        const float* cw = A.in[12] + (size_t)l * 3 * RW_COLS; const float* k_a = A.in[19] + l * 1024; const float* r_k = A.in[20] + l * 1024;
        const float* lnw = A.in[21] + l * 1024; const float* lnb = A.in[22] + l * 1024;
        for (int it = gw; it < nrows * 16; it += NGW) {
            const int m = it >> 4, h = it & 15, ch = h * 64 + lane;
            int idx, len; if (m < ML) { idx = m & (SEQ - 1); len = SEQ; } else { idx = (m - ML) & (CL - 1); len = CL; }
            const float o = Y[(size_t)m * 1024 + ch] + Y[((size_t)MT + m) * 1024 + ch];
            const float mean = wave_sum(o) * (1.f / 64.f); const float dv = o - mean; const float var = wave_sum(dv * dv) * (1.f / 64.f);
            const float on = dv * (1.f / sqrtf(var + 64e-5f)) * lnw[ch] + lnb[ch];
            const bf16* z = ZR + (size_t)m * ZR_W + ch;
            float r = bf2f(z[0]) * cw[RW_COLS + ch], k = bf2f(z[1024]) * cw[RW_COLS + 1024 + ch], v = bf2f(z[2048]) * cw[RW_COLS + 2048 + ch];
            if (idx > 0) { r += bf2f(z[-ZR_W]) * cw[ch]; k += bf2f(z[1024 - ZR_W]) * cw[1024 + ch]; v += bf2f(z[2048 - ZR_W]) * cw[2048 + ch]; }
            if (idx < len - 1) { r += bf2f(z[ZR_W]) * cw[2 * RW_COLS + ch]; k += bf2f(z[1024 + ZR_W]) * cw[2 * RW_COLS + 1024 + ch]; v += bf2f(z[2048 + ZR_W]) * cw[2 * RW_COLS + 2048 + ch]; }
            const float a0 = bf2f(AA[(size_t)m * 1024 + ch]), a1 = bf2f(AA[((size_t)MT + m) * 1024 + ch]);
            const float kaw = k_a[ch]; const float kd0 = k * (1.f + (a0 - 1.f) * kaw), kd1 = k * (1.f + (a1 - 1.f) * kaw);
            const float bs = wave_sum(r * (kd0 + kd1) * r_k[ch]);
            const float res = (on + bs * v) * bf2f(G[(size_t)m * 1024 + ch]);
            ORW[(size_t)m * 1024 + ch] = (bf16)f2bf(res);
        }
    }
    {
        const float* YG = RGN(float, R_YG); const bf16* ZG = RGN(bf16, R_ZG); bf16* OGL = RGN(bf16, R_OGL); const float* nw = A.in[25] + l * 512;
        const f32x4 nw0 = *(const f32x4*)(nw + lane * 8), nw1 = *(const f32x4*)(nw + lane * 8 + 4);
        for (int it = gw; it < nrows * 4; it += NGW) {
            const int m = it >> 2, h = it & 3;
            const float* yp = YG + (size_t)m * 2048 + h * 512 + lane * 8;
            f32x4 y0 = *(const f32x4*)yp, y1 = *(const f32x4*)(yp + 4);
            const float ss = wave_sum((y0.x * y0.x + y0.y * y0.y) + (y0.z * y0.z + y0.w * y0.w) + (y1.x * y1.x + y1.y * y1.y) + (y1.z * y1.z + y1.w * y1.w));
            const float rs = 1.f / sqrtf(ss * (1.f / 512.f) + 1e-5f);
            const v4u gw4 = *(const v4u*)(ZG + (size_t)m * ZG_W + 4096 + h * 512 + lane * 8);
            const f32x4 g0 = (f32x4){bflo(gw4.x), bfhi(gw4.x), bflo(gw4.y), bfhi(gw4.y)}, g1 = (f32x4){bflo(gw4.z), bfhi(gw4.z), bflo(gw4.w), bfhi(gw4.w)};
            y0 = y0 * rs * nw0; y1 = y1 * rs * nw1;
            v4u w; w.x = pk2(y0.x * fsilu(g0.x), y0.y * fsilu(g0.y)); w.y = pk2(y0.z * fsilu(g0.z), y0.w * fsilu(g0.w));
            w.z = pk2(y1.x * fsilu(g1.x), y1.y * fsilu(g1.y)); w.w = pk2(y1.z * fsilu(g1.z), y1.w * fsilu(g1.w));
            *(v4u*)(OGL + (size_t)m * 2048 + h * 512 + lane * 8) = w;
        }
    }
}


#ifndef MK_ONE_LAUNCH
#define MK_ONE_LAUNCH 1
#endif

template <int K> __device__ __forceinline__ void run_phase(const Frame& F, ArgsRef A, int l) {
    const float* mods = WSP(float, WS_MODS);
    bf16* HB = WSP(bf16, WS_HB);
    const bool last = (l == DEPTH - 1);
    const float* mods_l = mods + (size_t)l * 9 * 18432;
    const float* lng = A.in[6] + (size_t)l * 3 * D; const float* lnb = A.in[7] + (size_t)l * 3 * D;
    const int nrows = last ? ML : MT;
    if constexpr (K == -1) phase_init(F, A);
    if constexpr (K == 0) {
        if (l > 0) phase_ln<true, true>(F, MT, lng - D, lnb - D, mods_l, 0, 1);
        else phase_ln<false, true>(F, MT, nullptr, nullptr, mods_l, 0, 1);
        phase_convert(F, A, l, 0, 3);
    }
    if constexpr (K == 1 || K == 12) { const int M = (K == 1) ? MT : nrows; pg8::Gemm g{HB, RGN(bf16, R_WGU), M, 2 * FF, D, D, D}; pg8::StaticOrder S; S.init(M, 2 * FF, F.G, F.bid);
        pg8::EpiSwiglu E{RGN(bf16, R_H), FF}; pg8::gemm_phase<pg8::EpiSwiglu, pg8::StaticOrder, true, true>(F.lds, g, S, E); }
    if constexpr (K == 2 || K == 13) { const int M = (K == 2) ? MT : nrows; pg8::Gemm g{RGN(bf16, R_H), RGN(bf16, R_WDN), M, D, FF, FF, FF}; pg8::StaticOrder S; S.init(M, D, F.G, F.bid);
        pg8::EpiResid E{F.out, WSP(float, WS_XC), mods_l, (K == 2) ? 2 : 8, ALPHA, 0.5f}; pg8::gemm_phase<pg8::EpiResid, pg8::StaticOrder, true, true>(F.lds, g, S, E); }
    if constexpr (K == 3) phase_ln<true, true>(F, MT, lng, lnb, mods_l, 3, 4);
    if constexpr (K == 4) { pg8::Gemm g{HB, WSP(bf16, WS_WM + WM_IN), MT, NMIX, D, D, D}; pg8::StaticOrder S; S.init(MT, NMIX, F.G, F.bid);
        typedef pg8::EpiBf16Seg<0, WS_R + R_ZA, WS_R + R_ZR, WS_R + R_ZG, 6, 21, ZA_W, ZR_W, ZG_W> EpiWin; EpiWin E{F.ws};
        pg8::gemm_phase<EpiWin, pg8::StaticOrder, true, true>(F.lds, g, S, E); }
    if constexpr (K == 5) phase_prep(F, A, l);
    if constexpr (K == 6) {
        { pg8::Gemm g{RGN(bf16, R_LA), WSP(bf16, WS_WM + WM_LW), MT, 2048, 256, LA_W, 256}; pg8::StaticOrder S; S.init(MT, 2048, F.G, F.bid);
          pg8::EpiLora<0> E{RGN(float, R_WDEC), nullptr, A.in[13] + (size_t)l * 2048, (size_t)MT * 1024}; pg8::gemm_phase<pg8::EpiLora<0>, pg8::StaticOrder, true, true>(F.lds, g, S, E); }
    }
    if constexpr (K == 15) {
        { pg8::Gemm g{RGN(bf16, R_LA) + 256, WSP(bf16, WS_WM + WM_LA), MT, 2048, 256, LA_W, 256}; pg8::StaticOrder S; S.init(MT, 2048, F.G, F.bid);
          pg8::EpiLora<1> E{nullptr, RGN(bf16, R_AA), A.in[15] + (size_t)l * 2048, (size_t)MT * 1024}; pg8::gemm_phase<pg8::EpiLora<1>, pg8::StaticOrder, true, true>(F.lds, g, S, E); }
    }
    if constexpr (K == 16) {
        { pg8::Gemm g{RGN(bf16, R_LA) + 512, WSP(bf16, WS_WM + WM_LG), MT, 1024, 256, LA_W, 256}; pg8::StaticOrder S; S.init(MT, 1024, F.G, F.bid);
          pg8::EpiLora<2> E{nullptr, RGN(bf16, R_G), nullptr, 0}; pg8::gemm_phase<pg8::EpiLora<2>, pg8::StaticOrder, true, true>(F.lds, g, S, E); }
    }
    if constexpr (K == 7) phase_mix(F, A, l, last);
    if constexpr (K == 8) {
        phase_mixout(F, A, l, nrows);
        __syncthreads();
        pg8::Gemm g{HB, WSP(bf16, WS_WM + WM_IN) + (size_t)NMIX * D, nrows, GT_W, D, D, D}; pg8::StaticOrder S; S.init(nrows, GT_W, F.G, F.bid);
        typedef pg8::EpiBf16Seg<1, WS_R + R_GT, WS_R + R_GT, WS_R + R_GT, 1 << 20, 1 << 20, GT_W, GT_W, GT_W> EpiGate; EpiGate E{F.ws};
        pg8::gemm_phase<EpiGate, pg8::StaticOrder, true, true>(F.lds, g, S, E);
    }
    if constexpr (K == 9) {
        { pg8::Gemm g{RGN(bf16, R_ZA), WSP(bf16, WS_WM + WM_BA), nrows, D, 1024, ZA_W, 1024}; pg8::StaticOrder S; S.init(nrows, D, F.G, F.bid);
          pg8::EpiBranch<0> E{RGN(bf16, R_GT), GT_W, 0, RGN(float, R_MT), nullptr}; pg8::gemm_phase<pg8::EpiBranch<0>, pg8::StaticOrder, true, true>(F.lds, g, S, E); }
        { pg8::Gemm g{RGN(bf16, R_ORW), WSP(bf16, WS_WM + WM_BR), nrows, D, 1024, 1024, 1024}; pg8::StaticOrder S; S.init(nrows, D, F.G, F.bid);
          pg8::EpiBranch<1> E{RGN(bf16, R_GT), GT_W, 2048, RGN(float, R_MT), nullptr}; pg8::gemm_phase<pg8::EpiBranch<1>, pg8::StaticOrder, true, true>(F.lds, g, S, E); }
        { pg8::Gemm g{RGN(bf16, R_OGL), WSP(bf16, WS_WM + WM_BG), nrows, D, D, D, D}; pg8::StaticOrder S; S.init(nrows, D, F.G, F.bid);
          pg8::EpiBranch<2> E{RGN(bf16, R_GT), GT_W, 4096, RGN(float, R_MT), RGN(bf16, R_MG)}; pg8::gemm_phase<pg8::EpiBranch<2>, pg8::StaticOrder, true, true>(F.lds, g, S, E); }
    }
    if constexpr (K == 10) { pg8::Gemm g{RGN(bf16, R_MG), WSP(bf16, WS_WM + WM_OUT), nrows, D, D, D, D}; pg8::StaticOrder S; S.init(nrows, D, F.G, F.bid);
        pg8::EpiResid E{F.out, WSP(float, WS_XC), mods_l, 5, ALPHA, 1.0f}; pg8::gemm_phase<pg8::EpiResid, pg8::StaticOrder, true, true>(F.lds, g, S, E); }
    if constexpr (K == 11) { phase_ln<true, true>(F, nrows, lng + D, lnb + D, mods_l, 6, 7); phase_convert(F, A, l, 1, 1); }
    if constexpr (K == 14) phase_ln<true, false>(F, ML, lng + 2 * D, lnb + 2 * D, nullptr, 0, 0);
}

__device__ __forceinline__ void frame_init(Frame& F, const Args& A, unsigned char* lds_raw) {
    F.lds = (LAS unsigned char*)lds_raw;
    F.tid = threadIdx.x; F.lane = F.tid & 63; F.wave = __builtin_amdgcn_readfirstlane(F.tid >> 6);
    F.G = gridDim.x; F.bid = blockIdx.x; F.out = A.out; F.ws = A.ws;
}

template <int K> __global__ void __launch_bounds__(NTHR, 2) fwd_phase(Args A) {
    extern __shared__ __attribute__((aligned(16))) unsigned char lds_raw[];
    Frame F; frame_init(F, A, lds_raw);
    const CAS Args* ap = (const CAS Args*)__builtin_amdgcn_kernarg_segment_ptr();
    run_phase<K>(F, *ap, A.ph_lo);
}


#ifndef MK_UNROLL_LAYERS
#define MK_UNROLL_LAYERS 0
#endif
__device__ __forceinline__ void launder(Frame& F, int& l) {
    asm volatile("" : "+v"(F.tid), "+v"(F.lane));
    asm volatile("" : "+s"(F.wave), "+s"(F.bid), "+s"(F.G), "+s"(l));
    asm volatile("" : "+s"(F.ws), "+s"(F.out));
}
template <int K> __device__ __forceinline__ void run_phase_l(Frame F, int l) { launder(F, l); const CAS Args* ap = (const CAS Args*)__builtin_amdgcn_kernarg_segment_ptr(); asm volatile("" : "+s"(ap)); run_phase<K>(F, *ap, l); }
template <int L> __device__ __forceinline__ void run_layer(const Frame& F, int l, const XcdBarrier& bar) {
#define PB(K) run_phase_l<K>(F, l); xcd_barrier(bar);
    PB(0) PB(1) PB(2) PB(3) PB(4) PB(5)
    run_phase_l<6>(F, l); run_phase_l<15>(F, l); run_phase_l<16>(F, l); xcd_barrier(bar);
    PB(7) PB(8) PB(9) PB(10) PB(11) PB(12) PB(13)
#undef PB
}
__global__ void __launch_bounds__(NTHR, 2) fwd_all(Args A) {
    extern __shared__ __attribute__((aligned(16))) unsigned char lds_raw[];
    Frame F; frame_init(F, A, lds_raw);
    volatile LAS unsigned* MISC = (volatile LAS unsigned*)(F.lds + MISC_OFF);
    for (int u = F.tid; u < (LDS_BYTES - LDSCTL_OFF) / 4; u += NTHR) ((LAS unsigned*)(F.lds + LDSCTL_OFF))[u] = 0u;
    __syncthreads();
    const XcdBarrier bar = xcd_barrier_post((unsigned*)(F.ws + WS_CTL) + 4096, MISC + 8);
    run_phase_l<-1>(F, 0); xcd_barrier(bar);
#if MK_UNROLL_LAYERS
    run_layer<0>(F, 0, bar); run_layer<1>(F, 1, bar);
#else
    for (int l = 0; l < DEPTH; ++l) run_layer<0>(F, l, bar);
#endif
    run_phase_l<14>(F, DEPTH - 1);
}

template <int K> static void launch_phase(const Args& a, int l, int grid, hipStream_t stream) {
    static bool attr_done = false;
    if (!attr_done) { (void)hipFuncSetAttribute((const void*)fwd_phase<K>, hipFuncAttributeMaxDynamicSharedMemorySize, LDS_BYTES); attr_done = true; }
    Args b = a; b.ph_lo = l; b.ph_hi = 0;
    hipLaunchKernelGGL(fwd_phase<K>, dim3(grid), dim3(NTHR), LDS_BYTES, stream, b);
}

extern "C" void kernel_launch(void* const* d_in, const int* in_sizes, int n_in, void* d_out, int out_size, void* d_ws, size_t ws_size, hipStream_t stream) {
    static int grid = 0;
    if (grid == 0) {
        if (n_in != 30 || out_size != ML * D || ws_size < WS_END) { fprintf(stderr, "kernel_launch: unexpected shapes (n_in %d, out %d, ws %zu < %zu)\n", n_in, out_size, ws_size, (size_t)WS_END); grid = -1; return; }
        int dev = 0, cus = 0;
        if (hipGetDevice(&dev) != hipSuccess || hipDeviceGetAttribute(&cus, hipDeviceAttributeMultiprocessorCount, dev) != hipSuccess) { grid = -1; return; }
        grid = cus;
    }
    if (grid < 0) return;
    (void)hipMemsetAsync((char*)d_ws + WS_CTL, 0, CTL_ZERO_BYTES, stream);
    Args a{};
    for (int i = 0; i < 30; ++i) a.in[i] = (const float*)d_in[i];
    a.out = (float*)d_out; a.ws = (unsigned char*)d_ws;
#if MK_ONE_LAUNCH
    {
        static bool attr_done = false;
        if (!attr_done) { int per_cu = 0;
            if (hipFuncSetAttribute((const void*)fwd_all, hipFuncAttributeMaxDynamicSharedMemorySize, LDS_BYTES) != hipSuccess) { fprintf(stderr, "kernel_launch: hipFuncSetAttribute failed\n"); grid = -1; return; }
            if (hipOccupancyMaxActiveBlocksPerMultiprocessor(&per_cu, (const void*)fwd_all, NTHR, LDS_BYTES) != hipSuccess || per_cu < 1) { fprintf(stderr, "kernel_launch: occupancy query says %d blocks per CU; not launching\n", per_cu); (void)hipGetLastError(); grid = -1; return; }
            attr_done = true; }
        a.ph_lo = 0; a.ph_hi = 0;
        hipLaunchKernelGGL(fwd_all, dim3(grid), dim3(NTHR), LDS_BYTES, stream, a);
        return;
    }
#endif
    launch_phase<-1>(a, 0, grid, stream);
    for (int l = 0; l < DEPTH; ++l) {
        launch_phase<0>(a, l, grid, stream); launch_phase<1>(a, l, grid, stream); launch_phase<2>(a, l, grid, stream); launch_phase<3>(a, l, grid, stream);
        launch_phase<4>(a, l, grid, stream); launch_phase<5>(a, l, grid, stream); launch_phase<6>(a, l, grid, stream); launch_phase<15>(a, l, grid, stream); launch_phase<16>(a, l, grid, stream); launch_phase<7>(a, l, grid, stream);
        launch_phase<8>(a, l, grid, stream); launch_phase<9>(a, l, grid, stream); launch_phase<10>(a, l, grid, stream); launch_phase<11>(a, l, grid, stream);
        launch_phase<12>(a, l, grid, stream); launch_phase<13>(a, l, grid, stream);
    }
    launch_phase<14>(a, DEPTH - 1, grid, stream);
}
```

```cpp
#include <hip/hip_runtime.h>
#include <cstdio>
#include <cstdint>

#define GAS __attribute__((address_space(1)))
#define LAS __attribute__((address_space(3)))
typedef unsigned short bf16;
typedef unsigned v4u __attribute__((ext_vector_type(4)));
typedef unsigned v2u __attribute__((ext_vector_type(2)));
typedef float f32x4 __attribute__((ext_vector_type(4)));
typedef float f32x2 __attribute__((ext_vector_type(2)));
typedef short bf16x8 __attribute__((ext_vector_type(8)));

__device__ __forceinline__ float bf2f(unsigned short b) { return __builtin_bit_cast(float, ((unsigned)b) << 16); }
__device__ __forceinline__ float bflo(unsigned w) { return __builtin_bit_cast(float, w << 16); }
__device__ __forceinline__ float bfhi(unsigned w) { return __builtin_bit_cast(float, w & 0xffff0000u); }
__device__ __forceinline__ unsigned f2bf(float f) { unsigned u = __builtin_bit_cast(unsigned, f); return (u + 0x7fffu + ((u >> 16) & 1u)) >> 16; }
__device__ __forceinline__ unsigned pk2(float lo, float hi) { return f2bf(lo) | (f2bf(hi) << 16); }
__device__ __forceinline__ float wave_sum(float v) {
#pragma unroll
    for (int o = 1; o < 64; o <<= 1) v += __shfl_xor(v, o);
    return v;
}
__device__ __forceinline__ float fsigmoid(float x) { return 1.0f / (1.0f + __expf(-x)); }
__device__ __forceinline__ float fsilu(float x) { return x / (1.0f + __expf(-x)); }
__device__ __forceinline__ float fsoftplus(float x) { return fmaxf(x, 0.f) + __logf(1.0f + __expf(-fabsf(x))); }
__device__ __forceinline__ float ftanh(float x) { const float e = __expf(-2.0f * fabsf(x)); const float t = (1.0f - e) / (1.0f + e); return x < 0.f ? -t : t; }

namespace pg8 {
#define PG8_LAS __attribute__((address_space(3)))
typedef unsigned short bf16_t;
typedef short bf16x8 __attribute__((ext_vector_type(8)));
typedef float f32x4 __attribute__((ext_vector_type(4)));
typedef unsigned u32x4 __attribute__((ext_vector_type(4)));
constexpr int BM = 256, BK = 64, HALF = 128, HTB = HALF * BK * 2  , STAGE_BYTES = 8 * HTB, NXCD = 8, WGM = 8;

__host__ __device__ __forceinline__ int lds_byte(int r, int c) { const int st = (r >> 4) * 2 + (c >> 5), rr = r & 15, cc = c & 31, ob = rr * 64 + cc * 2; return st * 1024 + (ob ^ (((ob >> 9) & 1) << 5)); }
__host__ __device__ __forceinline__ void stage_rc(int b, int& R, int& C) { const int st = b / 1024, sb = b % 1024, swz = sb ^ (((sb >> 9) & 1) << 5); R = (st >> 1) * 16 + swz / 64; C = (st & 1) * 32 + (swz % 64) / 2; }
__host__ __device__ __forceinline__ int perm32(int rho) { const int n = rho >> 4, i = rho & 15; return 8 * (i >> 2) + 4 * n + (i & 3); }

struct Unit { int pm, pn; };
struct Gemm { const bf16_t* A; const bf16_t* Bt; int M, N, K, lda, ldb; };

struct StaticOrder {
    int nM, nN, nwg, G, c;
    __host__ __device__ void init(int M, int N, int G_, int c_) { nM = M / BM; nN = N / BM; nwg = nM * nN; G = G_; c = c_; }
    __host__ __device__ bool next(int i, Unit& u) const {
        const long L = (long)i * G + c; if (L >= nwg) return false;
        int wgid = (int)L; { const int q = nwg / NXCD, r = nwg % NXCD, xcd = wgid % NXCD, off = wgid / NXCD; wgid = (xcd < r ? xcd * (q + 1) : r * (q + 1) + (xcd - r) * q) + off; }
        const int nig = WGM * nN, gid = wgid / nig, fm = gid * WGM, gsz = (nM - fm) < WGM ? (nM - fm) : WGM;
        u.pm = fm + ((wgid % nig) % gsz); u.pn = (wgid % nig) / gsz; return true;
    }
    __device__ __forceinline__ void a_ready(const Unit&) const {}
    __device__ __forceinline__ void done(const Unit&) const {}
};

__device__ __forceinline__ unsigned cvt_pk_bf16(float lo, float hi) { unsigned r; asm volatile("v_cvt_pk_bf16_f32 %0, %1, %2" : "=v"(r) : "v"(lo), "v"(hi)); return r; }

#define EPI_ROWS_BEGIN \
    _Pragma("unroll") for (int ai = 0; ai < 2; ++ai) _Pragma("unroll") for (int m = 0; m < 4; ++m) { const int row = u.pm * BM + ai * HALF + wr * 64 + m * 16 + fr;
#define EPI_ROWS_END }

template <int ACT, size_t O0, size_t O1, size_t O2, int T1, int T2, int L0, int L1, int L2> struct EpiBf16Seg {
    static constexpr bool PERM = true, AFTER_DRAIN = false;
    unsigned char* ws;
    __device__ __forceinline__ void operator()(const f32x4 (&acc)[2][2][4][2], const Unit& u, int wr, int wc, int fr, int fq) const {
        const size_t off = u.pn >= T2 ? O2 : (u.pn >= T1 ? O1 : O0); const int l = u.pn >= T2 ? L2 : (u.pn >= T1 ? L1 : L0), tb = u.pn >= T2 ? T2 : (u.pn >= T1 ? T1 : 0);
        bf16_t* base = (bf16_t*)(ws + off);
        const int col0 = (u.pn - tb) * BM + wc * 32 + 8 * fq;
        EPI_ROWS_BEGIN
            bf16_t* rowp = base + (size_t)row * l + col0;
#pragma unroll
            for (int bj = 0; bj < 2; ++bj) { f32x4 v0 = acc[ai][bj][m][0], v1 = acc[ai][bj][m][1];
                if (ACT == 1) {
#pragma unroll
                    for (int j = 0; j < 4; ++j) { v0[j] = fsigmoid(v0[j]); v1[j] = fsigmoid(v1[j]); } }
                u32x4 w; w.x = cvt_pk_bf16(v0[0], v0[1]); w.y = cvt_pk_bf16(v0[2], v0[3]); w.z = cvt_pk_bf16(v1[0], v1[1]); w.w = cvt_pk_bf16(v1[2], v1[3]);
                *(u32x4*)(rowp + bj * HALF) = w; }
        EPI_ROWS_END
    }
};
struct EpiSwiglu {
    static constexpr bool PERM = true, AFTER_DRAIN = false;
    bf16_t* H; int ldh;
    __device__ __forceinline__ void operator()(const f32x4 (&acc)[2][2][4][2], const Unit& u, int wr, int wc, int fr, int fq) const {
        const int col0 = u.pn * HALF + wc * 32 + 8 * fq;
        EPI_ROWS_BEGIN
            f32x4 g0 = acc[ai][0][m][0], g1 = acc[ai][0][m][1]; const f32x4 u0 = acc[ai][1][m][0], u1 = acc[ai][1][m][1];
#pragma unroll
            for (int j = 0; j < 4; ++j) { g0[j] = fsilu(g0[j]) * u0[j]; g1[j] = fsilu(g1[j]) * u1[j]; }
            u32x4 w; w.x = cvt_pk_bf16(g0[0], g0[1]); w.y = cvt_pk_bf16(g0[2], g0[3]); w.z = cvt_pk_bf16(g1[0], g1[1]); w.w = cvt_pk_bf16(g1[2], g1[3]);
            *(u32x4*)(H + (size_t)row * ldh + col0) = w;
        EPI_ROWS_END
    }
};
struct EpiResid {
    static constexpr bool PERM = true, AFTER_DRAIN = false;
    float* xl; float* xc; const float* mods; int kmod; float alpha, coef;
    __device__ __forceinline__ void operator()(const f32x4 (&acc)[2][2][4][2], const Unit& u, int wr, int wc, int fr, int fq) const {
        const int bsel = u.pm < 64 ? (u.pm >> 3) : 8;
        const float* mp = mods + (size_t)bsel * (9 * 2048) + kmod * 2048;
        float* xb = u.pm < 64 ? xl : xc - (size_t)16384 * 2048;
        const int col0 = u.pn * BM + wc * 32 + 8 * fq;
        f32x4 mv[2][2];
#pragma unroll
        for (int bj = 0; bj < 2; ++bj)
#pragma unroll
            for (int n = 0; n < 2; ++n) mv[bj][n] = *(const f32x4*)(mp + col0 + bj * HALF + 4 * n) * coef;
        EPI_ROWS_BEGIN
            float* rowp = xb + (size_t)row * 2048 + col0;
#pragma unroll
            for (int bj = 0; bj < 2; ++bj)
#pragma unroll
                for (int n = 0; n < 2; ++n) { f32x4* p = (f32x4*)(rowp + bj * HALF + 4 * n); const f32x4 x = *p; *p = x * alpha + mv[bj][n] * acc[ai][bj][m][n]; }
            asm volatile("" ::: "memory");
        EPI_ROWS_END
    }
};
template <int MODE> struct EpiBranch {
    static constexpr bool PERM = true, AFTER_DRAIN = false;
    const bf16_t* GT; int ldg, goff; float* T; bf16_t* O;
    __device__ __forceinline__ void operator()(const f32x4 (&acc)[2][2][4][2], const Unit& u, int wr, int wc, int fr, int fq) const {
        const int col0 = u.pn * BM + wc * 32 + 8 * fq;
        EPI_ROWS_BEGIN
#pragma unroll
            for (int bj = 0; bj < 2; ++bj) {
                const u32x4 gw = *(const u32x4*)(GT + (size_t)row * ldg + goff + col0 + bj * HALF);
                f32x4 g0 = (f32x4){bflo(gw.x), bfhi(gw.x), bflo(gw.y), bfhi(gw.y)}, g1 = (f32x4){bflo(gw.z), bfhi(gw.z), bflo(gw.w), bfhi(gw.w)};
                f32x4 v0 = g0 * acc[ai][bj][m][0], v1 = g1 * acc[ai][bj][m][1];
                float* tp = T + (size_t)row * 2048 + col0 + bj * HALF;
                if (MODE >= 1) { v0 += *(const f32x4*)tp; v1 += *(const f32x4*)(tp + 4); }
                if (MODE <= 1) { *(f32x4*)tp = v0; *(f32x4*)(tp + 4) = v1; }
                else { u32x4 w; w.x = cvt_pk_bf16(v0[0], v0[1]); w.y = cvt_pk_bf16(v0[2], v0[3]); w.z = cvt_pk_bf16(v1[0], v1[1]); w.w = cvt_pk_bf16(v1[2], v1[3]);
                    *(u32x4*)(O + (size_t)row * 2048 + col0 + bj * HALF) = w; }
            }
            asm volatile("" ::: "memory");
        EPI_ROWS_END
    }
};
template <int MODE> struct EpiLora {
    static constexpr bool PERM = true, AFTER_DRAIN = false;
    float* WD; bf16_t* OB; const float* bias; size_t dstride;
    __device__ __forceinline__ void operator()(const f32x4 (&acc)[2][2][4][2], const Unit& u, int wr, int wc, int fr, int fq) const {
        const int colg = u.pn * BM + wc * 32 + 8 * fq;
        EPI_ROWS_BEGIN
#pragma unroll
            for (int bj = 0; bj < 2; ++bj) { const int cg = colg + bj * HALF; const int dir = (MODE == 2) ? 0 : (cg >> 10); const int c = (MODE == 2) ? cg : (cg & 1023);
                f32x4 v0 = acc[ai][bj][m][0], v1 = acc[ai][bj][m][1];
                if (MODE != 2) { v0 += *(const f32x4*)(bias + cg); v1 += *(const f32x4*)(bias + cg + 4); }
                if (MODE == 0) {
#pragma unroll
                    for (int j = 0; j < 4; ++j) { v0[j] = __expf(-__expf(-fsoftplus(-v0[j]) - 0.5f)); v1[j] = __expf(-__expf(-fsoftplus(-v1[j]) - 0.5f)); }
                    float* p = WD + (size_t)dir * dstride + (size_t)row * 1024 + c; *(f32x4*)p = v0; *(f32x4*)(p + 4) = v1;
                } else {
                    if (MODE == 1) {
#pragma unroll
                        for (int j = 0; j < 4; ++j) { v0[j] = fsigmoid(v0[j]); v1[j] = fsigmoid(v1[j]); } }
                    u32x4 w; w.x = cvt_pk_bf16(v0[0], v0[1]); w.y = cvt_pk_bf16(v0[2], v0[3]); w.z = cvt_pk_bf16(v1[0], v1[1]); w.w = cvt_pk_bf16(v1[2], v1[3]);
                    *(u32x4*)(OB + (size_t)dir * dstride + (size_t)row * 1024 + c) = w;
                }
            }
            asm volatile("" ::: "memory");
        EPI_ROWS_END
    }
};

template <class Epi, class Sched, bool ALIGN_EPI = false, bool SP2 = false>
__device__ __forceinline__ void gemm_phase(PG8_LAS unsigned char* lds, const Gemm g, const Sched& S, const Epi& E, int tid_in) {
    int tid_ = tid_in; asm volatile("" : "+v"(tid_));
    const int tid = tid_, wid = __builtin_amdgcn_readfirstlane(tid >> 6), lane = tid & 63, wr = wid >> 2, wc = wid & 3, fr = lane & 15, fq = lane >> 4;
    int K_ = g.K, lda_ = g.lda, ldb_ = g.ldb; asm volatile("" : "+s"(K_), "+s"(lda_), "+s"(ldb_));
    const int K = K_, nt = K / BK, lda = lda_, ldb = ldb_;
    unsigned voffA[2], voffB[2];
#pragma unroll
    for (int i = 0; i < 2; ++i) { int R, C; stage_rc(tid * 16 + i * 8192, R, C); const int Rb = Epi::PERM ? ((R & ~31) + perm32(R & 31)) : R;
        voffA[i] = (unsigned)(R * lda + C) * 2u; voffB[i] = (unsigned)(Rb * ldb + C) * 2u; }
    const size_t kstep = (size_t)(BK * 2);
    const size_t hsA = (size_t)HALF * lda * 2, hsB = (size_t)HALF * ldb * 2;
    const size_t tsA = 2 * hsA, tsB = 2 * hsB;
    const unsigned ldsw = (unsigned)wid * 1024u;
    const int aoff = lds_byte(wr * 64 + fr, fq * 8), boff = lds_byte(wc * 32 + fr, fq * 8);
#define PG8_SA(b, h) (((b) * 2 + (h)) * HTB)
#define PG8_SB(b, h) ((4 + (b) * 2 + (h)) * HTB)
#define PG8_STAGE(bufoff, gbase, voff) do { _Pragma("unroll") for (int _i = 0; _i < 2; ++_i) \
        __builtin_amdgcn_global_load_lds((const unsigned*)((const char*)(gbase) + (voff)[_i]), (PG8_LAS unsigned*)(lds + (bufoff) + ldsw + _i * 8192), 16, 0, 0); } while (0)
#define PG8_LDA(dst, b, h) do { _Pragma("unroll") for (int m = 0; m < 4; ++m) _Pragma("unroll") for (int k = 0; k < 2; ++k) dst[m][k] = *(const PG8_LAS bf16x8*)(lds + PG8_SA(b, h) + aoff + m * 2048 + k * 1024); } while (0)
#define PG8_LDB(dst, b, h) do { _Pragma("unroll") for (int n = 0; n < 2; ++n) _Pragma("unroll") for (int k = 0; k < 2; ++k) dst[n][k] = *(const PG8_LAS bf16x8*)(lds + PG8_SB(b, h) + boff + n * 2048 + k * 1024); } while (0)
#define PG8_MMA(ai, bj, At, Bt) do { __builtin_amdgcn_s_setprio(1); _Pragma("unroll") for (int m = 0; m < 4; ++m) _Pragma("unroll") for (int n = 0; n < 2; ++n) _Pragma("unroll") for (int k = 0; k < 2; ++k) \
        acc[ai][bj][m][n] = __builtin_amdgcn_mfma_f32_16x16x32_bf16(Bt[n][k], At[m][k], acc[ai][bj][m][n], 0, 0, 0); __builtin_amdgcn_s_setprio(0); } while (0)
#define PG8_WAIT_V(n) asm volatile("s_waitcnt vmcnt(" #n ")" ::: "memory")
#define PG8_WAIT_L(n) asm volatile("s_waitcnt lgkmcnt(" #n ")" ::: "memory")
#define PG8_BAR __builtin_amdgcn_s_barrier()
#define PG8_SCHED __builtin_amdgcn_sched_barrier(0)
    Unit cur, nxt; int ui = 0;
    if (!S.next(0, cur)) return;
    f32x4 acc[2][2][4][2];
#pragma unroll
    for (int a = 0; a < 2; ++a)
#pragma unroll
        for (int b = 0; b < 2; ++b)
#pragma unroll
            for (int m = 0; m < 4; ++m)
#pragma unroll
                for (int n = 0; n < 2; ++n) acc[a][b][m][n] = (f32x4){0.f, 0.f, 0.f, 0.f};
    bf16x8 At[4][2], B0[2][2], B1[2][2];
    const char* cA = (const char*)g.A + (size_t)cur.pm * tsA; const char* cB = (const char*)g.Bt + (size_t)cur.pn * tsB;
    S.a_ready(cur);
    if constexpr (SP2) {
        PG8_STAGE(PG8_SB(0, 0), cB, voffB); PG8_STAGE(PG8_SB(0, 1), cB + hsB, voffB); PG8_STAGE(PG8_SA(0, 0), cA, voffA); PG8_STAGE(PG8_SA(0, 1), cA + hsA, voffA);
        if (wr == 1) PG8_BAR;
        PG8_WAIT_V(2); PG8_BAR;
        PG8_STAGE(PG8_SB(1, 0), cB + kstep, voffB); PG8_STAGE(PG8_SA(1, 0), cA + kstep, voffA); PG8_STAGE(PG8_SB(1, 1), cB + hsB + kstep, voffB);
        PG8_WAIT_V(6); PG8_BAR;
    } else {
        PG8_STAGE(PG8_SB(0, 0), cB, voffB); PG8_STAGE(PG8_SA(0, 0), cA, voffA); PG8_STAGE(PG8_SB(0, 1), cB + hsB, voffB); PG8_STAGE(PG8_SA(0, 1), cA + hsA, voffA);
        if (wr == 1) PG8_BAR;
        PG8_WAIT_V(4); PG8_BAR;
        PG8_STAGE(PG8_SB(1, 0), cB + kstep, voffB); PG8_STAGE(PG8_SA(1, 0), cA + kstep, voffA); PG8_STAGE(PG8_SB(1, 1), cB + hsB + kstep, voffB);
        PG8_WAIT_V(6); PG8_BAR;
    }
    for (;;) {
        const bool has_next = S.next(ui + 1, nxt);
        const char* nA = has_next ? (const char*)g.A + (size_t)nxt.pm * tsA : cA; const char* nB = has_next ? (const char*)g.Bt + (size_t)nxt.pn * tsB : cB;
        for (int t = 0; t < nt; t += 2) {
            const bool last = (t == nt - 2);
            const char* a1 = cA + (size_t)(t + 1) * kstep;
            const char* a2 = last ? nA : cA + (size_t)(t + 2) * kstep; const char* b2 = last ? nB : cB + (size_t)(t + 2) * kstep;
            const char* a3 = a2 + kstep; const char* b3 = b2 + kstep;
            if (last && has_next) S.a_ready(nxt);
            if constexpr (SP2) {
            PG8_LDB(B0, 0, 0); PG8_LDB(B1, 0, 1); PG8_SCHED; PG8_LDA(At, 0, 0); PG8_STAGE(PG8_SA(1, 1), a1 + hsA, voffA);
            PG8_WAIT_V(8); PG8_WAIT_L(0); PG8_BAR; PG8_MMA(0, 0, At, B0); PG8_MMA(0, 1, At, B1); PG8_BAR; PG8_SCHED;
            PG8_LDA(At, 0, 1); PG8_STAGE(PG8_SB(0, 0), b2, voffB); PG8_STAGE(PG8_SB(0, 1), b2 + hsB, voffB); PG8_STAGE(PG8_SA(0, 0), a2, voffA);
            PG8_WAIT_V(8); PG8_WAIT_L(0); PG8_BAR; PG8_MMA(1, 0, At, B0); PG8_MMA(1, 1, At, B1); PG8_BAR; PG8_SCHED;
            PG8_LDB(B0, 1, 0); PG8_LDB(B1, 1, 1); PG8_SCHED; PG8_LDA(At, 1, 0); PG8_STAGE(PG8_SA(0, 1), a2 + hsA, voffA);
            PG8_WAIT_V(8); PG8_WAIT_L(0); PG8_BAR; PG8_MMA(0, 0, At, B0); PG8_MMA(0, 1, At, B1); PG8_BAR; PG8_SCHED;
            PG8_LDA(At, 1, 1); PG8_STAGE(PG8_SB(1, 0), b3, voffB); PG8_STAGE(PG8_SB(1, 1), b3 + hsB, voffB); PG8_STAGE(PG8_SA(1, 0), a3, voffA);
            PG8_WAIT_V(8); PG8_WAIT_L(0); PG8_BAR; PG8_MMA(1, 0, At, B0); PG8_MMA(1, 1, At, B1); PG8_BAR; PG8_SCHED;
            } else {
            PG8_LDB(B0, 0, 0); PG8_SCHED; PG8_LDA(At, 0, 0); PG8_STAGE(PG8_SA(1, 1), a1 + hsA, voffA);
            PG8_WAIT_L(8); PG8_BAR; PG8_WAIT_L(0); PG8_MMA(0, 0, At, B0); PG8_BAR; PG8_SCHED;
            PG8_LDB(B1, 0, 1); PG8_STAGE(PG8_SB(0, 0), b2, voffB);
            PG8_BAR; PG8_WAIT_L(0); PG8_MMA(0, 1, At, B1); PG8_BAR;
            PG8_LDA(At, 0, 1); PG8_STAGE(PG8_SA(0, 0), a2, voffA);
            PG8_BAR; PG8_WAIT_L(0); PG8_MMA(1, 0, At, B0); PG8_BAR; PG8_SCHED;
            PG8_STAGE(PG8_SB(0, 1), b2 + hsB, voffB);
            PG8_WAIT_V(6); PG8_BAR; PG8_MMA(1, 1, At, B1); PG8_BAR;
            PG8_LDB(B0, 1, 0); PG8_SCHED; PG8_LDA(At, 1, 0); PG8_STAGE(PG8_SA(0, 1), a2 + hsA, voffA);
            PG8_WAIT_L(8); PG8_BAR; PG8_WAIT_L(0); PG8_MMA(0, 0, At, B0); PG8_BAR; PG8_SCHED;
            PG8_LDB(B1, 1, 1); PG8_STAGE(PG8_SB(1, 0), b3, voffB);
            PG8_BAR; PG8_WAIT_L(0); PG8_MMA(0, 1, At, B1); PG8_BAR;
            PG8_LDA(At, 1, 1); PG8_STAGE(PG8_SA(1, 0), a3, voffA);
            PG8_BAR; PG8_WAIT_L(0); PG8_MMA(1, 0, At, B0); PG8_BAR; PG8_SCHED;
            PG8_STAGE(PG8_SB(1, 1), b3 + hsB, voffB);
            PG8_WAIT_V(6); PG8_BAR; PG8_MMA(1, 1, At, B1); PG8_BAR;
            }
        }
        if constexpr (ALIGN_EPI) { if (wr == 0) PG8_BAR; }
        if constexpr (!Epi::AFTER_DRAIN) { E(acc, cur, wr, wc, fr, fq); S.done(cur); }
        if (!has_next) break;
#pragma unroll
        for (int a = 0; a < 2; ++a)
#pragma unroll
            for (int b = 0; b < 2; ++b)
#pragma unroll
                for (int m = 0; m < 4; ++m)
#pragma unroll
                    for (int n = 0; n < 2; ++n) acc[a][b][m][n] = (f32x4){0.f, 0.f, 0.f, 0.f};
        cur = nxt; cA = nA; cB = nB; ++ui;
        if constexpr (ALIGN_EPI) { if (wr == 1) PG8_BAR; }
    }
    PG8_WAIT_V(0);
    if constexpr (!ALIGN_EPI) { if (wr == 0) PG8_BAR; }
    PG8_BAR;
    if constexpr (Epi::AFTER_DRAIN) { E.fused(acc, cur, wr, wc, fr, fq, lds, wid, lane); S.done(cur); }
#undef PG8_SA
#undef PG8_SB
#undef PG8_STAGE
#undef PG8_LDA
#undef PG8_LDB
#undef PG8_MMA
#undef PG8_WAIT_V
#undef PG8_WAIT_L
#undef PG8_BAR
#undef PG8_SCHED
}
}

#undef EPI_ROWS_BEGIN
#undef EPI_ROWS_END

constexpr int D = 2048, NB = 8, SEQ = 2048, CL = 256, ML = NB * SEQ, MC = NB * CL, MT = ML + MC;
constexpr int FF = 5632, NMOD = 9, DEPTH = 2;
constexpr int NIN_SRC = 17568;
constexpr int ZA_W = 1536, ZR_W = 3840, ZG_W = 6144, GT_W = 6144, NMIX = ZA_W + ZR_W + ZG_W  , NIN = NMIX + GT_W  ;
constexpr int RW_COLS = 3712, LA_W = 768;
constexpr float LN_EPS = 1e-5f, ALPHA = 1.41421356237f;
constexpr int NWAVES = 8, NTHR = 512;

constexpr size_t MiB = 1u << 20;
constexpr size_t WS_CTL = 0, CTL_ZERO_BYTES = 1 * MiB;
constexpr size_t WS_MODS = 1 * MiB;
constexpr size_t WS_XC = 4 * MiB;
constexpr size_t WS_HB = 20 * MiB;
constexpr size_t WS_WM = 92 * MiB;
constexpr size_t WM_IN = 0, WM_BA = 69 * MiB, WM_BR = 73 * MiB, WM_BG = 77 * MiB, WM_OUT = 85 * MiB, WM_LW = 93 * MiB, WM_LA = 94 * MiB, WM_LG = 95 * MiB;
constexpr size_t WS_R = 188 * MiB;
constexpr size_t R_WGU = 0, R_WDN = 44 * MiB, R_H = 66 * MiB;
constexpr size_t R_ZA = 0;
constexpr size_t R_ORW = 54 * MiB;
constexpr size_t R_OGL = 90 * MiB;
constexpr size_t R_ZR = 162 * MiB;
constexpr size_t R_AA = 297 * MiB;
constexpr size_t R_Y = 369 * MiB;
constexpr size_t R_G = 513 * MiB;
constexpr size_t R_ZG = 549 * MiB;
constexpr size_t R_YG = 765 * MiB;
constexpr size_t R_QR = 909 * MiB;
constexpr size_t R_KR = 941 * MiB;
constexpr size_t R_LA = 949 * MiB;
constexpr size_t R_WDEC = 976 * MiB;
constexpr size_t R_GL = 1120 * MiB;
constexpr size_t R_GT = R_QR;
constexpr size_t R_MT = R_ZR;
constexpr size_t R_MG = R_Y;
constexpr size_t R_END = 1192 * MiB;
constexpr size_t WS_END = WS_R + R_END;
static_assert(R_GT + (size_t)MT * GT_W * 2 <= R_END, "GT overlay");
static_assert(WS_END <= (size_t)1408 * MiB, "workspace budget");
static_assert(R_H + (size_t)MT * FF * 2 <= R_END, "H fits");

#define XB_TMO      128
#define XB_XCNT(j)  (256  + 64 * (j))
#define XB_XSUB(j)  (1280 + 64 * (j))
#define XB_XGEN(j)  (2304 + 64 * (j))
#define XB_TOP      3328
#define XB_TOPGEN   3392
#define XCD_BAR_WORDS 3456
#define XB_SPIN_CAP (1u << 18)
__device__ __forceinline__ unsigned xb_ld(unsigned* p)              { return __hip_atomic_load(p, __ATOMIC_RELAXED, __HIP_MEMORY_SCOPE_AGENT); }
__device__ __forceinline__ unsigned xb_add(unsigned* p, unsigned v) { return __hip_atomic_fetch_add(p, v, __ATOMIC_RELAXED, __HIP_MEMORY_SCOPE_AGENT); }
__device__ __forceinline__ unsigned xb_xcc_id() { return (unsigned)__builtin_amdgcn_s_getreg((3 << 11) | 20) & 0xFu; }
#define XB_SPIN(cond, bar) do { unsigned _sp = 0; while (cond) { __builtin_amdgcn_s_sleep(1); \
    if ((++_sp & 255u) == 0u) { if (xb_ld(&(bar)[XB_TMO])) break; if (_sp > XB_SPIN_CAP) { atomicAdd(&(bar)[XB_TMO], 1u); break; } } } } while (0)
struct XcdBarrier { unsigned* bar; unsigned x; volatile LAS unsigned* st; };
__device__ __forceinline__ XcdBarrier xcd_barrier_post(unsigned* bar, volatile LAS unsigned* st, int tid) {
    XcdBarrier b; b.bar = bar; b.x = xb_xcc_id(); b.st = st;
    if (tid == 0) (void)xb_add(&bar[XB_XCNT(b.x)], 1u);
    return b;
}
__device__ __forceinline__ void xcd_barrier_complete(unsigned* bar, unsigned x, unsigned& nloc, unsigned& nx) {
    const unsigned G = gridDim.x * gridDim.y * gridDim.z;
    unsigned sum, cnt, mine, sp = 0u;
    for (;;) {
        sum = 0u; cnt = 0u; mine = 0u;
#pragma unroll
        for (unsigned j = 0; j < 16; ++j) { const unsigned c = xb_ld(&bar[XB_XCNT(j)]); sum += c; cnt += (c > 0u) ? 1u : 0u; mine = (j == x) ? c : mine; }
        if (sum == G) break;
        __builtin_amdgcn_s_sleep(1);
        if ((++sp & 255u) == 0u) { if (xb_ld(&bar[XB_TMO])) break; if (sp > XB_SPIN_CAP) { atomicAdd(&bar[XB_TMO], 1u); break; } }
    }
    nloc = mine > 0u ? mine : 1u; nx = cnt > 0u ? cnt : 1u;
}
__device__ __forceinline__ void xcd_barrier(const XcdBarrier& b, int tid) {
    asm volatile("s_waitcnt vmcnt(0)" ::: "memory");
    __syncthreads();
    if (tid == 0) {
        unsigned* bar = b.bar; unsigned bx = b.x;
        asm volatile("" : "+s"(bar), "+s"(bx));
        __builtin_amdgcn_s_waitcnt(0);
        unsigned nloc = b.st[0], nx = b.st[1];
        if (nloc == 0u) { xcd_barrier_complete(bar, bx, nloc, nx); b.st[0] = nloc; b.st[1] = nx; }
        const unsigned old = xb_add(&bar[XB_XSUB(bx)], 1u);
        const unsigned gen = old / nloc;
        if (old + 1u == (gen + 1u) * nloc) {
            __builtin_amdgcn_fence(__ATOMIC_RELEASE, "agent");
            asm volatile("s_waitcnt vmcnt(0)" ::: "memory");
            const unsigned og = xb_add(&bar[XB_TOP], 1u);
            const unsigned tg = og / nx;
            if (og + 1u == (tg + 1u) * nx) xb_add(&bar[XB_TOPGEN], 1u);
            else XB_SPIN(xb_ld(&bar[XB_TOPGEN]) == tg, bar);
            __builtin_amdgcn_fence(__ATOMIC_ACQUIRE, "agent");
            xb_add(&bar[XB_XGEN(bx)], 1u);
            asm volatile("s_waitcnt vmcnt(0)" ::: "memory");
        } else {
            XB_SPIN(xb_ld(&bar[XB_XGEN(bx)]) == gen, bar);
            __builtin_amdgcn_fence(__ATOMIC_ACQUIRE, "agent");
            asm volatile("s_waitcnt vmcnt(0)" ::: "memory");
        }
    }
    __syncthreads();
}

constexpr int RING_BYTES = 143360;
constexpr int LDSCTL_OFF = RING_BYTES, MISC_OFF = LDSCTL_OFF + 320;
constexpr int LDS_BYTES = 147456;

struct Args { const float* in[30]; float* out; unsigned char* ws; int ph_lo, ph_hi; };
#define CAS __attribute__((address_space(4)))
typedef const CAS Args& ArgsRef;

struct Frame {
    LAS unsigned char* lds;
    int tid, lane, wave, G, bid;
    const float* const* in;
    float* out; unsigned char* ws;
};
#define WSP(T, off) ((T*)(F.ws + (off)))
#define RGN(T, off) ((T*)(F.ws + WS_R + (off)))
__device__ __forceinline__ float* xrow(const Frame& F, int m) { return m < ML ? F.out + (size_t)m * D : WSP(float, WS_XC) + (size_t)(m - ML) * D; }

__device__ __forceinline__ void tr_item(const float* W, int N, bf16* WT, int ldk, int k0, int scol0, int drow0, LAS float* scr, int lane) {
    if (scol0 >= 0) {
#pragma unroll 8
        for (int i = 0; i < 32; ++i) { const int kk = 2 * i + (lane >> 5); scr[kk * 33 + (lane & 31)] = W[(size_t)(k0 + kk) * N + scol0 + (lane & 31)]; }
    } else {
#pragma unroll 8
        for (int i = 0; i < 32; ++i) { const int kk = 2 * i + (lane >> 5); scr[kk * 33 + (lane & 31)] = 0.f; }
    }
    asm volatile("s_waitcnt vmcnt(0) lgkmcnt(0)" ::: "memory");
    const int c = lane & 7;
#pragma unroll
    for (int j = 0; j < 4; ++j) { const int n = (lane >> 3) + 8 * j; const LAS float* s = scr + (8 * c) * 33 + n;
        v4u o; o.x = pk2(s[0 * 33], s[1 * 33]); o.y = pk2(s[2 * 33], s[3 * 33]); o.z = pk2(s[4 * 33], s[5 * 33]); o.w = pk2(s[6 * 33], s[7 * 33]);
        *(v4u*)(WT + (size_t)(drow0 + n) * ldk + k0 + 8 * c) = o; }
    asm volatile("s_waitcnt lgkmcnt(0)" ::: "memory");
}
struct MapIdent { __device__ __forceinline__ int operator()(int drow) const { return drow; } };
struct MapGU { __device__ __forceinline__ int operator()(int drow) const { const int pn = drow >> 8, bj = (drow >> 7) & 1, i = drow & 127; return bj * FF + pn * 128 + i; } };
struct MapWin { __device__ __forceinline__ int operator()(int drow) const {
    if (drow < 5248) return drow;
    if (drow < 5280) return 11392 + (drow - 5248);
    if (drow < 5376) return -1;
    if (drow < 11520) return 5248 + (drow - 5376);
    return 11424 + (drow - 11520);
} };
template <class MAP> __device__ __forceinline__ void conv_matrix(const Frame& F, const float* W, int K, int N, bf16* WT, int NT, const MAP& mp, int& item0, int gw, int NGW) {
    LAS float* scr = (LAS float*)(F.lds + F.wave * 16384);
    const int nblk = NT / 32, nitems = (K / 64) * nblk;
    int first = ((gw - item0) % NGW + NGW) % NGW;
    for (int it = first; it < nitems; it += NGW) { const int kb = it / nblk, nb = it % nblk; tr_item(W, N, WT, K, kb * 64, mp(nb * 32), nb * 32, scr, F.lane); }
    item0 += nitems;
}

__device__ __forceinline__ int seq_row(int b, int dir, int p, int& idx, int& len) {
    if (p < CL) { idx = dir ? (CL - 1 - p) : p; len = CL; return ML + b * CL + idx; }
    const int q = p - CL; idx = dir ? (SEQ - 1 - q) : q; len = SEQ; return b * SEQ + idx;
}

__device__ __forceinline__ void phase_init(const Frame& F, ArgsRef A) {
    {
        const size_t n4 = (size_t)ML * D / 4; const f32x4* s = (const f32x4*)A.in[0]; f32x4* d = (f32x4*)F.out;
        for (size_t i = (size_t)F.bid * NTHR + F.tid; i < n4; i += (size_t)F.G * NTHR) d[i] = s[i];
        const size_t m4 = (size_t)MC * D / 4; const f32x4* s2 = (const f32x4*)A.in[2]; f32x4* d2 = WSP(f32x4, WS_XC);
        for (size_t i = (size_t)F.bid * NTHR + F.tid; i < m4; i += (size_t)F.G * NTHR) d2[i] = s2[i];
    }
    const float* c = A.in[1]; const float* cctx = A.in[3]; const float* ada_w = A.in[4]; const float* ada_b = A.in[5];
    float* mods = WSP(float, WS_MODS);
    LAS float* sc = (LAS float*)F.lds;
    LAS float* red = sc + 9 * 2048;
    for (int i = F.tid; i < 9 * 2048; i += NTHR) { const int bs = i >> 11, k = i & 2047; const float v = bs < 8 ? c[bs * 2048 + k] : cctx[k]; sc[i] = fsilu(v); }
    __syncthreads();
    for (int item = F.bid; item < 2 * 144; item += F.G) {
        const int l = item / 144, cb = item % 144, col = cb * 128 + 2 * F.lane;
        float a0[9], a1[9];
#pragma unroll
        for (int bs = 0; bs < 9; ++bs) { a0[bs] = 0.f; a1[bs] = 0.f; }
        const float* wp = ada_w + ((size_t)l * 2048 + F.wave * 256) * 18432 + col;
        const LAS float* sp = sc + F.wave * 256;
#pragma unroll 8
        for (int k = 0; k < 256; ++k) { const f32x2 w = *(const f32x2*)(wp + (size_t)k * 18432);
#pragma unroll
            for (int bs = 0; bs < 9; ++bs) { const float s = sp[bs * 2048 + k]; a0[bs] += s * w.x; a1[bs] += s * w.y; } }
#pragma unroll
        for (int bs = 0; bs < 9; ++bs) { red[(F.wave * 9 + bs) * 128 + 2 * F.lane] = a0[bs]; red[(F.wave * 9 + bs) * 128 + 2 * F.lane + 1] = a1[bs]; }
        __syncthreads();
        for (int o = F.tid; o < 9 * 128; o += NTHR) { const int bs = o >> 7, cc = o & 127; float s = ada_b[l * 18432 + cb * 128 + cc];
#pragma unroll
            for (int w = 0; w < 8; ++w) s += red[(w * 9 + bs) * 128 + cc];
            mods[((size_t)l * 9 + bs) * 18432 + cb * 128 + cc] = s; }
        __syncthreads();
    }
}

template <bool POST, bool MODH>
__device__ __forceinline__ void phase_ln(const Frame& F, int nrows, const float* g, const float* b, const float* mods_l, int kshift, int kscale) {
    const int gw = F.bid * NWAVES + F.wave, NGW = F.G * NWAVES;
    bf16* HB = WSP(bf16, WS_HB);
    for (int m = gw; m < nrows; m += NGW) {
        float* xr = xrow(F, m);
        f32x4 v[8];
#pragma unroll
        for (int j = 0; j < 8; ++j) v[j] = ((const f32x4*)xr)[F.lane + 64 * j];
        if (POST) {
            float s = 0.f;
#pragma unroll
            for (int j = 0; j < 8; ++j) s += (v[j].x + v[j].y) + (v[j].z + v[j].w);
            const float mean = wave_sum(s) * (1.f / D); float s2 = 0.f;
#pragma unroll
            for (int j = 0; j < 8; ++j) { v[j] = v[j] - mean; s2 += (v[j].x * v[j].x + v[j].y * v[j].y) + (v[j].z * v[j].z + v[j].w * v[j].w); }
            const float rstd = 1.f / sqrtf(wave_sum(s2) * (1.f / D) + LN_EPS);
#pragma unroll
            for (int j = 0; j < 8; ++j) { const f32x4 gg = ((const f32x4*)g)[F.lane + 64 * j], bb = ((const f32x4*)b)[F.lane + 64 * j]; v[j] = v[j] * rstd * gg + bb; ((f32x4*)xr)[F.lane + 64 * j] = v[j]; }
        }
        if (MODH) {
            float s = 0.f;
#pragma unroll
            for (int j = 0; j < 8; ++j) s += (v[j].x + v[j].y) + (v[j].z + v[j].w);
            const float mean = wave_sum(s) * (1.f / D); float s2 = 0.f;
#pragma unroll
            for (int j = 0; j < 8; ++j) { v[j] = v[j] - mean; s2 += (v[j].x * v[j].x + v[j].y * v[j].y) + (v[j].z * v[j].z + v[j].w * v[j].w); }
            const float rstd = 1.f / sqrtf(wave_sum(s2) * (1.f / D) + LN_EPS);
            const int bsel = m < ML ? (m >> 11) : 8;
            const f32x4* shp = (const f32x4*)(mods_l + (size_t)bsel * 18432 + kshift * 2048);
            const f32x4* scp = (const f32x4*)(mods_l + (size_t)bsel * 18432 + kscale * 2048);
            v2u* hp = (v2u*)(HB + (size_t)m * D);
#pragma unroll
            for (int j = 0; j < 8; ++j) { const f32x4 sh = shp[F.lane + 64 * j], scl = scp[F.lane + 64 * j]; const f32x4 o = v[j] * rstd * (scl + 1.0f) + sh;
                v2u w; w.x = pk2(o.x, o.y); w.y = pk2(o.z, o.w); hp[F.lane + 64 * j] = w; }
        }
    }
}

__device__ __forceinline__ void phase_convert(const Frame& F, ArgsRef A, int l, int ffn_i, int which) {
    const int gw = F.bid * NWAVES + F.wave, NGW = F.G * NWAVES; int item0 = 0;
    if (which & 1) {
        conv_matrix(F, A.in[8] + ((size_t)l * 2 + ffn_i) * D * (2 * FF), D, 2 * FF, RGN(bf16, R_WGU), 2 * FF, MapGU(), item0, gw, NGW);
        conv_matrix(F, A.in[9] + ((size_t)l * 2 + ffn_i) * FF * D, FF, D, RGN(bf16, R_WDN), D, MapIdent(), item0, gw, NGW);
    }
    if (which & 2) {
        conv_matrix(F, A.in[10] + (size_t)l * D * NIN_SRC, D, NIN_SRC, WSP(bf16, WS_WM + WM_IN), NIN, MapWin(), item0, gw, NGW);
        conv_matrix(F, A.in[26] + (size_t)l * 1024 * D, 1024, D, WSP(bf16, WS_WM + WM_BA), D, MapIdent(), item0, gw, NGW);
        conv_matrix(F, A.in[27] + (size_t)l * 1024 * D, 1024, D, WSP(bf16, WS_WM + WM_BR), D, MapIdent(), item0, gw, NGW);
        conv_matrix(F, A.in[28] + (size_t)l * D * D, D, D, WSP(bf16, WS_WM + WM_BG), D, MapIdent(), item0, gw, NGW);
        conv_matrix(F, A.in[29] + (size_t)l * D * D, D, D, WSP(bf16, WS_WM + WM_OUT), D, MapIdent(), item0, gw, NGW);
        const float* w2 = A.in[14] + (size_t)l * 2 * 96 * 1024; const float* a2 = A.in[16] + (size_t)l * 2 * 96 * 1024; const float* g2 = A.in[17] + (size_t)l * 256 * 1024;
        bf16* LW = WSP(bf16, WS_WM + WM_LW); bf16* LAw = WSP(bf16, WS_WM + WM_LA); bf16* LG = WSP(bf16, WS_WM + WM_LG);
        for (int e = F.bid * NTHR + F.tid; e < 2048 * 256; e += F.G * NTHR) { const int n = e >> 8, k = e & 255, dir = n >> 10, cc = n & 1023;
            const int kk = k - dir * 96; const bool liv = kk >= 0 && kk < 96;
            LW[e] = liv ? (bf16)f2bf(w2[((size_t)dir * 96 + kk) * 1024 + cc]) : (bf16)0;
            LAw[e] = liv ? (bf16)f2bf(a2[((size_t)dir * 96 + kk) * 1024 + cc]) : (bf16)0;
            if (n < 1024) LG[e] = (bf16)f2bf(g2[(size_t)k * 1024 + n]); }
    }
    __syncthreads();
}

__device__ __forceinline__ void phase_prep(const Frame& F, ArgsRef A, int l) {
    const int gw = F.bid * NWAVES + F.wave, NGW = F.G * NWAVES, lane = F.lane;
    const bf16* ZA = RGN(bf16, R_ZA); bf16* QR = RGN(bf16, R_QR); bf16* KR = RGN(bf16, R_KR);
    const bf16* ZR = RGN(bf16, R_ZR); bf16* LA = RGN(bf16, R_LA); unsigned* GL = RGN(unsigned, R_GL);
    {
        const int axis = lane >> 5, f = lane & 31;
        const float invf = exp2f(-(float)f * (13.287712379549449f / 32.0f));
        for (int m = gw; m < ML; m += NGW) {
            const int t = m & (SEQ - 1);
            const float pos = axis == 0 ? (float)(t >> 6) : (float)(t & 63);
            const float ang = pos * invf; const float sn = __sinf(ang), cs = __cosf(ang);
            const bf16* zr = ZA + (size_t)m * ZA_W;
#pragma unroll
            for (int hh = 0; hh < 10; ++hh) {
                const int cb = hh * 128 + axis * 64 + f;
                const float x1 = bf2f(zr[cb]), x2 = bf2f(zr[cb + 32]);
                const float o1 = x1 * cs - x2 * sn, o2 = x2 * cs + x1 * sn;
                if (hh < 8) { QR[(size_t)m * 1024 + cb] = (bf16)f2bf(o1); QR[(size_t)m * 1024 + cb + 32] = (bf16)f2bf(o2); }
                else { KR[(size_t)m * 256 + cb - 1024] = (bf16)f2bf(o1); KR[(size_t)m * 256 + cb - 1024 + 32] = (bf16)f2bf(o2); }
            }
        }
    }
    {
        const float* cw = A.in[12] + (size_t)l * 3 * RW_COLS;
        for (int m = gw; m < MT; m += NGW) {
            int idx, len; if (m < ML) { idx = m & (SEQ - 1); len = SEQ; } else { idx = (m - ML) & (CL - 1); len = CL; }
            const bool hasL = idx > 0, hasR = idx < len - 1;
            const bf16* z0 = ZR + (size_t)m * ZR_W;
#pragma unroll
            for (int jj0 = 0; jj0 < LA_W; jj0 += 64) {
                const int j = jj0 + lane; const int sec = j >> 8, jj = j & 255;
                float o = 0.f;
                if (sec == 2 || jj < 192) {
                    const int scol = (sec == 0 ? 3072 : sec == 1 ? 3264 : 3456) + jj;
                    float zc = bf2f(z0[scol]) * cw[RW_COLS + scol];
                    if (hasL) zc += bf2f(z0[scol - ZR_W]) * cw[scol];
                    if (hasR) zc += bf2f(z0[scol + ZR_W]) * cw[2 * RW_COLS + scol];
                    o = sec == 0 ? ftanh(zc) : (sec == 1 ? zc : fsigmoid(zc));
                }
                LA[(size_t)m * LA_W + j] = (bf16)f2bf(o);
            }
        }
    }
    {
        const float* wa2 = A.in[23] + (size_t)l * 2 * 16 * 1024; const float* ba = A.in[24] + (size_t)l * 2 * 1024;
        for (int item = F.bid; item < 2 * (MT / 16); item += F.G) {
            const int dir = item / (MT / 16), m0 = (item % (MT / 16)) * 16, c0 = 2 * F.tid;
            float w0[16], w1[16];
#pragma unroll
            for (int r = 0; r < 16; ++r) { const f32x2 w = *(const f32x2*)(wa2 + ((size_t)dir * 16 + r) * 1024 + c0); w0[r] = w.x; w1[r] = w.y; }
            const f32x2 bb = *(const f32x2*)(ba + dir * 1024 + c0);
            for (int rr = 0; rr < 16; ++rr) {
                const int m = m0 + rr; const bf16* ac = ZR + (size_t)m * ZR_W + 3712 + dir * 16;
                float s0 = bb.x, s1 = bb.y;
#pragma unroll
                for (int r = 0; r < 16; ++r) { const float a = bf2f(ac[r]); s0 += a * w0[r]; s1 += a * w1[r]; }
                const float la0 = -fsoftplus(-s0) * 0.0625f, la1 = -fsoftplus(-s1) * 0.0625f;
                GL[(((size_t)dir * MT + m) * 1024 + c0) >> 1] = pk2(la0, la1);
            }
        }
    }
}

__device__ __forceinline__ float dpp_f(float v, const int ctrl_sel) {
    const int x = __builtin_bit_cast(int, v); int r;
    if (ctrl_sel == 0) r = __builtin_amdgcn_update_dpp(0, x, 0xB1, 0xF, 0xF, false);
    else if (ctrl_sel == 1) r = __builtin_amdgcn_update_dpp(0, x, 0x4E, 0xF, 0xF, false);
    else if (ctrl_sel == 2) r = __builtin_amdgcn_update_dpp(0, x, 0x141, 0xF, 0xF, false);
    else r = __builtin_amdgcn_update_dpp(0, x, 0x140, 0xF, 0xF, false);
    return __builtin_bit_cast(float, r);
}
__device__ __forceinline__ float red16(float v) { v += dpp_f(v, 0); v += dpp_f(v, 1); v += dpp_f(v, 2); v += dpp_f(v, 3); return v; }
__device__ __forceinline__ float red4(float v) { v += dpp_f(v, 0); v += dpp_f(v, 1); return v; }

__device__ __forceinline__ void rwkv_scan_item(const Frame& F, ArgsRef A, int l, int item, bool last) {
    const int b = item >> 5, h = (item >> 1) & 15, dir = item & 1, lane = F.lane;
    LAS float* V6 = (LAS float*)F.lds;
    LAS float* SC = V6 + 64 * 384;
    LAS float* YB = SC + 128;
    const bf16* ZR = RGN(bf16, R_ZR); const float* WDEC = RGN(float, R_WDEC); const bf16* AA = RGN(bf16, R_AA); float* Y = RGN(float, R_Y);
    const float* cw = A.in[12] + (size_t)l * 3 * RW_COLS;
    const int ch = h * 64 + lane;
    float cr[3], ck[3], cv[3];
#pragma unroll
    for (int tap = 0; tap < 3; ++tap) { cr[tap] = cw[tap * RW_COLS + ch]; ck[tap] = cw[tap * RW_COLS + 1024 + ch]; cv[tap] = cw[tap * RW_COLS + 2048 + ch]; }
    const float kkw = A.in[18][l * 1024 + ch], kaw = A.in[19][l * 1024 + ch];
    const int jq = lane & 15, si0 = (F.wave * 4 + (lane >> 4)) * 2;
    float s0[4] = {0.f, 0.f, 0.f, 0.f}, s1[4] = {0.f, 0.f, 0.f, 0.f};
    for (int chunk = 0; chunk < 36; ++chunk) {
#pragma unroll 2
        for (int q = 0; q < 8; ++q) {
            const int tt = F.wave * 8 + q; int idx, len; const int m = seq_row(b, dir, chunk * 64 + tt, idx, len);
            const bf16* z = ZR + (size_t)m * ZR_W + ch;
            float r = bf2f(z[0]) * cr[1], k = bf2f(z[1024]) * ck[1], v = bf2f(z[2048]) * cv[1];
            if (idx > 0) { r += bf2f(z[-ZR_W]) * cr[0]; k += bf2f(z[1024 - ZR_W]) * ck[0]; v += bf2f(z[2048 - ZR_W]) * cv[0]; }
            if (idx < len - 1) { r += bf2f(z[ZR_W]) * cr[2]; k += bf2f(z[1024 + ZR_W]) * ck[2]; v += bf2f(z[2048 + ZR_W]) * cv[2]; }
            const float kr = k * kkw; const float nrm = sqrtf(wave_sum(kr * kr)); const float kk = kr / fmaxf(nrm, 1e-12f);
            const float w = WDEC[((size_t)dir * MT + m) * 1024 + ch]; const float a = bf2f(AA[((size_t)dir * MT + m) * 1024 + ch]);
            const float kd = k * (1.f + (a - 1.f) * kaw), kka = kk * a;
            const float c1 = wave_sum(kka * r), c2 = wave_sum(kd * r);
            LAS float* o = V6 + tt * 384 + lane; o[0] = w; o[64] = kd; o[128] = kka; o[192] = -kk; o[256] = w * r; o[320] = v;
            if (lane == 0) { SC[tt * 2] = c1; SC[tt * 2 + 1] = c2; }
        }
        __syncthreads();
#pragma unroll 4
        for (int tt = 0; tt < 64; ++tt) {
            const LAS float* vb = V6 + tt * 384 + jq * 4;
            const f32x4 w4 = *(const LAS f32x4*)(vb), kd4 = *(const LAS f32x4*)(vb + 64), ka4 = *(const LAS f32x4*)(vb + 128), nk4 = *(const LAS f32x4*)(vb + 192), wr4 = *(const LAS f32x4*)(vb + 256);
            const f32x2 vi = *(const LAS f32x2*)(V6 + tt * 384 + 320 + si0); const f32x2 cc = *(const LAS f32x2*)(SC + tt * 2);
            float sa0 = 0.f, yp0 = 0.f, sa1 = 0.f, yp1 = 0.f;
#pragma unroll
            for (int q = 0; q < 4; ++q) { sa0 += s0[q] * nk4[q]; yp0 += s0[q] * wr4[q]; sa1 += s1[q] * nk4[q]; yp1 += s1[q] * wr4[q]; }
            sa0 = red16(sa0); yp0 = red16(yp0); sa1 = red16(sa1); yp1 = red16(yp1);
            const float y0 = yp0 + sa0 * cc.x + vi.x * cc.y, y1 = yp1 + sa1 * cc.x + vi.y * cc.y;
#pragma unroll
            for (int q = 0; q < 4; ++q) { s0[q] = s0[q] * w4[q] + sa0 * ka4[q] + vi.x * kd4[q]; s1[q] = s1[q] * w4[q] + sa1 * ka4[q] + vi.y * kd4[q]; }
            if (jq == 0) { *(LAS f32x2*)(YB + tt * 64 + si0) = (f32x2){y0, y1}; }
        }
        __syncthreads();
        if (!(last && chunk < 4)) {
            for (int e = F.tid; e < 4096; e += NTHR) { const int tt = e >> 6, i = e & 63; int idx, len; const int m = seq_row(b, dir, chunk * 64 + tt, idx, len);
                Y[((size_t)dir * MT + m) * 1024 + h * 64 + i] = YB[e]; }
        }
        __syncthreads();
    }
}


constexpr int GQ_LD = 264, GT_LD = 72;
constexpr int G_QD = 0, G_KI = G_QD + 64 * GQ_LD * 2, G_KT = G_KI + 64 * GQ_LD * 2, G_VT = G_KT + 256 * GT_LD * 2, G_AM = G_VT + 128 * GT_LD * 2, G_EBL = G_AM + 64 * GT_LD * 2, G_TQ = G_EBL + 1024, G_END = G_TQ + 4096;
static_assert(G_END <= RING_BYTES, "GLA LDS map");
__device__ __forceinline__ unsigned opq(unsigned x) { asm volatile("" : "+v"(x)); return x; }
__device__ __forceinline__ bf16x8 pack8(const f32x4& a, const f32x4& b) {
    v4u w; w.x = pg8::cvt_pk_bf16(a[0], a[1]); w.y = pg8::cvt_pk_bf16(a[2], a[3]); w.z = pg8::cvt_pk_bf16(b[0], b[1]); w.w = pg8::cvt_pk_bf16(b[2], b[3]);
    return __builtin_bit_cast(bf16x8, w);
}
#define LD_(T, addr) (*(const LAS T*)(L + (addr)))
#define ST_(T, addr) (*(LAS T*)(L + (addr)))
__device__ __forceinline__ void gla_chunk_item(const Frame& F, int item, bool last) {
    const int b = item >> 5, h = (item >> 3) & 3, dir = (item >> 2) & 1, dvs = item & 3;
    LAS unsigned char* L = F.lds;
    const int tid = F.tid, lane = F.lane, w = F.wave, l16 = lane & 15, g = lane >> 4;
    const int dp = tid & 127, qt = tid >> 7;
    const int e8 = tid & 15, jj = tid >> 4;
    const bf16* ZG = RGN(bf16, R_ZG); const bf16* GL = RGN(bf16, R_GL) + (size_t)dir * MT * 1024;
    bf16* YG = RGN(bf16, R_YG) + (size_t)dir * MT * 2048;
    const int sgn = dir ? -1 : 1;
    const unsigned a_pq = opq(G_QD + ((16 * qt) * GQ_LD + 2 * dp) * 2);
    const unsigned a_pkt = opq(G_KT + ((2 * dp) * GT_LD + 16 * qt) * 2);
    const unsigned a_pvt = opq(G_VT + ((8 * e8) * GT_LD + jj) * 2);
    const unsigned a_ptq = opq(G_TQ + (2 * dp) * 4);
    const unsigned a_f8 = opq((l16 * GQ_LD + 8 * g) * 2);
    const unsigned a_f4 = opq(G_QD + (l16 * GQ_LD + 4 * g) * 2);
    const unsigned a_t8 = opq((l16 * GT_LD + 8 * g) * 2);
    const unsigned a_ebl = opq(G_EBL + 16 * g);
    f32x4 S[16];
#pragma unroll
    for (int t = 0; t < 16; ++t) S[t] = (f32x4){0.f, 0.f, 0.f, 0.f};
    unsigned rq[16], rk[16], rl[16]; v4u rv0, rv1;
#define GLA_ISSUE(chunk) do { int idx_, len_; const int r0_ = seq_row(b, dir, (chunk) * 64, idx_, len_); \
        const bf16* pz_ = ZG + (size_t)(r0_ + sgn * 16 * qt) * ZG_W + h * 256 + 2 * dp; const bf16* pl_ = GL + (size_t)(r0_ + sgn * 16 * qt) * 1024 + h * 256 + 2 * dp; \
        const long sz_ = (long)sgn * ZG_W, sl_ = (long)sgn * 1024; \
        _Pragma("unroll") for (int i = 0; i < 16; ++i) { asm volatile("" : "+v"(pz_), "+v"(pl_)); \
            rq[i] = *(const unsigned*)pz_; rk[i] = *(const unsigned*)(pz_ + 1024); rl[i] = *(const unsigned*)pl_; pz_ += sz_; pl_ += sl_; } \
        const bf16* pv_ = ZG + (size_t)(r0_ + sgn * jj) * ZG_W + 2048 + h * 512 + dvs * 128 + 8 * e8; \
        rv0 = *(const v4u*)pv_; rv1 = *(const v4u*)(pv_ + sz_ * 32); } while (0)
    GLA_ISSUE(0);
    for (int chunk = 0; chunk < 36; ++chunk) {
        int idx0, len0; const int r0 = seq_row(b, dir, chunk * 64, idx0, len0);
        {
            float s0 = 0.f, s1 = 0.f;
#pragma unroll
            for (int i = 0; i < 16; ++i) { s0 += bflo(rl[i]); s1 += bfhi(rl[i]); }
            ST_(f32x2, a_ptq + qt * 1024) = (f32x2){s0, s1};
        }
        __syncthreads();
        {
            float o0 = 0.f, o1 = 0.f, t0 = 0.f, t1 = 0.f;
#pragma unroll
            for (int q = 0; q < 4; ++q) { const f32x2 tq = LD_(f32x2, a_ptq + q * 1024); if (q < qt) { o0 += tq.x; o1 += tq.y; } t0 += tq.x; t1 += tq.y; }
            if (qt == 0) ST_(f32x2, G_EBL + 2 * dp * 4) = (f32x2){__expf(t0), __expf(t1)};
            unsigned kt0[8], kt1[8];
#pragma unroll
            for (int i = 0; i < 16; ++i) {
                o0 += bflo(rl[i]); o1 += bfhi(rl[i]);
                const float e0 = __expf(o0), e1 = __expf(o1), n0 = __expf(-o0), n1 = __expf(-o1);
                const unsigned qd = pg8::cvt_pk_bf16(bflo(rq[i]) * 0.0625f * e0, bfhi(rq[i]) * 0.0625f * e1);
                const unsigned ki = pg8::cvt_pk_bf16(bflo(rk[i]) * n0, bfhi(rk[i]) * n1);
                ST_(unsigned, a_pq + i * GQ_LD * 2) = qd;
                ST_(unsigned, a_pq + (G_KI - G_QD) + i * GQ_LD * 2) = ki;
                if (i & 1) { kt0[i >> 1] |= (ki << 16); kt1[i >> 1] |= (ki & 0xffff0000u); }
                else { kt0[i >> 1] = ki & 0xffffu; kt1[i >> 1] = ki >> 16; }
                asm volatile("" ::: "memory");
            }
            ST_(v4u, a_pkt) = (v4u){kt0[0], kt0[1], kt0[2], kt0[3]};
            ST_(v4u, a_pkt + 16) = (v4u){kt0[4], kt0[5], kt0[6], kt0[7]};
            ST_(v4u, a_pkt + GT_LD * 2) = (v4u){kt1[0], kt1[1], kt1[2], kt1[3]};
            ST_(v4u, a_pkt + GT_LD * 2 + 16) = (v4u){kt1[4], kt1[5], kt1[6], kt1[7]};
            const unsigned vv0[4] = {rv0.x, rv0.y, rv0.z, rv0.w}, vv1[4] = {rv1.x, rv1.y, rv1.z, rv1.w};
#pragma unroll
            for (int x = 0; x < 4; ++x) {
                ST_(unsigned short, a_pvt + (2 * x) * GT_LD * 2) = (unsigned short)(vv0[x] & 0xffffu);
                ST_(unsigned short, a_pvt + (2 * x + 1) * GT_LD * 2) = (unsigned short)(vv0[x] >> 16);
                ST_(unsigned short, a_pvt + (2 * x) * GT_LD * 2 + 64) = (unsigned short)(vv1[x] & 0xffffu);
                ST_(unsigned short, a_pvt + (2 * x + 1) * GT_LD * 2 + 64) = (unsigned short)(vv1[x] >> 16);
            }
        }
        __syncthreads();
        if (chunk + 1 < 36) GLA_ISSUE(chunk + 1);
#pragma unroll
        for (int tt = 0; tt < 2; ++tt) {
            const int t = 2 * w + tt, jt = t >> 2, it = t & 3;
            f32x4 acc = (f32x4){0.f, 0.f, 0.f, 0.f};
            if (jt <= it) {
                const unsigned ak = a_f8 + G_KI + jt * (16 * GQ_LD * 2), aq = a_f8 + G_QD + it * (16 * GQ_LD * 2);
#pragma unroll
                for (int s = 0; s < 8; ++s) {
                    const bf16x8 a = LD_(bf16x8, ak + 64 * s);
                    const bf16x8 bb = LD_(bf16x8, aq + 64 * s);
                    acc = __builtin_amdgcn_mfma_f32_16x16x32_bf16(a, bb, acc, 0, 0, 0);
                }
            }
            const int i = 16 * it + l16, j0 = 16 * jt + 4 * g;
            const float m0 = (j0 + 0 <= i) ? acc[0] : 0.f, m1 = (j0 + 1 <= i) ? acc[1] : 0.f, m2 = (j0 + 2 <= i) ? acc[2] : 0.f, m3 = (j0 + 3 <= i) ? acc[3] : 0.f;
            ST_(v2u, G_AM + (i * GT_LD + j0) * 2) = (v2u){pg8::cvt_pk_bf16(m0, m1), pg8::cvt_pk_bf16(m2, m3)};
        }
        __syncthreads();
        {
            f32x4 O[4];
#pragma unroll
            for (int mt = 0; mt < 4; ++mt) O[mt] = (f32x4){0.f, 0.f, 0.f, 0.f};
#pragma unroll
            for (int s = 0; s < 8; ++s) {
                const bf16x8 bs = pack8(S[2 * s], S[2 * s + 1]);
#pragma unroll
                for (int mt = 0; mt < 4; ++mt) {
                    const v2u a0 = LD_(v2u, a_f4 + (16 * mt * GQ_LD + 32 * s) * 2);
                    const v2u a1 = LD_(v2u, a_f4 + (16 * mt * GQ_LD + 32 * s + 16) * 2);
                    const bf16x8 a = __builtin_bit_cast(bf16x8, (v4u){a0.x, a0.y, a1.x, a1.y});
                    O[mt] = __builtin_amdgcn_mfma_f32_16x16x32_bf16(a, bs, O[mt], 0, 0, 0);
                }
                asm volatile("" ::: "memory");
            }
            const unsigned avt = a_t8 + G_VT + w * (16 * GT_LD * 2);
            const bf16x8 vb0 = LD_(bf16x8, avt);
            const bf16x8 vb1 = LD_(bf16x8, avt + 64);
#pragma unroll
            for (int mt = 0; mt < 4; ++mt) {
                const bf16x8 a0 = LD_(bf16x8, a_t8 + G_AM + mt * (16 * GT_LD * 2));
                O[mt] = __builtin_amdgcn_mfma_f32_16x16x32_bf16(a0, vb0, O[mt], 0, 0, 0);
                if (mt >= 2) { const bf16x8 a1 = LD_(bf16x8, a_t8 + G_AM + mt * (16 * GT_LD * 2) + 64);
                    O[mt] = __builtin_amdgcn_mfma_f32_16x16x32_bf16(a1, vb1, O[mt], 0, 0, 0); }
            }
            if (!(last && chunk < 4)) {
                bf16* yp = YG + (size_t)(r0 + sgn * 4 * g) * 2048 + h * 512 + dvs * 128 + 16 * w + l16;
                const long sy = (long)sgn * 2048;
#pragma unroll
                for (int mt = 0; mt < 4; ++mt) {
#pragma unroll
                    for (int r = 0; r < 4; ++r) { asm volatile("" : "+v"(yp)); yp[(long)r * sy] = (bf16)f2bf(O[mt][r]); }
                    yp += 16 * sy;
                }
            }
#pragma unroll
            for (int t = 0; t < 16; ++t) {
                const bf16x8 a0 = LD_(bf16x8, a_t8 + G_KT + t * (16 * GT_LD * 2));
                const bf16x8 a1 = LD_(bf16x8, a_t8 + G_KT + t * (16 * GT_LD * 2) + 64);
                S[t] = __builtin_amdgcn_mfma_f32_16x16x32_bf16(a0, vb0, S[t], 0, 0, 0);
                S[t] = __builtin_amdgcn_mfma_f32_16x16x32_bf16(a1, vb1, S[t], 0, 0, 0);
                const f32x4 eb = LD_(f32x4, a_ebl + 64 * t);
                S[t] = S[t] * eb;
                asm volatile("" ::: "memory");
            }
        }
        __syncthreads();
    }
#undef GLA_ISSUE
}
#undef LD_
#undef ST_

__device__ __forceinline__ void ld32bf(const bf16* p, float (&d)[32], float sc) {
#pragma unroll
    for (int i = 0; i < 4; ++i) { const v4u w = ((const v4u*)p)[i];
        d[8 * i + 0] = bflo(w.x) * sc; d[8 * i + 1] = bfhi(w.x) * sc; d[8 * i + 2] = bflo(w.y) * sc; d[8 * i + 3] = bfhi(w.y) * sc;
        d[8 * i + 4] = bflo(w.z) * sc; d[8 * i + 5] = bfhi(w.z) * sc; d[8 * i + 6] = bflo(w.w) * sc; d[8 * i + 7] = bfhi(w.w) * sc; }
}
__device__ __forceinline__ float dot32bf(const bf16* p, const float (&q)[32]) {
    float s0 = 0.f, s1 = 0.f;
#pragma unroll
    for (int i = 0; i < 4; ++i) { const v4u w = ((const v4u*)p)[i];
        s0 += q[8 * i + 0] * bflo(w.x); s1 += q[8 * i + 1] * bfhi(w.x); s0 += q[8 * i + 2] * bflo(w.y); s1 += q[8 * i + 3] * bfhi(w.y);
        s0 += q[8 * i + 4] * bflo(w.z); s1 += q[8 * i + 5] * bfhi(w.z); s0 += q[8 * i + 6] * bflo(w.w); s1 += q[8 * i + 7] * bfhi(w.w); }
    return s0 + s1;
}
__device__ __forceinline__ void attn_key(float s, bool valid, const bf16* vp, float& mx, float& lsum, float (&o)[32]) {
    s = red4(s);
    s = valid ? s : -1e30f;
    const float mn = fmaxf(mx, s);
    const float corr = __expf(mx - mn), p = __expf(s - mn);
    lsum = lsum * corr + p; mx = mn;
    if (__builtin_amdgcn_ballot_w64(corr != 1.0f) != 0ull) {
#pragma unroll
        for (int i = 0; i < 32; ++i) o[i] *= corr; }
#pragma unroll
    for (int i = 0; i < 4; ++i) { const v4u w = ((const v4u*)vp)[i];
        o[8 * i + 0] += p * bflo(w.x); o[8 * i + 1] += p * bfhi(w.x); o[8 * i + 2] += p * bflo(w.y); o[8 * i + 3] += p * bfhi(w.y);
        o[8 * i + 4] += p * bflo(w.z); o[8 * i + 5] += p * bfhi(w.z); o[8 * i + 6] += p * bflo(w.w); o[8 * i + 7] += p * bfhi(w.w); }
}
__device__ __forceinline__ void attn_store(bf16* op, const float (&o)[32], float inv) {
#pragma unroll
    for (int i = 0; i < 4; ++i) { v4u w; w.x = pk2(o[8 * i] * inv, o[8 * i + 1] * inv); w.y = pk2(o[8 * i + 2] * inv, o[8 * i + 3] * inv); w.z = pk2(o[8 * i + 4] * inv, o[8 * i + 5] * inv); w.w = pk2(o[8 * i + 6] * inv, o[8 * i + 7] * inv);
        ((v4u*)op)[i] = w; }
}
__device__ __forceinline__ void attn_item(const Frame& F, ArgsRef A, int l, int item) {
    const int lane = F.lane, qi = lane >> 2, part = lane & 3;
    bf16* ZA = RGN(bf16, R_ZA); const bf16* QR = RGN(bf16, R_QR); const bf16* KR = RGN(bf16, R_KR);
    const float scale = 0.08838834764831845f;
    float o[32];
#pragma unroll
    for (int i = 0; i < 32; ++i) o[i] = 0.f;
    if (item < 8192) {
        const int qb = item & 127, hq = (item >> 7) & 7, b = item >> 10, hk = hq >> 2;
        const int t = qb * 16 + qi, m = b * SEQ + t;
        float mx = A.in[11][l * 8 + hq], lsum = 1.f;
        {
            float qr[32]; ld32bf(QR + (size_t)m * 1024 + hq * 128 + part * 32, qr, scale);
            const int j0 = (qb * 16 - 128) > 0 ? (qb * 16 - 128) : 0, j1 = (qb * 16 + 15 + 128) < (SEQ - 1) ? (qb * 16 + 15 + 128) : (SEQ - 1);
            for (int j = j0; j <= j1; ++j) {
                const float s = dot32bf(KR + (size_t)(b * SEQ + j) * 256 + hk * 128 + part * 32, qr);
                const int dlt = t - j; const bool valid = dlt <= 128 && dlt >= -128;
                attn_key(s, valid, ZA + (size_t)(b * SEQ + j) * ZA_W + 1280 + hk * 128 + part * 32, mx, lsum, o);
            }
        }
        {
            float qp[32]; ld32bf(ZA + (size_t)m * ZA_W + hq * 128 + part * 32, qp, scale);
            for (int c = 0; c < CL; ++c) {
                const bf16* kr = ZA + (size_t)(ML + b * CL + c) * ZA_W + 1024 + hk * 128 + part * 32;
                const float s = dot32bf(kr, qp);
                attn_key(s, true, kr + 256, mx, lsum, o);
            }
        }
        attn_store(ZA + (size_t)m * ZA_W + hq * 128 + part * 32, o, 1.0f / lsum);
    } else {
        const int it = item - 8192; const int qb = it & 15, hq = (it >> 4) & 7, b = it >> 7, hk = hq >> 2;
        const int m = ML + b * CL + qb * 16 + qi;
        float mx = A.in[11][l * 8 + hq], lsum = 1.f;
        float qp[32]; ld32bf(ZA + (size_t)m * ZA_W + hq * 128 + part * 32, qp, scale);
        for (int c = 0; c < CL; ++c) {
            const bf16* kr = ZA + (size_t)(ML + b * CL + c) * ZA_W + 1024 + hk * 128 + part * 32;
            const float s = dot32bf(kr, qp);
            attn_key(s, true, kr + 256, mx, lsum, o);
        }
        attn_store(ZA + (size_t)m * ZA_W + hq * 128 + part * 32, o, 1.0f / lsum);
    }
}

__device__ __forceinline__ void phase_mix(const Frame& F, ArgsRef A, int l, bool last) {
#ifndef ONLY_GLA
    for (int item = F.bid; item < 256; item += F.G) rwkv_scan_item(F, A, l, item, last);
#endif
    for (int item = F.bid; item < 256; item += F.G) gla_chunk_item(F, item, last);
#ifdef ONLY_GLA
    return;
#endif
    const int gw = F.bid * NWAVES + F.wave, NGW = F.G * NWAVES;
    const int nitems = last ? 8192 : 8192 + 1024;
    for (int item = gw; item < nitems; item += NGW) attn_item(F, A, l, item);
}

__device__ __forceinline__ void phase_mixout(const Frame& F, ArgsRef A, int l, int nrows) {
    const int gw = F.bid * NWAVES + F.wave, NGW = F.G * NWAVES, lane = F.lane;
    {
        const bf16* ZR = RGN(bf16, R_ZR); const bf16* AA = RGN(bf16, R_AA); const float* Y = RGN(float, R_Y); const bf16* G = RGN(bf16, R_G); bf16* ORW = RGN(bf16, R_ORW);
        const float* cw = A.in[12] + (size_t)l * 3 * RW_COLS; const float* k_a = A.in[19] + l * 1024; const float* r_k = A.in[20] + l * 1024;
        const float* lnw = A.in[21] + l * 1024; const float* lnb = A.in[22] + l * 1024;
        for (int it = gw; it < nrows * 16; it += NGW) {
            const int m = it >> 4, h = it & 15, ch = h * 64 + lane;
            int idx, len; if (m < ML) { idx = m & (SEQ - 1); len = SEQ; } else { idx = (m - ML) & (CL - 1); len = CL; }
            const float o = Y[(size_t)m * 1024 + ch] + Y[((size_t)MT + m) * 1024 + ch];
            const float mean = wave_sum(o) * (1.f / 64.f); const float dv = o - mean; const float var = wave_sum(dv * dv) * (1.f / 64.f);
            const float on = dv * (1.f / sqrtf(var + 64e-5f)) * lnw[ch] + lnb[ch];
            const bf16* z = ZR + (size_t)m * ZR_W + ch;
            float r = bf2f(z[0]) * cw[RW_COLS + ch], k = bf2f(z[1024]) * cw[RW_COLS + 1024 + ch], v = bf2f(z[2048]) * cw[RW_COLS + 2048 + ch];
            if (idx > 0) { r += bf2f(z[-ZR_W]) * cw[ch]; k += bf2f(z[1024 - ZR_W]) * cw[1024 + ch]; v += bf2f(z[2048 - ZR_W]) * cw[2048 + ch]; }
            if (idx < len - 1) { r += bf2f(z[ZR_W]) * cw[2 * RW_COLS + ch]; k += bf2f(z[1024 + ZR_W]) * cw[2 * RW_COLS + 1024 + ch]; v += bf2f(z[2048 + ZR_W]) * cw[2 * RW_COLS + 2048 + ch]; }
            const float a0 = bf2f(AA[(size_t)m * 1024 + ch]), a1 = bf2f(AA[((size_t)MT + m) * 1024 + ch]);
            const float kaw = k_a[ch]; const float kd0 = k * (1.f + (a0 - 1.f) * kaw), kd1 = k * (1.f + (a1 - 1.f) * kaw);
            const float bs = wave_sum(r * (kd0 + kd1) * r_k[ch]);
            const float res = (on + bs * v) * bf2f(G[(size_t)m * 1024 + ch]);
            ORW[(size_t)m * 1024 + ch] = (bf16)f2bf(res);
        }
    }
    {
        const bf16* YG = RGN(bf16, R_YG); const bf16* ZG = RGN(bf16, R_ZG); bf16* OGL = RGN(bf16, R_OGL); const float* nw = A.in[25] + l * 512;
        const f32x4 nw0 = *(const f32x4*)(nw + lane * 8), nw1 = *(const f32x4*)(nw + lane * 8 + 4);
        for (int it = gw; it < nrows * 4; it += NGW) {
            const int m = it >> 2, h = it & 3;
            const v4u ya = *(const v4u*)(YG + (size_t)m * 2048 + h * 512 + lane * 8), yb = *(const v4u*)(YG + ((size_t)MT + m) * 2048 + h * 512 + lane * 8);
            f32x4 y0 = (f32x4){bflo(ya.x) + bflo(yb.x), bfhi(ya.x) + bfhi(yb.x), bflo(ya.y) + bflo(yb.y), bfhi(ya.y) + bfhi(yb.y)};
            f32x4 y1 = (f32x4){bflo(ya.z) + bflo(yb.z), bfhi(ya.z) + bfhi(yb.z), bflo(ya.w) + bflo(yb.w), bfhi(ya.w) + bfhi(yb.w)};
            const float ss = wave_sum((y0.x * y0.x + y0.y * y0.y) + (y0.z * y0.z + y0.w * y0.w) + (y1.x * y1.x + y1.y * y1.y) + (y1.z * y1.z + y1.w * y1.w));
            const float rs = 1.f / sqrtf(ss * (1.f / 512.f) + 1e-5f);
            const v4u gw4 = *(const v4u*)(ZG + (size_t)m * ZG_W + 4096 + h * 512 + lane * 8);
            const f32x4 g0 = (f32x4){bflo(gw4.x), bfhi(gw4.x), bflo(gw4.y), bfhi(gw4.y)}, g1 = (f32x4){bflo(gw4.z), bfhi(gw4.z), bflo(gw4.w), bfhi(gw4.w)};
            y0 = y0 * rs * nw0; y1 = y1 * rs * nw1;
            v4u w; w.x = pk2(y0.x * fsilu(g0.x), y0.y * fsilu(g0.y)); w.y = pk2(y0.z * fsilu(g0.z), y0.w * fsilu(g0.w));
            w.z = pk2(y1.x * fsilu(g1.x), y1.y * fsilu(g1.y)); w.w = pk2(y1.z * fsilu(g1.z), y1.w * fsilu(g1.w));
            *(v4u*)(OGL + (size_t)m * 2048 + h * 512 + lane * 8) = w;
        }
    }
}


#ifndef MK_ONE_LAUNCH
#define MK_ONE_LAUNCH 1
#endif

template <int K> __device__ __forceinline__ void run_phase(const Frame& F, ArgsRef A, int l) {
    const float* mods = WSP(float, WS_MODS);
    bf16* HB = WSP(bf16, WS_HB);
    const bool last = (l == DEPTH - 1);
    const float* mods_l = mods + (size_t)l * 9 * 18432;
    const float* lng = A.in[6] + (size_t)l * 3 * D; const float* lnb = A.in[7] + (size_t)l * 3 * D;
    const int nrows = last ? ML : MT;
    if constexpr (K == -1) phase_init(F, A);
    if constexpr (K == 0) {
        if (l > 0) phase_ln<true, true>(F, MT, lng - D, lnb - D, mods_l, 0, 1);
        else phase_ln<false, true>(F, MT, nullptr, nullptr, mods_l, 0, 1);
        phase_convert(F, A, l, 0, 3);
    }
    if constexpr (K == 1 || K == 12) { const int M = (K == 1) ? MT : nrows; pg8::Gemm g{HB, RGN(bf16, R_WGU), M, 2 * FF, D, D, D}; pg8::StaticOrder S; S.init(M, 2 * FF, F.G, F.bid);
        pg8::EpiSwiglu E{RGN(bf16, R_H), FF}; pg8::gemm_phase<pg8::EpiSwiglu, pg8::StaticOrder, true, true>(F.lds, g, S, E, F.tid); }
    if constexpr (K == 2 || K == 13) { const int M = (K == 2) ? MT : nrows; pg8::Gemm g{RGN(bf16, R_H), RGN(bf16, R_WDN), M, D, FF, FF, FF}; pg8::StaticOrder S; S.init(M, D, F.G, F.bid);
        pg8::EpiResid E{F.out, WSP(float, WS_XC), mods_l, (K == 2) ? 2 : 8, ALPHA, 0.5f}; pg8::gemm_phase<pg8::EpiResid, pg8::StaticOrder, true, true>(F.lds, g, S, E, F.tid); }
    if constexpr (K == 3) phase_ln<true, true>(F, MT, lng, lnb, mods_l, 3, 4);
    if constexpr (K == 4) { pg8::Gemm g{HB, WSP(bf16, WS_WM + WM_IN), MT, NMIX, D, D, D}; pg8::StaticOrder S; S.init(MT, NMIX, F.G, F.bid);
        typedef pg8::EpiBf16Seg<0, WS_R + R_ZA, WS_R + R_ZR, WS_R + R_ZG, 6, 21, ZA_W, ZR_W, ZG_W> EpiWin; EpiWin E{F.ws};
        pg8::gemm_phase<EpiWin, pg8::StaticOrder, true, true>(F.lds, g, S, E, F.tid); }
    if constexpr (K == 5) phase_prep(F, A, l);
    if constexpr (K == 6) {
        { pg8::Gemm g{RGN(bf16, R_LA), WSP(bf16, WS_WM + WM_LW), MT, 2048, 256, LA_W, 256}; pg8::StaticOrder S; S.init(MT, 2048, F.G, F.bid);
          pg8::EpiLora<0> E{RGN(float, R_WDEC), nullptr, A.in[13] + (size_t)l * 2048, (size_t)MT * 1024}; pg8::gemm_phase<pg8::EpiLora<0>, pg8::StaticOrder, true, true>(F.lds, g, S, E, F.tid); }
    }
    if constexpr (K == 15) {
        { pg8::Gemm g{RGN(bf16, R_LA) + 256, WSP(bf16, WS_WM + WM_LA), MT, 2048, 256, LA_W, 256}; pg8::StaticOrder S; S.init(MT, 2048, F.G, F.bid);
          pg8::EpiLora<1> E{nullptr, RGN(bf16, R_AA), A.in[15] + (size_t)l * 2048, (size_t)MT * 1024}; pg8::gemm_phase<pg8::EpiLora<1>, pg8::StaticOrder, true, true>(F.lds, g, S, E, F.tid); }
    }
    if constexpr (K == 16) {
        { pg8::Gemm g{RGN(bf16, R_LA) + 512, WSP(bf16, WS_WM + WM_LG), MT, 1024, 256, LA_W, 256}; pg8::StaticOrder S; S.init(MT, 1024, F.G, F.bid);
          pg8::EpiLora<2> E{nullptr, RGN(bf16, R_G), nullptr, 0}; pg8::gemm_phase<pg8::EpiLora<2>, pg8::StaticOrder, true, true>(F.lds, g, S, E, F.tid); }
    }
    if constexpr (K == 7) phase_mix(F, A, l, last);
    if constexpr (K == 8) {
        phase_mixout(F, A, l, nrows);
        __syncthreads();
        pg8::Gemm g{HB, WSP(bf16, WS_WM + WM_IN) + (size_t)NMIX * D, nrows, GT_W, D, D, D}; pg8::StaticOrder S; S.init(nrows, GT_W, F.G, F.bid);
        typedef pg8::EpiBf16Seg<1, WS_R + R_GT, WS_R + R_GT, WS_R + R_GT, 1 << 20, 1 << 20, GT_W, GT_W, GT_W> EpiGate; EpiGate E{F.ws};
        pg8::gemm_phase<EpiGate, pg8::StaticOrder, true, true>(F.lds, g, S, E, F.tid);
    }
    if constexpr (K == 9) {
        { pg8::Gemm g{RGN(bf16, R_ZA), WSP(bf16, WS_WM + WM_BA), nrows, D, 1024, ZA_W, 1024}; pg8::StaticOrder S; S.init(nrows, D, F.G, F.bid);
          pg8::EpiBranch<0> E{RGN(bf16, R_GT), GT_W, 0, RGN(float, R_MT), nullptr}; pg8::gemm_phase<pg8::EpiBranch<0>, pg8::StaticOrder, true, true>(F.lds, g, S, E, F.tid); }
        { pg8::Gemm g{RGN(bf16, R_ORW), WSP(bf16, WS_WM + WM_BR), nrows, D, 1024, 1024, 1024}; pg8::StaticOrder S; S.init(nrows, D, F.G, F.bid);
          pg8::EpiBranch<1> E{RGN(bf16, R_GT), GT_W, 2048, RGN(float, R_MT), nullptr}; pg8::gemm_phase<pg8::EpiBranch<1>, pg8::StaticOrder, true, true>(F.lds, g, S, E, F.tid); }
        { pg8::Gemm g{RGN(bf16, R_OGL), WSP(bf16, WS_WM + WM_BG), nrows, D, D, D, D}; pg8::StaticOrder S; S.init(nrows, D, F.G, F.bid);
          pg8::EpiBranch<2> E{RGN(bf16, R_GT), GT_W, 4096, RGN(float, R_MT), RGN(bf16, R_MG)}; pg8::gemm_phase<pg8::EpiBranch<2>, pg8::StaticOrder, true, true>(F.lds, g, S, E, F.tid); }
    }
    if constexpr (K == 10) { pg8::Gemm g{RGN(bf16, R_MG), WSP(bf16, WS_WM + WM_OUT), nrows, D, D, D, D}; pg8::StaticOrder S; S.init(nrows, D, F.G, F.bid);
        pg8::EpiResid E{F.out, WSP(float, WS_XC), mods_l, 5, ALPHA, 1.0f}; pg8::gemm_phase<pg8::EpiResid, pg8::StaticOrder, true, true>(F.lds, g, S, E, F.tid); }
    if constexpr (K == 11) { phase_ln<true, true>(F, nrows, lng + D, lnb + D, mods_l, 6, 7); phase_convert(F, A, l, 1, 1); }
    if constexpr (K == 14) phase_ln<true, false>(F, ML, lng + 2 * D, lnb + 2 * D, nullptr, 0, 0);
}

__device__ __forceinline__ void frame_init(Frame& F, const Args& A, unsigned char* lds_raw) {
    F.lds = (LAS unsigned char*)lds_raw;
    F.tid = threadIdx.x; F.lane = F.tid & 63; F.wave = __builtin_amdgcn_readfirstlane(F.tid >> 6);
    F.G = gridDim.x; F.bid = blockIdx.x; F.out = A.out; F.ws = A.ws;
}

template <int K> __global__ void __launch_bounds__(NTHR, 2) fwd_phase(Args A) {
    extern __shared__ __attribute__((aligned(16))) unsigned char lds_raw[];
    Frame F; frame_init(F, A, lds_raw);
    const CAS Args* ap = (const CAS Args*)__builtin_amdgcn_kernarg_segment_ptr();
    run_phase<K>(F, *ap, A.ph_lo);
}


#ifndef MK_UNROLL_LAYERS
#define MK_UNROLL_LAYERS 0
#endif
__device__ __forceinline__ void launder(Frame& F, int& l) {
    asm volatile("" : "+v"(F.tid));
    F.lane = F.tid & 63; F.wave = __builtin_amdgcn_readfirstlane(F.tid >> 6);
    asm volatile("" : "+s"(F.bid), "+s"(F.G), "+s"(l));
    asm volatile("" : "+s"(F.ws), "+s"(F.out));
}
template <int K> __device__ __forceinline__ void run_phase_l(Frame F, int l) { launder(F, l); const CAS Args* ap = (const CAS Args*)__builtin_amdgcn_kernarg_segment_ptr(); asm volatile("" : "+s"(ap)); run_phase<K>(F, *ap, l); }
template <int L> __device__ __forceinline__ void run_layer(const Frame& F, int l, const XcdBarrier& bar) {
#define PB(K) run_phase_l<K>(F, l); xcd_barrier(bar, F.tid);
    PB(0) PB(1) PB(2) PB(3) PB(4) PB(5)
    run_phase_l<6>(F, l); run_phase_l<15>(F, l); run_phase_l<16>(F, l); xcd_barrier(bar, F.tid);
    PB(7) PB(8) PB(9) PB(10) PB(11) PB(12) PB(13)
#undef PB
}
__global__ void __launch_bounds__(NTHR, 2) fwd_all(Args A) {
    extern __shared__ __attribute__((aligned(16))) unsigned char lds_raw[];
    Frame F; frame_init(F, A, lds_raw);
    volatile LAS unsigned* MISC = (volatile LAS unsigned*)(F.lds + MISC_OFF);
    for (int u = F.tid; u < (LDS_BYTES - LDSCTL_OFF) / 4; u += NTHR) ((LAS unsigned*)(F.lds + LDSCTL_OFF))[u] = 0u;
    __syncthreads();
    const XcdBarrier bar = xcd_barrier_post((unsigned*)(F.ws + WS_CTL) + 4096, MISC + 8, F.tid);
    run_phase_l<-1>(F, 0); xcd_barrier(bar, F.tid);
#if MK_UNROLL_LAYERS
    run_layer<0>(F, 0, bar); run_layer<1>(F, 1, bar);
#else
    for (int l = 0; l < DEPTH; ++l) run_layer<0>(F, l, bar);
#endif
    run_phase_l<14>(F, DEPTH - 1);
}

template <int K> static void launch_phase(const Args& a, int l, int grid, hipStream_t stream) {
    static bool attr_done = false;
    if (!attr_done) { (void)hipFuncSetAttribute((const void*)fwd_phase<K>, hipFuncAttributeMaxDynamicSharedMemorySize, LDS_BYTES); attr_done = true; }
    Args b = a; b.ph_lo = l; b.ph_hi = 0;
    hipLaunchKernelGGL(fwd_phase<K>, dim3(grid), dim3(NTHR), LDS_BYTES, stream, b);
}

extern "C" void kernel_launch(void* const* d_in, const int* in_sizes, int n_in, void* d_out, int out_size, void* d_ws, size_t ws_size, hipStream_t stream) {
    static int grid = 0;
    if (grid == 0) {
        if (n_in != 30 || out_size != ML * D || ws_size < WS_END) { fprintf(stderr, "kernel_launch: unexpected shapes (n_in %d, out %d, ws %zu < %zu)\n", n_in, out_size, ws_size, (size_t)WS_END); grid = -1; return; }
        int dev = 0, cus = 0;
        if (hipGetDevice(&dev) != hipSuccess || hipDeviceGetAttribute(&cus, hipDeviceAttributeMultiprocessorCount, dev) != hipSuccess) { grid = -1; return; }
        grid = cus;
    }
    if (grid < 0) return;
    (void)hipMemsetAsync((char*)d_ws + WS_CTL, 0, CTL_ZERO_BYTES, stream);
    Args a{};
    for (int i = 0; i < 30; ++i) a.in[i] = (const float*)d_in[i];
    a.out = (float*)d_out; a.ws = (unsigned char*)d_ws;
#if MK_ONE_LAUNCH
    {
        static bool attr_done = false;
        if (!attr_done) { int per_cu = 0;
            if (hipFuncSetAttribute((const void*)fwd_all, hipFuncAttributeMaxDynamicSharedMemorySize, LDS_BYTES) != hipSuccess) { fprintf(stderr, "kernel_launch: hipFuncSetAttribute failed\n"); grid = -1; return; }
            if (hipOccupancyMaxActiveBlocksPerMultiprocessor(&per_cu, (const void*)fwd_all, NTHR, LDS_BYTES) != hipSuccess || per_cu < 1) { fprintf(stderr, "kernel_launch: occupancy query says %d blocks per CU; not launching\n", per_cu); (void)hipGetLastError(); grid = -1; return; }
            attr_done = true; }
        a.ph_lo = 0; a.ph_hi = 0;
        hipLaunchKernelGGL(fwd_all, dim3(grid), dim3(NTHR), LDS_BYTES, stream, a);
        return;
    }
#endif
    launch_phase<-1>(a, 0, grid, stream);
    for (int l = 0; l < DEPTH; ++l) {
        launch_phase<0>(a, l, grid, stream); launch_phase<1>(a, l, grid, stream); launch_phase<2>(a, l, grid, stream); launch_phase<3>(a, l, grid, stream);
        launch_phase<4>(a, l, grid, stream); launch_phase<5>(a, l, grid, stream); launch_phase<6>(a, l, grid, stream); launch_phase<15>(a, l, grid, stream); launch_phase<16>(a, l, grid, stream); launch_phase<7>(a, l, grid, stream);
        launch_phase<8>(a, l, grid, stream); launch_phase<9>(a, l, grid, stream); launch_phase<10>(a, l, grid, stream); launch_phase<11>(a, l, grid, stream);
        launch_phase<12>(a, l, grid, stream); launch_phase<13>(a, l, grid, stream);
    }
    launch_phase<14>(a, DEPTH - 1, grid, stream);
}
```

```cpp
#include <hip/hip_runtime.h>
#include <cstdio>
#include <cstdint>

#define GAS __attribute__((address_space(1)))
#define LAS __attribute__((address_space(3)))
typedef unsigned short bf16;
typedef unsigned v4u __attribute__((ext_vector_type(4)));
typedef unsigned v2u __attribute__((ext_vector_type(2)));
typedef float f32x4 __attribute__((ext_vector_type(4)));
typedef float f32x2 __attribute__((ext_vector_type(2)));
typedef short bf16x8 __attribute__((ext_vector_type(8)));

__device__ __forceinline__ float bf2f(unsigned short b) { return __builtin_bit_cast(float, ((unsigned)b) << 16); }
__device__ __forceinline__ float bflo(unsigned w) { return __builtin_bit_cast(float, w << 16); }
__device__ __forceinline__ float bfhi(unsigned w) { return __builtin_bit_cast(float, w & 0xffff0000u); }
__device__ __forceinline__ unsigned f2bf(float f) { unsigned u = __builtin_bit_cast(unsigned, f); return (u + 0x7fffu + ((u >> 16) & 1u)) >> 16; }
__device__ __forceinline__ unsigned pk2(float lo, float hi) { return f2bf(lo) | (f2bf(hi) << 16); }
template <int CTRL, int ROW_MASK> __device__ __forceinline__ float dppf(float v) {
    return __builtin_bit_cast(float, __builtin_amdgcn_update_dpp(0, __builtin_bit_cast(int, v), CTRL, ROW_MASK, 0xF, false)); }
__device__ __forceinline__ float wave_sum(float v) {
    v += dppf<0xB1, 0xF>(v);
    v += dppf<0x4E, 0xF>(v);
    v += dppf<0x141, 0xF>(v);
    v += dppf<0x140, 0xF>(v);
    v += dppf<0x142, 0xA>(v);
    v += dppf<0x143, 0xC>(v);
    return __builtin_bit_cast(float, __builtin_amdgcn_readlane(__builtin_bit_cast(int, v), 63));
}
__device__ __forceinline__ void half_swap(float& a, float& b) { asm volatile("v_nop\n\tv_nop\n\tv_permlane32_swap_b32 %0, %1\n\tv_nop\n\tv_nop" : "+v"(a), "+v"(b)); }
__device__ __forceinline__ float xhalf_max(float v) { float a = v, b = v; half_swap(a, b); return fmaxf(a, b); }
__device__ __forceinline__ float xhalf_sum(float v) { float a = v, b = v; half_swap(a, b); return a + b; }
__device__ __forceinline__ float fsigmoid(float x) { return 1.0f / (1.0f + __expf(-x)); }
__device__ __forceinline__ float fsilu(float x) { return x / (1.0f + __expf(-x)); }
__device__ __forceinline__ float fsoftplus(float x) { return fmaxf(x, 0.f) + __logf(1.0f + __expf(-fabsf(x))); }
__device__ __forceinline__ float ftanh(float x) { const float e = __expf(-2.0f * fabsf(x)); const float t = (1.0f - e) / (1.0f + e); return x < 0.f ? -t : t; }

namespace pg8 {
#define PG8_LAS __attribute__((address_space(3)))
typedef unsigned short bf16_t;
typedef short bf16x8 __attribute__((ext_vector_type(8)));
typedef float f32x4 __attribute__((ext_vector_type(4)));
typedef unsigned u32x4 __attribute__((ext_vector_type(4)));
constexpr int BM = 256, BK = 64, HALF = 128, HTB = HALF * BK * 2  , STAGE_BYTES = 8 * HTB, NXCD = 8, WGM = 8;

__host__ __device__ __forceinline__ int lds_byte(int r, int c) { const int st = (r >> 4) * 2 + (c >> 5), rr = r & 15, cc = c & 31, ob = rr * 64 + cc * 2; return st * 1024 + (ob ^ (((ob >> 9) & 1) << 5)); }
__host__ __device__ __forceinline__ void stage_rc(int b, int& R, int& C) { const int st = b / 1024, sb = b % 1024, swz = sb ^ (((sb >> 9) & 1) << 5); R = (st >> 1) * 16 + swz / 64; C = (st & 1) * 32 + (swz % 64) / 2; }
__host__ __device__ __forceinline__ int perm32(int rho) { const int n = rho >> 4, i = rho & 15; return 8 * (i >> 2) + 4 * n + (i & 3); }

struct Unit { int pm, pn; };
struct Gemm { const bf16_t* A; const bf16_t* Bt; int M, N, K, lda, ldb; };

struct StaticOrder {
    int nM, nN, nwg, G, c;
    __host__ __device__ void init(int M, int N, int G_, int c_) { nM = M / BM; nN = N / BM; nwg = nM * nN; G = G_; c = c_; }
    __host__ __device__ bool next(int i, Unit& u) const {
        const long L = (long)i * G + c; if (L >= nwg) return false;
        int wgid = (int)L; { const int q = nwg / NXCD, r = nwg % NXCD, xcd = wgid % NXCD, off = wgid / NXCD; wgid = (xcd < r ? xcd * (q + 1) : r * (q + 1) + (xcd - r) * q) + off; }
        const int nig = WGM * nN, gid = wgid / nig, fm = gid * WGM, gsz = (nM - fm) < WGM ? (nM - fm) : WGM;
        u.pm = fm + ((wgid % nig) % gsz); u.pn = (wgid % nig) / gsz; return true;
    }
    __device__ __forceinline__ void a_ready(const Unit&) const {}
    __device__ __forceinline__ void done(const Unit&) const {}
};

typedef __bf16 bf2_t_ __attribute__((ext_vector_type(2)));
typedef float f2_t_ __attribute__((ext_vector_type(2)));
__device__ __forceinline__ unsigned cvt_pk_bf16(float lo, float hi) { const f2_t_ v = {lo, hi}; return __builtin_bit_cast(unsigned, __builtin_convertvector(v, bf2_t_)); }

#define EPI_ROWS_BEGIN \
    _Pragma("unroll") for (int ai = 0; ai < 2; ++ai) _Pragma("unroll") for (int m = 0; m < 4; ++m) { const int row = u.pm * BM + ai * HALF + wr * 64 + m * 16 + fr;
#define EPI_ROWS_END }

template <int ACT, size_t O0, size_t O1, size_t O2, int T1, int T2, int L0, int L1, int L2> struct EpiBf16Seg {
    static constexpr bool PERM = true, AFTER_DRAIN = false;
    unsigned char* ws;
    __device__ __forceinline__ void operator()(const f32x4 (&acc)[2][2][4][2], const Unit& u, int wr, int wc, int fr, int fq) const {
        const size_t off = u.pn >= T2 ? O2 : (u.pn >= T1 ? O1 : O0); const int l = u.pn >= T2 ? L2 : (u.pn >= T1 ? L1 : L0), tb = u.pn >= T2 ? T2 : (u.pn >= T1 ? T1 : 0);
        bf16_t* base = (bf16_t*)(ws + off);
        const int col0 = (u.pn - tb) * BM + wc * 32 + 8 * fq;
        EPI_ROWS_BEGIN
            bf16_t* rowp = base + (size_t)row * l + col0;
#pragma unroll
            for (int bj = 0; bj < 2; ++bj) { f32x4 v0 = acc[ai][bj][m][0], v1 = acc[ai][bj][m][1];
                if (ACT == 1) {
#pragma unroll
                    for (int j = 0; j < 4; ++j) { v0[j] = fsigmoid(v0[j]); v1[j] = fsigmoid(v1[j]); } }
                u32x4 w; w.x = cvt_pk_bf16(v0[0], v0[1]); w.y = cvt_pk_bf16(v0[2], v0[3]); w.z = cvt_pk_bf16(v1[0], v1[1]); w.w = cvt_pk_bf16(v1[2], v1[3]);
                *(u32x4*)(rowp + bj * HALF) = w; }
        EPI_ROWS_END
    }
};
struct EpiSwiglu {
    static constexpr bool PERM = true, AFTER_DRAIN = false;
    bf16_t* H; int ldh;
    __device__ __forceinline__ void operator()(const f32x4 (&acc)[2][2][4][2], const Unit& u, int wr, int wc, int fr, int fq) const {
        const int col0 = u.pn * HALF + wc * 32 + 8 * fq;
        EPI_ROWS_BEGIN
            f32x4 g0 = acc[ai][0][m][0], g1 = acc[ai][0][m][1]; const f32x4 u0 = acc[ai][1][m][0], u1 = acc[ai][1][m][1];
#pragma unroll
            for (int j = 0; j < 4; ++j) { g0[j] = fsilu(g0[j]) * u0[j]; g1[j] = fsilu(g1[j]) * u1[j]; }
            u32x4 w; w.x = cvt_pk_bf16(g0[0], g0[1]); w.y = cvt_pk_bf16(g0[2], g0[3]); w.z = cvt_pk_bf16(g1[0], g1[1]); w.w = cvt_pk_bf16(g1[2], g1[3]);
            *(u32x4*)(H + (size_t)row * ldh + col0) = w;
        EPI_ROWS_END
    }
};
struct EpiResid {
    static constexpr bool PERM = true, AFTER_DRAIN = false;
    float* xl; float* xc; const float* mods; int kmod; float alpha, coef;
    __device__ __forceinline__ void operator()(const f32x4 (&acc)[2][2][4][2], const Unit& u, int wr, int wc, int fr, int fq) const {
        const int bsel = u.pm < 64 ? (u.pm >> 3) : 8;
        const float* mp = mods + (size_t)bsel * (9 * 2048) + kmod * 2048;
        float* xb = u.pm < 64 ? xl : xc - (size_t)16384 * 2048;
        const int col0 = u.pn * BM + wc * 32 + 8 * fq;
        f32x4 mv[2][2];
#pragma unroll
        for (int bj = 0; bj < 2; ++bj)
#pragma unroll
            for (int n = 0; n < 2; ++n) mv[bj][n] = *(const f32x4*)(mp + col0 + bj * HALF + 4 * n) * coef;
        EPI_ROWS_BEGIN
            float* rowp = xb + (size_t)row * 2048 + col0;
#pragma unroll
            for (int bj = 0; bj < 2; ++bj)
#pragma unroll
                for (int n = 0; n < 2; ++n) { f32x4* p = (f32x4*)(rowp + bj * HALF + 4 * n); const f32x4 x = *p; *p = x * alpha + mv[bj][n] * acc[ai][bj][m][n]; }
            asm volatile("" ::: "memory");
        EPI_ROWS_END
    }
};
template <int MODE> struct EpiBranch {
    static constexpr bool PERM = true, AFTER_DRAIN = false;
    const bf16_t* GT; int ldg, goff; float* T; bf16_t* O;
    __device__ __forceinline__ void operator()(const f32x4 (&acc)[2][2][4][2], const Unit& u, int wr, int wc, int fr, int fq) const {
        const int col0 = u.pn * BM + wc * 32 + 8 * fq;
        EPI_ROWS_BEGIN
#pragma unroll
            for (int bj = 0; bj < 2; ++bj) {
                const u32x4 gw = *(const u32x4*)(GT + (size_t)row * ldg + goff + col0 + bj * HALF);
                f32x4 g0 = (f32x4){bflo(gw.x), bfhi(gw.x), bflo(gw.y), bfhi(gw.y)}, g1 = (f32x4){bflo(gw.z), bfhi(gw.z), bflo(gw.w), bfhi(gw.w)};
                f32x4 v0 = g0 * acc[ai][bj][m][0], v1 = g1 * acc[ai][bj][m][1];
                float* tp = T + (size_t)row * 2048 + col0 + bj * HALF;
                if (MODE >= 1) { v0 += *(const f32x4*)tp; v1 += *(const f32x4*)(tp + 4); }
                if (MODE <= 1) { *(f32x4*)tp = v0; *(f32x4*)(tp + 4) = v1; }
                else { u32x4 w; w.x = cvt_pk_bf16(v0[0], v0[1]); w.y = cvt_pk_bf16(v0[2], v0[3]); w.z = cvt_pk_bf16(v1[0], v1[1]); w.w = cvt_pk_bf16(v1[2], v1[3]);
                    *(u32x4*)(O + (size_t)row * 2048 + col0 + bj * HALF) = w; }
            }
            asm volatile("" ::: "memory");
        EPI_ROWS_END
    }
};
template <int MODE> struct EpiLora {
    static constexpr bool PERM = true, AFTER_DRAIN = false;
    float* WD; bf16_t* OB; const float* bias; size_t dstride;
    __device__ __forceinline__ void operator()(const f32x4 (&acc)[2][2][4][2], const Unit& u, int wr, int wc, int fr, int fq) const {
        const int colg = u.pn * BM + wc * 32 + 8 * fq;
        EPI_ROWS_BEGIN
#pragma unroll
            for (int bj = 0; bj < 2; ++bj) { const int cg = colg + bj * HALF; const int dir = (MODE == 2) ? 0 : (cg >> 10); const int c = (MODE == 2) ? cg : (cg & 1023);
                f32x4 v0 = acc[ai][bj][m][0], v1 = acc[ai][bj][m][1];
                if (MODE != 2) { v0 += *(const f32x4*)(bias + cg); v1 += *(const f32x4*)(bias + cg + 4); }
                if (MODE == 0) {
#pragma unroll
                    for (int j = 0; j < 4; ++j) { v0[j] = __expf(-__expf(-fsoftplus(-v0[j]) - 0.5f)); v1[j] = __expf(-__expf(-fsoftplus(-v1[j]) - 0.5f)); }
                    float* p = WD + (size_t)dir * dstride + (size_t)row * 1024 + c; *(f32x4*)p = v0; *(f32x4*)(p + 4) = v1;
                } else {
                    if (MODE == 1) {
#pragma unroll
                        for (int j = 0; j < 4; ++j) { v0[j] = fsigmoid(v0[j]); v1[j] = fsigmoid(v1[j]); } }
                    u32x4 w; w.x = cvt_pk_bf16(v0[0], v0[1]); w.y = cvt_pk_bf16(v0[2], v0[3]); w.z = cvt_pk_bf16(v1[0], v1[1]); w.w = cvt_pk_bf16(v1[2], v1[3]);
                    *(u32x4*)(OB + (size_t)dir * dstride + (size_t)row * 1024 + c) = w;
                }
            }
            asm volatile("" ::: "memory");
        EPI_ROWS_END
    }
};

template <class Epi, class Sched, bool ALIGN_EPI = false, bool SP2 = false>
__device__ __forceinline__ void gemm_phase(PG8_LAS unsigned char* lds, const Gemm g, const Sched& S, const Epi& E, int tid_in) {
    int tid_ = tid_in; asm volatile("" : "+v"(tid_));
    const int tid = tid_, wid = __builtin_amdgcn_readfirstlane(tid >> 6), lane = tid & 63, wr = wid >> 2, wc = wid & 3, fr = lane & 15, fq = lane >> 4;
    int K_ = g.K, lda_ = g.lda, ldb_ = g.ldb; asm volatile("" : "+s"(K_), "+s"(lda_), "+s"(ldb_));
    const int K = K_, nt = K / BK, lda = lda_, ldb = ldb_;
    unsigned voffA[2], voffB[2];
#pragma unroll
    for (int i = 0; i < 2; ++i) { int R, C; stage_rc(tid * 16 + i * 8192, R, C); const int Rb = Epi::PERM ? ((R & ~31) + perm32(R & 31)) : R;
        voffA[i] = (unsigned)(R * lda + C) * 2u; voffB[i] = (unsigned)(Rb * ldb + C) * 2u; }
    const size_t kstep = (size_t)(BK * 2);
    const size_t hsA = (size_t)HALF * lda * 2, hsB = (size_t)HALF * ldb * 2;
    const size_t tsA = 2 * hsA, tsB = 2 * hsB;
    const unsigned ldsw = (unsigned)wid * 1024u;
    const int aoff = lds_byte(wr * 64 + fr, fq * 8), boff = lds_byte(wc * 32 + fr, fq * 8);
#define PG8_SA(b, h) (((b) * 2 + (h)) * HTB)
#define PG8_SB(b, h) ((4 + (b) * 2 + (h)) * HTB)
#define PG8_STAGE(bufoff, gbase, voff) do { _Pragma("unroll") for (int _i = 0; _i < 2; ++_i) \
        __builtin_amdgcn_global_load_lds((const unsigned*)((const char*)(gbase) + (voff)[_i]), (PG8_LAS unsigned*)(lds + (bufoff) + ldsw + _i * 8192), 16, 0, 0); } while (0)
#define PG8_LDA(dst, b, h) do { _Pragma("unroll") for (int m = 0; m < 4; ++m) _Pragma("unroll") for (int k = 0; k < 2; ++k) dst[m][k] = *(const PG8_LAS bf16x8*)(lds + PG8_SA(b, h) + aoff + m * 2048 + k * 1024); } while (0)
#define PG8_LDB(dst, b, h) do { _Pragma("unroll") for (int n = 0; n < 2; ++n) _Pragma("unroll") for (int k = 0; k < 2; ++k) dst[n][k] = *(const PG8_LAS bf16x8*)(lds + PG8_SB(b, h) + boff + n * 2048 + k * 1024); } while (0)
#define PG8_MMA(ai, bj, At, Bt) do { __builtin_amdgcn_s_setprio(1); _Pragma("unroll") for (int m = 0; m < 4; ++m) _Pragma("unroll") for (int n = 0; n < 2; ++n) _Pragma("unroll") for (int k = 0; k < 2; ++k) \
        acc[ai][bj][m][n] = __builtin_amdgcn_mfma_f32_16x16x32_bf16(Bt[n][k], At[m][k], acc[ai][bj][m][n], 0, 0, 0); __builtin_amdgcn_s_setprio(0); } while (0)
#define PG8_WAIT_V(n) asm volatile("s_waitcnt vmcnt(" #n ")" ::: "memory")
#define PG8_WAIT_L(n) asm volatile("s_waitcnt lgkmcnt(" #n ")" ::: "memory")
#define PG8_BAR __builtin_amdgcn_s_barrier()
#define PG8_SCHED __builtin_amdgcn_sched_barrier(0)
    Unit cur, nxt; int ui = 0;
    if (!S.next(0, cur)) return;
    f32x4 acc[2][2][4][2];
#pragma unroll
    for (int a = 0; a < 2; ++a)
#pragma unroll
        for (int b = 0; b < 2; ++b)
#pragma unroll
            for (int m = 0; m < 4; ++m)
#pragma unroll
                for (int n = 0; n < 2; ++n) acc[a][b][m][n] = (f32x4){0.f, 0.f, 0.f, 0.f};
    bf16x8 At[4][2], B0[2][2], B1[2][2];
    const char* cA = (const char*)g.A + (size_t)cur.pm * tsA; const char* cB = (const char*)g.Bt + (size_t)cur.pn * tsB;
    S.a_ready(cur);
    if constexpr (SP2) {
        PG8_STAGE(PG8_SB(0, 0), cB, voffB); PG8_STAGE(PG8_SB(0, 1), cB + hsB, voffB); PG8_STAGE(PG8_SA(0, 0), cA, voffA); PG8_STAGE(PG8_SA(0, 1), cA + hsA, voffA);
        if (wr == 1) PG8_BAR;
        PG8_WAIT_V(2); PG8_BAR;
        PG8_STAGE(PG8_SB(1, 0), cB + kstep, voffB); PG8_STAGE(PG8_SA(1, 0), cA + kstep, voffA); PG8_STAGE(PG8_SB(1, 1), cB + hsB + kstep, voffB);
        PG8_WAIT_V(6); PG8_BAR;
    } else {
        PG8_STAGE(PG8_SB(0, 0), cB, voffB); PG8_STAGE(PG8_SA(0, 0), cA, voffA); PG8_STAGE(PG8_SB(0, 1), cB + hsB, voffB); PG8_STAGE(PG8_SA(0, 1), cA + hsA, voffA);
        if (wr == 1) PG8_BAR;
        PG8_WAIT_V(4); PG8_BAR;
        PG8_STAGE(PG8_SB(1, 0), cB + kstep, voffB); PG8_STAGE(PG8_SA(1, 0), cA + kstep, voffA); PG8_STAGE(PG8_SB(1, 1), cB + hsB + kstep, voffB);
        PG8_WAIT_V(6); PG8_BAR;
    }
    for (;;) {
        const bool has_next = S.next(ui + 1, nxt);
        const char* nA = has_next ? (const char*)g.A + (size_t)nxt.pm * tsA : cA; const char* nB = has_next ? (const char*)g.Bt + (size_t)nxt.pn * tsB : cB;
        for (int t = 0; t < nt; t += 2) {
            const bool last = (t == nt - 2);
            const char* a1 = cA + (size_t)(t + 1) * kstep;
            const char* a2 = last ? nA : cA + (size_t)(t + 2) * kstep; const char* b2 = last ? nB : cB + (size_t)(t + 2) * kstep;
            const char* a3 = a2 + kstep; const char* b3 = b2 + kstep;
            if (last && has_next) S.a_ready(nxt);
            if constexpr (SP2) {
            PG8_LDB(B0, 0, 0); PG8_LDB(B1, 0, 1); PG8_SCHED; PG8_LDA(At, 0, 0); PG8_STAGE(PG8_SA(1, 1), a1 + hsA, voffA);
            PG8_WAIT_V(8); PG8_WAIT_L(0); PG8_BAR; PG8_MMA(0, 0, At, B0); PG8_MMA(0, 1, At, B1); PG8_BAR; PG8_SCHED;
            PG8_LDA(At, 0, 1); PG8_STAGE(PG8_SB(0, 0), b2, voffB); PG8_STAGE(PG8_SB(0, 1), b2 + hsB, voffB); PG8_STAGE(PG8_SA(0, 0), a2, voffA);
            PG8_WAIT_V(8); PG8_WAIT_L(0); PG8_BAR; PG8_MMA(1, 0, At, B0); PG8_MMA(1, 1, At, B1); PG8_BAR; PG8_SCHED;
            PG8_LDB(B0, 1, 0); PG8_LDB(B1, 1, 1); PG8_SCHED; PG8_LDA(At, 1, 0); PG8_STAGE(PG8_SA(0, 1), a2 + hsA, voffA);
            PG8_WAIT_V(8); PG8_WAIT_L(0); PG8_BAR; PG8_MMA(0, 0, At, B0); PG8_MMA(0, 1, At, B1); PG8_BAR; PG8_SCHED;
            PG8_LDA(At, 1, 1); PG8_STAGE(PG8_SB(1, 0), b3, voffB); PG8_STAGE(PG8_SB(1, 1), b3 + hsB, voffB); PG8_STAGE(PG8_SA(1, 0), a3, voffA);
            PG8_WAIT_V(8); PG8_WAIT_L(0); PG8_BAR; PG8_MMA(1, 0, At, B0); PG8_MMA(1, 1, At, B1); PG8_BAR; PG8_SCHED;
            } else {
            PG8_LDB(B0, 0, 0); PG8_SCHED; PG8_LDA(At, 0, 0); PG8_STAGE(PG8_SA(1, 1), a1 + hsA, voffA);
            PG8_WAIT_L(8); PG8_BAR; PG8_WAIT_L(0); PG8_MMA(0, 0, At, B0); PG8_BAR; PG8_SCHED;
            PG8_LDB(B1, 0, 1); PG8_STAGE(PG8_SB(0, 0), b2, voffB);
            PG8_BAR; PG8_WAIT_L(0); PG8_MMA(0, 1, At, B1); PG8_BAR;
            PG8_LDA(At, 0, 1); PG8_STAGE(PG8_SA(0, 0), a2, voffA);
            PG8_BAR; PG8_WAIT_L(0); PG8_MMA(1, 0, At, B0); PG8_BAR; PG8_SCHED;
            PG8_STAGE(PG8_SB(0, 1), b2 + hsB, voffB);
            PG8_WAIT_V(6); PG8_BAR; PG8_MMA(1, 1, At, B1); PG8_BAR;
            PG8_LDB(B0, 1, 0); PG8_SCHED; PG8_LDA(At, 1, 0); PG8_STAGE(PG8_SA(0, 1), a2 + hsA, voffA);
            PG8_WAIT_L(8); PG8_BAR; PG8_WAIT_L(0); PG8_MMA(0, 0, At, B0); PG8_BAR; PG8_SCHED;
            PG8_LDB(B1, 1, 1); PG8_STAGE(PG8_SB(1, 0), b3, voffB);
            PG8_BAR; PG8_WAIT_L(0); PG8_MMA(0, 1, At, B1); PG8_BAR;
            PG8_LDA(At, 1, 1); PG8_STAGE(PG8_SA(1, 0), a3, voffA);
            PG8_BAR; PG8_WAIT_L(0); PG8_MMA(1, 0, At, B0); PG8_BAR; PG8_SCHED;
            PG8_STAGE(PG8_SB(1, 1), b3 + hsB, voffB);
            PG8_WAIT_V(6); PG8_BAR; PG8_MMA(1, 1, At, B1); PG8_BAR;
            }
        }
        if constexpr (ALIGN_EPI) { if (wr == 0) PG8_BAR; }
        if constexpr (!Epi::AFTER_DRAIN) { E(acc, cur, wr, wc, fr, fq); S.done(cur); }
        if (!has_next) break;
#pragma unroll
        for (int a = 0; a < 2; ++a)
#pragma unroll
            for (int b = 0; b < 2; ++b)
#pragma unroll
                for (int m = 0; m < 4; ++m)
#pragma unroll
                    for (int n = 0; n < 2; ++n) acc[a][b][m][n] = (f32x4){0.f, 0.f, 0.f, 0.f};
        cur = nxt; cA = nA; cB = nB; ++ui;
        if constexpr (ALIGN_EPI) { if (wr == 1) PG8_BAR; }
    }
    PG8_WAIT_V(0);
    if constexpr (!ALIGN_EPI) { if (wr == 0) PG8_BAR; }
    PG8_BAR;
    if constexpr (Epi::AFTER_DRAIN) { E.fused(acc, cur, wr, wc, fr, fq, lds, wid, lane); S.done(cur); }
#undef PG8_SA
#undef PG8_SB
#undef PG8_STAGE
#undef PG8_LDA
#undef PG8_LDB
#undef PG8_MMA
#undef PG8_WAIT_V
#undef PG8_WAIT_L
#undef PG8_BAR
#undef PG8_SCHED
}
}

#undef EPI_ROWS_BEGIN
#undef EPI_ROWS_END

constexpr int D = 2048, NB = 8, SEQ = 2048, CL = 256, ML = NB * SEQ, MC = NB * CL, MT = ML + MC;
constexpr int FF = 5632, NMOD = 9, DEPTH = 2;
constexpr int NIN_SRC = 17568;
constexpr int ZA_W = 1536, ZR_W = 3840, ZG_W = 6144, GT_W = 6144, NMIX = ZA_W + ZR_W + ZG_W  , NIN = NMIX + GT_W  ;
constexpr int RW_COLS = 3712, LA_W = 768;
constexpr float LN_EPS = 1e-5f, ALPHA = 1.41421356237f;
constexpr int NWAVES = 8, NTHR = 512;

constexpr size_t MiB = 1u << 20;
constexpr size_t WS_CTL = 0, CTL_ZERO_BYTES = 1 * MiB;
constexpr size_t WS_MODS = 1 * MiB;
constexpr size_t WS_XC = 4 * MiB;
constexpr size_t WS_HB = 20 * MiB;
constexpr size_t WS_WM = 92 * MiB;
constexpr size_t WM_IN = 0, WM_BA = 69 * MiB, WM_BR = 73 * MiB, WM_BG = 77 * MiB, WM_OUT = 85 * MiB, WM_LW = 93 * MiB, WM_LA = 94 * MiB, WM_LG = 95 * MiB;
constexpr size_t WS_R = 188 * MiB;
constexpr size_t R_WGU = 0, R_WDN = 44 * MiB, R_H = 66 * MiB;
constexpr size_t R_ZA = 0;
constexpr size_t R_ORW = 54 * MiB;
constexpr size_t R_OGL = 90 * MiB;
constexpr size_t R_ZR = 162 * MiB;
constexpr size_t R_AA = 297 * MiB;
constexpr size_t R_Y = 369 * MiB;
constexpr size_t R_G = 513 * MiB;
constexpr size_t R_ZG = 549 * MiB;
constexpr size_t R_YG = 765 * MiB;
constexpr size_t R_QR = 909 * MiB;
constexpr size_t R_KR = 941 * MiB;
constexpr size_t R_LA = 949 * MiB;
constexpr size_t R_WDEC = 976 * MiB;
constexpr size_t R_GL = 1120 * MiB;
constexpr size_t R_GT = R_QR;
constexpr size_t R_MT = R_ZR;
constexpr size_t R_MG = R_Y;
constexpr size_t R_END = 1192 * MiB;
constexpr size_t WS_END = WS_R + R_END;
static_assert(R_GT + (size_t)MT * GT_W * 2 <= R_END, "GT overlay");
static_assert(WS_END <= (size_t)1408 * MiB, "workspace budget");
static_assert(R_H + (size_t)MT * FF * 2 <= R_END, "H fits");

#define XB_TMO      128
#define XB_XCNT(j)  (256  + 64 * (j))
#define XB_XSUB(j)  (1280 + 64 * (j))
#define XB_XGEN(j)  (2304 + 64 * (j))
#define XB_TOP      3328
#define XB_TOPGEN   3392
#define XCD_BAR_WORDS 3456
#define XB_SPIN_CAP (1u << 18)
__device__ __forceinline__ unsigned xb_ld(unsigned* p)              { return __hip_atomic_load(p, __ATOMIC_RELAXED, __HIP_MEMORY_SCOPE_AGENT); }
__device__ __forceinline__ unsigned xb_add(unsigned* p, unsigned v) { return __hip_atomic_fetch_add(p, v, __ATOMIC_RELAXED, __HIP_MEMORY_SCOPE_AGENT); }
__device__ __forceinline__ unsigned xb_xcc_id() { return (unsigned)__builtin_amdgcn_s_getreg((3 << 11) | 20) & 0xFu; }
#define XB_SPIN(cond, bar) do { unsigned _sp = 0; while (cond) { __builtin_amdgcn_s_sleep(1); \
    if ((++_sp & 255u) == 0u) { if (xb_ld(&(bar)[XB_TMO])) break; if (_sp > XB_SPIN_CAP) { atomicAdd(&(bar)[XB_TMO], 1u); break; } } } } while (0)
struct XcdBarrier { unsigned* bar; unsigned x; volatile LAS unsigned* st; };
__device__ __forceinline__ XcdBarrier xcd_barrier_post(unsigned* bar, volatile LAS unsigned* st, int tid) {
    XcdBarrier b; b.bar = bar; b.x = xb_xcc_id(); b.st = st;
    if (tid == 0) (void)xb_add(&bar[XB_XCNT(b.x)], 1u);
    return b;
}
__device__ __forceinline__ void xcd_barrier_complete(unsigned* bar, unsigned x, unsigned& nloc, unsigned& nx) {
    const unsigned G = gridDim.x * gridDim.y * gridDim.z;
    unsigned sum, cnt, mine, sp = 0u;
    for (;;) {
        sum = 0u; cnt = 0u; mine = 0u;
#pragma unroll
        for (unsigned j = 0; j < 16; ++j) { const unsigned c = xb_ld(&bar[XB_XCNT(j)]); sum += c; cnt += (c > 0u) ? 1u : 0u; mine = (j == x) ? c : mine; }
        if (sum == G) break;
        __builtin_amdgcn_s_sleep(1);
        if ((++sp & 255u) == 0u) { if (xb_ld(&bar[XB_TMO])) break; if (sp > XB_SPIN_CAP) { atomicAdd(&bar[XB_TMO], 1u); break; } }
    }
    nloc = mine > 0u ? mine : 1u; nx = cnt > 0u ? cnt : 1u;
}
__device__ __forceinline__ void xcd_barrier(const XcdBarrier& b, int tid) {
    asm volatile("s_waitcnt vmcnt(0)" ::: "memory");
    __syncthreads();
    if (tid == 0) {
        unsigned* bar = b.bar; unsigned bx = b.x;
        asm volatile("" : "+s"(bar), "+s"(bx));
        __builtin_amdgcn_s_waitcnt(0);
        unsigned nloc = b.st[0], nx = b.st[1];
        if (nloc == 0u) { xcd_barrier_complete(bar, bx, nloc, nx); b.st[0] = nloc; b.st[1] = nx; }
        const unsigned old = xb_add(&bar[XB_XSUB(bx)], 1u);
        const unsigned gen = old / nloc;
        if (old + 1u == (gen + 1u) * nloc) {
            __builtin_amdgcn_fence(__ATOMIC_RELEASE, "agent");
            asm volatile("s_waitcnt vmcnt(0)" ::: "memory");
            const unsigned og = xb_add(&bar[XB_TOP], 1u);
            const unsigned tg = og / nx;
            if (og + 1u == (tg + 1u) * nx) xb_add(&bar[XB_TOPGEN], 1u);
            else XB_SPIN(xb_ld(&bar[XB_TOPGEN]) == tg, bar);
            __builtin_amdgcn_fence(__ATOMIC_ACQUIRE, "agent");
            xb_add(&bar[XB_XGEN(bx)], 1u);
            asm volatile("s_waitcnt vmcnt(0)" ::: "memory");
        } else {
            XB_SPIN(xb_ld(&bar[XB_XGEN(bx)]) == gen, bar);
            __builtin_amdgcn_fence(__ATOMIC_ACQUIRE, "agent");
            asm volatile("s_waitcnt vmcnt(0)" ::: "memory");
        }
    }
    __syncthreads();
}

constexpr int RING_BYTES = 143360;
constexpr int LDSCTL_OFF = RING_BYTES, MISC_OFF = LDSCTL_OFF + 320;
constexpr int LDS_BYTES = 147456;

struct Args { const float* in[30]; float* out; unsigned char* ws; int ph_lo, ph_hi; };
#define CAS __attribute__((address_space(4)))
typedef const CAS Args& ArgsRef;

struct Frame {
    LAS unsigned char* lds;
    int tid, lane, wave, G, bid;
    const float* const* in;
    float* out; unsigned char* ws;
};
#define WSP(T, off) ((T*)(F.ws + (off)))
#define RGN(T, off) ((T*)(F.ws + WS_R + (off)))
__device__ __forceinline__ float* xrow(const Frame& F, int m) { return m < ML ? F.out + (size_t)m * D : WSP(float, WS_XC) + (size_t)(m - ML) * D; }

__device__ __forceinline__ void tr_item(const float* W, int N, bf16* WT, int ldk, int k0, int scol0, int drow0, LAS float* scr, int lane) {
    if (scol0 >= 0) {
#pragma unroll 8
        for (int i = 0; i < 32; ++i) { const int kk = 2 * i + (lane >> 5); scr[kk * 33 + (lane & 31)] = W[(size_t)(k0 + kk) * N + scol0 + (lane & 31)]; }
    } else {
#pragma unroll 8
        for (int i = 0; i < 32; ++i) { const int kk = 2 * i + (lane >> 5); scr[kk * 33 + (lane & 31)] = 0.f; }
    }
    asm volatile("s_waitcnt vmcnt(0) lgkmcnt(0)" ::: "memory");
    const int c = lane & 7;
#pragma unroll
    for (int j = 0; j < 4; ++j) { const int n = (lane >> 3) + 8 * j; const LAS float* s = scr + (8 * c) * 33 + n;
        v4u o; o.x = pk2(s[0 * 33], s[1 * 33]); o.y = pk2(s[2 * 33], s[3 * 33]); o.z = pk2(s[4 * 33], s[5 * 33]); o.w = pk2(s[6 * 33], s[7 * 33]);
        *(v4u*)(WT + (size_t)(drow0 + n) * ldk + k0 + 8 * c) = o; }
    asm volatile("s_waitcnt lgkmcnt(0)" ::: "memory");
}
struct MapIdent { __device__ __forceinline__ int operator()(int drow) const { return drow; } };
struct MapGU { __device__ __forceinline__ int operator()(int drow) const { const int pn = drow >> 8, bj = (drow >> 7) & 1, i = drow & 127; return bj * FF + pn * 128 + i; } };
struct MapWin { __device__ __forceinline__ int operator()(int drow) const {
    if (drow < 5248) return drow;
    if (drow < 5280) return 11392 + (drow - 5248);
    if (drow < 5376) return -1;
    if (drow < 11520) return 5248 + (drow - 5376);
    return 11424 + (drow - 11520);
} };
template <class MAP> __device__ __forceinline__ void conv_matrix(const Frame& F, const float* W, int K, int N, bf16* WT, int NT, const MAP& mp, int& item0, int gw, int NGW) {
    LAS float* scr = (LAS float*)(F.lds + F.wave * 16384);
    const int nblk = NT / 32, nitems = (K / 64) * nblk;
    int first = ((gw - item0) % NGW + NGW) % NGW;
    for (int it = first; it < nitems; it += NGW) { const int kb = it / nblk, nb = it % nblk; tr_item(W, N, WT, K, kb * 64, mp(nb * 32), nb * 32, scr, F.lane); }
    item0 += nitems;
}

__device__ __forceinline__ int seq_row(int b, int dir, int p, int& idx, int& len) {
    if (p < CL) { idx = dir ? (CL - 1 - p) : p; len = CL; return ML + b * CL + idx; }
    const int q = p - CL; idx = dir ? (SEQ - 1 - q) : q; len = SEQ; return b * SEQ + idx;
}

__device__ __forceinline__ void phase_init(const Frame& F, ArgsRef A) {
    {
        const size_t n4 = (size_t)ML * D / 4; const f32x4* s = (const f32x4*)A.in[0]; f32x4* d = (f32x4*)F.out;
        for (size_t i = (size_t)F.bid * NTHR + F.tid; i < n4; i += (size_t)F.G * NTHR) d[i] = s[i];
        const size_t m4 = (size_t)MC * D / 4; const f32x4* s2 = (const f32x4*)A.in[2]; f32x4* d2 = WSP(f32x4, WS_XC);
        for (size_t i = (size_t)F.bid * NTHR + F.tid; i < m4; i += (size_t)F.G * NTHR) d2[i] = s2[i];
    }
    const float* c = A.in[1]; const float* cctx = A.in[3]; const float* ada_w = A.in[4]; const float* ada_b = A.in[5];
    float* mods = WSP(float, WS_MODS);
    LAS float* sc = (LAS float*)F.lds;
    LAS float* red = sc + 9 * 2048;
    for (int i = F.tid; i < 9 * 2048; i += NTHR) { const int bs = i >> 11, k = i & 2047; const float v = bs < 8 ? c[bs * 2048 + k] : cctx[k]; sc[i] = fsilu(v); }
    __syncthreads();
    for (int item = F.bid; item < 2 * 144; item += F.G) {
        const int l = item / 144, cb = item % 144, col = cb * 128 + 2 * F.lane;
        float a0[9], a1[9];
#pragma unroll
        for (int bs = 0; bs < 9; ++bs) { a0[bs] = 0.f; a1[bs] = 0.f; }
        const float* wp = ada_w + ((size_t)l * 2048 + F.wave * 256) * 18432 + col;
        const LAS float* sp = sc + F.wave * 256;
#pragma unroll 8
        for (int k = 0; k < 256; ++k) { const f32x2 w = *(const f32x2*)(wp + (size_t)k * 18432);
#pragma unroll
            for (int bs = 0; bs < 9; ++bs) { const float s = sp[bs * 2048 + k]; a0[bs] += s * w.x; a1[bs] += s * w.y; } }
#pragma unroll
        for (int bs = 0; bs < 9; ++bs) { red[(F.wave * 9 + bs) * 128 + 2 * F.lane] = a0[bs]; red[(F.wave * 9 + bs) * 128 + 2 * F.lane + 1] = a1[bs]; }
        __syncthreads();
        for (int o = F.tid; o < 9 * 128; o += NTHR) { const int bs = o >> 7, cc = o & 127; float s = ada_b[l * 18432 + cb * 128 + cc];
#pragma unroll
            for (int w = 0; w < 8; ++w) s += red[(w * 9 + bs) * 128 + cc];
            mods[((size_t)l * 9 + bs) * 18432 + cb * 128 + cc] = s; }
        __syncthreads();
    }
}

template <bool POST, bool MODH>
__device__ __forceinline__ void phase_ln(const Frame& F, int nrows, const float* g, const float* b, const float* mods_l, int kshift, int kscale) {
    const int gw = F.bid * NWAVES + F.wave, NGW = F.G * NWAVES;
    bf16* HB = WSP(bf16, WS_HB);
    for (int m = gw; m < nrows; m += NGW) {
        float* xr = xrow(F, m);
        f32x4 v[8];
#pragma unroll
        for (int j = 0; j < 8; ++j) v[j] = ((const f32x4*)xr)[F.lane + 64 * j];
        if (POST) {
            float s = 0.f;
#pragma unroll
            for (int j = 0; j < 8; ++j) s += (v[j].x + v[j].y) + (v[j].z + v[j].w);
            const float mean = wave_sum(s) * (1.f / D); float s2 = 0.f;
#pragma unroll
            for (int j = 0; j < 8; ++j) { v[j] = v[j] - mean; s2 += (v[j].x * v[j].x + v[j].y * v[j].y) + (v[j].z * v[j].z + v[j].w * v[j].w); }
            const float rstd = 1.f / sqrtf(wave_sum(s2) * (1.f / D) + LN_EPS);
#pragma unroll
            for (int j = 0; j < 8; ++j) { const f32x4 gg = ((const f32x4*)g)[F.lane + 64 * j], bb = ((const f32x4*)b)[F.lane + 64 * j]; v[j] = v[j] * rstd * gg + bb; ((f32x4*)xr)[F.lane + 64 * j] = v[j]; }
        }
        if (MODH) {
            float s = 0.f;
#pragma unroll
            for (int j = 0; j < 8; ++j) s += (v[j].x + v[j].y) + (v[j].z + v[j].w);
            const float mean = wave_sum(s) * (1.f / D); float s2 = 0.f;
#pragma unroll
            for (int j = 0; j < 8; ++j) { v[j] = v[j] - mean; s2 += (v[j].x * v[j].x + v[j].y * v[j].y) + (v[j].z * v[j].z + v[j].w * v[j].w); }
            const float rstd = 1.f / sqrtf(wave_sum(s2) * (1.f / D) + LN_EPS);
            const int bsel = m < ML ? (m >> 11) : 8;
            const f32x4* shp = (const f32x4*)(mods_l + (size_t)bsel * 18432 + kshift * 2048);
            const f32x4* scp = (const f32x4*)(mods_l + (size_t)bsel * 18432 + kscale * 2048);
            v2u* hp = (v2u*)(HB + (size_t)m * D);
#pragma unroll
            for (int j = 0; j < 8; ++j) { const f32x4 sh = shp[F.lane + 64 * j], scl = scp[F.lane + 64 * j]; const f32x4 o = v[j] * rstd * (scl + 1.0f) + sh;
                v2u w; w.x = pk2(o.x, o.y); w.y = pk2(o.z, o.w); hp[F.lane + 64 * j] = w; }
        }
    }
}

__device__ __forceinline__ void phase_convert(const Frame& F, ArgsRef A, int l, int ffn_i, int which) {
    const int gw = F.bid * NWAVES + F.wave, NGW = F.G * NWAVES; int item0 = 0;
    if (which & 1) {
        conv_matrix(F, A.in[8] + ((size_t)l * 2 + ffn_i) * D * (2 * FF), D, 2 * FF, RGN(bf16, R_WGU), 2 * FF, MapGU(), item0, gw, NGW);
        conv_matrix(F, A.in[9] + ((size_t)l * 2 + ffn_i) * FF * D, FF, D, RGN(bf16, R_WDN), D, MapIdent(), item0, gw, NGW);
    }
    if (which & 2) {
        conv_matrix(F, A.in[10] + (size_t)l * D * NIN_SRC, D, NIN_SRC, WSP(bf16, WS_WM + WM_IN), NIN, MapWin(), item0, gw, NGW);
        conv_matrix(F, A.in[26] + (size_t)l * 1024 * D, 1024, D, WSP(bf16, WS_WM + WM_BA), D, MapIdent(), item0, gw, NGW);
        conv_matrix(F, A.in[27] + (size_t)l * 1024 * D, 1024, D, WSP(bf16, WS_WM + WM_BR), D, MapIdent(), item0, gw, NGW);
        conv_matrix(F, A.in[28] + (size_t)l * D * D, D, D, WSP(bf16, WS_WM + WM_BG), D, MapIdent(), item0, gw, NGW);
        conv_matrix(F, A.in[29] + (size_t)l * D * D, D, D, WSP(bf16, WS_WM + WM_OUT), D, MapIdent(), item0, gw, NGW);
        const float* w2 = A.in[14] + (size_t)l * 2 * 96 * 1024; const float* a2 = A.in[16] + (size_t)l * 2 * 96 * 1024; const float* g2 = A.in[17] + (size_t)l * 256 * 1024;
        bf16* LW = WSP(bf16, WS_WM + WM_LW); bf16* LAw = WSP(bf16, WS_WM + WM_LA); bf16* LG = WSP(bf16, WS_WM + WM_LG);
        for (int e = F.bid * NTHR + F.tid; e < 2048 * 256; e += F.G * NTHR) { const int n = e >> 8, k = e & 255, dir = n >> 10, cc = n & 1023;
            const int kk = k - dir * 96; const bool liv = kk >= 0 && kk < 96;
            LW[e] = liv ? (bf16)f2bf(w2[((size_t)dir * 96 + kk) * 1024 + cc]) : (bf16)0;
            LAw[e] = liv ? (bf16)f2bf(a2[((size_t)dir * 96 + kk) * 1024 + cc]) : (bf16)0;
            if (n < 1024) LG[e] = (bf16)f2bf(g2[(size_t)k * 1024 + n]); }
    }
    __syncthreads();
}

__device__ __forceinline__ void phase_prep(const Frame& F, ArgsRef A, int l) {
    const int gw = F.bid * NWAVES + F.wave, NGW = F.G * NWAVES, lane = F.lane;
    const bf16* ZA = RGN(bf16, R_ZA); bf16* QR = RGN(bf16, R_QR); bf16* KR = RGN(bf16, R_KR);
    const bf16* ZR = RGN(bf16, R_ZR); bf16* LA = RGN(bf16, R_LA); unsigned* GL = RGN(unsigned, R_GL);
    {
        const int axis = lane >> 5, f = lane & 31;
        const float invf = exp2f(-(float)f * (13.287712379549449f / 32.0f));
        for (int m = gw; m < ML; m += NGW) {
            const int t = m & (SEQ - 1);
            const float pos = axis == 0 ? (float)(t >> 6) : (float)(t & 63);
            const float ang = pos * invf; const float sn = __sinf(ang), cs = __cosf(ang);
            const bf16* zr = ZA + (size_t)m * ZA_W;
#pragma unroll
            for (int hh = 0; hh < 10; ++hh) {
                const int cb = hh * 128 + axis * 64 + f;
                const float x1 = bf2f(zr[cb]), x2 = bf2f(zr[cb + 32]);
                const float o1 = x1 * cs - x2 * sn, o2 = x2 * cs + x1 * sn;
                if (hh < 8) { QR[(size_t)m * 1024 + cb] = (bf16)f2bf(o1); QR[(size_t)m * 1024 + cb + 32] = (bf16)f2bf(o2); }
                else { KR[(size_t)m * 256 + cb - 1024] = (bf16)f2bf(o1); KR[(size_t)m * 256 + cb - 1024 + 32] = (bf16)f2bf(o2); }
            }
        }
    }
    {
        const float* cw = A.in[12] + (size_t)l * 3 * RW_COLS;
        for (int m = gw; m < MT; m += NGW) {
            int idx, len; if (m < ML) { idx = m & (SEQ - 1); len = SEQ; } else { idx = (m - ML) & (CL - 1); len = CL; }
            const bool hasL = idx > 0, hasR = idx < len - 1;
            const bf16* z0 = ZR + (size_t)m * ZR_W;
#pragma unroll
            for (int jj0 = 0; jj0 < LA_W; jj0 += 64) {
                const int j = jj0 + lane; const int sec = j >> 8, jj = j & 255;
                float o = 0.f;
                if (sec == 2 || jj < 192) {
                    const int scol = (sec == 0 ? 3072 : sec == 1 ? 3264 : 3456) + jj;
                    float zc = bf2f(z0[scol]) * cw[RW_COLS + scol];
                    if (hasL) zc += bf2f(z0[scol - ZR_W]) * cw[scol];
                    if (hasR) zc += bf2f(z0[scol + ZR_W]) * cw[2 * RW_COLS + scol];
                    o = sec == 0 ? ftanh(zc) : (sec == 1 ? zc : fsigmoid(zc));
                }
                LA[(size_t)m * LA_W + j] = (bf16)f2bf(o);
            }
        }
    }
    {
        const float* wa2 = A.in[23] + (size_t)l * 2 * 16 * 1024; const float* ba = A.in[24] + (size_t)l * 2 * 1024;
        for (int item = F.bid; item < 2 * (MT / 16); item += F.G) {
            const int dir = item / (MT / 16), m0 = (item % (MT / 16)) * 16, c0 = 2 * F.tid;
            float w0[16], w1[16];
#pragma unroll
            for (int r = 0; r < 16; ++r) { const f32x2 w = *(const f32x2*)(wa2 + ((size_t)dir * 16 + r) * 1024 + c0); w0[r] = w.x; w1[r] = w.y; }
            const f32x2 bb = *(const f32x2*)(ba + dir * 1024 + c0);
            for (int rr = 0; rr < 16; ++rr) {
                const int m = m0 + rr; const bf16* ac = ZR + (size_t)m * ZR_W + 3712 + dir * 16;
                float s0 = bb.x, s1 = bb.y;
#pragma unroll
                for (int r = 0; r < 16; ++r) { const float a = bf2f(ac[r]); s0 += a * w0[r]; s1 += a * w1[r]; }
                const float la0 = -fsoftplus(-s0) * 0.0625f, la1 = -fsoftplus(-s1) * 0.0625f;
                GL[(((size_t)dir * MT + m) * 1024 + c0) >> 1] = pk2(la0, la1);
            }
        }
    }
}

__device__ __forceinline__ float dpp_f(float v, const int ctrl_sel) {
    const int x = __builtin_bit_cast(int, v); int r;
    if (ctrl_sel == 0) r = __builtin_amdgcn_update_dpp(0, x, 0xB1, 0xF, 0xF, false);
    else if (ctrl_sel == 1) r = __builtin_amdgcn_update_dpp(0, x, 0x4E, 0xF, 0xF, false);
    else if (ctrl_sel == 2) r = __builtin_amdgcn_update_dpp(0, x, 0x141, 0xF, 0xF, false);
    else r = __builtin_amdgcn_update_dpp(0, x, 0x140, 0xF, 0xF, false);
    return __builtin_bit_cast(float, r);
}
__device__ __forceinline__ float red16(float v) { v += dpp_f(v, 0); v += dpp_f(v, 1); v += dpp_f(v, 2); v += dpp_f(v, 3); return v; }
__device__ __forceinline__ float red4(float v) { v += dpp_f(v, 0); v += dpp_f(v, 1); return v; }

__device__ __forceinline__ void rwkv_scan_item(const Frame& F, ArgsRef A, int l, int item, bool last) {
    const int b = item >> 5, h = (item >> 1) & 15, dir = item & 1, lane = F.lane;
    LAS float* V6 = (LAS float*)F.lds;
    LAS float* SC = V6 + 64 * 384;
    LAS float* YB = SC + 128;
    const bf16* ZR = RGN(bf16, R_ZR); const float* WDEC = RGN(float, R_WDEC); const bf16* AA = RGN(bf16, R_AA); float* Y = RGN(float, R_Y);
    const float* cw = A.in[12] + (size_t)l * 3 * RW_COLS;
    const int ch = h * 64 + lane;
    float cr[3], ck[3], cv[3];
#pragma unroll
    for (int tap = 0; tap < 3; ++tap) { cr[tap] = cw[tap * RW_COLS + ch]; ck[tap] = cw[tap * RW_COLS + 1024 + ch]; cv[tap] = cw[tap * RW_COLS + 2048 + ch]; }
    const float kkw = A.in[18][l * 1024 + ch], kaw = A.in[19][l * 1024 + ch];
    const int jq = lane & 15, si0 = (F.wave * 4 + (lane >> 4)) * 2;
    float s0[4] = {0.f, 0.f, 0.f, 0.f}, s1[4] = {0.f, 0.f, 0.f, 0.f};
    for (int chunk = 0; chunk < 36; ++chunk) {
#pragma unroll 2
        for (int q = 0; q < 8; ++q) {
            const int tt = F.wave * 8 + q; int idx, len; const int m = seq_row(b, dir, chunk * 64 + tt, idx, len);
            const bf16* z = ZR + (size_t)m * ZR_W + ch;
            float r = bf2f(z[0]) * cr[1], k = bf2f(z[1024]) * ck[1], v = bf2f(z[2048]) * cv[1];
            if (idx > 0) { r += bf2f(z[-ZR_W]) * cr[0]; k += bf2f(z[1024 - ZR_W]) * ck[0]; v += bf2f(z[2048 - ZR_W]) * cv[0]; }
            if (idx < len - 1) { r += bf2f(z[ZR_W]) * cr[2]; k += bf2f(z[1024 + ZR_W]) * ck[2]; v += bf2f(z[2048 + ZR_W]) * cv[2]; }
            const float kr = k * kkw; const float nrm = sqrtf(wave_sum(kr * kr)); const float kk = kr / fmaxf(nrm, 1e-12f);
            const float w = WDEC[((size_t)dir * MT + m) * 1024 + ch]; const float a = bf2f(AA[((size_t)dir * MT + m) * 1024 + ch]);
            const float kd = k * (1.f + (a - 1.f) * kaw), kka = kk * a;
            const float c1 = wave_sum(kka * r), c2 = wave_sum(kd * r);
            LAS float* o = V6 + tt * 384 + lane; o[0] = w; o[64] = kd; o[128] = kka; o[192] = -kk; o[256] = w * r; o[320] = v;
            if (lane == 0) { SC[tt * 2] = c1; SC[tt * 2 + 1] = c2; }
        }
        __syncthreads();
#pragma unroll 4
        for (int tt = 0; tt < 64; ++tt) {
            const LAS float* vb = V6 + tt * 384 + jq * 4;
            const f32x4 w4 = *(const LAS f32x4*)(vb), kd4 = *(const LAS f32x4*)(vb + 64), ka4 = *(const LAS f32x4*)(vb + 128), nk4 = *(const LAS f32x4*)(vb + 192), wr4 = *(const LAS f32x4*)(vb + 256);
            const f32x2 vi = *(const LAS f32x2*)(V6 + tt * 384 + 320 + si0); const f32x2 cc = *(const LAS f32x2*)(SC + tt * 2);
            float sa0 = 0.f, yp0 = 0.f, sa1 = 0.f, yp1 = 0.f;
#pragma unroll
            for (int q = 0; q < 4; ++q) { sa0 += s0[q] * nk4[q]; yp0 += s0[q] * wr4[q]; sa1 += s1[q] * nk4[q]; yp1 += s1[q] * wr4[q]; }
            sa0 = red16(sa0); yp0 = red16(yp0); sa1 = red16(sa1); yp1 = red16(yp1);
            const float y0 = yp0 + sa0 * cc.x + vi.x * cc.y, y1 = yp1 + sa1 * cc.x + vi.y * cc.y;
#pragma unroll
            for (int q = 0; q < 4; ++q) { s0[q] = s0[q] * w4[q] + sa0 * ka4[q] + vi.x * kd4[q]; s1[q] = s1[q] * w4[q] + sa1 * ka4[q] + vi.y * kd4[q]; }
            if (jq == 0) { *(LAS f32x2*)(YB + tt * 64 + si0) = (f32x2){y0, y1}; }
        }
        __syncthreads();
        if (!(last && chunk < 4)) {
            for (int e = F.tid; e < 4096; e += NTHR) { const int tt = e >> 6, i = e & 63; int idx, len; const int m = seq_row(b, dir, chunk * 64 + tt, idx, len);
                Y[((size_t)dir * MT + m) * 1024 + h * 64 + i] = YB[e]; }
        }
        __syncthreads();
    }
}


constexpr int GQ_LD = 264, GT_LD = 72;
constexpr int G_QD = 0, G_KI = G_QD + 64 * GQ_LD * 2, G_KT = G_KI + 64 * GQ_LD * 2, G_VT = G_KT + 256 * GT_LD * 2, G_AM = G_VT + 128 * GT_LD * 2, G_EBL = G_AM + 64 * GT_LD * 2, G_TQ = G_EBL + 1024, G_END = G_TQ + 4096;
static_assert(G_END <= RING_BYTES, "GLA LDS map");
__device__ __forceinline__ unsigned opq(unsigned x) { asm volatile("" : "+v"(x)); return x; }
__device__ __forceinline__ bf16x8 pack8(const f32x4& a, const f32x4& b) {
    v4u w; w.x = pg8::cvt_pk_bf16(a[0], a[1]); w.y = pg8::cvt_pk_bf16(a[2], a[3]); w.z = pg8::cvt_pk_bf16(b[0], b[1]); w.w = pg8::cvt_pk_bf16(b[2], b[3]);
    return __builtin_bit_cast(bf16x8, w);
}
#define LD_(T, addr) (*(const LAS T*)(L + (addr)))
#define ST_(T, addr) (*(LAS T*)(L + (addr)))
__device__ __forceinline__ void gla_chunk_item(const Frame& F, int item, bool last) {
    const int b = item >> 5, h = (item >> 3) & 3, dir = (item >> 2) & 1, dvs = item & 3;
    LAS unsigned char* L = F.lds;
    const int tid = F.tid, lane = F.lane, w = F.wave, l16 = lane & 15, g = lane >> 4;
    const int dp = tid & 127, qt = tid >> 7;
    const int e8 = tid & 15, jj = tid >> 4;
    const bf16* ZG = RGN(bf16, R_ZG); const bf16* GL = RGN(bf16, R_GL) + (size_t)dir * MT * 1024;
    bf16* YG = RGN(bf16, R_YG) + (size_t)dir * MT * 2048;
    const int sgn = dir ? -1 : 1;
    const unsigned a_pq = opq(G_QD + ((16 * qt) * GQ_LD + 2 * dp) * 2);
    const unsigned a_pkt = opq(G_KT + ((2 * dp) * GT_LD + 16 * qt) * 2);
    const unsigned a_pvt = opq(G_VT + ((8 * e8) * GT_LD + jj) * 2);
    const unsigned a_ptq = opq(G_TQ + (2 * dp) * 4);
    const unsigned a_f8 = opq((l16 * GQ_LD + 8 * g) * 2);
    const unsigned a_f4 = opq(G_QD + (l16 * GQ_LD + 4 * g) * 2);
    const unsigned a_t8 = opq((l16 * GT_LD + 8 * g) * 2);
    const unsigned a_ebl = opq(G_EBL + 16 * g);
    f32x4 S[16];
#pragma unroll
    for (int t = 0; t < 16; ++t) S[t] = (f32x4){0.f, 0.f, 0.f, 0.f};
    unsigned rq[16], rk[16], rl[16]; v4u rv0, rv1;
#define GLA_ISSUE(chunk) do { int idx_, len_; const int r0_ = seq_row(b, dir, (chunk) * 64, idx_, len_); \
        const bf16* pz_ = ZG + (size_t)(r0_ + sgn * 16 * qt) * ZG_W + h * 256 + 2 * dp; const bf16* pl_ = GL + (size_t)(r0_ + sgn * 16 * qt) * 1024 + h * 256 + 2 * dp; \
        const long sz_ = (long)sgn * ZG_W, sl_ = (long)sgn * 1024; \
        _Pragma("unroll") for (int i = 0; i < 16; ++i) { asm volatile("" : "+v"(pz_), "+v"(pl_)); \
            rq[i] = *(const unsigned*)pz_; rk[i] = *(const unsigned*)(pz_ + 1024); rl[i] = *(const unsigned*)pl_; pz_ += sz_; pl_ += sl_; } \
        const bf16* pv_ = ZG + (size_t)(r0_ + sgn * jj) * ZG_W + 2048 + h * 512 + dvs * 128 + 8 * e8; \
        rv0 = *(const v4u*)pv_; rv1 = *(const v4u*)(pv_ + sz_ * 32); } while (0)
    GLA_ISSUE(0);
    for (int chunk = 0; chunk < 36; ++chunk) {
        int idx0, len0; const int r0 = seq_row(b, dir, chunk * 64, idx0, len0);
        {
            float s0 = 0.f, s1 = 0.f;
#pragma unroll
            for (int i = 0; i < 16; ++i) { s0 += bflo(rl[i]); s1 += bfhi(rl[i]); }
            ST_(f32x2, a_ptq + qt * 1024) = (f32x2){s0, s1};
        }
        __syncthreads();
        {
            float o0 = 0.f, o1 = 0.f, t0 = 0.f, t1 = 0.f;
#pragma unroll
            for (int q = 0; q < 4; ++q) { const f32x2 tq = LD_(f32x2, a_ptq + q * 1024); if (q < qt) { o0 += tq.x; o1 += tq.y; } t0 += tq.x; t1 += tq.y; }
            if (qt == 0) ST_(f32x2, G_EBL + 2 * dp * 4) = (f32x2){__expf(t0), __expf(t1)};
            unsigned kt0[8], kt1[8];
#pragma unroll
            for (int i = 0; i < 16; ++i) {
                o0 += bflo(rl[i]); o1 += bfhi(rl[i]);
                const float e0 = __expf(o0), e1 = __expf(o1), n0 = __expf(-o0), n1 = __expf(-o1);
                const unsigned qd = pg8::cvt_pk_bf16(bflo(rq[i]) * 0.0625f * e0, bfhi(rq[i]) * 0.0625f * e1);
                const unsigned ki = pg8::cvt_pk_bf16(bflo(rk[i]) * n0, bfhi(rk[i]) * n1);
                ST_(unsigned, a_pq + i * GQ_LD * 2) = qd;
                ST_(unsigned, a_pq + (G_KI - G_QD) + i * GQ_LD * 2) = ki;
                if (i & 1) { kt0[i >> 1] |= (ki << 16); kt1[i >> 1] |= (ki & 0xffff0000u); }
                else { kt0[i >> 1] = ki & 0xffffu; kt1[i >> 1] = ki >> 16; }
                asm volatile("" ::: "memory");
            }
            ST_(v4u, a_pkt) = (v4u){kt0[0], kt0[1], kt0[2], kt0[3]};
            ST_(v4u, a_pkt + 16) = (v4u){kt0[4], kt0[5], kt0[6], kt0[7]};
            ST_(v4u, a_pkt + GT_LD * 2) = (v4u){kt1[0], kt1[1], kt1[2], kt1[3]};
            ST_(v4u, a_pkt + GT_LD * 2 + 16) = (v4u){kt1[4], kt1[5], kt1[6], kt1[7]};
            const unsigned vv0[4] = {rv0.x, rv0.y, rv0.z, rv0.w}, vv1[4] = {rv1.x, rv1.y, rv1.z, rv1.w};
#pragma unroll
            for (int x = 0; x < 4; ++x) {
                ST_(unsigned short, a_pvt + (2 * x) * GT_LD * 2) = (unsigned short)(vv0[x] & 0xffffu);
                ST_(unsigned short, a_pvt + (2 * x + 1) * GT_LD * 2) = (unsigned short)(vv0[x] >> 16);
                ST_(unsigned short, a_pvt + (2 * x) * GT_LD * 2 + 64) = (unsigned short)(vv1[x] & 0xffffu);
                ST_(unsigned short, a_pvt + (2 * x + 1) * GT_LD * 2 + 64) = (unsigned short)(vv1[x] >> 16);
            }
        }
        __syncthreads();
        if (chunk + 1 < 36) GLA_ISSUE(chunk + 1);
#pragma unroll
        for (int tt = 0; tt < 2; ++tt) {
            const int t = 2 * w + tt, jt = t >> 2, it = t & 3;
            f32x4 acc = (f32x4){0.f, 0.f, 0.f, 0.f};
            if (jt <= it) {
                const unsigned ak = a_f8 + G_KI + jt * (16 * GQ_LD * 2), aq = a_f8 + G_QD + it * (16 * GQ_LD * 2);
#pragma unroll
                for (int s = 0; s < 8; ++s) {
                    const bf16x8 a = LD_(bf16x8, ak + 64 * s);
                    const bf16x8 bb = LD_(bf16x8, aq + 64 * s);
                    acc = __builtin_amdgcn_mfma_f32_16x16x32_bf16(a, bb, acc, 0, 0, 0);
                }
            }
            const int i = 16 * it + l16, j0 = 16 * jt + 4 * g;
            const float m0 = (j0 + 0 <= i) ? acc[0] : 0.f, m1 = (j0 + 1 <= i) ? acc[1] : 0.f, m2 = (j0 + 2 <= i) ? acc[2] : 0.f, m3 = (j0 + 3 <= i) ? acc[3] : 0.f;
            ST_(v2u, G_AM + (i * GT_LD + j0) * 2) = (v2u){pg8::cvt_pk_bf16(m0, m1), pg8::cvt_pk_bf16(m2, m3)};
        }
        __syncthreads();
        {
            f32x4 O[4];
#pragma unroll
            for (int mt = 0; mt < 4; ++mt) O[mt] = (f32x4){0.f, 0.f, 0.f, 0.f};
#pragma unroll
            for (int s = 0; s < 8; ++s) {
                const bf16x8 bs = pack8(S[2 * s], S[2 * s + 1]);
#pragma unroll
                for (int mt = 0; mt < 4; ++mt) {
                    const v2u a0 = LD_(v2u, a_f4 + (16 * mt * GQ_LD + 32 * s) * 2);
                    const v2u a1 = LD_(v2u, a_f4 + (16 * mt * GQ_LD + 32 * s + 16) * 2);
                    const bf16x8 a = __builtin_bit_cast(bf16x8, (v4u){a0.x, a0.y, a1.x, a1.y});
                    O[mt] = __builtin_amdgcn_mfma_f32_16x16x32_bf16(a, bs, O[mt], 0, 0, 0);
                }
                asm volatile("" ::: "memory");
            }
            const unsigned avt = a_t8 + G_VT + w * (16 * GT_LD * 2);
            const bf16x8 vb0 = LD_(bf16x8, avt);
            const bf16x8 vb1 = LD_(bf16x8, avt + 64);
#pragma unroll
            for (int mt = 0; mt < 4; ++mt) {
                const bf16x8 a0 = LD_(bf16x8, a_t8 + G_AM + mt * (16 * GT_LD * 2));
                O[mt] = __builtin_amdgcn_mfma_f32_16x16x32_bf16(a0, vb0, O[mt], 0, 0, 0);
                if (mt >= 2) { const bf16x8 a1 = LD_(bf16x8, a_t8 + G_AM + mt * (16 * GT_LD * 2) + 64);
                    O[mt] = __builtin_amdgcn_mfma_f32_16x16x32_bf16(a1, vb1, O[mt], 0, 0, 0); }
            }
            if (!(last && chunk < 4)) {
                bf16* yp = YG + (size_t)(r0 + sgn * 4 * g) * 2048 + h * 512 + dvs * 128 + 16 * w + l16;
                const long sy = (long)sgn * 2048;
#pragma unroll
                for (int mt = 0; mt < 4; ++mt) {
#pragma unroll
                    for (int r = 0; r < 4; ++r) { asm volatile("" : "+v"(yp)); yp[(long)r * sy] = (bf16)f2bf(O[mt][r]); }
                    yp += 16 * sy;
                }
            }
#pragma unroll
            for (int t = 0; t < 16; ++t) {
                const bf16x8 a0 = LD_(bf16x8, a_t8 + G_KT + t * (16 * GT_LD * 2));
                const bf16x8 a1 = LD_(bf16x8, a_t8 + G_KT + t * (16 * GT_LD * 2) + 64);
                S[t] = __builtin_amdgcn_mfma_f32_16x16x32_bf16(a0, vb0, S[t], 0, 0, 0);
                S[t] = __builtin_amdgcn_mfma_f32_16x16x32_bf16(a1, vb1, S[t], 0, 0, 0);
                const f32x4 eb = LD_(f32x4, a_ebl + 64 * t);
                S[t] = S[t] * eb;
                asm volatile("" ::: "memory");
            }
        }
        __syncthreads();
    }
#undef GLA_ISSUE
}
#undef LD_
#undef ST_

constexpr int AK_LD = 136, AV_LD = 68;
constexpr int A_K = 0, A_VT = A_K + 64 * AK_LD * 2, A_END = A_VT + 128 * AV_LD * 2;
static_assert(A_END <= RING_BYTES, "attention LDS map");
typedef float f32x16 __attribute__((ext_vector_type(16)));
#define LD_(T, addr) (*(const LAS T*)(L + (addr)))
#define ST_(T, addr) (*(LAS T*)(L + (addr)))
__device__ __forceinline__ void attn_mfma_item(const Frame& F, ArgsRef A, int l, int item) {
    LAS unsigned char* L = F.lds;
    const int tid = F.tid, lane = F.lane, w = F.wave, l32 = lane & 31, g = lane >> 5;
    bf16* ZA = RGN(bf16, R_ZA); const bf16* QR = RGN(bf16, R_QR); const bf16* KR = RGN(bf16, R_KR);
    const bool isctx = item >= 512;
    int b, hk, t0;
    if (!isctx) { b = item >> 6; hk = (item >> 5) & 1; t0 = (item & 31) * 64; }
    else { const int it = item - 512; b = it >> 3; hk = (it >> 2) & 1; t0 = (it & 3) * 64; }
    const int hq = hk * 4 + (w >> 1), tq = t0 + 32 * (w & 1) + l32;
    const size_t qrow = isctx ? (size_t)(ML + b * CL + tq) : (size_t)(b * SEQ + tq);
    const float C2 = 0.08838834764831845f * 1.4426950408889634f;
    const int skey = tid >> 3, sc = tid & 7;
    const unsigned a_sk = opq(A_K + (skey * AK_LD + 8 * sc) * 2);
    const unsigned a_sv = opq(A_VT + ((8 * sc) * AV_LD + skey) * 2);
    const unsigned a_kf = opq(A_K + (l32 * AK_LD + 8 * g) * 2);
    const unsigned a_vf = opq(A_VT + (l32 * AV_LD + 4 * g) * 2);
    bf16x8 qf[8];
    {
        const bf16* qp = (isctx ? (const bf16*)ZA + qrow * ZA_W : QR + qrow * 1024) + hq * 128 + 8 * g;
#pragma unroll
        for (int s = 0; s < 8; ++s) qf[s] = *(const bf16x8*)(qp + 16 * s);
    }
    float mrun = A.in[11][l * 8 + hq] * 1.4426950408889634f, lsum = (g == 0) ? 1.f : 0.f;
    f32x16 O[4];
#pragma unroll
    for (int mt = 0; mt < 4; ++mt)
#pragma unroll
        for (int r = 0; r < 16; ++r) O[mt][r] = 0.f;
    int tfirst = isctx ? 5 : 0;
    if (!isctx) { while (t0 - 128 + 64 * tfirst < 0) ++tfirst; }
    v4u pk0, pk1, pv0, pv1;
#define ATT_PREFETCH(tile) do { const bf16 *kp_, *vp_; \
        if ((tile) < 5) { const size_t r_ = (size_t)(b * SEQ + t0 - 128 + 64 * (tile) + skey); kp_ = KR + r_ * 256 + hk * 128 + 8 * sc; vp_ = ZA + r_ * ZA_W + 1280 + hk * 128 + 8 * sc; } \
        else { const size_t r_ = (size_t)(ML + b * CL + 64 * ((tile) - 5) + skey); kp_ = ZA + r_ * ZA_W + 1024 + hk * 128 + 8 * sc; vp_ = kp_ + 256; } \
        pk0 = *(const v4u*)kp_; pk1 = *(const v4u*)(kp_ + 64); pv0 = *(const v4u*)vp_; pv1 = *(const v4u*)(vp_ + 64); } while (0)
    int tile = tfirst;
    ATT_PREFETCH(tile);
    bool plainq = isctx;
    while (tile < 9) {
        __syncthreads();
        ST_(v4u, a_sk) = pk0; ST_(v4u, a_sk + 128) = pk1;
        {
            const unsigned vv0[4] = {pv0.x, pv0.y, pv0.z, pv0.w}, vv1[4] = {pv1.x, pv1.y, pv1.z, pv1.w};
#pragma unroll
            for (int x = 0; x < 4; ++x) {
                ST_(unsigned short, a_sv + (2 * x) * AV_LD * 2) = (unsigned short)(vv0[x] & 0xffffu);
                ST_(unsigned short, a_sv + (2 * x + 1) * AV_LD * 2) = (unsigned short)(vv0[x] >> 16);
                ST_(unsigned short, a_sv + (64 + 2 * x) * AV_LD * 2) = (unsigned short)(vv1[x] & 0xffffu);
                ST_(unsigned short, a_sv + (64 + 2 * x + 1) * AV_LD * 2) = (unsigned short)(vv1[x] >> 16);
            }
        }
        __syncthreads();
        const int cur = tile;
        int nxt = cur + 1;
        if (nxt < 5 && t0 - 128 + 64 * nxt >= SEQ) nxt = 5;
        if (nxt < 9) ATT_PREFETCH(nxt);
        if (cur >= 5 && !plainq) {
            const bf16* qp = (const bf16*)ZA + qrow * ZA_W + hq * 128 + 8 * g;
#pragma unroll
            for (int s = 0; s < 8; ++s) qf[s] = *(const bf16x8*)(qp + 16 * s);
            plainq = true;
        }
        f32x16 sc0, sc1;
#pragma unroll
        for (int r = 0; r < 16; ++r) { sc0[r] = 0.f; sc1[r] = 0.f; }
#pragma unroll
        for (int s = 0; s < 8; ++s) {
            const bf16x8 k0 = LD_(bf16x8, a_kf + 32 * s), k1 = LD_(bf16x8, a_kf + 32 * AK_LD * 2 + 32 * s);
            sc0 = __builtin_amdgcn_mfma_f32_32x32x16_bf16(k0, qf[s], sc0, 0, 0, 0);
            sc1 = __builtin_amdgcn_mfma_f32_32x32x16_bf16(k1, qf[s], sc1, 0, 0, 0);
        }
        float tmax = -3.0e38f;
        if (cur < 5) {
            const int kbase = t0 - 128 + 64 * cur - tq + 4 * g;
#pragma unroll
            for (int r = 0; r < 16; ++r) { const int d0 = kbase + 8 * (r >> 2) + (r & 3), d1 = d0 + 32;
                sc0[r] = (d0 >= -128 && d0 <= 128) ? sc0[r] * C2 : -1.0e30f; sc1[r] = (d1 >= -128 && d1 <= 128) ? sc1[r] * C2 : -1.0e30f; }
        } else {
#pragma unroll
            for (int r = 0; r < 16; ++r) { sc0[r] *= C2; sc1[r] *= C2; }
        }
#pragma unroll
        for (int r = 0; r < 16; ++r) tmax = fmaxf(tmax, fmaxf(sc0[r], sc1[r]));
        tmax = xhalf_max(tmax);
        const float mnew = fmaxf(mrun, tmax);
        const float corr = exp2f(mrun - mnew);
        mrun = mnew;
        float ps = 0.f;
#pragma unroll
        for (int r = 0; r < 16; ++r) { sc0[r] = exp2f(sc0[r] - mnew); sc1[r] = exp2f(sc1[r] - mnew); ps += sc0[r] + sc1[r]; }
        lsum = lsum * corr + ps;
        if (__builtin_amdgcn_ballot_w64(corr != 1.0f) != 0ull) {
#pragma unroll
            for (int mt = 0; mt < 4; ++mt)
#pragma unroll
                for (int r = 0; r < 16; ++r) O[mt][r] *= corr;
        }
#pragma unroll
        for (int u = 0; u < 2; ++u)
#pragma unroll
            for (int s = 0; s < 2; ++s) {
                v4u pw;
                if (u == 0) { pw.x = pg8::cvt_pk_bf16(sc0[8 * s + 0], sc0[8 * s + 1]); pw.y = pg8::cvt_pk_bf16(sc0[8 * s + 2], sc0[8 * s + 3]); pw.z = pg8::cvt_pk_bf16(sc0[8 * s + 4], sc0[8 * s + 5]); pw.w = pg8::cvt_pk_bf16(sc0[8 * s + 6], sc0[8 * s + 7]); }
                else { pw.x = pg8::cvt_pk_bf16(sc1[8 * s + 0], sc1[8 * s + 1]); pw.y = pg8::cvt_pk_bf16(sc1[8 * s + 2], sc1[8 * s + 3]); pw.z = pg8::cvt_pk_bf16(sc1[8 * s + 4], sc1[8 * s + 5]); pw.w = pg8::cvt_pk_bf16(sc1[8 * s + 6], sc1[8 * s + 7]); }
                const bf16x8 pb = __builtin_bit_cast(bf16x8, pw);
#pragma unroll
                for (int mt = 0; mt < 4; ++mt) {
                    const v2u a0 = LD_(v2u, a_vf + (32 * mt * AV_LD + 32 * u + 16 * s) * 2);
                    const v2u a1 = LD_(v2u, a_vf + (32 * mt * AV_LD + 32 * u + 16 * s + 8) * 2);
                    const bf16x8 av = __builtin_bit_cast(bf16x8, (v4u){a0.x, a0.y, a1.x, a1.y});
                    O[mt] = __builtin_amdgcn_mfma_f32_32x32x16_bf16(av, pb, O[mt], 0, 0, 0);
                }
            }
        tile = nxt;
    }
#undef ATT_PREFETCH
    lsum = xhalf_sum(lsum);
    const float inv = 1.0f / lsum;
    bf16* op = ZA + qrow * ZA_W + hq * 128 + 4 * g;
#pragma unroll
    for (int mt = 0; mt < 4; ++mt)
#pragma unroll
        for (int i = 0; i < 4; ++i) {
            v2u o; o.x = pg8::cvt_pk_bf16(O[mt][4 * i] * inv, O[mt][4 * i + 1] * inv); o.y = pg8::cvt_pk_bf16(O[mt][4 * i + 2] * inv, O[mt][4 * i + 3] * inv);
            *(v2u*)(op + 32 * mt + 8 * i) = o;
        }
}
#undef LD_
#undef ST_

__device__ __forceinline__ void phase_mix(const Frame& F, ArgsRef A, int l, bool last) {
#ifndef ONLY_GLA
    for (int item = F.bid; item < 256; item += F.G) rwkv_scan_item(F, A, l, item, last);
#endif
    for (int item = F.bid; item < 256; item += F.G) gla_chunk_item(F, item, last);
#ifdef ONLY_GLA
    return;
#endif
    const int nitems = last ? 512 : 576;
    for (int item = F.bid; item < nitems; item += F.G) attn_mfma_item(F, A, l, item);
}

__device__ __forceinline__ void phase_mixout(const Frame& F, ArgsRef A, int l, int nrows) {
    const int gw = F.bid * NWAVES + F.wave, NGW = F.G * NWAVES, lane = F.lane;
    {
        const bf16* ZR = RGN(bf16, R_ZR); const bf16* AA = RGN(bf16, R_AA); const float* Y = RGN(float, R_Y); const bf16* G = RGN(bf16, R_G); bf16* ORW = RGN(bf16, R_ORW);
        const float* cw = A.in[12] + (size_t)l * 3 * RW_COLS; const float* k_a = A.in[19] + l * 1024; const float* r_k = A.in[20] + l * 1024;
        const float* lnw = A.in[21] + l * 1024; const float* lnb = A.in[22] + l * 1024;
        for (int it = gw; it < nrows * 16; it += NGW) {
            const int m = it >> 4, h = it & 15, ch = h * 64 + lane;
            int idx, len; if (m < ML) { idx = m & (SEQ - 1); len = SEQ; } else { idx = (m - ML) & (CL - 1); len = CL; }
            const float o = Y[(size_t)m * 1024 + ch] + Y[((size_t)MT + m) * 1024 + ch];
            const float mean = wave_sum(o) * (1.f / 64.f); const float dv = o - mean; const float var = wave_sum(dv * dv) * (1.f / 64.f);
            const float on = dv * (1.f / sqrtf(var + 64e-5f)) * lnw[ch] + lnb[ch];
            const bf16* z = ZR + (size_t)m * ZR_W + ch;
            float r = bf2f(z[0]) * cw[RW_COLS + ch], k = bf2f(z[1024]) * cw[RW_COLS + 1024 + ch], v = bf2f(z[2048]) * cw[RW_COLS + 2048 + ch];
            if (idx > 0) { r += bf2f(z[-ZR_W]) * cw[ch]; k += bf2f(z[1024 - ZR_W]) * cw[1024 + ch]; v += bf2f(z[2048 - ZR_W]) * cw[2048 + ch]; }
            if (idx < len - 1) { r += bf2f(z[ZR_W]) * cw[2 * RW_COLS + ch]; k += bf2f(z[1024 + ZR_W]) * cw[2 * RW_COLS + 1024 + ch]; v += bf2f(z[2048 + ZR_W]) * cw[2 * RW_COLS + 2048 + ch]; }
            const float a0 = bf2f(AA[(size_t)m * 1024 + ch]), a1 = bf2f(AA[((size_t)MT + m) * 1024 + ch]);
            const float kaw = k_a[ch]; const float kd0 = k * (1.f + (a0 - 1.f) * kaw), kd1 = k * (1.f + (a1 - 1.f) * kaw);
            const float bs = wave_sum(r * (kd0 + kd1) * r_k[ch]);
            const float res = (on + bs * v) * bf2f(G[(size_t)m * 1024 + ch]);
            ORW[(size_t)m * 1024 + ch] = (bf16)f2bf(res);
        }
    }
    {
        const bf16* YG = RGN(bf16, R_YG); const bf16* ZG = RGN(bf16, R_ZG); bf16* OGL = RGN(bf16, R_OGL); const float* nw = A.in[25] + l * 512;
        const f32x4 nw0 = *(const f32x4*)(nw + lane * 8), nw1 = *(const f32x4*)(nw + lane * 8 + 4);
        for (int it = gw; it < nrows * 4; it += NGW) {
            const int m = it >> 2, h = it & 3;
            const v4u ya = *(const v4u*)(YG + (size_t)m * 2048 + h * 512 + lane * 8), yb = *(const v4u*)(YG + ((size_t)MT + m) * 2048 + h * 512 + lane * 8);
            f32x4 y0 = (f32x4){bflo(ya.x) + bflo(yb.x), bfhi(ya.x) + bfhi(yb.x), bflo(ya.y) + bflo(yb.y), bfhi(ya.y) + bfhi(yb.y)};
            f32x4 y1 = (f32x4){bflo(ya.z) + bflo(yb.z), bfhi(ya.z) + bfhi(yb.z), bflo(ya.w) + bflo(yb.w), bfhi(ya.w) + bfhi(yb.w)};
            const float ss = wave_sum((y0.x * y0.x + y0.y * y0.y) + (y0.z * y0.z + y0.w * y0.w) + (y1.x * y1.x + y1.y * y1.y) + (y1.z * y1.z + y1.w * y1.w));
            const float rs = 1.f / sqrtf(ss * (1.f / 512.f) + 1e-5f);
            const v4u gw4 = *(const v4u*)(ZG + (size_t)m * ZG_W + 4096 + h * 512 + lane * 8);
            const f32x4 g0 = (f32x4){bflo(gw4.x), bfhi(gw4.x), bflo(gw4.y), bfhi(gw4.y)}, g1 = (f32x4){bflo(gw4.z), bfhi(gw4.z), bflo(gw4.w), bfhi(gw4.w)};
            y0 = y0 * rs * nw0; y1 = y1 * rs * nw1;
            v4u w; w.x = pk2(y0.x * fsilu(g0.x), y0.y * fsilu(g0.y)); w.y = pk2(y0.z * fsilu(g0.z), y0.w * fsilu(g0.w));
            w.z = pk2(y1.x * fsilu(g1.x), y1.y * fsilu(g1.y)); w.w = pk2(y1.z * fsilu(g1.z), y1.w * fsilu(g1.w));
            *(v4u*)(OGL + (size_t)m * 2048 + h * 512 + lane * 8) = w;
        }
    }
}


#ifndef MK_ONE_LAUNCH
#define MK_ONE_LAUNCH 1
#endif

template <int K> __device__ __forceinline__ void run_phase(const Frame& F, ArgsRef A, int l) {
    const float* mods = WSP(float, WS_MODS);
    bf16* HB = WSP(bf16, WS_HB);
    const bool last = (l == DEPTH - 1);
    const float* mods_l = mods + (size_t)l * 9 * 18432;
    const float* lng = A.in[6] + (size_t)l * 3 * D; const float* lnb = A.in[7] + (size_t)l * 3 * D;
    const int nrows = last ? ML : MT;
    if constexpr (K == -1) phase_init(F, A);
    if constexpr (K == 0) {
        if (l > 0) phase_ln<true, true>(F, MT, lng - D, lnb - D, mods_l, 0, 1);
        else phase_ln<false, true>(F, MT, nullptr, nullptr, mods_l, 0, 1);
        phase_convert(F, A, l, 0, 3);
    }
    if constexpr (K == 1 || K == 12) { const int M = (K == 1) ? MT : nrows; pg8::Gemm g{HB, RGN(bf16, R_WGU), M, 2 * FF, D, D, D}; pg8::StaticOrder S; S.init(M, 2 * FF, F.G, F.bid);
        pg8::EpiSwiglu E{RGN(bf16, R_H), FF}; pg8::gemm_phase<pg8::EpiSwiglu, pg8::StaticOrder, true, true>(F.lds, g, S, E, F.tid); }
    if constexpr (K == 2 || K == 13) { const int M = (K == 2) ? MT : nrows; pg8::Gemm g{RGN(bf16, R_H), RGN(bf16, R_WDN), M, D, FF, FF, FF}; pg8::StaticOrder S; S.init(M, D, F.G, F.bid);
        pg8::EpiResid E{F.out, WSP(float, WS_XC), mods_l, (K == 2) ? 2 : 8, ALPHA, 0.5f}; pg8::gemm_phase<pg8::EpiResid, pg8::StaticOrder, true, true>(F.lds, g, S, E, F.tid); }
    if constexpr (K == 3) phase_ln<true, true>(F, MT, lng, lnb, mods_l, 3, 4);
    if constexpr (K == 4) { pg8::Gemm g{HB, WSP(bf16, WS_WM + WM_IN), MT, NMIX, D, D, D}; pg8::StaticOrder S; S.init(MT, NMIX, F.G, F.bid);
        typedef pg8::EpiBf16Seg<0, WS_R + R_ZA, WS_R + R_ZR, WS_R + R_ZG, 6, 21, ZA_W, ZR_W, ZG_W> EpiWin; EpiWin E{F.ws};
        pg8::gemm_phase<EpiWin, pg8::StaticOrder, true, true>(F.lds, g, S, E, F.tid); }
    if constexpr (K == 5) phase_prep(F, A, l);
    if constexpr (K == 6) {
        { pg8::Gemm g{RGN(bf16, R_LA), WSP(bf16, WS_WM + WM_LW), MT, 2048, 256, LA_W, 256}; pg8::StaticOrder S; S.init(MT, 2048, F.G, F.bid);
          pg8::EpiLora<0> E{RGN(float, R_WDEC), nullptr, A.in[13] + (size_t)l * 2048, (size_t)MT * 1024}; pg8::gemm_phase<pg8::EpiLora<0>, pg8::StaticOrder, true, true>(F.lds, g, S, E, F.tid); }
    }
    if constexpr (K == 15) {
        { pg8::Gemm g{RGN(bf16, R_LA) + 256, WSP(bf16, WS_WM + WM_LA), MT, 2048, 256, LA_W, 256}; pg8::StaticOrder S; S.init(MT, 2048, F.G, F.bid);
          pg8::EpiLora<1> E{nullptr, RGN(bf16, R_AA), A.in[15] + (size_t)l * 2048, (size_t)MT * 1024}; pg8::gemm_phase<pg8::EpiLora<1>, pg8::StaticOrder, true, true>(F.lds, g, S, E, F.tid); }
    }
    if constexpr (K == 16) {
        { pg8::Gemm g{RGN(bf16, R_LA) + 512, WSP(bf16, WS_WM + WM_LG), MT, 1024, 256, LA_W, 256}; pg8::StaticOrder S; S.init(MT, 1024, F.G, F.bid);
          pg8::EpiLora<2> E{nullptr, RGN(bf16, R_G), nullptr, 0}; pg8::gemm_phase<pg8::EpiLora<2>, pg8::StaticOrder, true, true>(F.lds, g, S, E, F.tid); }
    }
    if constexpr (K == 7) phase_mix(F, A, l, last);
    if constexpr (K == 8) {
        phase_mixout(F, A, l, nrows);
        __syncthreads();
        pg8::Gemm g{HB, WSP(bf16, WS_WM + WM_IN) + (size_t)NMIX * D, nrows, GT_W, D, D, D}; pg8::StaticOrder S; S.init(nrows, GT_W, F.G, F.bid);
        typedef pg8::EpiBf16Seg<1, WS_R + R_GT, WS_R + R_GT, WS_R + R_GT, 1 << 20, 1 << 20, GT_W, GT_W, GT_W> EpiGate; EpiGate E{F.ws};
        pg8::gemm_phase<EpiGate, pg8::StaticOrder, true, true>(F.lds, g, S, E, F.tid);
    }
    if constexpr (K == 9) {
        { pg8::Gemm g{RGN(bf16, R_ZA), WSP(bf16, WS_WM + WM_BA), nrows, D, 1024, ZA_W, 1024}; pg8::StaticOrder S; S.init(nrows, D, F.G, F.bid);
          pg8::EpiBranch<0> E{RGN(bf16, R_GT), GT_W, 0, RGN(float, R_MT), nullptr}; pg8::gemm_phase<pg8::EpiBranch<0>, pg8::StaticOrder, true, true>(F.lds, g, S, E, F.tid); }
        { pg8::Gemm g{RGN(bf16, R_ORW), WSP(bf16, WS_WM + WM_BR), nrows, D, 1024, 1024, 1024}; pg8::StaticOrder S; S.init(nrows, D, F.G, F.bid);
          pg8::EpiBranch<1> E{RGN(bf16, R_GT), GT_W, 2048, RGN(float, R_MT), nullptr}; pg8::gemm_phase<pg8::EpiBranch<1>, pg8::StaticOrder, true, true>(F.lds, g, S, E, F.tid); }
        { pg8::Gemm g{RGN(bf16, R_OGL), WSP(bf16, WS_WM + WM_BG), nrows, D, D, D, D}; pg8::StaticOrder S; S.init(nrows, D, F.G, F.bid);
          pg8::EpiBranch<2> E{RGN(bf16, R_GT), GT_W, 4096, RGN(float, R_MT), RGN(bf16, R_MG)}; pg8::gemm_phase<pg8::EpiBranch<2>, pg8::StaticOrder, true, true>(F.lds, g, S, E, F.tid); }
    }
    if constexpr (K == 10) { pg8::Gemm g{RGN(bf16, R_MG), WSP(bf16, WS_WM + WM_OUT), nrows, D, D, D, D}; pg8::StaticOrder S; S.init(nrows, D, F.G, F.bid);
        pg8::EpiResid E{F.out, WSP(float, WS_XC), mods_l, 5, ALPHA, 1.0f}; pg8::gemm_phase<pg8::EpiResid, pg8::StaticOrder, true, true>(F.lds, g, S, E, F.tid); }
    if constexpr (K == 11) { phase_ln<true, true>(F, nrows, lng + D, lnb + D, mods_l, 6, 7); phase_convert(F, A, l, 1, 1); }
    if constexpr (K == 14) phase_ln<true, false>(F, ML, lng + 2 * D, lnb + 2 * D, nullptr, 0, 0);
}

__device__ __forceinline__ void frame_init(Frame& F, const Args& A, unsigned char* lds_raw) {
    F.lds = (LAS unsigned char*)lds_raw;
    F.tid = threadIdx.x; F.lane = F.tid & 63; F.wave = __builtin_amdgcn_readfirstlane(F.tid >> 6);
    F.G = gridDim.x; F.bid = blockIdx.x; F.out = A.out; F.ws = A.ws;
}

template <int K> __global__ void __launch_bounds__(NTHR, 2) fwd_phase(Args A) {
    extern __shared__ __attribute__((aligned(16))) unsigned char lds_raw[];
    Frame F; frame_init(F, A, lds_raw);
    const CAS Args* ap = (const CAS Args*)__builtin_amdgcn_kernarg_segment_ptr();
    run_phase<K>(F, *ap, A.ph_lo);
}


#ifndef MK_UNROLL_LAYERS
#define MK_UNROLL_LAYERS 0
#endif
__device__ __forceinline__ void launder(Frame& F, int& l) {
    asm volatile("" : "+v"(F.tid));
    F.lane = F.tid & 63; F.wave = __builtin_amdgcn_readfirstlane(F.tid >> 6);
    asm volatile("" : "+s"(F.bid), "+s"(F.G), "+s"(l));
    asm volatile("" : "+s"(F.ws), "+s"(F.out));
}
template <int K> __device__ __forceinline__ void run_phase_l(Frame F, int l) { launder(F, l); const CAS Args* ap = (const CAS Args*)__builtin_amdgcn_kernarg_segment_ptr(); asm volatile("" : "+s"(ap)); run_phase<K>(F, *ap, l); }
template <int L> __device__ __forceinline__ void run_layer(const Frame& F, int l, const XcdBarrier& bar) {
#define PB(K) run_phase_l<K>(F, l); xcd_barrier(bar, F.tid);
    PB(0) PB(1) PB(2) PB(3) PB(4) PB(5)
    run_phase_l<6>(F, l); run_phase_l<15>(F, l); run_phase_l<16>(F, l); xcd_barrier(bar, F.tid);
    PB(7) PB(8) PB(9) PB(10) PB(11) PB(12) PB(13)
#undef PB
}
__global__ void __launch_bounds__(NTHR, 2) fwd_all(Args A) {
    extern __shared__ __attribute__((aligned(16))) unsigned char lds_raw[];
    Frame F; frame_init(F, A, lds_raw);
    volatile LAS unsigned* MISC = (volatile LAS unsigned*)(F.lds + MISC_OFF);
    for (int u = F.tid; u < (LDS_BYTES - LDSCTL_OFF) / 4; u += NTHR) ((LAS unsigned*)(F.lds + LDSCTL_OFF))[u] = 0u;
    __syncthreads();
    const XcdBarrier bar = xcd_barrier_post((unsigned*)(F.ws + WS_CTL) + 4096, MISC + 8, F.tid);
    run_phase_l<-1>(F, 0); xcd_barrier(bar, F.tid);
#if MK_UNROLL_LAYERS
    run_layer<0>(F, 0, bar); run_layer<1>(F, 1, bar);
#else
    for (int l = 0; l < DEPTH; ++l) run_layer<0>(F, l, bar);
#endif
    run_phase_l<14>(F, DEPTH - 1);
}

template <int K> static void launch_phase(const Args& a, int l, int grid, hipStream_t stream) {
    static bool attr_done = false;
    if (!attr_done) { (void)hipFuncSetAttribute((const void*)fwd_phase<K>, hipFuncAttributeMaxDynamicSharedMemorySize, LDS_BYTES); attr_done = true; }
    Args b = a; b.ph_lo = l; b.ph_hi = 0;
    hipLaunchKernelGGL(fwd_phase<K>, dim3(grid), dim3(NTHR), LDS_BYTES, stream, b);
}

extern "C" void kernel_launch(void* const* d_in, const int* in_sizes, int n_in, void* d_out, int out_size, void* d_ws, size_t ws_size, hipStream_t stream) {
    static int grid = 0;
    if (grid == 0) {
        if (n_in != 30 || out_size != ML * D || ws_size < WS_END) { fprintf(stderr, "kernel_launch: unexpected shapes (n_in %d, out %d, ws %zu < %zu)\n", n_in, out_size, ws_size, (size_t)WS_END); grid = -1; return; }
        int dev = 0, cus = 0;
        if (hipGetDevice(&dev) != hipSuccess || hipDeviceGetAttribute(&cus, hipDeviceAttributeMultiprocessorCount, dev) != hipSuccess) { grid = -1; return; }
        grid = cus;
    }
    if (grid < 0) return;
    (void)hipMemsetAsync((char*)d_ws + WS_CTL, 0, CTL_ZERO_BYTES, stream);
    Args a{};
    for (int i = 0; i < 30; ++i) a.in[i] = (const float*)d_in[i];
    a.out = (float*)d_out; a.ws = (unsigned char*)d_ws;
#if MK_ONE_LAUNCH
    {
        static bool attr_done = false;
        if (!attr_done) { int per_cu = 0;
            if (hipFuncSetAttribute((const void*)fwd_all, hipFuncAttributeMaxDynamicSharedMemorySize, LDS_BYTES) != hipSuccess) { fprintf(stderr, "kernel_launch: hipFuncSetAttribute failed\n"); grid = -1; return; }
            if (hipOccupancyMaxActiveBlocksPerMultiprocessor(&per_cu, (const void*)fwd_all, NTHR, LDS_BYTES) != hipSuccess || per_cu < 1) { fprintf(stderr, "kernel_launch: occupancy query says %d blocks per CU; not launching\n", per_cu); (void)hipGetLastError(); grid = -1; return; }
            attr_done = true; }
        a.ph_lo = 0; a.ph_hi = 0;
        hipLaunchKernelGGL(fwd_all, dim3(grid), dim3(NTHR), LDS_BYTES, stream, a);
        return;
    }
#endif
    launch_phase<-1>(a, 0, grid, stream);
    for (int l = 0; l < DEPTH; ++l) {
        launch_phase<0>(a, l, grid, stream); launch_phase<1>(a, l, grid, stream); launch_phase<2>(a, l, grid, stream); launch_phase<3>(a, l, grid, stream);
        launch_phase<4>(a, l, grid, stream); launch_phase<5>(a, l, grid, stream); launch_phase<6>(a, l, grid, stream); launch_phase<15>(a, l, grid, stream); launch_phase<16>(a, l, grid, stream); launch_phase<7>(a, l, grid, stream);
        launch_phase<8>(a, l, grid, stream); launch_phase<9>(a, l, grid, stream); launch_phase<10>(a, l, grid, stream); launch_phase<11>(a, l, grid, stream);
        launch_phase<12>(a, l, grid, stream); launch_phase<13>(a, l, grid, stream);
    }
    launch_phase<14>(a, DEPTH - 1, grid, stream);
}
```

```cpp
#include <hip/hip_runtime.h>
#include <cstdio>
#include <cstdint>

#define GAS __attribute__((address_space(1)))
#define LAS __attribute__((address_space(3)))
typedef unsigned short bf16;
typedef unsigned v4u __attribute__((ext_vector_type(4)));
typedef unsigned v2u __attribute__((ext_vector_type(2)));
typedef float v2f __attribute__((ext_vector_type(2)));
typedef float f32x4 __attribute__((ext_vector_type(4)));
typedef float f32x2 __attribute__((ext_vector_type(2)));
typedef short bf16x8 __attribute__((ext_vector_type(8)));

__device__ __forceinline__ float bf2f(unsigned short b) { return __builtin_bit_cast(float, ((unsigned)b) << 16); }
__device__ __forceinline__ float bflo(unsigned w) { return __builtin_bit_cast(float, w << 16); }
__device__ __forceinline__ float bfhi(unsigned w) { return __builtin_bit_cast(float, w & 0xffff0000u); }
typedef __bf16 bf2n_t_ __attribute__((ext_vector_type(2)));
__device__ __forceinline__ unsigned pk2(float lo, float hi) { const f32x2 v = {lo, hi}; return __builtin_bit_cast(unsigned, __builtin_convertvector(v, bf2n_t_)); }
__device__ __forceinline__ unsigned f2bf(float f) { return pk2(f, 0.f) & 0xffffu; }
template <int CTRL, int ROW_MASK> __device__ __forceinline__ float dppf(float v) {
    return __builtin_bit_cast(float, __builtin_amdgcn_update_dpp(0, __builtin_bit_cast(int, v), CTRL, ROW_MASK, 0xF, false)); }
__device__ __forceinline__ float wave_sum(float v) {
    v += dppf<0xB1, 0xF>(v);
    v += dppf<0x4E, 0xF>(v);
    v += dppf<0x141, 0xF>(v);
    v += dppf<0x140, 0xF>(v);
    v += dppf<0x142, 0xA>(v);
    v += dppf<0x143, 0xC>(v);
    return __builtin_bit_cast(float, __builtin_amdgcn_readlane(__builtin_bit_cast(int, v), 63));
}
__device__ __forceinline__ void half_swap(float& a, float& b) { asm volatile("v_nop\n\tv_nop\n\tv_permlane32_swap_b32 %0, %1\n\tv_nop\n\tv_nop" : "+v"(a), "+v"(b)); }
__device__ __forceinline__ float xhalf_max(float v) { float a = v, b = v; half_swap(a, b); return fmaxf(a, b); }
__device__ __forceinline__ float xhalf_sum(float v) { float a = v, b = v; half_swap(a, b); return a + b; }
__device__ __forceinline__ float fsigmoid(float x) { return __builtin_amdgcn_rcpf(1.0f + __expf(-x)); }
__device__ __forceinline__ float fsilu(float x) { return x * __builtin_amdgcn_rcpf(1.0f + __expf(-x)); }
__device__ __forceinline__ float fsoftplus(float x) { return fmaxf(x, 0.f) + __logf(1.0f + __expf(-fabsf(x))); }
__device__ __forceinline__ float ftanh(float x) { const float e = __expf(-2.0f * fabsf(x)); const float t = (1.0f - e) * __builtin_amdgcn_rcpf(1.0f + e); return x < 0.f ? -t : t; }

namespace pg8 {
#define PG8_LAS __attribute__((address_space(3)))
typedef unsigned short bf16_t;
typedef short bf16x8 __attribute__((ext_vector_type(8)));
typedef float f32x4 __attribute__((ext_vector_type(4)));
typedef unsigned u32x4 __attribute__((ext_vector_type(4)));
constexpr int BM = 256, BK = 64, HALF = 128, HTB = HALF * BK * 2  , STAGE_BYTES = 8 * HTB, NXCD = 8, WGM = 8;

__host__ __device__ __forceinline__ int lds_byte(int r, int c) { const int st = (r >> 4) * 2 + (c >> 5), rr = r & 15, cc = c & 31, ob = rr * 64 + cc * 2; return st * 1024 + (ob ^ (((ob >> 9) & 1) << 5)); }
__host__ __device__ __forceinline__ void stage_rc(int b, int& R, int& C) { const int st = b / 1024, sb = b % 1024, swz = sb ^ (((sb >> 9) & 1) << 5); R = (st >> 1) * 16 + swz / 64; C = (st & 1) * 32 + (swz % 64) / 2; }
__host__ __device__ __forceinline__ int perm32(int rho) { const int n = rho >> 4, i = rho & 15; return 8 * (i >> 2) + 4 * n + (i & 3); }

struct Unit { int pm, pn, kq; };
struct Gemm { const bf16_t* A; const bf16_t* Bt; int M, N, K, lda, ldb; int kqb; int jt, jb; };

struct StaticOrder {
    int nM, nN, nwg, G, c;
    __host__ __device__ void init(int M, int N, int G_, int c_) { nM = M / BM; nN = N / BM; nwg = nM * nN; G = G_; c = c_; }
    __host__ __device__ bool next(int i, Unit& u) const {
        const long L = (long)i * G + c; if (L >= nwg) return false;
        int wgid = (int)L; { const int q = nwg / NXCD, r = nwg % NXCD, xcd = wgid % NXCD, off = wgid / NXCD; wgid = (xcd < r ? xcd * (q + 1) : r * (q + 1) + (xcd - r) * q) + off; }
        const int nig = WGM * nN, gid = wgid / nig, fm = gid * WGM, gsz = (nM - fm) < WGM ? (nM - fm) : WGM;
        u.pm = fm + ((wgid % nig) % gsz); u.pn = (wgid % nig) / gsz; u.kq = 0; return true;
    }
    __device__ __forceinline__ void a_ready(const Unit&) const {}
    __device__ __forceinline__ void done(const Unit&) const {}
};

struct SplitKOrder {
    int nM, nN, nq, G, c;
    __host__ __device__ void init(int M, int N, int NQ, int G_, int c_) { nM = M / BM; nN = N / BM; nq = NQ; G = G_; c = c_; }
    __host__ __device__ bool next(int i, Unit& u) const { const long L = (long)i * G + c; if (L >= (long)nM * nN * nq) return false; const int t = (int)L / nq; u.kq = (int)L % nq; u.pm = t % nM; u.pn = t / nM; return true; }
    __device__ __forceinline__ void a_ready(const Unit&) const {}
    __device__ __forceinline__ void done(const Unit&) const {}
};
typedef __bf16 bf2_t_ __attribute__((ext_vector_type(2)));
typedef float f2_t_ __attribute__((ext_vector_type(2)));
__device__ __forceinline__ unsigned cvt_pk_bf16(float lo, float hi) { const f2_t_ v = {lo, hi}; return __builtin_bit_cast(unsigned, __builtin_convertvector(v, bf2_t_)); }

#define EPI_ROWS_BEGIN \
    _Pragma("unroll") for (int ai = 0; ai < 2; ++ai) _Pragma("unroll") for (int m = 0; m < 4; ++m) { const int row = u.pm * BM + ai * HALF + wr * 64 + m * 16 + fr;
#define EPI_ROWS_END }

template <int ACT, size_t O0, size_t O1, size_t O2, int T1, int T2, int L0, int L1, int L2> struct EpiBf16Seg {
    static constexpr bool PERM = true, AFTER_DRAIN = false;
    unsigned char* ws;
    __device__ __forceinline__ void operator()(const f32x4 (&acc)[2][2][4][2], const Unit& u, int wr, int wc, int fr, int fq) const {
        const size_t off = u.pn >= T2 ? O2 : (u.pn >= T1 ? O1 : O0); const int l = u.pn >= T2 ? L2 : (u.pn >= T1 ? L1 : L0), tb = u.pn >= T2 ? T2 : (u.pn >= T1 ? T1 : 0);
        bf16_t* base = (bf16_t*)(ws + off);
        const int col0 = (u.pn - tb) * BM + wc * 32 + 8 * fq;
        EPI_ROWS_BEGIN
            bf16_t* rowp = base + (size_t)row * l + col0;
#pragma unroll
            for (int bj = 0; bj < 2; ++bj) { f32x4 v0 = acc[ai][bj][m][0], v1 = acc[ai][bj][m][1];
                if (ACT == 1) {
#pragma unroll
                    for (int j = 0; j < 4; ++j) { v0[j] = fsigmoid(v0[j]); v1[j] = fsigmoid(v1[j]); } }
                u32x4 w; w.x = cvt_pk_bf16(v0[0], v0[1]); w.y = cvt_pk_bf16(v0[2], v0[3]); w.z = cvt_pk_bf16(v1[0], v1[1]); w.w = cvt_pk_bf16(v1[2], v1[3]);
                *(u32x4*)(rowp + bj * HALF) = w; }
        EPI_ROWS_END
    }
};
struct EpiSwiglu {
    static constexpr bool PERM = true, AFTER_DRAIN = false;
    bf16_t* H; int ldh;
    __device__ __forceinline__ void operator()(const f32x4 (&acc)[2][2][4][2], const Unit& u, int wr, int wc, int fr, int fq) const {
        const int col0 = u.pn * HALF + wc * 32 + 8 * fq;
        EPI_ROWS_BEGIN
            f32x4 g0 = acc[ai][0][m][0], g1 = acc[ai][0][m][1]; const f32x4 u0 = acc[ai][1][m][0], u1 = acc[ai][1][m][1];
#pragma unroll
            for (int j = 0; j < 4; ++j) { g0[j] = fsilu(g0[j]) * u0[j]; g1[j] = fsilu(g1[j]) * u1[j]; }
            u32x4 w; w.x = cvt_pk_bf16(g0[0], g0[1]); w.y = cvt_pk_bf16(g0[2], g0[3]); w.z = cvt_pk_bf16(g1[0], g1[1]); w.w = cvt_pk_bf16(g1[2], g1[3]);
            *(u32x4*)(H + (size_t)row * ldh + col0) = w;
        EPI_ROWS_END
    }
};
struct EpiPartial {
    static constexpr bool PERM = true, AFTER_DRAIN = false;
    float* P; int ldp; size_t qstride;
    __device__ __forceinline__ void operator()(const f32x4 (&acc)[2][2][4][2], const Unit& u, int wr, int wc, int fr, int fq) const {
        const int col0 = u.pn * BM + wc * 32 + 8 * fq; float* base = P + (size_t)u.kq * qstride;
        EPI_ROWS_BEGIN
            float* rowp = base + (size_t)row * ldp + col0;
#pragma unroll
            for (int bj = 0; bj < 2; ++bj)
#pragma unroll
                for (int n = 0; n < 2; ++n) *(f32x4*)(rowp + bj * HALF + 4 * n) = acc[ai][bj][m][n];
        EPI_ROWS_END
    }
};
constexpr float RES_ALPHA = 1.41421356237f;
template <int COEF2> struct EpiResid {
    static constexpr bool PERM = true, AFTER_DRAIN = false;
    float* xl; const float* mods; const float* sl; const float* st; const float* lg; const float* lb; int kmod;
    __device__ __forceinline__ void operator()(const f32x4 (&acc)[2][2][4][2], const Unit& u, int wr, int wc, int fr, int fq) const {
        const float* mp = mods + (size_t)(u.pm >> 3) * (9 * 2048) + kmod * 2048;
        const int col0 = u.pn * BM + wc * 32 + 8 * fq;
        const bool ln = st != nullptr; constexpr float al = RES_ALPHA, coef = 0.5f * COEF2;
        const float* stp = ln ? st : mods;
        const int row0 = u.pm * BM + wr * 64 + fr;
        const size_t rbase = (size_t)row0 * 2048 + col0;
#pragma unroll
        for (int bj = 0; bj < 2; ++bj) {
            f32x4 mv[2], ag[2], ab[2];
#pragma unroll
            for (int n = 0; n < 2; ++n) { mv[n] = *(const f32x4*)(mp + col0 + bj * HALF + 4 * n) * coef;
                const f32x4 g4 = *(const f32x4*)(lg + col0 + bj * HALF + 4 * n), b4 = *(const f32x4*)(lb + col0 + bj * HALF + 4 * n);
                const f32x4 g4s = ln ? g4 : (f32x4){1.f, 1.f, 1.f, 1.f}, b4s = ln ? b4 : (f32x4){0.f, 0.f, 0.f, 0.f};
                ag[n] = g4s * al; ab[n] = b4s * al; }
            f32x4 xa[3][2]; f2_t_ ms[3];
#define RES_LOADG(slot, g_) do { const int ro_ = ((g_) >> 2) * HALF + ((g_) & 3) * 16; \
                _Pragma("unroll") for (int n = 0; n < 2; ++n) xa[slot][n] = *(const f32x4*)(sl + rbase + (size_t)ro_ * 2048 + bj * HALF + 4 * n); \
                ms[slot] = *(const f2_t_*)(stp + 2 * (row0 + ro_)); } while (0)
            RES_LOADG(0, 0); RES_LOADG(1, 1);
#pragma unroll
            for (int gi = 0; gi < 8; ++gi) {
                const int ai = gi >> 2, m = gi & 3;
                if (gi + 2 < 8) RES_LOADG((gi + 2) % 3, gi + 2);
                asm volatile("" ::: "memory");
                float* rowp = xl + rbase + (size_t)(ai * HALF + m * 16) * 2048 + bj * HALF;
                const float mean = ln ? ms[gi % 3][0] : 0.f, rstd = ln ? ms[gi % 3][1] : 1.f;
#pragma unroll
                for (int n = 0; n < 2; ++n) { const f32x4 t = ag[n] * rstd;
                    *(f32x4*)(rowp + 4 * n) = (xa[gi % 3][n] - mean) * t + (ab[n] + mv[n] * acc[ai][bj][m][n]); }
                asm volatile("" ::: "memory");
            }
#undef RES_LOADG
        }
    }
};
template <int MODE> struct EpiBranch {
    static constexpr bool PERM = true, AFTER_DRAIN = false;
    const bf16_t* GT; int ldg, goff; float* T; bf16_t* O;
    __device__ __forceinline__ void operator()(const f32x4 (&acc)[2][2][4][2], const Unit& u, int wr, int wc, int fr, int fq) const {
        const int col0 = u.pn * BM + wc * 32 + 8 * fq;
        const size_t r0 = (size_t)(u.pm * BM + wr * 64 + fr);
        u32x4 gw[2][2]; f32x4 tv[2][2][2];
#pragma unroll
        for (int bj = 0; bj < 2; ++bj) { gw[0][bj] = *(const u32x4*)(GT + r0 * ldg + goff + col0 + bj * HALF);
            if (MODE >= 1) { const float* tp = T + r0 * 2048 + col0 + bj * HALF; tv[0][bj][0] = *(const f32x4*)tp; tv[0][bj][1] = *(const f32x4*)(tp + 4); } }
#pragma unroll
        for (int gi = 0; gi < 8; ++gi) {
            const int ai = gi >> 2, m = gi & 3; const size_t row = r0 + ai * HALF + m * 16;
            if (gi < 7) { const size_t row2 = r0 + ((gi + 1) >> 2) * HALF + ((gi + 1) & 3) * 16;
#pragma unroll
                for (int bj = 0; bj < 2; ++bj) { gw[(gi + 1) & 1][bj] = *(const u32x4*)(GT + row2 * ldg + goff + col0 + bj * HALF);
                    if (MODE >= 1) { const float* tp = T + row2 * 2048 + col0 + bj * HALF; tv[(gi + 1) & 1][bj][0] = *(const f32x4*)tp; tv[(gi + 1) & 1][bj][1] = *(const f32x4*)(tp + 4); } } }
            asm volatile("" ::: "memory");
#pragma unroll
            for (int bj = 0; bj < 2; ++bj) {
                const u32x4 g4 = gw[gi & 1][bj];
                const f32x4 g0 = (f32x4){bflo(g4.x), bfhi(g4.x), bflo(g4.y), bfhi(g4.y)}, g1 = (f32x4){bflo(g4.z), bfhi(g4.z), bflo(g4.w), bfhi(g4.w)};
                f32x4 v0 = g0 * acc[ai][bj][m][0], v1 = g1 * acc[ai][bj][m][1];
                float* tp = T + row * 2048 + col0 + bj * HALF;
                if (MODE >= 1) { v0 += tv[gi & 1][bj][0]; v1 += tv[gi & 1][bj][1]; }
                if (MODE <= 1) { *(f32x4*)tp = v0; *(f32x4*)(tp + 4) = v1; }
                else { u32x4 w; w.x = cvt_pk_bf16(v0[0], v0[1]); w.y = cvt_pk_bf16(v0[2], v0[3]); w.z = cvt_pk_bf16(v1[0], v1[1]); w.w = cvt_pk_bf16(v1[2], v1[3]);
                    *(u32x4*)(O + row * 2048 + col0 + bj * HALF) = w; }
            }
            asm volatile("" ::: "memory");
        }
    }
};
struct EpiBranchFused {
    static constexpr bool PERM = true, AFTER_DRAIN = false, MID = true;
    static constexpr int H1 = 16, H2 = 32;
    const bf16_t* GT; int ldg; bf16_t* O;
    static __device__ __forceinline__ void unpack(const u32x4 g4, f32x4& g0, f32x4& g1) { g0 = (f32x4){bflo(g4.x), bfhi(g4.x), bflo(g4.y), bfhi(g4.y)}; g1 = (f32x4){bflo(g4.z), bfhi(g4.z), bflo(g4.w), bfhi(g4.w)}; }
    __device__ __forceinline__ void mid(f32x4 (&acc)[2][2][4][2], const Unit& u, int wr, int wc, int fr, int fq, bool second) const {
        const int col0 = u.pn * BM + wc * 32 + 8 * fq;
        const size_t r0 = (size_t)(u.pm * BM + wr * 64 + fr);
        const int on = second ? 2048 : 0, od = second ? 4096 : 2048;
        const float nfloor = second ? 1e-20f : 0.f;
        u32x4 gn[2][2], gd[2][2];
#pragma unroll
        for (int bj = 0; bj < 2; ++bj) { gn[0][bj] = *(const u32x4*)(GT + r0 * ldg + on + col0 + bj * HALF); gd[0][bj] = *(const u32x4*)(GT + r0 * ldg + od + col0 + bj * HALF); }
#pragma unroll
        for (int gi = 0; gi < 8; ++gi) {
            const int ai = gi >> 2, m = gi & 3;
            if (gi < 7) { const size_t row2 = r0 + ((gi + 1) >> 2) * HALF + ((gi + 1) & 3) * 16;
#pragma unroll
                for (int bj = 0; bj < 2; ++bj) { gn[(gi + 1) & 1][bj] = *(const u32x4*)(GT + row2 * ldg + on + col0 + bj * HALF); gd[(gi + 1) & 1][bj] = *(const u32x4*)(GT + row2 * ldg + od + col0 + bj * HALF); } }
            asm volatile("" ::: "memory");
#pragma unroll
            for (int bj = 0; bj < 2; ++bj) {
                f32x4 n0, n1, d0, d1; unpack(gn[gi & 1][bj], n0, n1); unpack(gd[gi & 1][bj], d0, d1);
#pragma unroll
                for (int j = 0; j < 4; ++j) {
                    acc[ai][bj][m][0][j] *= fmaxf(n0[j], nfloor) * __builtin_amdgcn_rcpf(fmaxf(d0[j], 1e-20f));
                    acc[ai][bj][m][1][j] *= fmaxf(n1[j], nfloor) * __builtin_amdgcn_rcpf(fmaxf(d1[j], 1e-20f)); }
            }
            asm volatile("" ::: "memory");
        }
    }
    __device__ __forceinline__ void operator()(const f32x4 (&acc)[2][2][4][2], const Unit& u, int wr, int wc, int fr, int fq) const {
        const int col0 = u.pn * BM + wc * 32 + 8 * fq;
        const size_t r0 = (size_t)(u.pm * BM + wr * 64 + fr);
        u32x4 gw[2][2];
#pragma unroll
        for (int bj = 0; bj < 2; ++bj) gw[0][bj] = *(const u32x4*)(GT + r0 * ldg + 4096 + col0 + bj * HALF);
#pragma unroll
        for (int gi = 0; gi < 8; ++gi) {
            const int ai = gi >> 2, m = gi & 3; const size_t row = r0 + ai * HALF + m * 16;
            if (gi < 7) { const size_t row2 = r0 + ((gi + 1) >> 2) * HALF + ((gi + 1) & 3) * 16;
#pragma unroll
                for (int bj = 0; bj < 2; ++bj) gw[(gi + 1) & 1][bj] = *(const u32x4*)(GT + row2 * ldg + 4096 + col0 + bj * HALF); }
            asm volatile("" ::: "memory");
#pragma unroll
            for (int bj = 0; bj < 2; ++bj) {
                f32x4 g0, g1; unpack(gw[gi & 1][bj], g0, g1);
                f32x4 v0, v1;
#pragma unroll
                for (int j = 0; j < 4; ++j) { v0[j] = acc[ai][bj][m][0][j] * fmaxf(g0[j], 1e-20f); v1[j] = acc[ai][bj][m][1][j] * fmaxf(g1[j], 1e-20f); }
                u32x4 w; w.x = cvt_pk_bf16(v0[0], v0[1]); w.y = cvt_pk_bf16(v0[2], v0[3]); w.z = cvt_pk_bf16(v1[0], v1[1]); w.w = cvt_pk_bf16(v1[2], v1[3]);
                *(u32x4*)(O + row * 2048 + col0 + bj * HALF) = w;
            }
            asm volatile("" ::: "memory");
        }
    }
};
template <int MODE> struct EpiLora {
    static constexpr bool PERM = true, AFTER_DRAIN = false;
    float* WD; bf16_t* OB; const float* bias; size_t dstride;
    __device__ __forceinline__ void operator()(const f32x4 (&acc)[2][2][4][2], const Unit& u, int wr, int wc, int fr, int fq) const {
        const int colg = u.pn * BM + wc * 32 + 8 * fq;
        f32x4 bv[2][2];
#pragma unroll
        for (int bj = 0; bj < 2; ++bj) { if (MODE != 2) { bv[bj][0] = *(const f32x4*)(bias + colg + bj * HALF); bv[bj][1] = *(const f32x4*)(bias + colg + bj * HALF + 4); } else { bv[bj][0] = (f32x4){0.f, 0.f, 0.f, 0.f}; bv[bj][1] = bv[bj][0]; } }
        EPI_ROWS_BEGIN
#pragma unroll
            for (int bj = 0; bj < 2; ++bj) { const int cg = colg + bj * HALF; const int dir = (MODE == 2) ? 0 : (cg >> 10); const int c = (MODE == 2) ? cg : (cg & 1023);
                f32x4 v0 = acc[ai][bj][m][0], v1 = acc[ai][bj][m][1];
                if (MODE != 2) { v0 += bv[bj][0]; v1 += bv[bj][1]; }
                if (MODE == 0) {
#pragma unroll
                    for (int j = 0; j < 4; ++j) { v0[j] = -__expf(-fsoftplus(-v0[j]) - 0.5f); v1[j] = -__expf(-fsoftplus(-v1[j]) - 0.5f); }
                    float* p = WD + (size_t)dir * dstride + (size_t)row * 1024 + c; *(f32x4*)p = v0; *(f32x4*)(p + 4) = v1;
                } else {
                    if (MODE == 1) {
#pragma unroll
                        for (int j = 0; j < 4; ++j) { v0[j] = fsigmoid(v0[j]); v1[j] = fsigmoid(v1[j]); } }
                    u32x4 w; w.x = cvt_pk_bf16(v0[0], v0[1]); w.y = cvt_pk_bf16(v0[2], v0[3]); w.z = cvt_pk_bf16(v1[0], v1[1]); w.w = cvt_pk_bf16(v1[2], v1[3]);
                    *(u32x4*)(OB + (size_t)dir * dstride + (size_t)row * 1024 + c) = w;
                }
            }
            asm volatile("" ::: "memory");
        EPI_ROWS_END
    }
};

template <class E, class = void> struct mid_hook { static constexpr bool value = false; };
template <class E> struct mid_hook<E, decltype((void)E::MID)> { static constexpr bool value = E::MID; };
template <class Epi, class Sched, bool ALIGN_EPI = false, bool SP2 = false>
__device__ __forceinline__ void gemm_phase(PG8_LAS unsigned char* lds, const Gemm g, const Sched& S, const Epi& E, int tid_in) {
    int tid_ = tid_in; asm volatile("" : "+v"(tid_));
    const int tid = tid_, wid = __builtin_amdgcn_readfirstlane(tid >> 6), lane = tid & 63, wr = wid >> 2, wc = wid & 3, fr = lane & 15, fq = lane >> 4;
    int K_ = g.K, lda_ = g.lda, ldb_ = g.ldb; asm volatile("" : "+s"(K_), "+s"(lda_), "+s"(ldb_));
    const int K = K_, nt = K / BK, lda = lda_, ldb = ldb_;
    int jt_ = g.jt, jb_ = g.jb; asm volatile("" : "+s"(jt_), "+s"(jb_));
    const int jt = jt_; const size_t jb = (size_t)jb_;
    unsigned voffA[2], voffB[2];
#pragma unroll
    for (int i = 0; i < 2; ++i) { int R, C; stage_rc(tid * 16 + i * 8192, R, C); const int Rb = Epi::PERM ? ((R & ~31) + perm32(R & 31)) : R;
        voffA[i] = (unsigned)(R * lda + C) * 2u; voffB[i] = (unsigned)(Rb * ldb + C) * 2u; }
    const size_t kstep = (size_t)(BK * 2);
    const size_t hsA = (size_t)HALF * lda * 2, hsB = (size_t)HALF * ldb * 2;
    const size_t tsA = 2 * hsA, tsB = 2 * hsB;
    const unsigned ldsw = (unsigned)wid * 1024u;
    const int aoff = lds_byte(wr * 64 + fr, fq * 8), boff = lds_byte(wc * 32 + fr, fq * 8);
#define PG8_SA(b, h) (((b) * 2 + (h)) * HTB)
#define PG8_SB(b, h) ((4 + (b) * 2 + (h)) * HTB)
#define PG8_STAGE(bufoff, gbase, voff) do { _Pragma("unroll") for (int _i = 0; _i < 2; ++_i) \
        __builtin_amdgcn_global_load_lds((const unsigned*)((const char*)(gbase) + (voff)[_i]), (PG8_LAS unsigned*)(lds + (bufoff) + ldsw + _i * 8192), 16, 0, 0); } while (0)
#define PG8_LDA(dst, b, h) do { _Pragma("unroll") for (int m = 0; m < 4; ++m) _Pragma("unroll") for (int k = 0; k < 2; ++k) dst[m][k] = *(const PG8_LAS bf16x8*)(lds + PG8_SA(b, h) + aoff + m * 2048 + k * 1024); } while (0)
#define PG8_LDB(dst, b, h) do { _Pragma("unroll") for (int n = 0; n < 2; ++n) _Pragma("unroll") for (int k = 0; k < 2; ++k) dst[n][k] = *(const PG8_LAS bf16x8*)(lds + PG8_SB(b, h) + boff + n * 2048 + k * 1024); } while (0)
#define PG8_MMA(ai, bj, At, Bt) do { __builtin_amdgcn_s_setprio(1); _Pragma("unroll") for (int m = 0; m < 4; ++m) _Pragma("unroll") for (int n = 0; n < 2; ++n) _Pragma("unroll") for (int k = 0; k < 2; ++k) \
        acc[ai][bj][m][n] = __builtin_amdgcn_mfma_f32_16x16x32_bf16(Bt[n][k], At[m][k], acc[ai][bj][m][n], 0, 0, 0); __builtin_amdgcn_s_setprio(0); } while (0)
#define PG8_WAIT_V(n) asm volatile("s_waitcnt vmcnt(" #n ")" ::: "memory")
#define PG8_WAIT_L(n) asm volatile("s_waitcnt lgkmcnt(" #n ")" ::: "memory")
#define PG8_BAR __builtin_amdgcn_s_barrier()
#define PG8_SCHED __builtin_amdgcn_sched_barrier(0)
    Unit cur, nxt; int ui = 0;
    if (!S.next(0, cur)) return;
    f32x4 acc[2][2][4][2];
#pragma unroll
    for (int a = 0; a < 2; ++a)
#pragma unroll
        for (int b = 0; b < 2; ++b)
#pragma unroll
            for (int m = 0; m < 4; ++m)
#pragma unroll
                for (int n = 0; n < 2; ++n) acc[a][b][m][n] = (f32x4){0.f, 0.f, 0.f, 0.f};
    bf16x8 At[4][2], B0[2][2], B1[2][2];
    const char* cA = (const char*)g.A + (size_t)cur.pm * tsA + (size_t)cur.kq * g.kqb; const char* cB = (const char*)g.Bt + (size_t)cur.pn * tsB + (size_t)cur.kq * g.kqb;
    S.a_ready(cur);
    if constexpr (SP2) {
        PG8_STAGE(PG8_SB(0, 0), cB, voffB); PG8_STAGE(PG8_SB(0, 1), cB + hsB, voffB); PG8_STAGE(PG8_SA(0, 0), cA, voffA); PG8_STAGE(PG8_SA(0, 1), cA + hsA, voffA);
        if (wr == 1) PG8_BAR;
        PG8_WAIT_V(2); PG8_BAR;
        PG8_STAGE(PG8_SB(1, 0), cB + kstep, voffB); PG8_STAGE(PG8_SA(1, 0), cA + kstep, voffA); PG8_STAGE(PG8_SB(1, 1), cB + hsB + kstep, voffB);
        PG8_WAIT_V(6); PG8_BAR;
    } else {
        PG8_STAGE(PG8_SB(0, 0), cB, voffB); PG8_STAGE(PG8_SA(0, 0), cA, voffA); PG8_STAGE(PG8_SB(0, 1), cB + hsB, voffB); PG8_STAGE(PG8_SA(0, 1), cA + hsA, voffA);
        if (wr == 1) PG8_BAR;
        PG8_WAIT_V(4); PG8_BAR;
        PG8_STAGE(PG8_SB(1, 0), cB + kstep, voffB); PG8_STAGE(PG8_SA(1, 0), cA + kstep, voffA); PG8_STAGE(PG8_SB(1, 1), cB + hsB + kstep, voffB);
        PG8_WAIT_V(6); PG8_BAR;
    }
    for (;;) {
        const bool has_next = S.next(ui + 1, nxt);
        const char* nA = has_next ? (const char*)g.A + (size_t)nxt.pm * tsA + (size_t)nxt.kq * g.kqb : cA; const char* nB = has_next ? (const char*)g.Bt + (size_t)nxt.pn * tsB + (size_t)nxt.kq * g.kqb : cB;
        for (int t = 0; t < nt; t += 2) {
            const bool last = (t == nt - 2);
            if constexpr (mid_hook<Epi>::value) { if (t == Epi::H1 || t == Epi::H2) E.mid(acc, cur, wr, wc, fr, fq, t == Epi::H2); }
            const char* a1 = cA + (size_t)(t + 1) * kstep + (t >= jt ? jb : 0);
            const char* a2 = last ? nA : cA + (size_t)(t + 2) * kstep + (t + 2 >= jt ? jb : 0); const char* b2 = last ? nB : cB + (size_t)(t + 2) * kstep;
            const char* a3 = a2 + kstep; const char* b3 = b2 + kstep;
            if (last && has_next) S.a_ready(nxt);
            if constexpr (SP2) {
            PG8_LDB(B0, 0, 0); PG8_LDB(B1, 0, 1); PG8_SCHED; PG8_LDA(At, 0, 0); PG8_STAGE(PG8_SA(1, 1), a1 + hsA, voffA);
            PG8_WAIT_V(8); PG8_WAIT_L(0); PG8_BAR; PG8_MMA(0, 0, At, B0); PG8_MMA(0, 1, At, B1); PG8_BAR; PG8_SCHED;
            PG8_LDA(At, 0, 1); PG8_STAGE(PG8_SB(0, 0), b2, voffB); PG8_STAGE(PG8_SB(0, 1), b2 + hsB, voffB); PG8_STAGE(PG8_SA(0, 0), a2, voffA);
            PG8_WAIT_V(8); PG8_WAIT_L(0); PG8_BAR; PG8_MMA(1, 0, At, B0); PG8_MMA(1, 1, At, B1); PG8_BAR; PG8_SCHED;
            PG8_LDB(B0, 1, 0); PG8_LDB(B1, 1, 1); PG8_SCHED; PG8_LDA(At, 1, 0); PG8_STAGE(PG8_SA(0, 1), a2 + hsA, voffA);
            PG8_WAIT_V(8); PG8_WAIT_L(0); PG8_BAR; PG8_MMA(0, 0, At, B0); PG8_MMA(0, 1, At, B1); PG8_BAR; PG8_SCHED;
            PG8_LDA(At, 1, 1); PG8_STAGE(PG8_SB(1, 0), b3, voffB); PG8_STAGE(PG8_SB(1, 1), b3 + hsB, voffB); PG8_STAGE(PG8_SA(1, 0), a3, voffA);
            PG8_WAIT_V(8); PG8_WAIT_L(0); PG8_BAR; PG8_MMA(1, 0, At, B0); PG8_MMA(1, 1, At, B1); PG8_BAR; PG8_SCHED;
            } else {
            PG8_LDB(B0, 0, 0); PG8_SCHED; PG8_LDA(At, 0, 0); PG8_STAGE(PG8_SA(1, 1), a1 + hsA, voffA);
            PG8_WAIT_L(8); PG8_BAR; PG8_WAIT_L(0); PG8_MMA(0, 0, At, B0); PG8_BAR; PG8_SCHED;
            PG8_LDB(B1, 0, 1); PG8_STAGE(PG8_SB(0, 0), b2, voffB);
            PG8_BAR; PG8_WAIT_L(0); PG8_MMA(0, 1, At, B1); PG8_BAR;
            PG8_LDA(At, 0, 1); PG8_STAGE(PG8_SA(0, 0), a2, voffA);
            PG8_BAR; PG8_WAIT_L(0); PG8_MMA(1, 0, At, B0); PG8_BAR; PG8_SCHED;
            PG8_STAGE(PG8_SB(0, 1), b2 + hsB, voffB);
            PG8_WAIT_V(6); PG8_BAR; PG8_MMA(1, 1, At, B1); PG8_BAR;
            PG8_LDB(B0, 1, 0); PG8_SCHED; PG8_LDA(At, 1, 0); PG8_STAGE(PG8_SA(0, 1), a2 + hsA, voffA);
            PG8_WAIT_L(8); PG8_BAR; PG8_WAIT_L(0); PG8_MMA(0, 0, At, B0); PG8_BAR; PG8_SCHED;
            PG8_LDB(B1, 1, 1); PG8_STAGE(PG8_SB(1, 0), b3, voffB);
            PG8_BAR; PG8_WAIT_L(0); PG8_MMA(0, 1, At, B1); PG8_BAR;
            PG8_LDA(At, 1, 1); PG8_STAGE(PG8_SA(1, 0), a3, voffA);
            PG8_BAR; PG8_WAIT_L(0); PG8_MMA(1, 0, At, B0); PG8_BAR; PG8_SCHED;
            PG8_STAGE(PG8_SB(1, 1), b3 + hsB, voffB);
            PG8_WAIT_V(6); PG8_BAR; PG8_MMA(1, 1, At, B1); PG8_BAR;
            }
        }
        if constexpr (ALIGN_EPI) { if (wr == 0) PG8_BAR; }
        if constexpr (!Epi::AFTER_DRAIN) { E(acc, cur, wr, wc, fr, fq); S.done(cur); }
        if (!has_next) break;
#pragma unroll
        for (int a = 0; a < 2; ++a)
#pragma unroll
            for (int b = 0; b < 2; ++b)
#pragma unroll
                for (int m = 0; m < 4; ++m)
#pragma unroll
                    for (int n = 0; n < 2; ++n) acc[a][b][m][n] = (f32x4){0.f, 0.f, 0.f, 0.f};
        cur = nxt; cA = nA; cB = nB; ++ui;
        if constexpr (ALIGN_EPI) { if (wr == 1) PG8_BAR; }
    }
    PG8_WAIT_V(0);
    if constexpr (!ALIGN_EPI) { if (wr == 0) PG8_BAR; }
    PG8_BAR;
    if constexpr (Epi::AFTER_DRAIN) { E.fused(acc, cur, wr, wc, fr, fq, lds, wid, lane); S.done(cur); }
#undef PG8_SA
#undef PG8_SB
#undef PG8_STAGE
#undef PG8_LDA
#undef PG8_LDB
#undef PG8_MMA
#undef PG8_WAIT_V
#undef PG8_WAIT_L
#undef PG8_BAR
#undef PG8_SCHED
}
}

#undef EPI_ROWS_BEGIN
#undef EPI_ROWS_END

constexpr int D = 2048, NB = 8, SEQ = 2048, CL = 256, ML = NB * SEQ, MC = NB * CL, MT = ML + MC;
constexpr int FF = 5632, NMOD = 9, DEPTH = 2;
constexpr int NIN_SRC = 17568;
constexpr int ZA_LD = 4608;
constexpr int OC_RW = 1536, OC_GL = 2560;
constexpr int ZA_W = 1536, ZR_W = 3840, ZG_W = 6144, GT_W = 6144, NMIX = ZA_W + ZR_W + ZG_W  , NIN = NMIX + GT_W  ;
constexpr int RW_COLS = 3712, LA_W = 768;
constexpr float LN_EPS = 1e-5f, ALPHA = 1.41421356237f;
static_assert(ALPHA == pg8::RES_ALPHA, "residual scale");
constexpr int NWAVES = 8, NTHR = 512;

constexpr size_t MiB = 1u << 20;
constexpr size_t WS_CTL = 0, CTL_ZERO_BYTES = 1 * MiB;
constexpr size_t WS_MODS = 1 * MiB;
constexpr size_t WS_STATS = 3 * MiB;
constexpr size_t WS_XC = 4 * MiB;
constexpr size_t WS_HB = 20 * MiB;
constexpr size_t WS_WM = 92 * MiB;
constexpr size_t WM_IN = 0, WM_BA = 69 * MiB, WM_BR = 73 * MiB, WM_BG = 77 * MiB, WM_OUT = 85 * MiB, WM_LW = 93 * MiB, WM_LA = 94 * MiB, WM_LG = 95 * MiB;
constexpr size_t WS_R = 188 * MiB;
constexpr size_t R_WGU = 0, R_WDN = 44 * MiB, R_H = 66 * MiB;
constexpr size_t R_ZA = 0;
constexpr size_t R_ZR = 162 * MiB;
constexpr size_t R_AA = 297 * MiB;
constexpr size_t R_Y = 369 * MiB;
constexpr size_t R_G = 513 * MiB;
constexpr size_t R_ZG = 549 * MiB;
constexpr size_t R_YG = 765 * MiB;
constexpr size_t R_QR = 909 * MiB;
constexpr size_t R_KR = 941 * MiB;
constexpr size_t R_LA = 949 * MiB;
constexpr size_t R_WDEC = 976 * MiB;
constexpr size_t R_GL = 1120 * MiB;
constexpr size_t R_GT = R_QR;
constexpr size_t R_MG = R_Y;
constexpr size_t R_PART = 600 * MiB;
constexpr size_t R_BS = 1192 * MiB;
constexpr size_t R_END = 1195 * MiB;
constexpr size_t WS_END = WS_R + R_END;
static_assert(R_GT + (size_t)MT * GT_W * 2 <= R_END, "GT overlay");
static_assert(WS_END <= (size_t)1408 * MiB, "workspace budget");
static_assert(R_H + (size_t)MT * FF * 2 <= R_END, "H fits");

#ifndef MK_EARLY_WB
#define MK_EARLY_WB 0
#endif
#define XB_TMO      128
#define XB_XCNT(j)  (256  + 64 * (j))
#define XB_XSUB(j)  (1280 + 64 * (j))
#define XB_XGEN(j)  (2304 + 64 * (j))
#define XB_TOP      3328
#define XB_TOPGEN   3392
#define XCD_BAR_WORDS 3456
#define XB_SPIN_CAP (1u << 18)
__device__ __forceinline__ unsigned xb_ld(unsigned* p)              { return __hip_atomic_load(p, __ATOMIC_RELAXED, __HIP_MEMORY_SCOPE_AGENT); }
__device__ __forceinline__ unsigned xb_add(unsigned* p, unsigned v) { return __hip_atomic_fetch_add(p, v, __ATOMIC_RELAXED, __HIP_MEMORY_SCOPE_AGENT); }
__device__ __forceinline__ unsigned xb_xcc_id() { return (unsigned)__builtin_amdgcn_s_getreg((3 << 11) | 20) & 0xFu; }
#define XB_SPIN(cond, bar) do { unsigned _sp = 0; while (cond) { __builtin_amdgcn_s_sleep(1); \
    if ((++_sp & 255u) == 0u) { if (xb_ld(&(bar)[XB_TMO])) break; if (_sp > XB_SPIN_CAP) { atomicAdd(&(bar)[XB_TMO], 1u); break; } } } } while (0)
struct XcdBarrier { unsigned* bar; unsigned x; volatile LAS unsigned* st; };
__device__ __forceinline__ XcdBarrier xcd_barrier_post(unsigned* bar, volatile LAS unsigned* st, int tid) {
    XcdBarrier b; b.bar = bar; b.x = xb_xcc_id(); b.st = st;
    if (tid == 0) (void)xb_add(&bar[XB_XCNT(b.x)], 1u);
    return b;
}
__device__ __forceinline__ void xcd_barrier_complete(unsigned* bar, unsigned x, unsigned& nloc, unsigned& nx) {
    const unsigned G = gridDim.x * gridDim.y * gridDim.z;
    unsigned sum, cnt, mine, sp = 0u;
    for (;;) {
        sum = 0u; cnt = 0u; mine = 0u;
#pragma unroll
        for (unsigned j = 0; j < 16; ++j) { const unsigned c = xb_ld(&bar[XB_XCNT(j)]); sum += c; cnt += (c > 0u) ? 1u : 0u; mine = (j == x) ? c : mine; }
        if (sum == G) break;
        __builtin_amdgcn_s_sleep(1);
        if ((++sp & 255u) == 0u) { if (xb_ld(&bar[XB_TMO])) break; if (sp > XB_SPIN_CAP) { atomicAdd(&bar[XB_TMO], 1u); break; } }
    }
    nloc = mine > 0u ? mine : 1u; nx = cnt > 0u ? cnt : 1u;
}
__device__ __forceinline__ void xcd_barrier(const XcdBarrier& b, int tid) {
    asm volatile("s_waitcnt vmcnt(0)" ::: "memory");
    __syncthreads();
    if (tid == 0) {
        unsigned* bar = b.bar; unsigned bx = b.x;
        asm volatile("" : "+s"(bar), "+s"(bx));
        __builtin_amdgcn_s_waitcnt(0);
        unsigned nloc = b.st[0], nx = b.st[1];
        if (nloc == 0u) { xcd_barrier_complete(bar, bx, nloc, nx); b.st[0] = nloc; b.st[1] = nx; }
#if MK_EARLY_WB
        __builtin_amdgcn_fence(__ATOMIC_RELEASE, "agent");
        asm volatile("s_waitcnt vmcnt(0)" ::: "memory");
#endif
        const unsigned old = xb_add(&bar[XB_XSUB(bx)], 1u);
        const unsigned gen = old / nloc;
        if (old + 1u == (gen + 1u) * nloc) {
            __builtin_amdgcn_fence(__ATOMIC_RELEASE, "agent");
            asm volatile("s_waitcnt vmcnt(0)" ::: "memory");
            const unsigned og = xb_add(&bar[XB_TOP], 1u);
            const unsigned tg = og / nx;
            if (og + 1u == (tg + 1u) * nx) xb_add(&bar[XB_TOPGEN], 1u);
            else XB_SPIN(xb_ld(&bar[XB_TOPGEN]) == tg, bar);
            __builtin_amdgcn_fence(__ATOMIC_ACQUIRE, "agent");
            xb_add(&bar[XB_XGEN(bx)], 1u);
            asm volatile("s_waitcnt vmcnt(0)" ::: "memory");
        } else {
            XB_SPIN(xb_ld(&bar[XB_XGEN(bx)]) == gen, bar);
            __builtin_amdgcn_fence(__ATOMIC_ACQUIRE, "agent");
            asm volatile("s_waitcnt vmcnt(0)" ::: "memory");
        }
    }
    __syncthreads();
}

constexpr int RING_BYTES = 143360;
constexpr int LDSCTL_OFF = RING_BYTES, MISC_OFF = LDSCTL_OFF + 320;
constexpr int LDS_BYTES = 147456;

struct Args { const float* in[30]; float* out; unsigned char* ws; int ph_lo, ph_hi; };
#define CAS __attribute__((address_space(4)))
typedef const CAS Args& ArgsRef;

struct Frame {
    LAS unsigned char* lds;
    int tid, lane, wave, G, bid;
    const float* const* in;
    GAS float* out; GAS unsigned char* ws;
};
#define AIN(i) ((const float*)(const GAS float*)A.in[i])
#define WSP(T, off) ((T*)(F.ws + (off)))
#define RGN(T, off) ((T*)(F.ws + WS_R + (off)))
__device__ __forceinline__ float* xrow(const Frame& F, int m) { return m < ML ? (float*)(F.out + (size_t)m * D) : WSP(float, WS_XC) + (size_t)(m - ML) * D; }

__device__ __forceinline__ void tr_item(const float* W, int N, bf16* WT, int ldk, int k0, int scol0, int drow0, LAS float* scr, int lane) {
    if (scol0 >= 0) {
#pragma unroll 8
        for (int i = 0; i < 32; ++i) { const int kk = 2 * i + (lane >> 5); scr[kk * 33 + (lane & 31)] = W[(size_t)(k0 + kk) * N + scol0 + (lane & 31)]; }
    } else {
#pragma unroll 8
        for (int i = 0; i < 32; ++i) { const int kk = 2 * i + (lane >> 5); scr[kk * 33 + (lane & 31)] = 0.f; }
    }
    asm volatile("s_waitcnt vmcnt(0) lgkmcnt(0)" ::: "memory");
    const int c = lane & 7;
#pragma unroll
    for (int j = 0; j < 4; ++j) { const int n = (lane >> 3) + 8 * j; const LAS float* s = scr + (8 * c) * 33 + n;
        v4u o; o.x = pk2(s[0 * 33], s[1 * 33]); o.y = pk2(s[2 * 33], s[3 * 33]); o.z = pk2(s[4 * 33], s[5 * 33]); o.w = pk2(s[6 * 33], s[7 * 33]);
        *(v4u*)(WT + (size_t)(drow0 + n) * ldk + k0 + 8 * c) = o; }
    asm volatile("s_waitcnt lgkmcnt(0)" ::: "memory");
}
struct MapIdent { __device__ __forceinline__ int operator()(int drow) const { return drow; } };
struct MapGU { __device__ __forceinline__ int operator()(int drow) const { const int pn = drow >> 8, bj = (drow >> 7) & 1, i = drow & 127; return bj * FF + pn * 128 + i; } };
struct MapWin { __device__ __forceinline__ int operator()(int drow) const {
    if (drow < 5248) return drow;
    if (drow < 5280) return 11392 + (drow - 5248);
    if (drow < 5376) return -1;
    if (drow < 11520) return 5248 + (drow - 5376);
    return 11424 + (drow - 11520);
} };
template <class MAP> __device__ __forceinline__ void conv_matrix(const Frame& F, const float* W, int K, int N, bf16* WT, int NT, const MAP& mp, int& item0, int gw, int NGW, int ldk = 0) {
    LAS float* scr = (LAS float*)(F.lds + F.wave * 16384);
    const int nblk = NT / 32, nitems = (K / 64) * nblk;
    int first = ((gw - item0) % NGW + NGW) % NGW;
    for (int it = first; it < nitems; it += NGW) { const int kb = it / nblk, nb = it % nblk; tr_item(W, N, WT, ldk ? ldk : K, kb * 64, mp(nb * 32), nb * 32, scr, F.lane); }
    item0 += nitems;
}

__device__ __forceinline__ int seq_row(int b, int dir, int p, int& idx, int& len) {
    if (p < CL) { idx = dir ? (CL - 1 - p) : p; len = CL; return ML + b * CL + idx; }
    const int q = p - CL; idx = dir ? (SEQ - 1 - q) : q; len = SEQ; return b * SEQ + idx;
}

__device__ __forceinline__ void phase_init(const Frame& F, ArgsRef A) {
    const float* c = AIN(1); const float* cctx = AIN(3); const float* ada_w = AIN(4); const float* ada_b = AIN(5);
    float* mods = WSP(float, WS_MODS);
    LAS float* sc = (LAS float*)F.lds;
    LAS float* red = sc + 9 * 2048;
    for (int i = F.tid; i < 9 * 2048; i += NTHR) { const int bs = i >> 11, k = i & 2047; const float v = bs < 8 ? c[bs * 2048 + k] : cctx[k]; sc[i] = fsilu(v); }
    __syncthreads();
    for (int item = F.bid; item < 2 * 144; item += F.G) {
        const int l = item / 144, cb = item % 144, col = cb * 128 + 2 * F.lane;
        float a0[9], a1[9];
#pragma unroll
        for (int bs = 0; bs < 9; ++bs) { a0[bs] = 0.f; a1[bs] = 0.f; }
        const float* wp = ada_w + ((size_t)l * 2048 + F.wave * 256) * 18432 + col;
        const LAS float* sp = sc + F.wave * 256;
#pragma unroll 8
        for (int k = 0; k < 256; ++k) { const f32x2 w = *(const f32x2*)(wp + (size_t)k * 18432);
#pragma unroll
            for (int bs = 0; bs < 9; ++bs) { const float s = sp[bs * 2048 + k]; a0[bs] += s * w.x; a1[bs] += s * w.y; } }
#pragma unroll
        for (int bs = 0; bs < 9; ++bs) { red[(F.wave * 9 + bs) * 128 + 2 * F.lane] = a0[bs]; red[(F.wave * 9 + bs) * 128 + 2 * F.lane + 1] = a1[bs]; }
        __syncthreads();
        for (int o = F.tid; o < 9 * 128; o += NTHR) { const int bs = o >> 7, cc = o & 127; float s = ada_b[l * 18432 + cb * 128 + cc];
#pragma unroll
            for (int w = 0; w < 8; ++w) s += red[(w * 9 + bs) * 128 + cc];
            mods[((size_t)l * 9 + bs) * 18432 + cb * 128 + cc] = s; }
        __syncthreads();
    }
}

template <bool POST, bool MODH, bool WX = false>
__device__ __forceinline__ void phase_ln(const Frame& F, int nrows, const float* g, const float* b, const float* mods_l, int kshift, int kscale, const float* part = nullptr, const float* pmod = nullptr, float pcoef = 0.f, const float* src_l = nullptr, const float* src_c = nullptr) {
    const int gw = F.bid * NWAVES + F.wave, NGW = F.G * NWAVES;
    bf16* HB = WSP(bf16, WS_HB);
    for (int m = gw; m < nrows; m += NGW) {
        float* xr = xrow(F, m);
        const float* xs = (m < ML) ? (src_l ? src_l + (size_t)m * D : xr) : (src_c ? src_c + (size_t)(m - ML) * D : xr);
        f32x4 v[8];
#pragma unroll
        for (int j = 0; j < 8; ++j) v[j] = ((const f32x4*)xs)[F.lane + 64 * j];
        if (POST && part != nullptr && m >= ML) {
            const f32x4* pp = (const f32x4*)(part + (size_t)(m - ML) * D);
#pragma unroll
            for (int j = 0; j < 8; ++j) { const int o = F.lane + 64 * j; const f32x4 ps = (pp[o] + pp[o + (size_t)MC * D / 4]) + (pp[o + 2 * ((size_t)MC * D / 4)] + pp[o + 3 * ((size_t)MC * D / 4)]);
                v[j] = v[j] * ALPHA + ((const f32x4*)pmod)[o] * pcoef * ps; }
        }
        if (POST) {
            float s = 0.f;
#pragma unroll
            for (int j = 0; j < 8; ++j) s += (v[j].x + v[j].y) + (v[j].z + v[j].w);
            const float mean = wave_sum(s) * (1.f / D); float s2 = 0.f;
#pragma unroll
            for (int j = 0; j < 8; ++j) { v[j] = v[j] - mean; s2 += (v[j].x * v[j].x + v[j].y * v[j].y) + (v[j].z * v[j].z + v[j].w * v[j].w); }
            const float rstd = 1.f / sqrtf(wave_sum(s2) * (1.f / D) + LN_EPS);
#pragma unroll
            for (int j = 0; j < 8; ++j) { const f32x4 gg = ((const f32x4*)g)[F.lane + 64 * j], bb = ((const f32x4*)b)[F.lane + 64 * j]; v[j] = v[j] * rstd * gg + bb; if (WX || m >= ML) ((f32x4*)xr)[F.lane + 64 * j] = v[j]; }
            if (!WX && m < ML && F.lane == 0) *(v2f*)(WSP(float, WS_STATS) + 2 * m) = (v2f){mean, rstd};
        }
        if (MODH) {
            float s = 0.f;
#pragma unroll
            for (int j = 0; j < 8; ++j) s += (v[j].x + v[j].y) + (v[j].z + v[j].w);
            const float mean = wave_sum(s) * (1.f / D); float s2 = 0.f;
#pragma unroll
            for (int j = 0; j < 8; ++j) { v[j] = v[j] - mean; s2 += (v[j].x * v[j].x + v[j].y * v[j].y) + (v[j].z * v[j].z + v[j].w * v[j].w); }
            const float rstd = 1.f / sqrtf(wave_sum(s2) * (1.f / D) + LN_EPS);
            const int bsel = m < ML ? (m >> 11) : 8;
            const f32x4* shp = (const f32x4*)(mods_l + (size_t)bsel * 18432 + kshift * 2048);
            const f32x4* scp = (const f32x4*)(mods_l + (size_t)bsel * 18432 + kscale * 2048);
            v2u* hp = (v2u*)(HB + (size_t)m * D);
#pragma unroll
            for (int j = 0; j < 8; ++j) { const f32x4 sh = shp[F.lane + 64 * j], scl = scp[F.lane + 64 * j]; const f32x4 o = v[j] * rstd * (scl + 1.0f) + sh;
                v2u w; w.x = pk2(o.x, o.y); w.y = pk2(o.z, o.w); hp[F.lane + 64 * j] = w; }
        }
    }
}

__device__ __forceinline__ void phase_convert(const Frame& F, ArgsRef A, int l, int ffn_i, int which) {
    const int gw = F.bid * NWAVES + F.wave, NGW = F.G * NWAVES; int item0 = 0;
    if (which & 1) {
        conv_matrix(F, AIN(8) + ((size_t)l * 2 + ffn_i) * D * (2 * FF), D, 2 * FF, RGN(bf16, R_WGU), 2 * FF, MapGU(), item0, gw, NGW);
        conv_matrix(F, AIN(9) + ((size_t)l * 2 + ffn_i) * FF * D, FF, D, RGN(bf16, R_WDN), D, MapIdent(), item0, gw, NGW);
    }
    if (which & 2) {
        conv_matrix(F, AIN(10) + (size_t)l * D * NIN_SRC, D, NIN_SRC, WSP(bf16, WS_WM + WM_IN), NIN, MapWin(), item0, gw, NGW);
        conv_matrix(F, AIN(26) + (size_t)l * 1024 * D, 1024, D, WSP(bf16, WS_WM + WM_BA), D, MapIdent(), item0, gw, NGW, 4096);
        conv_matrix(F, AIN(27) + (size_t)l * 1024 * D, 1024, D, WSP(bf16, WS_WM + WM_BA) + 1024, D, MapIdent(), item0, gw, NGW, 4096);
        conv_matrix(F, AIN(28) + (size_t)l * D * D, D, D, WSP(bf16, WS_WM + WM_BA) + 2048, D, MapIdent(), item0, gw, NGW, 4096);
        conv_matrix(F, AIN(29) + (size_t)l * D * D, D, D, WSP(bf16, WS_WM + WM_OUT), D, MapIdent(), item0, gw, NGW);
        const float* w2 = AIN(14) + (size_t)l * 2 * 96 * 1024; const float* a2 = AIN(16) + (size_t)l * 2 * 96 * 1024; const float* g2 = AIN(17) + (size_t)l * 256 * 1024;
        bf16* LW = WSP(bf16, WS_WM + WM_LW); bf16* LAw = WSP(bf16, WS_WM + WM_LA); bf16* LG = WSP(bf16, WS_WM + WM_LG);
        for (int e = F.bid * NTHR + F.tid; e < 2048 * 256; e += F.G * NTHR) { const int n = e >> 8, k = e & 255, dir = n >> 10, cc = n & 1023;
            const int kk = k - dir * 96; const bool liv = kk >= 0 && kk < 96;
            LW[e] = liv ? (bf16)f2bf(w2[((size_t)dir * 96 + kk) * 1024 + cc]) : (bf16)0;
            LAw[e] = liv ? (bf16)f2bf(a2[((size_t)dir * 96 + kk) * 1024 + cc]) : (bf16)0;
            if (n < 1024) LG[e] = (bf16)f2bf(g2[(size_t)k * 1024 + n]); }
    }
    __syncthreads();
}

__device__ __forceinline__ float red16s(float v) { v += dppf<0xB1, 0xF>(v); v += dppf<0x4E, 0xF>(v); v += dppf<0x141, 0xF>(v); v += dppf<0x140, 0xF>(v); return v; }
__device__ __forceinline__ void phase_prep(const Frame& F, ArgsRef A, int l) {
    const int gw = F.bid * NWAVES + F.wave, NGW = F.G * NWAVES, lane = F.lane;
    const bf16* ZA = RGN(bf16, R_ZA); bf16* QR = RGN(bf16, R_QR); bf16* KR = RGN(bf16, R_KR);
    const bf16* ZR = RGN(bf16, R_ZR); bf16* LA = RGN(bf16, R_LA); unsigned* GL = RGN(unsigned, R_GL);
    {
        const int f2 = 2 * (lane & 15), axis = (lane >> 4) & 1, hs = lane >> 5;
        const float invf0 = exp2f(-(float)f2 * (13.287712379549449f / 32.0f)), invf1 = exp2f(-(float)(f2 + 1) * (13.287712379549449f / 32.0f));
        for (int m0 = gw; m0 < ML; m0 += 4 * NGW) {
            unsigned w1[4][5], w2[4][5];
#pragma unroll
            for (int i = 0; i < 4; ++i) { const int mm = m0 + i * NGW, m = mm < ML ? mm : ML - 1;
                const bf16* zr = ZA + (size_t)m * ZA_LD + hs * 128 + axis * 64 + f2;
#pragma unroll
                for (int hp = 0; hp < 5; ++hp) { w1[i][hp] = *(const unsigned*)(zr + hp * 256); w2[i][hp] = *(const unsigned*)(zr + hp * 256 + 32); } }
            asm volatile("" ::: "memory");
#pragma unroll
            for (int i = 0; i < 4; ++i) { const int m = m0 + i * NGW;
                if (m < ML) {
                    const int t = m & (SEQ - 1);
                    const float pos = axis == 0 ? (float)(t >> 6) : (float)(t & 63);
                    const float a0 = pos * invf0, a1 = pos * invf1; const float sn0 = __sinf(a0), cs0 = __cosf(a0), sn1 = __sinf(a1), cs1 = __cosf(a1);
#pragma unroll
                    for (int hp = 0; hp < 5; ++hp) {
                        const float x10 = bflo(w1[i][hp]), x11 = bfhi(w1[i][hp]), x20 = bflo(w2[i][hp]), x21 = bfhi(w2[i][hp]);
                        const unsigned o1 = pk2(x10 * cs0 - x20 * sn0, x11 * cs1 - x21 * sn1), o2 = pk2(x20 * cs0 + x10 * sn0, x21 * cs1 + x11 * sn1);
                        const int hh = 2 * hp + hs;
                        bf16* dst = hh < 8 ? QR + (size_t)m * 1024 + hh * 128 + axis * 64 + f2 : KR + (size_t)m * 256 + (hh - 8) * 128 + axis * 64 + f2;
                        *(unsigned*)dst = o1; *(unsigned*)(dst + 32) = o2;
                    }
                }
            }
        }
    }
    {
        const float* cw = AIN(12) + (size_t)l * 3 * RW_COLS;
        float t0[6][2], t1[6][2], t2[6][2]; int scol[6]; bool lv[6];
#pragma unroll
        for (int it = 0; it < 6; ++it) { const int j = 2 * (lane + 64 * it), sec = j >> 8, jj = j & 255; const bool live = sec == 2 || jj < 192; lv[it] = live;
            scol[it] = (sec == 0 ? 3072 : sec == 1 ? 3264 : 3456) + (live ? jj : 0);
#pragma unroll
            for (int e = 0; e < 2; ++e) { t0[it][e] = live ? cw[scol[it] + e] : 0.f; t1[it][e] = live ? cw[RW_COLS + scol[it] + e] : 0.f; t2[it][e] = live ? cw[2 * RW_COLS + scol[it] + e] : 0.f; } }
        for (int m0 = gw; m0 < MT; m0 += 3 * NGW) {
            unsigned wc[3][6], wl[3][6], wr[3][6];
#pragma unroll
            for (int i = 0; i < 3; ++i) { const int mm = m0 + i * NGW, m = mm < MT ? mm : MT - 1;
                int idx, len; if (m < ML) { idx = m & (SEQ - 1); len = SEQ; } else { idx = (m - ML) & (CL - 1); len = CL; }
                const bf16* z0 = ZR + (size_t)m * ZR_W; const bf16* zl = idx > 0 ? z0 - ZR_W : z0; const bf16* zrr = idx < len - 1 ? z0 + ZR_W : z0;
#pragma unroll
                for (int it = 0; it < 6; ++it) { wc[i][it] = *(const unsigned*)(z0 + scol[it]); wl[i][it] = *(const unsigned*)(zl + scol[it]); wr[i][it] = *(const unsigned*)(zrr + scol[it]); } }
            asm volatile("" ::: "memory");
#pragma unroll
            for (int i = 0; i < 3; ++i) { const int m = m0 + i * NGW;
                if (m < MT) {
                    int idx, len; if (m < ML) { idx = m & (SEQ - 1); len = SEQ; } else { idx = (m - ML) & (CL - 1); len = CL; }
                    const float fl = idx > 0 ? 1.f : 0.f, fr = idx < len - 1 ? 1.f : 0.f;
#pragma unroll
                    for (int it = 0; it < 6; ++it) {
                        float c0 = bflo(wc[i][it]) * t1[it][0] + fl * bflo(wl[i][it]) * t0[it][0] + fr * bflo(wr[i][it]) * t2[it][0];
                        float c1 = bfhi(wc[i][it]) * t1[it][1] + fl * bfhi(wl[i][it]) * t0[it][1] + fr * bfhi(wr[i][it]) * t2[it][1];
                        const int sec = it >> 1;
                        if (sec == 0) { c0 = ftanh(c0); c1 = ftanh(c1); } else if (sec == 2) { c0 = fsigmoid(c0); c1 = fsigmoid(c1); }
                        *(unsigned*)(LA + (size_t)m * LA_W + 2 * (lane + 64 * it)) = lv[it] ? pk2(c0, c1) : 0u;
                    }
                }
            }
        }
    }
    {
        __syncthreads();
        LAS unsigned short* TW = (LAS unsigned short*)F.lds;
        LAS float* TB = (LAS float*)(F.lds + 65536);
        const float* wa2 = AIN(23) + (size_t)l * 2 * 16 * 1024; const float* ba = AIN(24) + (size_t)l * 2 * 1024;
        for (int e = F.tid; e < 2 * 16 * 1024; e += NTHR) { const int dr = e >> 10, cc = e & 1023, dir = dr >> 4, r = dr & 15; TW[(dir * 1024 + cc) * 16 + r] = (unsigned short)f2bf(wa2[e]); }
        for (int e = F.tid; e < 2048; e += NTHR) TB[e] = ba[e];
        __syncthreads();
        const int l16 = lane & 15, g = lane >> 4;
        bf16* GLb = RGN(bf16, R_GL);
        const f32x4 zero4 = (f32x4){0.f, 0.f, 0.f, 0.f};
        for (int item = gw; item < (MT / 16) * 4; item += NGW) {
            const int rb = item >> 2, qq = item & 3, m = rb * 16 + l16;
            const bf16x8 af = *(const bf16x8*)(ZR + (size_t)m * ZR_W + 3712 + 8 * g);
            const int dir = qq >> 1;
            const bool live = (g >> 1) == dir;
            bf16* gp = GLb + ((size_t)dir * MT + m) * 1024 + ((512 * qq) & 1023) + 8 * g;
#pragma unroll 4
            for (int q = 0; q < 16; ++q) {
                const int ch0 = 512 * qq + 32 * q;
                const unsigned wa_ = (unsigned)((ch0 + 8 * (l16 >> 2) + (l16 & 3)) * 32 + (g & 1) * 16);
                bf16x8 w0 = *(const LAS bf16x8*)((LAS unsigned char*)TW + wa_), w1 = *(const LAS bf16x8*)((LAS unsigned char*)TW + wa_ + 4 * 32);
                if (!live) { w0 = (bf16x8){0, 0, 0, 0, 0, 0, 0, 0}; w1 = w0; }
                const f32x4 d0 = __builtin_amdgcn_mfma_f32_16x16x32_bf16(w0, af, zero4, 0, 0, 0), d1 = __builtin_amdgcn_mfma_f32_16x16x32_bf16(w1, af, zero4, 0, 0, 0);
                const f32x4 b0 = *(const LAS f32x4*)(TB + ch0 + 8 * g), b1 = *(const LAS f32x4*)(TB + ch0 + 8 * g + 4);
                float o[8];
#pragma unroll
                for (int r = 0; r < 4; ++r) { o[r] = -fsoftplus(-(d0[r] + b0[r])) * 0.0625f; o[4 + r] = -fsoftplus(-(d1[r] + b1[r])) * 0.0625f; }
                *(v4u*)(gp + 32 * q) = (v4u){pk2(o[0], o[1]), pk2(o[2], o[3]), pk2(o[4], o[5]), pk2(o[6], o[7])};
            }
        }
        __syncthreads();
    }
}

__device__ __forceinline__ unsigned opq(unsigned x) { asm volatile("" : "+v"(x)); return x; }
__device__ __forceinline__ bf16x8 pack8(const f32x4& a, const f32x4& b) {
    v4u w; w.x = pg8::cvt_pk_bf16(a[0], a[1]); w.y = pg8::cvt_pk_bf16(a[2], a[3]); w.z = pg8::cvt_pk_bf16(b[0], b[1]); w.w = pg8::cvt_pk_bf16(b[2], b[3]);
    return __builtin_bit_cast(bf16x8, w);
}
typedef short s16x4 __attribute__((ext_vector_type(4)));
__device__ __forceinline__ bf16x8 tr8(LAS unsigned char* L, unsigned a0, unsigned a1) {
    const s16x4 x = __builtin_amdgcn_ds_read_tr16_b64_v4i16((LAS s16x4*)(L + a0)), y = __builtin_amdgcn_ds_read_tr16_b64_v4i16((LAS s16x4*)(L + a1));
    return __builtin_shufflevector(x, y, 0, 1, 2, 3, 4, 5, 6, 7);
}
constexpr int RC_LD = 72;
constexpr int RC_QP = 0, RC_RT = 9216, RC_KD = 18432, RC_KA = 27648, RC_KDT = 36864, RC_KAT = 46080, RC_VT = 55296, RC_MKA = 64512, RC_MKD = 73728, RC_NKA = 82944, RC_NKD = 92160,
              RC_DG = 101376, RC_TB = 105472, RC_EB = 107520, RC_TQ = 107776, RC_BI = 109824, RC_END = 126208;
static_assert(RC_END <= RING_BYTES, "RWKV LDS map");
#define LD_(T, addr) (*(const LAS T*)(L + (addr)))
#define ST_(T, addr) (*(LAS T*)(L + (addr)))
__device__ __forceinline__ bf16x8 kperm(LAS unsigned char* L, unsigned addr) {
    const v2u a0 = LD_(v2u, addr), a1 = LD_(v2u, addr + 32); return __builtin_bit_cast(bf16x8, (v4u){a0.x, a0.y, a1.x, a1.y}); }
__device__ __forceinline__ void rwkv_chunk_item(const Frame& F, ArgsRef A, int l, int item, bool last) {
    const int b = item >> 5, h = (item >> 1) & 15, dir = item & 1, tid = F.tid, lane = F.lane, w = F.wave, sgn = dir ? -1 : 1, l16 = lane & 15, g = lane >> 4;
    LAS unsigned char* L = F.lds;
    const bf16* ZR = RGN(bf16, R_ZR); const float* WLD = RGN(float, R_WDEC) + (size_t)dir * MT * 1024; const bf16* AA = RGN(bf16, R_AA) + (size_t)dir * MT * 1024;
    float* Y = RGN(float, R_Y) + (size_t)dir * MT * 1024;
    const float* cw = AIN(12) + (size_t)l * 3 * RW_COLS;
    const int j0 = 4 * l16, ch = h * 64 + j0;
    const int tA = dir ? 2 : 0, tB = dir ? 0 : 2;
    const f32x4 kkw = *(const f32x4*)(AIN(18) + l * 1024 + ch), kaw = *(const f32x4*)(AIN(19) + l * 1024 + ch);
    const int cj = tid & 63, ct8 = tid >> 6;
    const unsigned a_row = opq((unsigned)(((8 * w + g) * RC_LD + j0) * 2));
    const unsigned a_tr = opq((unsigned)((((lane & 15) >> 2) * RC_LD + 4 * (lane & 3)) * 2));
    const unsigned a_f8 = opq((unsigned)((l16 * RC_LD + 8 * g) * 2));
    const unsigned a_f4 = opq((unsigned)((l16 * RC_LD + 4 * g) * 2));

    f32x4 S[4];
#pragma unroll
    for (int t = 0; t < 4; ++t) S[t] = (f32x4){0.f, 0.f, 0.f, 0.f};
    v2u zz[2][3][3], za[2]; float pl[8];
#define RC_ISSUE(chunk) do { int idx_, len_; const int c_ = (chunk); const int r0_ = seq_row(b, dir, c_ * 64, idx_, len_); \
        const int plo_ = c_ < 4 ? 0 : CL, phi_ = c_ < 4 ? CL : CL + SEQ; \
        _Pragma("unroll") for (int p = 0; p < 2; ++p) { const int t_ = 8 * w + 4 * p + g; \
            _Pragma("unroll") for (int x = 0; x < 3; ++x) { const int pp_ = c_ * 64 + t_ + x - 1; const bool ok_ = pp_ >= plo_ && pp_ < phi_; \
                const GAS bf16* zp_ = (const GAS bf16*)(ZR + (size_t)(ok_ ? r0_ + sgn * (t_ + x - 1) : r0_) * ZR_W + ch); asm volatile("" : "+v"(zp_)); \
                const v2u q0_ = *(const GAS v2u*)zp_, q1_ = *(const GAS v2u*)(zp_ + 1024), q2_ = *(const GAS v2u*)(zp_ + 2048); const v2u zero_ = (v2u){0u, 0u}; \
                zz[p][x][0] = ok_ ? q0_ : zero_; zz[p][x][1] = ok_ ? q1_ : zero_; zz[p][x][2] = ok_ ? q2_ : zero_; } \
            za[p] = *(const GAS v2u*)(const GAS bf16*)(AA + (size_t)(r0_ + sgn * t_) * 1024 + ch); } \
        { const GAS float* wp_ = (const GAS float*)(WLD + (size_t)(r0_ + sgn * 8 * ct8) * 1024 + h * 64 + cj); const long st_ = (long)sgn * 1024; \
          _Pragma("unroll") for (int q = 0; q < 8; ++q) { asm volatile("" : "+v"(wp_)); pl[q] = *wp_; wp_ += st_; } } } while (0)
    RC_ISSUE(0);
    for (int chunk = 0; chunk < 36; ++chunk) {
        int idx0, len0; const int r0 = seq_row(b, dir, chunk * 64, idx0, len0);
        const unsigned a_tqs = opq((unsigned)(RC_TQ + (ct8 * 64 + cj) * 4)), a_tqr = opq((unsigned)(RC_TQ + cj * 4)), a_bis = opq((unsigned)(RC_BI + (8 * ct8 * 64 + cj) * 4));
        { float s = 0.f;
#pragma unroll
          for (int q = 0; q < 8; ++q) s += pl[q];
          ST_(float, a_tqs) = s; }
        __syncthreads();
        { float o = 0.f, tot = 0.f;
#pragma unroll
          for (int q = 0; q < 8; ++q) { const float tq = LD_(float, a_tqr + q * 256); if (q < ct8) o += tq; tot += tq; }
          if (ct8 == 0) ST_(float, RC_EB + cj * 4) = __expf(tot);
#pragma unroll
          for (int q = 0; q < 8; ++q) { o += pl[q]; ST_(float, a_bis + q * 256) = o; } }
        __syncthreads();
        f32x4 tp[3][3];
#pragma unroll
        for (int kind = 0; kind < 3; ++kind) { const GAS float* cp = (const GAS float*)(cw + kind * 1024 + ch); asm volatile("" : "+v"(cp));
            tp[0][kind] = *(const GAS f32x4*)(cp + tA * RW_COLS); tp[1][kind] = *(const GAS f32x4*)(cp + RW_COLS); tp[2][kind] = *(const GAS f32x4*)(cp + tB * RW_COLS); }
        const unsigned a_bir = opq((unsigned)(RC_BI + ((8 * w + g) * 64 + j0) * 4));
#pragma unroll
        for (int p = 0; p < 2; ++p) {
            const int t = 8 * w + 4 * p + g;
            f32x4 rkv[3];
#pragma unroll
            for (int kind = 0; kind < 3; ++kind) {
                const v2u wa = zz[p][0][kind], wc = zz[p][1][kind], wb = zz[p][2][kind];
                const f32x4 xa = (f32x4){bflo(wa.x), bfhi(wa.x), bflo(wa.y), bfhi(wa.y)}, xc = (f32x4){bflo(wc.x), bfhi(wc.x), bflo(wc.y), bfhi(wc.y)}, xb = (f32x4){bflo(wb.x), bfhi(wb.x), bflo(wb.y), bfhi(wb.y)};
                rkv[kind] = xa * tp[0][kind] + xc * tp[1][kind] + xb * tp[2][kind]; }
            const f32x4 r = rkv[0], k = rkv[1], v = rkv[2];
            const f32x4 kr = k * kkw;
            const float n2 = red16s((kr.x * kr.x + kr.y * kr.y) + (kr.z * kr.z + kr.w * kr.w));
            const f32x4 kk = kr * __builtin_amdgcn_rsqf(fmaxf(n2, 1e-24f));
            const f32x4 a = (f32x4){bflo(za[p].x), bfhi(za[p].x), bflo(za[p].y), bfhi(za[p].y)};
            const f32x4 kd = k * ((a - 1.0f) * kaw + 1.0f), kka = kk * a;
            {
              const GAS float* rp = (const GAS float*)(AIN(20) + l * 1024 + ch); asm volatile("" : "+v"(rp)); const f32x4 rkp = *(const GAS f32x4*)rp;
              const f32x4 pb = r * kd * rkp; const float bsum = red16s((pb.x + pb.y) + (pb.z + pb.w));
              if (l16 == 0) RGN(float, R_BS)[((size_t)dir * MT + (size_t)(r0 + sgn * t)) * 16 + h] = bsum; }
            const f32x4 bi = LD_(f32x4, a_bir + p * 1024);
            f32x4 bx = (f32x4){0.f, 0.f, 0.f, 0.f}; if (t > 0) bx = LD_(f32x4, a_bir + p * 1024 - 256);
            f32x4 ex, ei, en;
#pragma unroll
            for (int c = 0; c < 4; ++c) { ex[c] = __expf(bx[c]); ei[c] = __expf(bi[c]); en[c] = __expf(-bi[c]); }
            const f32x4 qp = kk * ex * -1.0f, rt = r * ei, kdn = kd * en, kan = kka * en;
            const unsigned ar = a_row + p * (4 * RC_LD * 2);
            ST_(v2u, RC_QP + ar) = (v2u){pg8::cvt_pk_bf16(qp.x, qp.y), pg8::cvt_pk_bf16(qp.z, qp.w)};
            ST_(v2u, RC_RT + ar) = (v2u){pg8::cvt_pk_bf16(rt.x, rt.y), pg8::cvt_pk_bf16(rt.z, rt.w)};
            const unsigned kd01 = pg8::cvt_pk_bf16(kdn.x, kdn.y), kd23 = pg8::cvt_pk_bf16(kdn.z, kdn.w), ka01 = pg8::cvt_pk_bf16(kan.x, kan.y), ka23 = pg8::cvt_pk_bf16(kan.z, kan.w);
            const unsigned v01 = pg8::cvt_pk_bf16(v.x, v.y), v23 = pg8::cvt_pk_bf16(v.z, v.w);
            ST_(v2u, RC_KD + ar) = (v2u){kd01, kd23}; ST_(v2u, RC_KA + ar) = (v2u){ka01, ka23};
            ST_(v2u, RC_VT + ar) = (v2u){v01, v23};
            asm volatile("" ::: "memory");
        }
        __syncthreads();
        if (chunk + 1 < 36) RC_ISSUE(chunk + 1);
        const unsigned a_dgs = opq((unsigned)(RC_DG + (l16 * 16 + 4 * g) * 4));
#pragma unroll
        for (int tt2 = 0; tt2 < 2; ++tt2) {
            const int id = 2 * w + tt2, st = id >> 2, tt = id & 3;
            f32x4 mka = (f32x4){0.f, 0.f, 0.f, 0.f}, mkd = mka, nka = mka, nkd = mka;
            if (st <= tt) {
                const unsigned as_ = a_f8 + st * (16 * RC_LD * 2), at_ = a_f8 + tt * (16 * RC_LD * 2);
#pragma unroll
                for (int ks = 0; ks < 2; ++ks) {
                    const bf16x8 fka = LD_(bf16x8, RC_KA + as_ + 64 * ks), fkd = LD_(bf16x8, RC_KD + as_ + 64 * ks), fqp = LD_(bf16x8, RC_QP + at_ + 64 * ks), frt = LD_(bf16x8, RC_RT + at_ + 64 * ks);
                    mka = __builtin_amdgcn_mfma_f32_16x16x32_bf16(fka, fqp, mka, 0, 0, 0); mkd = __builtin_amdgcn_mfma_f32_16x16x32_bf16(fkd, fqp, mkd, 0, 0, 0);
                    nka = __builtin_amdgcn_mfma_f32_16x16x32_bf16(fka, frt, nka, 0, 0, 0); nkd = __builtin_amdgcn_mfma_f32_16x16x32_bf16(fkd, frt, nkd, 0, 0, 0);
                }
            }
            const int t = 16 * tt + (int)opq((unsigned)l16), s0 = 16 * st + 4 * (int)opq((unsigned)g);
#pragma unroll
            for (int r = 0; r < 4; ++r) { const bool lt = (s0 + r) < t, le = (s0 + r) <= t; mka[r] = lt ? mka[r] : 0.f; mkd[r] = lt ? mkd[r] : 0.f; nka[r] = le ? nka[r] : 0.f; nkd[r] = le ? nkd[r] : 0.f; }
            const unsigned am = a_f4 + tt * (16 * RC_LD * 2) + st * 32;
            ST_(v2u, RC_MKA + am) = (v2u){pg8::cvt_pk_bf16(mka[0], mka[1]), pg8::cvt_pk_bf16(mka[2], mka[3])};
            ST_(v2u, RC_MKD + am) = (v2u){pg8::cvt_pk_bf16(mkd[0], mkd[1]), pg8::cvt_pk_bf16(mkd[2], mkd[3])};
            ST_(v2u, RC_NKA + am) = (v2u){pg8::cvt_pk_bf16(nka[0], nka[1]), pg8::cvt_pk_bf16(nka[2], nka[3])};
            ST_(v2u, RC_NKD + am) = (v2u){pg8::cvt_pk_bf16(nkd[0], nkd[1]), pg8::cvt_pk_bf16(nkd[2], nkd[3])};
            if (st == tt) ST_(f32x4, a_dgs + st * 1024) = mka;
        }
        __syncthreads();
        if (w == 4) {
            const unsigned a_dgb = opq((unsigned)(RC_DG + g * 1024)), a_tbs = opq((unsigned)(RC_TB + (g * 256 + l16) * 2));
            float tc[16]; const int lq = (int)opq((unsigned)l16);
#pragma unroll
            for (int t = 0; t < 16; ++t) {
                float acc = (t == lq) ? 1.f : 0.f;
                const f32x4 L0 = LD_(f32x4, a_dgb + t * 64), L1 = LD_(f32x4, a_dgb + t * 64 + 16), L2 = LD_(f32x4, a_dgb + t * 64 + 32), L3 = LD_(f32x4, a_dgb + t * 64 + 48);
                const float lr[16] = {L0[0], L0[1], L0[2], L0[3], L1[0], L1[1], L1[2], L1[3], L2[0], L2[1], L2[2], L2[3], L3[0], L3[1], L3[2], L3[3]};
#pragma unroll
                for (int s = 0; s < 16; ++s) if (s < t) acc += lr[s] * tc[s];
                tc[t] = acc;
                ST_(unsigned short, a_tbs + t * 32) = (unsigned short)f2bf(acc);
            }
        }
        f32x4 X[4], O[4], U[4];
        const f32x4 zero4 = (f32x4){0.f, 0.f, 0.f, 0.f};
        bf16x8 vb0, vb1;
        if (w < 4) {
            const bf16x8 sf0 = pack8(S[0], S[1]), sf1 = pack8(S[2], S[3]);
            { const unsigned av = RC_VT + a_tr + (8 * g) * (RC_LD * 2) + w * 32; vb0 = tr8(L, av, av + 4 * RC_LD * 2); vb1 = tr8(L, av + 32 * RC_LD * 2, av + 36 * RC_LD * 2); }
#pragma unroll
            for (int mt = 0; mt < 4; ++mt) {
                const unsigned o4 = a_f4 + mt * (16 * RC_LD * 2), o8 = a_f8 + mt * (16 * RC_LD * 2);
                X[mt] = __builtin_amdgcn_mfma_f32_16x16x32_bf16(kperm(L, RC_QP + o4), sf0, zero4, 0, 0, 0);
                X[mt] = __builtin_amdgcn_mfma_f32_16x16x32_bf16(kperm(L, RC_QP + o4 + 64), sf1, X[mt], 0, 0, 0);
                X[mt] = __builtin_amdgcn_mfma_f32_16x16x32_bf16(LD_(bf16x8, RC_MKD + o8), vb0, X[mt], 0, 0, 0);
                X[mt] = __builtin_amdgcn_mfma_f32_16x16x32_bf16(LD_(bf16x8, RC_MKD + o8 + 64), vb1, X[mt], 0, 0, 0);
                O[mt] = __builtin_amdgcn_mfma_f32_16x16x32_bf16(kperm(L, RC_RT + o4), sf0, zero4, 0, 0, 0);
                O[mt] = __builtin_amdgcn_mfma_f32_16x16x32_bf16(kperm(L, RC_RT + o4 + 64), sf1, O[mt], 0, 0, 0);
                O[mt] = __builtin_amdgcn_mfma_f32_16x16x32_bf16(LD_(bf16x8, RC_NKD + o8), vb0, O[mt], 0, 0, 0);
                O[mt] = __builtin_amdgcn_mfma_f32_16x16x32_bf16(LD_(bf16x8, RC_NKD + o8 + 64), vb1, O[mt], 0, 0, 0);
                asm volatile("" ::: "memory");
            }
#pragma unroll
            for (int jt = 0; jt < 4; ++jt) { const unsigned ak = RC_KD + a_tr + (8 * g) * (RC_LD * 2) + jt * 32;
                S[jt] = __builtin_amdgcn_mfma_f32_16x16x32_bf16(tr8(L, ak, ak + 4 * RC_LD * 2), vb0, S[jt], 0, 0, 0);
                S[jt] = __builtin_amdgcn_mfma_f32_16x16x32_bf16(tr8(L, ak + 32 * RC_LD * 2, ak + 36 * RC_LD * 2), vb1, S[jt], 0, 0, 0); }
        }
        __syncthreads();
        if (w < 4) {
            const unsigned a_tbf = opq((unsigned)(RC_TB + (l16 * 16 + 4 * g) * 2)), a_ebr = opq((unsigned)(RC_EB + 16 * g));
#define RC_TBF(tb) __builtin_bit_cast(bf16x8, (v4u){LD_(v2u, a_tbf + (tb) * 512).x, LD_(v2u, a_tbf + (tb) * 512).y, 0u, 0u})
            U[0] = __builtin_amdgcn_mfma_f32_16x16x32_bf16(RC_TBF(0), pack8(X[0], zero4), zero4, 0, 0, 0);
            X[1] = __builtin_amdgcn_mfma_f32_16x16x32_bf16(kperm(L, RC_MKA + a_f4 + 1 * (16 * RC_LD * 2)), pack8(U[0], zero4), X[1], 0, 0, 0);
            U[1] = __builtin_amdgcn_mfma_f32_16x16x32_bf16(RC_TBF(1), pack8(X[1], zero4), zero4, 0, 0, 0);
            const bf16x8 uf0 = pack8(U[0], U[1]);
            X[2] = __builtin_amdgcn_mfma_f32_16x16x32_bf16(kperm(L, RC_MKA + a_f4 + 2 * (16 * RC_LD * 2)), uf0, X[2], 0, 0, 0);
            U[2] = __builtin_amdgcn_mfma_f32_16x16x32_bf16(RC_TBF(2), pack8(X[2], zero4), zero4, 0, 0, 0);
            X[3] = __builtin_amdgcn_mfma_f32_16x16x32_bf16(kperm(L, RC_MKA + a_f4 + 3 * (16 * RC_LD * 2)), uf0, X[3], 0, 0, 0);
            X[3] = __builtin_amdgcn_mfma_f32_16x16x32_bf16(kperm(L, RC_MKA + a_f4 + 3 * (16 * RC_LD * 2) + 64), pack8(U[2], zero4), X[3], 0, 0, 0);
            U[3] = __builtin_amdgcn_mfma_f32_16x16x32_bf16(RC_TBF(3), pack8(X[3], zero4), zero4, 0, 0, 0);
            const bf16x8 uf1 = pack8(U[2], U[3]);
#undef RC_TBF
#pragma unroll
            for (int mt = 0; mt < 4; ++mt) { const unsigned o4 = a_f4 + mt * (16 * RC_LD * 2);
                O[mt] = __builtin_amdgcn_mfma_f32_16x16x32_bf16(kperm(L, RC_NKA + o4), uf0, O[mt], 0, 0, 0);
                O[mt] = __builtin_amdgcn_mfma_f32_16x16x32_bf16(kperm(L, RC_NKA + o4 + 64), uf1, O[mt], 0, 0, 0); }
#pragma unroll
            for (int jt = 0; jt < 4; ++jt) { const unsigned ak = RC_KA + a_tr + (4 * g) * (RC_LD * 2) + jt * 32;
                S[jt] = __builtin_amdgcn_mfma_f32_16x16x32_bf16(tr8(L, ak, ak + 16 * RC_LD * 2), uf0, S[jt], 0, 0, 0);
                S[jt] = __builtin_amdgcn_mfma_f32_16x16x32_bf16(tr8(L, ak + 32 * RC_LD * 2, ak + 48 * RC_LD * 2), uf1, S[jt], 0, 0, 0);
                S[jt] = S[jt] * LD_(f32x4, a_ebr + jt * 64); }
            if (!(last && chunk < 4)) {
                GAS float* yp = (GAS float*)(Y + (size_t)(r0 + sgn * 4 * g) * 1024 + h * 64 + 16 * w + l16);
                const long sy = (long)sgn * 1024;
#pragma unroll
                for (int mt = 0; mt < 4; ++mt) {
#pragma unroll
                    for (int r = 0; r < 4; ++r) { asm volatile("" : "+v"(yp)); yp[(long)r * sy] = O[mt][r]; }
                    yp += 16 * sy;
                }
            }
        }
        __syncthreads();
    }
#undef RC_ISSUE
}
#undef LD_
#undef ST_

constexpr int GQ_LD = 264, GT_LD = 72;
constexpr int GV_LD = 136;
constexpr int G_QD = 0, G_KI = G_QD + 64 * GQ_LD * 2, G_KT = G_KI + 64 * GQ_LD * 2, G_VT = G_KT + 256 * GT_LD * 2, G_AM = G_VT + 128 * GT_LD * 2, G_EBL = G_AM + 64 * GT_LD * 2, G_TQ = G_EBL + 1024, G_END = G_TQ + 4096;
static_assert(G_END <= RING_BYTES, "GLA LDS map");
#define LD_(T, addr) (*(const LAS T*)(L + (addr)))
#define ST_(T, addr) (*(LAS T*)(L + (addr)))
template <int VAR> __device__ __forceinline__ void gla_chunk_item(const Frame& F, int item, bool last) {
    const int b = item >> 5, h = (item >> 3) & 3, dir = (item >> 2) & 1, dvs = item & 3;
    LAS unsigned char* L = F.lds;
    const int tid = F.tid, lane = F.lane, w = F.wave, l16 = lane & 15, g = lane >> 4;
    const int dp = tid & 127, qt = tid >> 7;
    const int e8 = tid & 15, jj = tid >> 4;
    const bf16* ZG = RGN(bf16, R_ZG); const bf16* GL = RGN(bf16, R_GL) + (size_t)dir * MT * 1024;
    bf16* YG = RGN(bf16, R_YG) + (size_t)dir * MT * 2048;
    const int sgn = dir ? -1 : 1;
    f32x4 S[16];
#pragma unroll
    for (int t = 0; t < 16; ++t) S[t] = (f32x4){0.f, 0.f, 0.f, 0.f};
    unsigned rq[16], rk[16], rl[16]; v4u rv0, rv1;
#define GLA_ISSUE(chunk) do { int idx_, len_; const int r0_ = seq_row(b, dir, (chunk) * 64, idx_, len_); \
        const GAS bf16* pz_ = (const GAS bf16*)(ZG + (size_t)(r0_ + sgn * 16 * qt) * ZG_W + h * 256 + 2 * dp); const GAS bf16* pl_ = (const GAS bf16*)(GL + (size_t)(r0_ + sgn * 16 * qt) * 1024 + h * 256 + 2 * dp); \
        const long sz_ = (long)sgn * ZG_W, sl_ = (long)sgn * 1024; \
        _Pragma("unroll") for (int i = 0; i < 16; ++i) { asm volatile("" : "+v"(pz_), "+v"(pl_)); \
            rq[i] = *(const GAS unsigned*)pz_; rk[i] = *(const GAS unsigned*)(pz_ + 1024); rl[i] = *(const GAS unsigned*)pl_; pz_ += sz_; pl_ += sl_; } \
        const bf16* pv_ = ZG + (size_t)(r0_ + sgn * jj) * ZG_W + 2048 + h * 512 + dvs * 128 + 8 * e8; \
        rv0 = *(const v4u*)pv_; rv1 = *(const v4u*)(pv_ + sz_ * 32); } while (0)
    GLA_ISSUE(0);
    for (int chunk = 0; chunk < 36; ++chunk) {
        int idx0, len0; const int r0 = seq_row(b, dir, chunk * 64, idx0, len0);
        const unsigned a_ptq = opq(G_TQ + (2 * dp) * 4);
        {
            float s0 = 0.f, s1 = 0.f;
#pragma unroll
            for (int i = 0; i < 16; ++i) { s0 += bflo(rl[i]); s1 += bfhi(rl[i]); }
            ST_(f32x2, a_ptq + qt * 1024) = (f32x2){s0, s1};
        }
        __syncthreads();
        if (VAR != 2)
        {
            float o0 = 0.f, o1 = 0.f, t0 = 0.f, t1 = 0.f;
#pragma unroll
            for (int q = 0; q < 4; ++q) { const f32x2 tq = LD_(f32x2, a_ptq + q * 1024); if (q < qt) { o0 += tq.x; o1 += tq.y; } t0 += tq.x; t1 += tq.y; }
            if (qt == 0) ST_(f32x2, G_EBL + 2 * dp * 4) = (f32x2){__expf(t0), __expf(t1)};
            unsigned kt0[8], kt1[8];
            const unsigned a_pq = opq(G_QD + ((16 * qt) * GQ_LD + 2 * dp) * 2);
            const unsigned a_pkt = opq(G_KT + ((2 * dp) * GT_LD + 16 * qt) * 2);
        const unsigned a_pvt = opq(G_VT + (jj * GV_LD + 8 * e8) * 2);
#pragma unroll
            for (int i = 0; i < 16; ++i) {
                o0 += bflo(rl[i]); o1 += bfhi(rl[i]);
                const float e0 = __expf(o0), e1 = __expf(o1), n0 = __expf(-o0), n1 = __expf(-o1);
                const unsigned qd = pg8::cvt_pk_bf16(bflo(rq[i]) * 0.0625f * e0, bfhi(rq[i]) * 0.0625f * e1);
                const unsigned ki = pg8::cvt_pk_bf16(bflo(rk[i]) * n0, bfhi(rk[i]) * n1);
                ST_(unsigned, a_pq + i * GQ_LD * 2) = qd;
                ST_(unsigned, a_pq + (G_KI - G_QD) + i * GQ_LD * 2) = ki;
                if (i & 1) { kt0[i >> 1] |= (ki << 16); kt1[i >> 1] |= (ki & 0xffff0000u); }
                else { kt0[i >> 1] = ki & 0xffffu; kt1[i >> 1] = ki >> 16; }
                asm volatile("" ::: "memory");
            }
            ST_(v4u, a_pkt) = (v4u){kt0[0], kt0[1], kt0[2], kt0[3]};
            ST_(v4u, a_pkt + 16) = (v4u){kt0[4], kt0[5], kt0[6], kt0[7]};
            ST_(v4u, a_pkt + GT_LD * 2) = (v4u){kt1[0], kt1[1], kt1[2], kt1[3]};
            ST_(v4u, a_pkt + GT_LD * 2 + 16) = (v4u){kt1[4], kt1[5], kt1[6], kt1[7]};
            ST_(v4u, a_pvt) = rv0; ST_(v4u, a_pvt + 32 * GV_LD * 2) = rv1;
        }
        __syncthreads();
        if (chunk + 1 < 36 && VAR != 1) GLA_ISSUE(chunk + 1);
        const unsigned a_f8 = opq((l16 * GQ_LD + 8 * g) * 2);
#pragma unroll
        for (int tt = 0; tt < 2; ++tt) {
            const int t = 2 * w + tt, jt = t >> 2, it = t & 3;
            f32x4 acc = (f32x4){0.f, 0.f, 0.f, 0.f};
            if (jt <= it) {
                const unsigned ak = a_f8 + G_KI + jt * (16 * GQ_LD * 2), aq = a_f8 + G_QD + it * (16 * GQ_LD * 2);
#pragma unroll
                for (int s = 0; s < 8; ++s) {
                    const bf16x8 a = LD_(bf16x8, ak + 64 * s);
                    const bf16x8 bb = LD_(bf16x8, aq + 64 * s);
                    acc = __builtin_amdgcn_mfma_f32_16x16x32_bf16(a, bb, acc, 0, 0, 0);
                }
            }
            const int i = 16 * it + l16, j0 = 16 * jt + 4 * g;
            const float m0 = (j0 + 0 <= i) ? acc[0] : 0.f, m1 = (j0 + 1 <= i) ? acc[1] : 0.f, m2 = (j0 + 2 <= i) ? acc[2] : 0.f, m3 = (j0 + 3 <= i) ? acc[3] : 0.f;
            ST_(v2u, G_AM + (i * GT_LD + j0) * 2) = (v2u){pg8::cvt_pk_bf16(m0, m1), pg8::cvt_pk_bf16(m2, m3)};
        }
        __syncthreads();
        if (VAR != 3)
        {
            const unsigned a_f4 = opq(G_QD + (l16 * GQ_LD + 4 * g) * 2), a_t8 = opq((l16 * GT_LD + 8 * g) * 2), a_ebl = opq(G_EBL + 16 * g);
            const unsigned a_vtr = opq(G_VT + ((8 * g + (l16 >> 2)) * GV_LD + 16 * w + 4 * (l16 & 3)) * 2);
            const unsigned a_os = opq(G_KI + ((4 * g) * GV_LD + 16 * w + l16) * 2);
            f32x4 O[4];
#pragma unroll
            for (int mt = 0; mt < 4; ++mt) O[mt] = (f32x4){0.f, 0.f, 0.f, 0.f};
#pragma unroll
            for (int s = 0; s < 8; ++s) {
                const bf16x8 bs = pack8(S[2 * s], S[2 * s + 1]);
#pragma unroll
                for (int mt = 0; mt < 4; ++mt) {
                    const v2u a0 = LD_(v2u, a_f4 + (16 * mt * GQ_LD + 32 * s) * 2);
                    const v2u a1 = LD_(v2u, a_f4 + (16 * mt * GQ_LD + 32 * s + 16) * 2);
                    const bf16x8 a = __builtin_bit_cast(bf16x8, (v4u){a0.x, a0.y, a1.x, a1.y});
                    O[mt] = __builtin_amdgcn_mfma_f32_16x16x32_bf16(a, bs, O[mt], 0, 0, 0);
                }
                asm volatile("" ::: "memory");
            }
            const bf16x8 vb0 = tr8(L, a_vtr, a_vtr + 4 * GV_LD * 2);
            const bf16x8 vb1 = tr8(L, a_vtr + 32 * GV_LD * 2, a_vtr + 36 * GV_LD * 2);
#pragma unroll
            for (int mt = 0; mt < 4; ++mt) {
                const bf16x8 a0 = LD_(bf16x8, a_t8 + G_AM + mt * (16 * GT_LD * 2));
                O[mt] = __builtin_amdgcn_mfma_f32_16x16x32_bf16(a0, vb0, O[mt], 0, 0, 0);
                if (mt >= 2) { const bf16x8 a1 = LD_(bf16x8, a_t8 + G_AM + mt * (16 * GT_LD * 2) + 64);
                    O[mt] = __builtin_amdgcn_mfma_f32_16x16x32_bf16(a1, vb1, O[mt], 0, 0, 0); }
            }
            if (VAR == 0 && !(last && chunk < 4)) {
                const unsigned aos = a_os;
#pragma unroll
                for (int mt = 0; mt < 4; ++mt)
#pragma unroll
                    for (int r = 0; r < 4; ++r) ST_(unsigned short, aos + (16 * mt + r) * (GV_LD * 2)) = (unsigned short)f2bf(O[mt][r]);
            }
#pragma unroll
            for (int t = 0; t < 16; ++t) {
                const bf16x8 a0 = LD_(bf16x8, a_t8 + G_KT + t * (16 * GT_LD * 2));
                const bf16x8 a1 = LD_(bf16x8, a_t8 + G_KT + t * (16 * GT_LD * 2) + 64);
                S[t] = __builtin_amdgcn_mfma_f32_16x16x32_bf16(a0, vb0, S[t], 0, 0, 0);
                S[t] = __builtin_amdgcn_mfma_f32_16x16x32_bf16(a1, vb1, S[t], 0, 0, 0);
                const f32x4 eb = LD_(f32x4, a_ebl + 64 * t);
                S[t] = S[t] * eb;
                asm volatile("" ::: "memory");
            }
        }
        __syncthreads();
        if (VAR == 0 && !(last && chunk < 4)) {
            const unsigned a_or = opq(G_KI + ((tid >> 4) * GV_LD + 8 * (tid & 15)) * 2);
            const v4u o0 = LD_(v4u, a_or), o1 = LD_(v4u, a_or + 32 * GV_LD * 2);
            GAS bf16* yp = (GAS bf16*)(YG + (size_t)(r0 + sgn * (tid >> 4)) * 2048 + h * 512 + dvs * 128 + 8 * (tid & 15));
            *(GAS v4u*)yp = o0; *(GAS v4u*)(yp + (long)sgn * 32 * 2048) = o1;
        }
    }
#undef GLA_ISSUE
    if (VAR != 0) { float chk = 0.f;
#pragma unroll
        for (int t = 0; t < 16; ++t) chk += S[t][0] + S[t][1] + S[t][2] + S[t][3];
        chk += __uint_as_float(rq[0] ^ rk[3] ^ rl[7]);
        if (chk == 1.2345e-30f) YG[0] = (bf16)1; }
}
#undef LD_
#undef ST_

constexpr int AK_LD = 136, AV_LD = 136;
constexpr int A_K = 0, A_VT = A_K + 64 * AK_LD * 2, A_END = A_VT + 64 * AV_LD * 2;
static_assert(A_END <= RING_BYTES, "attention LDS map");
typedef float f32x16 __attribute__((ext_vector_type(16)));
#define LD_(T, addr) (*(const LAS T*)(L + (addr)))
#define ST_(T, addr) (*(LAS T*)(L + (addr)))
template <bool NOSTORE> __device__ __forceinline__ void attn_mfma_item(const Frame& F, ArgsRef A, int l, int item) {
    LAS unsigned char* L = F.lds;
    const int tid = F.tid, lane = F.lane, w = F.wave, l32 = lane & 31, g = lane >> 5;
    bf16* ZA = RGN(bf16, R_ZA); const bf16* QR = RGN(bf16, R_QR); const bf16* KR = RGN(bf16, R_KR);
    const bool isctx = item >= 512;
    int b, hk, t0;
    if (!isctx) { b = item >> 6; hk = (item >> 5) & 1; t0 = (item & 31) * 64; }
    else { const int it = item - 512; b = it >> 3; hk = (it >> 2) & 1; t0 = (it & 3) * 64; }
    const int hq = hk * 4 + (w >> 1), tq = t0 + 32 * (w & 1) + l32;
    const size_t qrow = isctx ? (size_t)(ML + b * CL + tq) : (size_t)(b * SEQ + tq);
    const float C2 = 0.08838834764831845f * 1.4426950408889634f;
    const int skey = tid >> 3, sc = tid & 7;
    const unsigned a_sk = opq(A_K + (skey * AK_LD + 8 * sc) * 2);
    const unsigned a_sv = opq(A_VT + (skey * AV_LD + 8 * sc) * 2);
    const unsigned a_kf = opq(A_K + (l32 * AK_LD + 8 * g) * 2);
    const unsigned a_vf = opq(A_VT + ((4 * g + ((lane & 15) >> 2)) * AV_LD + 16 * ((lane >> 4) & 1) + 4 * (lane & 3)) * 2);
    bf16x8 qf[8];
    {
        const bf16* qp = (isctx ? (const bf16*)ZA + qrow * ZA_LD : QR + qrow * 1024) + hq * 128 + 8 * g;
#pragma unroll
        for (int s = 0; s < 8; ++s) qf[s] = *(const bf16x8*)(qp + 16 * s);
    }
    float mrun = AIN(11)[l * 8 + hq] * 1.4426950408889634f, lsum = (g == 0) ? 1.f : 0.f;
    f32x16 O[4];
#pragma unroll
    for (int mt = 0; mt < 4; ++mt)
#pragma unroll
        for (int r = 0; r < 16; ++r) O[mt][r] = 0.f;
    int tfirst = isctx ? 5 : 0;
    if (!isctx) { while (t0 - 128 + 64 * tfirst < 0) ++tfirst; }
    v4u pk0, pk1, pv0, pv1;
#define ATT_PREFETCH(tile) do { const bf16 *kp_, *vp_; \
        if ((tile) < 5) { const size_t r_ = (size_t)(b * SEQ + t0 - 128 + 64 * (tile) + skey); kp_ = KR + r_ * 256 + hk * 128 + 8 * sc; vp_ = ZA + r_ * ZA_LD + 1280 + hk * 128 + 8 * sc; } \
        else { const size_t r_ = (size_t)(ML + b * CL + 64 * ((tile) - 5) + skey); kp_ = ZA + r_ * ZA_LD + 1024 + hk * 128 + 8 * sc; vp_ = kp_ + 256; } \
        pk0 = *(const v4u*)kp_; pk1 = *(const v4u*)(kp_ + 64); pv0 = *(const v4u*)vp_; pv1 = *(const v4u*)(vp_ + 64); } while (0)
    int tile = tfirst;
    ATT_PREFETCH(tile);
    bool plainq = isctx;
    while (tile < 9) {
        __syncthreads();
        ST_(v4u, a_sk) = pk0; ST_(v4u, a_sk + 128) = pk1;
        ST_(v4u, a_sv) = pv0; ST_(v4u, a_sv + 128) = pv1;
        __syncthreads();
        const int cur = tile;
        int nxt = cur + 1;
        if (nxt < 5 && t0 - 128 + 64 * nxt >= SEQ) nxt = 5;
        if (nxt < 9) ATT_PREFETCH(nxt);
        if (cur >= 5 && !plainq) {
            const bf16* qp = (const bf16*)ZA + qrow * ZA_LD + hq * 128 + 8 * g;
#pragma unroll
            for (int s = 0; s < 8; ++s) qf[s] = *(const bf16x8*)(qp + 16 * s);
            plainq = true;
        }
        f32x16 sc0, sc1;
#pragma unroll
        for (int r = 0; r < 16; ++r) { sc0[r] = 0.f; sc1[r] = 0.f; }
#pragma unroll
        for (int s = 0; s < 8; ++s) {
            const bf16x8 k0 = LD_(bf16x8, a_kf + 32 * s), k1 = LD_(bf16x8, a_kf + 32 * AK_LD * 2 + 32 * s);
            sc0 = __builtin_amdgcn_mfma_f32_32x32x16_bf16(k0, qf[s], sc0, 0, 0, 0);
            sc1 = __builtin_amdgcn_mfma_f32_32x32x16_bf16(k1, qf[s], sc1, 0, 0, 0);
        }
        float tmax = -3.0e38f;
        if (cur < 5) {
            const int kbase = t0 - 128 + 64 * cur - tq + 4 * g;
#pragma unroll
            for (int r = 0; r < 16; ++r) { const int d0 = kbase + 8 * (r >> 2) + (r & 3), d1 = d0 + 32;
                sc0[r] = (d0 >= -128 && d0 <= 128) ? sc0[r] * C2 : -1.0e30f; sc1[r] = (d1 >= -128 && d1 <= 128) ? sc1[r] * C2 : -1.0e30f; }
        } else {
#pragma unroll
            for (int r = 0; r < 16; ++r) { sc0[r] *= C2; sc1[r] *= C2; }
        }
#pragma unroll
        for (int r = 0; r < 16; ++r) tmax = fmaxf(tmax, fmaxf(sc0[r], sc1[r]));
        tmax = xhalf_max(tmax);
        const float mnew = fmaxf(mrun, tmax);
        const float corr = __builtin_amdgcn_exp2f(mrun - mnew);
        mrun = mnew;
        float ps = 0.f;
#pragma unroll
        for (int r = 0; r < 16; ++r) { sc0[r] = __builtin_amdgcn_exp2f(sc0[r] - mnew); sc1[r] = __builtin_amdgcn_exp2f(sc1[r] - mnew); ps += sc0[r] + sc1[r]; }
        lsum = lsum * corr + ps;
        if (__builtin_amdgcn_ballot_w64(corr != 1.0f) != 0ull) {
#pragma unroll
            for (int mt = 0; mt < 4; ++mt)
#pragma unroll
                for (int r = 0; r < 16; ++r) O[mt][r] *= corr;
        }
#pragma unroll
        for (int u = 0; u < 2; ++u)
#pragma unroll
            for (int s = 0; s < 2; ++s) {
                v4u pw;
                if (u == 0) { pw.x = pg8::cvt_pk_bf16(sc0[8 * s + 0], sc0[8 * s + 1]); pw.y = pg8::cvt_pk_bf16(sc0[8 * s + 2], sc0[8 * s + 3]); pw.z = pg8::cvt_pk_bf16(sc0[8 * s + 4], sc0[8 * s + 5]); pw.w = pg8::cvt_pk_bf16(sc0[8 * s + 6], sc0[8 * s + 7]); }
                else { pw.x = pg8::cvt_pk_bf16(sc1[8 * s + 0], sc1[8 * s + 1]); pw.y = pg8::cvt_pk_bf16(sc1[8 * s + 2], sc1[8 * s + 3]); pw.z = pg8::cvt_pk_bf16(sc1[8 * s + 4], sc1[8 * s + 5]); pw.w = pg8::cvt_pk_bf16(sc1[8 * s + 6], sc1[8 * s + 7]); }
                const bf16x8 pb = __builtin_bit_cast(bf16x8, pw);
#pragma unroll
                for (int mt = 0; mt < 4; ++mt) {
                    const bf16x8 av = tr8(L, a_vf + ((32 * u + 16 * s) * AV_LD + 32 * mt) * 2, a_vf + ((32 * u + 16 * s + 8) * AV_LD + 32 * mt) * 2);
                    O[mt] = __builtin_amdgcn_mfma_f32_32x32x16_bf16(av, pb, O[mt], 0, 0, 0);
                }
            }
        tile = nxt;
    }
#undef ATT_PREFETCH
    lsum = xhalf_sum(lsum);
    const float inv = 1.0f / lsum;
    bf16* op = ZA + qrow * ZA_LD + hq * 128 + 4 * g;
    if (NOSTORE) { float chk = inv;
#pragma unroll
        for (int mt = 0; mt < 4; ++mt) chk += O[mt][0] + O[mt][5] + O[mt][10] + O[mt][15];
        if (chk == 1.2345e-30f) op[0] = (bf16)1;
        return; }
#pragma unroll
    for (int mt = 0; mt < 4; ++mt)
#pragma unroll
        for (int i = 0; i < 4; ++i) {
            v2u o; o.x = pg8::cvt_pk_bf16(O[mt][4 * i] * inv, O[mt][4 * i + 1] * inv); o.y = pg8::cvt_pk_bf16(O[mt][4 * i + 2] * inv, O[mt][4 * i + 3] * inv);
            *(v2u*)(op + 32 * mt + 8 * i) = o;
        }
}
#undef LD_
#undef ST_

#ifndef MK_PROBE
#define MK_PROBE 0
#endif
#define PROBE_SPIN(bit, t0_) do { if ((MK_PROBE & (bit)) != 0) { asm volatile("s_waitcnt vmcnt(0) lgkmcnt(0)" ::: "memory"); const unsigned long long t1_ = __builtin_amdgcn_s_memrealtime(); \
        while (__builtin_amdgcn_s_memrealtime() - t1_ < t1_ - (t0_)) __builtin_amdgcn_s_sleep(8); } } while (0)
__device__ __forceinline__ void phase_mix(const Frame& F, ArgsRef A, int l, bool last) {
    unsigned long long tp = (MK_PROBE & 0x700) ? __builtin_amdgcn_s_memrealtime() : 0ull;
#if !defined(MIX_ONLY) || MIX_ONLY == 1
    for (int v = F.bid; v < 256; v += F.G) rwkv_chunk_item(F, A, l, ((v & 7) << 5) | (v >> 3), last);
#endif
    PROBE_SPIN(0x100, tp);
    if (MK_PROBE & 0x700) tp = __builtin_amdgcn_s_memrealtime();
#if !defined(MIX_ONLY) || MIX_ONLY == 2
    for (int v = F.bid; v < 256; v += F.G) { const int x = v & 7, y = v >> 3; gla_chunk_item<0>(F, ((x + 8 * (y >> 3)) << 3) | (y & 7), last); }

#endif
    PROBE_SPIN(0x200, tp);
    if (MK_PROBE & 0x700) tp = __builtin_amdgcn_s_memrealtime();
    {
        const int x = F.bid & 7; const unsigned nt = last ? 64u : 72u;
        unsigned* ctr = (unsigned*)(F.ws + WS_CTL) + 8192 + (l * 8 + x) * 64;
        volatile LAS unsigned* tk = (volatile LAS unsigned*)(F.lds + MISC_OFF) + 16;
        for (;;) {
            if (F.tid == 0) *tk = __hip_atomic_fetch_add(ctr, 1u, __ATOMIC_RELAXED, __HIP_MEMORY_SCOPE_AGENT);
            __syncthreads();
            const unsigned t = *tk;
            __syncthreads();
            if (t >= nt) break;
            const int item = t < 64u ? ((x << 6) | (int)t) : 512 + ((x << 3) | (int)(t - 64u));
#if !defined(MIX_ONLY) || MIX_ONLY == 3
            attn_mfma_item<false>(F, A, l, item);
#endif
        }
    }
    PROBE_SPIN(0x400, tp);
}

__device__ __forceinline__ void phase_mixout(const Frame& F, ArgsRef A, int l, int nrows) {
    const int gw = F.bid * NWAVES + F.wave, NGW = F.G * NWAVES, lane = F.lane;
    {
        const bf16* ZR = RGN(bf16, R_ZR); const float* Y = RGN(float, R_Y); const bf16* G = RGN(bf16, R_G); bf16* ORW = RGN(bf16, R_ZA) + OC_RW; const float* BS = RGN(float, R_BS);
        const float* cw = AIN(12) + (size_t)l * 3 * RW_COLS;
        const int cg = F.wave & 3, c0 = cg * 256 + lane * 4, hd = cg * 4 + (lane >> 4);
        f32x4 tpv[3];
#pragma unroll
        for (int tap = 0; tap < 3; ++tap) tpv[tap] = *(const f32x4*)(cw + tap * RW_COLS + 2 * 1024 + c0);
        const f32x4 lnw = *(const f32x4*)(AIN(21) + l * 1024 + c0), lnb = *(const f32x4*)(AIN(22) + l * 1024 + c0);
        for (int m = F.bid * 2 + (F.wave >> 2); m < nrows; m += 2 * F.G) {
            int idx, len; if (m < ML) { idx = m & (SEQ - 1); len = SEQ; } else { idx = (m - ML) & (CL - 1); len = CL; }
            const float fl = idx > 0 ? 1.f : 0.f, fr = idx < len - 1 ? 1.f : 0.f;
            const bf16* z0 = ZR + (size_t)m * ZR_W + 2 * 1024 + c0; const bf16* zl = idx > 0 ? z0 - ZR_W : z0; const bf16* zrr = idx < len - 1 ? z0 + ZR_W : z0;
            const v2u wc = *(const v2u*)z0, wl = *(const v2u*)zl, wr = *(const v2u*)zrr;
            const f32x4 xc = (f32x4){bflo(wc.x), bfhi(wc.x), bflo(wc.y), bfhi(wc.y)}, xl = (f32x4){bflo(wl.x), bfhi(wl.x), bflo(wl.y), bfhi(wl.y)}, xr = (f32x4){bflo(wr.x), bfhi(wr.x), bflo(wr.y), bfhi(wr.y)};
            const f32x4 v = xc * tpv[1] + xl * tpv[0] * fl + xr * tpv[2] * fr;
            const f32x4 y0 = *(const f32x4*)(Y + (size_t)m * 1024 + c0), y1 = *(const f32x4*)(Y + ((size_t)MT + m) * 1024 + c0);
            const float bs = BS[(size_t)m * 16 + hd] + BS[((size_t)MT + m) * 16 + hd];
            const f32x4 o = y0 + y1;
            const float mean = red16s((o.x + o.y) + (o.z + o.w)) * (1.f / 64.f); const f32x4 dv = o - mean;
            const float var = red16s((dv.x * dv.x + dv.y * dv.y) + (dv.z * dv.z + dv.w * dv.w)) * (1.f / 64.f);
            const f32x4 on = dv * (1.f / sqrtf(var + 64e-5f)) * lnw + lnb;
            const v2u gw2 = *(const v2u*)(G + (size_t)m * 1024 + c0);
            const f32x4 gv = (f32x4){bflo(gw2.x), bfhi(gw2.x), bflo(gw2.y), bfhi(gw2.y)};
            const f32x4 res = (on + v * bs) * gv;
            *(v2u*)(ORW + (size_t)m * ZA_LD + c0) = (v2u){pk2(res.x, res.y), pk2(res.z, res.w)};
        }
    }
    {
        const bf16* YG = RGN(bf16, R_YG); const bf16* ZG = RGN(bf16, R_ZG); bf16* OGL = RGN(bf16, R_ZA) + OC_GL; const float* nw = AIN(25) + l * 512;
        const f32x4 nw0 = *(const f32x4*)(nw + lane * 8), nw1 = *(const f32x4*)(nw + lane * 8 + 4);
        for (int it = gw; it < nrows * 4; it += NGW) {
            const int m = it >> 2, h = it & 3;
            const v4u ya = *(const v4u*)(YG + (size_t)m * 2048 + h * 512 + lane * 8), yb = *(const v4u*)(YG + ((size_t)MT + m) * 2048 + h * 512 + lane * 8);
            f32x4 y0 = (f32x4){bflo(ya.x) + bflo(yb.x), bfhi(ya.x) + bfhi(yb.x), bflo(ya.y) + bflo(yb.y), bfhi(ya.y) + bfhi(yb.y)};
            f32x4 y1 = (f32x4){bflo(ya.z) + bflo(yb.z), bfhi(ya.z) + bfhi(yb.z), bflo(ya.w) + bflo(yb.w), bfhi(ya.w) + bfhi(yb.w)};
            const float ss = wave_sum((y0.x * y0.x + y0.y * y0.y) + (y0.z * y0.z + y0.w * y0.w) + (y1.x * y1.x + y1.y * y1.y) + (y1.z * y1.z + y1.w * y1.w));
            const float rs = 1.f / sqrtf(ss * (1.f / 512.f) + 1e-5f);
            const v4u gw4 = *(const v4u*)(ZG + (size_t)m * ZG_W + 4096 + h * 512 + lane * 8);
            const f32x4 g0 = (f32x4){bflo(gw4.x), bfhi(gw4.x), bflo(gw4.y), bfhi(gw4.y)}, g1 = (f32x4){bflo(gw4.z), bfhi(gw4.z), bflo(gw4.w), bfhi(gw4.w)};
            y0 = y0 * rs * nw0; y1 = y1 * rs * nw1;
            v4u w; w.x = pk2(y0.x * fsilu(g0.x), y0.y * fsilu(g0.y)); w.y = pk2(y0.z * fsilu(g0.z), y0.w * fsilu(g0.w));
            w.z = pk2(y1.x * fsilu(g1.x), y1.y * fsilu(g1.y)); w.w = pk2(y1.z * fsilu(g1.z), y1.w * fsilu(g1.w));
            *(v4u*)(OGL + (size_t)m * ZA_LD + h * 512 + lane * 8) = w;
        }
    }
}


#define NOPK
#ifndef MK_ONE_LAUNCH
#define MK_ONE_LAUNCH 1
#endif

template <int K> __device__ __forceinline__ void run_phase(const Frame& F, ArgsRef A, int l) {
    const float* mods = WSP(float, WS_MODS);
    bf16* HB = WSP(bf16, WS_HB);
    const bool last = (l == DEPTH - 1);
    const float* mods_l = mods + (size_t)l * 9 * 18432;
    const float* lng = AIN(6) + (size_t)l * 3 * D; const float* lnb = AIN(7) + (size_t)l * 3 * D;
    const int nrows = last ? ML : MT;
    if constexpr (K == -1) phase_init(F, A);
    if constexpr (K == 0) {
        if (l > 0) phase_ln<true, true>(F, MT, lng - D, lnb - D, mods_l, 0, 1, RGN(float, R_PART), mods_l - 9 * 18432 + 8 * 18432 + 8 * 2048, 0.5f);
        else phase_ln<false, true>(F, MT, nullptr, nullptr, mods_l, 0, 1, nullptr, nullptr, 0.f, AIN(0), AIN(2));
        phase_convert(F, A, l, 0, 3);
    }
    if constexpr (K == 1 || K == 12) { const int M = (K == 1) ? MT : nrows; pg8::Gemm g{HB, RGN(bf16, R_WGU), M, 2 * FF, D, D, D, 0}; pg8::StaticOrder S; S.init(M, 2 * FF, F.G, F.bid);
        pg8::EpiSwiglu E{RGN(bf16, R_H), FF}; pg8::gemm_phase<pg8::EpiSwiglu, pg8::StaticOrder, true, true>(F.lds, g, S, E, F.tid); }
    if constexpr (K == 2 || K == 13) { const int M = (K == 2) ? MT : nrows;
        { pg8::Gemm g{RGN(bf16, R_H), RGN(bf16, R_WDN), ML, D, FF, FF, FF, 0}; pg8::StaticOrder S; S.init(ML, D, F.G, F.bid);
          const bool first = (K == 2) && l == 0;
          const float* pg_ = (K == 2) ? (first ? lng : lng - D) : lng + D; const float* pb_ = (K == 2) ? (first ? lnb : lnb - D) : lnb + D;
          pg8::EpiResid<1> E{(float*)F.out, mods_l, first ? AIN(0) : (const float*)F.out, first ? nullptr : WSP(const float, WS_STATS), pg_, pb_, (K == 2) ? 2 : 8}; pg8::gemm_phase<pg8::EpiResid<1>, pg8::StaticOrder, true, true>(F.lds, g, S, E, F.tid); }
        if (M == MT) { pg8::Gemm g{RGN(bf16, R_H) + (size_t)ML * FF, RGN(bf16, R_WDN), MC, D, FF / 4, FF, FF, (FF / 4) * 2}; pg8::SplitKOrder S; S.init(MC, D, 4, F.G, F.bid);
          pg8::EpiPartial E{RGN(float, R_PART), D, (size_t)MC * D}; pg8::gemm_phase<pg8::EpiPartial, pg8::SplitKOrder, true, true>(F.lds, g, S, E, F.tid); }
    }
    if constexpr (K == 3) phase_ln<true, true>(F, MT, lng, lnb, mods_l, 3, 4, RGN(float, R_PART), mods_l + 8 * 18432 + 2 * 2048, 0.5f, nullptr, l == 0 ? AIN(2) : nullptr);
    if constexpr (K == 4) { pg8::Gemm g{HB, WSP(bf16, WS_WM + WM_IN), MT, NMIX, D, D, D, 0}; pg8::StaticOrder S; S.init(MT, NMIX, F.G, F.bid);
        typedef pg8::EpiBf16Seg<0, WS_R + R_ZA, WS_R + R_ZR, WS_R + R_ZG, 6, 21, ZA_LD, ZR_W, ZG_W> EpiWin; EpiWin E{(unsigned char*)F.ws};
        pg8::gemm_phase<EpiWin, pg8::StaticOrder, true, true>(F.lds, g, S, E, F.tid); }
    if constexpr (K == 5) { phase_prep(F, A, l);
#if (MK_PROBE & 0x100000)
        __syncthreads();
        for (int v = F.bid; v < 576; v += F.G) { const int item = v < 512 ? (((v & 7) << 6) | ((v >> 3) & 31) | ((v >> 8) << 5)) : 512 + ((((v - 512) & 7) << 3) | ((v - 512) >> 3)); attn_mfma_item<true>(F, A, l, item); }
#endif
#if (MK_PROBE & 0x200000)
        __syncthreads();
        for (int v = F.bid; v < 256; v += F.G) rwkv_chunk_item(F, A, l, ((v & 7) << 5) | (v >> 3), true);
#endif
#if (MK_PROBE & 0xF0000)
        __syncthreads();
        for (int v = F.bid; v < 256; v += F.G) { const int x = v & 7, y = v >> 3; gla_chunk_item<(MK_PROBE >> 16) & 15>(F, ((x + 8 * (y >> 3)) << 3) | (y & 7), true); }
#endif
    }
    if constexpr (K == 6) {
        { pg8::Gemm g{RGN(bf16, R_LA), WSP(bf16, WS_WM + WM_LW), MT, 2048, 256, LA_W, 256, 0}; pg8::StaticOrder S; S.init(MT, 2048, F.G, F.bid);
          pg8::EpiLora<0> E{RGN(float, R_WDEC), nullptr, AIN(13) + (size_t)l * 2048, (size_t)MT * 1024}; pg8::gemm_phase<pg8::EpiLora<0>, pg8::StaticOrder, true, true>(F.lds, g, S, E, F.tid); }
    }
    if constexpr (K == 15) {
        { pg8::Gemm g{RGN(bf16, R_LA) + 256, WSP(bf16, WS_WM + WM_LA), MT, 2048, 256, LA_W, 256, 0}; pg8::StaticOrder S; S.init(MT, 2048, F.G, F.bid);
          pg8::EpiLora<1> E{nullptr, RGN(bf16, R_AA), AIN(15) + (size_t)l * 2048, (size_t)MT * 1024}; pg8::gemm_phase<pg8::EpiLora<1>, pg8::StaticOrder, true, true>(F.lds, g, S, E, F.tid); }
    }
    if constexpr (K == 16) {
        { pg8::Gemm g{RGN(bf16, R_LA) + 512, WSP(bf16, WS_WM + WM_LG), MT, 1024, 256, LA_W, 256, 0}; pg8::StaticOrder S; S.init(MT, 1024, F.G, F.bid);
          pg8::EpiLora<2> E{nullptr, RGN(bf16, R_G), nullptr, 0}; pg8::gemm_phase<pg8::EpiLora<2>, pg8::StaticOrder, true, true>(F.lds, g, S, E, F.tid); }
    }
    if constexpr (K == 7) phase_mix(F, A, l, last);
    if constexpr (K == 8) {
        phase_mixout(F, A, l, nrows);
        __syncthreads();
        pg8::Gemm g{HB, WSP(bf16, WS_WM + WM_IN) + (size_t)NMIX * D, nrows, GT_W, D, D, D, 0}; pg8::StaticOrder S; S.init(nrows, GT_W, F.G, F.bid);
        typedef pg8::EpiBf16Seg<1, WS_R + R_GT, WS_R + R_GT, WS_R + R_GT, 1 << 20, 1 << 20, GT_W, GT_W, GT_W> EpiGate; EpiGate E{(unsigned char*)F.ws};
        pg8::gemm_phase<EpiGate, pg8::StaticOrder, true, true>(F.lds, g, S, E, F.tid);
    }
    if constexpr (K == 9) {
        pg8::Gemm g{RGN(bf16, R_ZA), WSP(bf16, WS_WM + WM_BA), nrows, D, 4096, ZA_LD, 4096, 0, 16, (OC_RW - 1024) * 2}; pg8::StaticOrder S; S.init(nrows, D, F.G, F.bid);
        pg8::EpiBranchFused E{RGN(bf16, R_GT), GT_W, RGN(bf16, R_MG)}; pg8::gemm_phase<pg8::EpiBranchFused, pg8::StaticOrder, true, true>(F.lds, g, S, E, F.tid);
    }
    if constexpr (K == 10) {
        { pg8::Gemm g{RGN(bf16, R_MG), WSP(bf16, WS_WM + WM_OUT), ML, D, D, D, D, 0}; pg8::StaticOrder S; S.init(ML, D, F.G, F.bid);
          pg8::EpiResid<2> E{(float*)F.out, mods_l, (const float*)F.out, WSP(const float, WS_STATS), lng, lnb, 5}; pg8::gemm_phase<pg8::EpiResid<2>, pg8::StaticOrder, true, true>(F.lds, g, S, E, F.tid); }
        if (nrows == MT) { pg8::Gemm g{RGN(bf16, R_MG) + (size_t)ML * D, WSP(bf16, WS_WM + WM_OUT), MC, D, D / 4, D, D, (D / 4) * 2}; pg8::SplitKOrder S; S.init(MC, D, 4, F.G, F.bid);
          pg8::EpiPartial E{RGN(float, R_PART), D, (size_t)MC * D}; pg8::gemm_phase<pg8::EpiPartial, pg8::SplitKOrder, true, true>(F.lds, g, S, E, F.tid); }
    }
    if constexpr (K == 11) { phase_ln<true, true>(F, nrows, lng + D, lnb + D, mods_l, 6, 7, RGN(float, R_PART), mods_l + 8 * 18432 + 5 * 2048, 1.0f); phase_convert(F, A, l, 1, 1); }
    if constexpr (K == 14) phase_ln<true, false, true>(F, ML, lng + 2 * D, lnb + 2 * D, nullptr, 0, 0);
}

__device__ __forceinline__ void frame_init(Frame& F, const Args& A, unsigned char* lds_raw) {
    F.lds = (LAS unsigned char*)lds_raw;
    F.tid = threadIdx.x; F.lane = F.tid & 63; F.wave = __builtin_amdgcn_readfirstlane(F.tid >> 6);
    F.G = gridDim.x; F.bid = blockIdx.x; F.out = (GAS float*)A.out; F.ws = (GAS unsigned char*)A.ws;
}

template <int K> __global__ void __launch_bounds__(NTHR, 2) NOPK fwd_phase(Args A) {
    extern __shared__ __attribute__((aligned(16))) unsigned char lds_raw[];
    Frame F; frame_init(F, A, lds_raw);
    const CAS Args* ap = (const CAS Args*)__builtin_amdgcn_kernarg_segment_ptr();
    run_phase<K>(F, *ap, A.ph_lo);
}


#ifndef MK_UNROLL_LAYERS
#define MK_UNROLL_LAYERS 0
#endif
__device__ __forceinline__ void launder(Frame& F, int& l) {
    asm volatile("" : "+s"(F.wave));
    { int ln; asm volatile("v_mbcnt_lo_u32_b32 %0, -1, 0\n\tv_mbcnt_hi_u32_b32 %0, -1, %0" : "=v"(ln)); F.lane = ln; }
    F.tid = F.wave * 64 + F.lane;
    asm volatile("" : "+s"(F.bid), "+s"(F.G), "+s"(l));
    asm volatile("" : "+s"(F.ws), "+s"(F.out));
}
template <int K> __device__ __forceinline__ constexpr int phase_group() { return (K == 1 || K == 2 || K == 4 || K == 6 || K == 15 || K == 16 || K == 9 || K == 10 || K == 12 || K == 13) ? 1 : (K == 7 ? 2 : (K == 8 ? 4 : (K == 5 ? 8 : (K == 0 || K == 11 ? 16 : (K == 3 || K == 14 ? 32 : 64))))); }
template <int K> __device__ __forceinline__ void run_phase_l(Frame F, int l) {
    if constexpr ((MK_PROBE & phase_group<K>()) != 0) {
        const unsigned long long t0 = __builtin_amdgcn_s_memrealtime();
        { Frame F2 = F; int l2 = l; launder(F2, l2); const CAS Args* ap = (const CAS Args*)__builtin_amdgcn_kernarg_segment_ptr(); asm volatile("" : "+s"(ap)); run_phase<K>(F2, *ap, l2); }
        asm volatile("s_waitcnt vmcnt(0) lgkmcnt(0)" ::: "memory");
        const unsigned long long t1 = __builtin_amdgcn_s_memrealtime();
        while (__builtin_amdgcn_s_memrealtime() - t1 < t1 - t0) __builtin_amdgcn_s_sleep(8);
        return;
    }
    launder(F, l); const CAS Args* ap = (const CAS Args*)__builtin_amdgcn_kernarg_segment_ptr(); asm volatile("" : "+s"(ap)); run_phase<K>(F, *ap, l); }
template <int L> __device__ __forceinline__ void run_layer(const Frame& F, int l, const XcdBarrier& bar) {
#if (MK_PROBE & 0x2000)
#define XBAR2(t_) do { const unsigned long long tb0_ = __builtin_amdgcn_s_memrealtime(); xcd_barrier(bar, (t_)); const unsigned long long tb1_ = __builtin_amdgcn_s_memrealtime(); \
    while (__builtin_amdgcn_s_memrealtime() - tb1_ < tb1_ - tb0_) __builtin_amdgcn_s_sleep(8); } while (0)
#elif (MK_PROBE & 0x1000)
#define XBAR2(t_) xcd_barrier(bar, (t_)); xcd_barrier(bar, (t_))
#else
#define XBAR2(t_) xcd_barrier(bar, (t_))
#endif
#define PB(K) run_phase_l<K>(F, l); { int ln_; asm volatile("v_mbcnt_lo_u32_b32 %0, -1, 0\n\tv_mbcnt_hi_u32_b32 %0, -1, %0" : "=v"(ln_)); XBAR2(F.wave * 64 + ln_); }
    PB(0) PB(1) PB(2) PB(3) PB(4) PB(5)
    run_phase_l<6>(F, l); run_phase_l<15>(F, l); run_phase_l<16>(F, l); { int ln_; asm volatile("v_mbcnt_lo_u32_b32 %0, -1, 0\n\tv_mbcnt_hi_u32_b32 %0, -1, %0" : "=v"(ln_)); XBAR2(F.wave * 64 + ln_); }
    PB(7) PB(8) PB(9) PB(10) PB(11) PB(12) PB(13)
#undef PB
}
__global__ void __launch_bounds__(NTHR, 2) NOPK fwd_all(Args A) {
    extern __shared__ __attribute__((aligned(16))) unsigned char lds_raw[];
    Frame F; frame_init(F, A, lds_raw);
    volatile LAS unsigned* MISC = (volatile LAS unsigned*)(F.lds + MISC_OFF);
    for (int u = F.tid; u < (LDS_BYTES - LDSCTL_OFF) / 4; u += NTHR) ((LAS unsigned*)(F.lds + LDSCTL_OFF))[u] = 0u;
    __syncthreads();
    const XcdBarrier bar = xcd_barrier_post((unsigned*)(F.ws + WS_CTL) + 4096, MISC + 8, F.tid);
    run_phase_l<-1>(F, 0); { int ln_; asm volatile("v_mbcnt_lo_u32_b32 %0, -1, 0\n\tv_mbcnt_hi_u32_b32 %0, -1, %0" : "=v"(ln_)); XBAR2(F.wave * 64 + ln_); }
#if MK_UNROLL_LAYERS
    run_layer<0>(F, 0, bar); run_layer<1>(F, 1, bar);
#else
    for (int l = 0; l < DEPTH; ++l) run_layer<0>(F, l, bar);
#endif
    run_phase_l<14>(F, DEPTH - 1);
}

template <int K> static void launch_phase(const Args& a, int l, int grid, hipStream_t stream) {
    static bool attr_done = false;
    if (!attr_done) { (void)hipFuncSetAttribute((const void*)fwd_phase<K>, hipFuncAttributeMaxDynamicSharedMemorySize, LDS_BYTES); attr_done = true; }
    Args b = a; b.ph_lo = l; b.ph_hi = 0;
    hipLaunchKernelGGL(fwd_phase<K>, dim3(grid), dim3(NTHR), LDS_BYTES, stream, b);
}

extern "C" void kernel_launch(void* const* d_in, const int* in_sizes, int n_in, void* d_out, int out_size, void* d_ws, size_t ws_size, hipStream_t stream) {
    static int grid = 0;
    if (grid == 0) {
        if (n_in != 30 || out_size != ML * D || ws_size < WS_END) { fprintf(stderr, "kernel_launch: unexpected shapes (n_in %d, out %d, ws %zu < %zu)\n", n_in, out_size, ws_size, (size_t)WS_END); grid = -1; return; }
        int dev = 0, cus = 0;
        if (hipGetDevice(&dev) != hipSuccess || hipDeviceGetAttribute(&cus, hipDeviceAttributeMultiprocessorCount, dev) != hipSuccess) { grid = -1; return; }
        grid = cus;
    }
    if (grid < 0) return;
    (void)hipMemsetAsync((char*)d_ws + WS_CTL, 0, CTL_ZERO_BYTES, stream);
    Args a{};
    for (int i = 0; i < 30; ++i) a.in[i] = (const float*)d_in[i];
    a.out = (float*)d_out; a.ws = (unsigned char*)d_ws;
#if MK_ONE_LAUNCH
    {
        static bool attr_done = false;
        if (!attr_done) { int per_cu = 0;
            if (hipFuncSetAttribute((const void*)fwd_all, hipFuncAttributeMaxDynamicSharedMemorySize, LDS_BYTES) != hipSuccess) { fprintf(stderr, "kernel_launch: hipFuncSetAttribute failed\n"); grid = -1; return; }
            if (hipOccupancyMaxActiveBlocksPerMultiprocessor(&per_cu, (const void*)fwd_all, NTHR, LDS_BYTES) != hipSuccess || per_cu < 1) { fprintf(stderr, "kernel_launch: occupancy query says %d blocks per CU; not launching\n", per_cu); (void)hipGetLastError(); grid = -1; return; }
            attr_done = true; }
        a.ph_lo = 0; a.ph_hi = 0;
        hipLaunchKernelGGL(fwd_all, dim3(grid), dim3(NTHR), LDS_BYTES, stream, a);
        return;
    }
#endif
    launch_phase<-1>(a, 0, grid, stream);
    for (int l = 0; l < DEPTH; ++l) {
        launch_phase<0>(a, l, grid, stream); launch_phase<1>(a, l, grid, stream); launch_phase<2>(a, l, grid, stream); launch_phase<3>(a, l, grid, stream);
        launch_phase<4>(a, l, grid, stream); launch_phase<5>(a, l, grid, stream); launch_phase<6>(a, l, grid, stream); launch_phase<15>(a, l, grid, stream); launch_phase<16>(a, l, grid, stream); launch_phase<7>(a, l, grid, stream);
        launch_phase<8>(a, l, grid, stream); launch_phase<9>(a, l, grid, stream); launch_phase<10>(a, l, grid, stream); launch_phase<11>(a, l, grid, stream);
        launch_phase<12>(a, l, grid, stream); launch_phase<13>(a, l, grid, stream);
    }
    launch_phase<14>(a, DEPTH - 1, grid, stream);
}
```

```cpp
#include <hip/hip_runtime.h>
#include <cstdio>
#include <cstdint>

#define GAS __attribute__((address_space(1)))
#define LAS __attribute__((address_space(3)))
typedef unsigned short bf16;
typedef unsigned v4u __attribute__((ext_vector_type(4)));
typedef unsigned v2u __attribute__((ext_vector_type(2)));
typedef float v2f __attribute__((ext_vector_type(2)));
typedef float f32x4 __attribute__((ext_vector_type(4)));
typedef float f32x2 __attribute__((ext_vector_type(2)));
typedef short bf16x8 __attribute__((ext_vector_type(8)));

__device__ __forceinline__ float bf2f(unsigned short b) { return __builtin_bit_cast(float, ((unsigned)b) << 16); }
__device__ __forceinline__ float bflo(unsigned w) { return __builtin_bit_cast(float, w << 16); }
__device__ __forceinline__ float bfhi(unsigned w) { return __builtin_bit_cast(float, w & 0xffff0000u); }
typedef __bf16 bf2n_t_ __attribute__((ext_vector_type(2)));
__device__ __forceinline__ unsigned pk2(float lo, float hi) { const f32x2 v = {lo, hi}; return __builtin_bit_cast(unsigned, __builtin_convertvector(v, bf2n_t_)); }
__device__ __forceinline__ unsigned f2bf(float f) { return pk2(f, 0.f) & 0xffffu; }
template <int CTRL, int ROW_MASK> __device__ __forceinline__ float dppf(float v) {
    return __builtin_bit_cast(float, __builtin_amdgcn_update_dpp(0, __builtin_bit_cast(int, v), CTRL, ROW_MASK, 0xF, false)); }
__device__ __forceinline__ float wave_sum(float v) {
    v += dppf<0xB1, 0xF>(v);
    v += dppf<0x4E, 0xF>(v);
    v += dppf<0x141, 0xF>(v);
    v += dppf<0x140, 0xF>(v);
    v += dppf<0x142, 0xA>(v);
    v += dppf<0x143, 0xC>(v);
    return __builtin_bit_cast(float, __builtin_amdgcn_readlane(__builtin_bit_cast(int, v), 63));
}
__device__ __forceinline__ void half_swap(float& a, float& b) { asm volatile("v_nop\n\tv_nop\n\tv_permlane32_swap_b32 %0, %1\n\tv_nop\n\tv_nop" : "+v"(a), "+v"(b)); }
__device__ __forceinline__ float xhalf_max(float v) { float a = v, b = v; half_swap(a, b); return fmaxf(a, b); }
__device__ __forceinline__ float xhalf_sum(float v) { float a = v, b = v; half_swap(a, b); return a + b; }
__device__ __forceinline__ float fsigmoid(float x) { return __builtin_amdgcn_rcpf(1.0f + __expf(-x)); }
__device__ __forceinline__ float fsilu(float x) { return x * __builtin_amdgcn_rcpf(1.0f + __expf(-x)); }
__device__ __forceinline__ float fsoftplus(float x) { return fmaxf(x, 0.f) + __logf(1.0f + __expf(-fabsf(x))); }
__device__ __forceinline__ float ftanh(float x) { const float e = __expf(-2.0f * fabsf(x)); const float t = (1.0f - e) * __builtin_amdgcn_rcpf(1.0f + e); return x < 0.f ? -t : t; }

namespace pg8 {
#define PG8_LAS __attribute__((address_space(3)))
typedef unsigned short bf16_t;
typedef short bf16x8 __attribute__((ext_vector_type(8)));
typedef float f32x4 __attribute__((ext_vector_type(4)));
typedef unsigned u32x4 __attribute__((ext_vector_type(4)));
constexpr int BM = 256, BK = 64, HALF = 128, HTB = HALF * BK * 2  , STAGE_BYTES = 8 * HTB, NXCD = 8, WGM = 8;

__host__ __device__ __forceinline__ int lds_byte(int r, int c) { const int st = (r >> 4) * 2 + (c >> 5), rr = r & 15, cc = c & 31, ob = rr * 64 + cc * 2; return st * 1024 + (ob ^ (((ob >> 9) & 1) << 5)); }
__host__ __device__ __forceinline__ void stage_rc(int b, int& R, int& C) { const int st = b / 1024, sb = b % 1024, swz = sb ^ (((sb >> 9) & 1) << 5); R = (st >> 1) * 16 + swz / 64; C = (st & 1) * 32 + (swz % 64) / 2; }
__host__ __device__ __forceinline__ int perm32(int rho) { const int n = rho >> 4, i = rho & 15; return 8 * (i >> 2) + 4 * n + (i & 3); }

struct Unit { int pm, pn, kq; };
struct Gemm { const bf16_t* A; const bf16_t* Bt; int M, N, K, lda, ldb; int kqb; int jt, jb; };

struct StaticOrder {
    int nM, nN, nwg, G, c;
    __host__ __device__ void init(int M, int N, int G_, int c_) { nM = M / BM; nN = N / BM; nwg = nM * nN; G = G_; c = c_; }
    __host__ __device__ bool next(int i, Unit& u) const {
        const long L = (long)i * G + c; if (L >= nwg) return false;
        int wgid = (int)L; { const int q = nwg / NXCD, r = nwg % NXCD, xcd = wgid % NXCD, off = wgid / NXCD; wgid = (xcd < r ? xcd * (q + 1) : r * (q + 1) + (xcd - r) * q) + off; }
        const int nig = WGM * nN, gid = wgid / nig, fm = gid * WGM, gsz = (nM - fm) < WGM ? (nM - fm) : WGM;
        u.pm = fm + ((wgid % nig) % gsz); u.pn = (wgid % nig) / gsz; u.kq = 0; return true;
    }
    __device__ __forceinline__ void a_ready(const Unit&) const {}
    __device__ __forceinline__ void done(const Unit&) const {}
};

struct SplitKOrder {
    int nM, nN, nq, G, c;
    __host__ __device__ void init(int M, int N, int NQ, int G_, int c_) { nM = M / BM; nN = N / BM; nq = NQ; G = G_; c = c_; }
    __host__ __device__ bool next(int i, Unit& u) const { const long L = (long)i * G + c; if (L >= (long)nM * nN * nq) return false; const int t = (int)L / nq; u.kq = (int)L % nq; u.pm = t % nM; u.pn = t / nM; return true; }
    __device__ __forceinline__ void a_ready(const Unit&) const {}
    __device__ __forceinline__ void done(const Unit&) const {}
};
typedef __bf16 bf2_t_ __attribute__((ext_vector_type(2)));
typedef float f2_t_ __attribute__((ext_vector_type(2)));
__device__ __forceinline__ unsigned cvt_pk_bf16(float lo, float hi) { const f2_t_ v = {lo, hi}; return __builtin_bit_cast(unsigned, __builtin_convertvector(v, bf2_t_)); }

#define EPI_ROWS_BEGIN \
    _Pragma("unroll") for (int ai = 0; ai < 2; ++ai) _Pragma("unroll") for (int m = 0; m < 4; ++m) { const int row = u.pm * BM + ai * HALF + wr * 64 + m * 16 + fr;
#define EPI_ROWS_END }

template <int ACT, size_t O0, size_t O1, size_t O2, int T1, int T2, int L0, int L1, int L2> struct EpiBf16Seg {
    static constexpr bool PERM = true, AFTER_DRAIN = false;
    unsigned char* ws;
    __device__ __forceinline__ void operator()(const f32x4 (&acc)[2][2][4][2], const Unit& u, int wr, int wc, int fr, int fq) const {
        const size_t off = u.pn >= T2 ? O2 : (u.pn >= T1 ? O1 : O0); const int l = u.pn >= T2 ? L2 : (u.pn >= T1 ? L1 : L0), tb = u.pn >= T2 ? T2 : (u.pn >= T1 ? T1 : 0);
        bf16_t* base = (bf16_t*)(ws + off);
        const int col0 = (u.pn - tb) * BM + wc * 32 + 8 * fq;
        EPI_ROWS_BEGIN
            bf16_t* rowp = base + (size_t)row * l + col0;
#pragma unroll
            for (int bj = 0; bj < 2; ++bj) { f32x4 v0 = acc[ai][bj][m][0], v1 = acc[ai][bj][m][1];
                if (ACT == 1) {
#pragma unroll
                    for (int j = 0; j < 4; ++j) { v0[j] = fsigmoid(v0[j]); v1[j] = fsigmoid(v1[j]); } }
                u32x4 w; w.x = cvt_pk_bf16(v0[0], v0[1]); w.y = cvt_pk_bf16(v0[2], v0[3]); w.z = cvt_pk_bf16(v1[0], v1[1]); w.w = cvt_pk_bf16(v1[2], v1[3]);
                *(u32x4*)(rowp + bj * HALF) = w; }
        EPI_ROWS_END
    }
};
struct EpiSwiglu {
    static constexpr bool PERM = true, AFTER_DRAIN = false;
    bf16_t* H; int ldh;
    __device__ __forceinline__ void operator()(const f32x4 (&acc)[2][2][4][2], const Unit& u, int wr, int wc, int fr, int fq) const {
        const int col0 = u.pn * HALF + wc * 32 + 8 * fq;
        EPI_ROWS_BEGIN
            f32x4 g0 = acc[ai][0][m][0], g1 = acc[ai][0][m][1]; const f32x4 u0 = acc[ai][1][m][0], u1 = acc[ai][1][m][1];
#pragma unroll
            for (int j = 0; j < 4; ++j) { g0[j] = fsilu(g0[j]) * u0[j]; g1[j] = fsilu(g1[j]) * u1[j]; }
            u32x4 w; w.x = cvt_pk_bf16(g0[0], g0[1]); w.y = cvt_pk_bf16(g0[2], g0[3]); w.z = cvt_pk_bf16(g1[0], g1[1]); w.w = cvt_pk_bf16(g1[2], g1[3]);
            *(u32x4*)(H + (size_t)row * ldh + col0) = w;
        EPI_ROWS_END
    }
};
struct EpiPartial {
    static constexpr bool PERM = true, AFTER_DRAIN = false;
    float* P; int ldp; size_t qstride;
    __device__ __forceinline__ void operator()(const f32x4 (&acc)[2][2][4][2], const Unit& u, int wr, int wc, int fr, int fq) const {
        const int col0 = u.pn * BM + wc * 32 + 8 * fq; float* base = P + (size_t)u.kq * qstride;
        EPI_ROWS_BEGIN
            float* rowp = base + (size_t)row * ldp + col0;
#pragma unroll
            for (int bj = 0; bj < 2; ++bj)
#pragma unroll
                for (int n = 0; n < 2; ++n) *(f32x4*)(rowp + bj * HALF + 4 * n) = acc[ai][bj][m][n];
        EPI_ROWS_END
    }
};
constexpr float RES_ALPHA = 1.41421356237f;
template <int COEF2> struct EpiResid {
    static constexpr bool PERM = true, AFTER_DRAIN = false;
    float* xl; const float* mods; const float* sl; const float* st; const float* lg; const float* lb; int kmod;
    __device__ __forceinline__ void operator()(const f32x4 (&acc)[2][2][4][2], const Unit& u, int wr, int wc, int fr, int fq) const {
        const float* mp = mods + (size_t)(u.pm >> 3) * (9 * 2048) + kmod * 2048;
        const int col0 = u.pn * BM + wc * 32 + 8 * fq;
        const bool ln = st != nullptr; constexpr float al = RES_ALPHA, coef = 0.5f * COEF2;
        const float* stp = ln ? st : mods;
        const int row0 = u.pm * BM + wr * 64 + fr;
        const size_t rbase = (size_t)row0 * 2048 + col0;
#pragma unroll
        for (int bj = 0; bj < 2; ++bj) {
            f32x4 mv[2], ag[2], ab[2];
#pragma unroll
            for (int n = 0; n < 2; ++n) { mv[n] = *(const f32x4*)(mp + col0 + bj * HALF + 4 * n) * coef;
                const f32x4 g4 = *(const f32x4*)(lg + col0 + bj * HALF + 4 * n), b4 = *(const f32x4*)(lb + col0 + bj * HALF + 4 * n);
                const f32x4 g4s = ln ? g4 : (f32x4){1.f, 1.f, 1.f, 1.f}, b4s = ln ? b4 : (f32x4){0.f, 0.f, 0.f, 0.f};
                ag[n] = g4s * al; ab[n] = b4s * al; }
            f32x4 xa[3][2]; f2_t_ ms[3];
#define RES_LOADG(slot, g_) do { const int ro_ = ((g_) >> 2) * HALF + ((g_) & 3) * 16; \
                _Pragma("unroll") for (int n = 0; n < 2; ++n) xa[slot][n] = *(const f32x4*)(sl + rbase + (size_t)ro_ * 2048 + bj * HALF + 4 * n); \
                ms[slot] = *(const f2_t_*)(stp + 2 * (row0 + ro_)); } while (0)
            RES_LOADG(0, 0); RES_LOADG(1, 1);
#pragma unroll
            for (int gi = 0; gi < 8; ++gi) {
                const int ai = gi >> 2, m = gi & 3;
                if (gi + 2 < 8) RES_LOADG((gi + 2) % 3, gi + 2);
                asm volatile("" ::: "memory");
                float* rowp = xl + rbase + (size_t)(ai * HALF + m * 16) * 2048 + bj * HALF;
                const float mean = ln ? ms[gi % 3][0] : 0.f, rstd = ln ? ms[gi % 3][1] : 1.f;
#pragma unroll
                for (int n = 0; n < 2; ++n) { const f32x4 t = ag[n] * rstd;
                    *(f32x4*)(rowp + 4 * n) = (xa[gi % 3][n] - mean) * t + (ab[n] + mv[n] * acc[ai][bj][m][n]); }
                asm volatile("" ::: "memory");
            }
#undef RES_LOADG
        }
    }
};
template <int MODE> struct EpiBranch {
    static constexpr bool PERM = true, AFTER_DRAIN = false;
    const bf16_t* GT; int ldg, goff; float* T; bf16_t* O;
    __device__ __forceinline__ void operator()(const f32x4 (&acc)[2][2][4][2], const Unit& u, int wr, int wc, int fr, int fq) const {
        const int col0 = u.pn * BM + wc * 32 + 8 * fq;
        const size_t r0 = (size_t)(u.pm * BM + wr * 64 + fr);
        u32x4 gw[2][2]; f32x4 tv[2][2][2];
#pragma unroll
        for (int bj = 0; bj < 2; ++bj) { gw[0][bj] = *(const u32x4*)(GT + r0 * ldg + goff + col0 + bj * HALF);
            if (MODE >= 1) { const float* tp = T + r0 * 2048 + col0 + bj * HALF; tv[0][bj][0] = *(const f32x4*)tp; tv[0][bj][1] = *(const f32x4*)(tp + 4); } }
#pragma unroll
        for (int gi = 0; gi < 8; ++gi) {
            const int ai = gi >> 2, m = gi & 3; const size_t row = r0 + ai * HALF + m * 16;
            if (gi < 7) { const size_t row2 = r0 + ((gi + 1) >> 2) * HALF + ((gi + 1) & 3) * 16;
#pragma unroll
                for (int bj = 0; bj < 2; ++bj) { gw[(gi + 1) & 1][bj] = *(const u32x4*)(GT + row2 * ldg + goff + col0 + bj * HALF);
                    if (MODE >= 1) { const float* tp = T + row2 * 2048 + col0 + bj * HALF; tv[(gi + 1) & 1][bj][0] = *(const f32x4*)tp; tv[(gi + 1) & 1][bj][1] = *(const f32x4*)(tp + 4); } } }
            asm volatile("" ::: "memory");
#pragma unroll
            for (int bj = 0; bj < 2; ++bj) {
                const u32x4 g4 = gw[gi & 1][bj];
                const f32x4 g0 = (f32x4){bflo(g4.x), bfhi(g4.x), bflo(g4.y), bfhi(g4.y)}, g1 = (f32x4){bflo(g4.z), bfhi(g4.z), bflo(g4.w), bfhi(g4.w)};
                f32x4 v0 = g0 * acc[ai][bj][m][0], v1 = g1 * acc[ai][bj][m][1];
                float* tp = T + row * 2048 + col0 + bj * HALF;
                if (MODE >= 1) { v0 += tv[gi & 1][bj][0]; v1 += tv[gi & 1][bj][1]; }
                if (MODE <= 1) { *(f32x4*)tp = v0; *(f32x4*)(tp + 4) = v1; }
                else { u32x4 w; w.x = cvt_pk_bf16(v0[0], v0[1]); w.y = cvt_pk_bf16(v0[2], v0[3]); w.z = cvt_pk_bf16(v1[0], v1[1]); w.w = cvt_pk_bf16(v1[2], v1[3]);
                    *(u32x4*)(O + row * 2048 + col0 + bj * HALF) = w; }
            }
            asm volatile("" ::: "memory");
        }
    }
};
struct EpiBranchFused {
    static constexpr bool PERM = true, AFTER_DRAIN = false, MID = true;
    static constexpr int H1 = 16, H2 = 32;
    const bf16_t* GT; int ldg; bf16_t* O;
    static __device__ __forceinline__ void unpack(const u32x4 g4, f32x4& g0, f32x4& g1) { g0 = (f32x4){bflo(g4.x), bfhi(g4.x), bflo(g4.y), bfhi(g4.y)}; g1 = (f32x4){bflo(g4.z), bfhi(g4.z), bflo(g4.w), bfhi(g4.w)}; }
    __device__ __forceinline__ void mid(f32x4 (&acc)[2][2][4][2], const Unit& u, int wr, int wc, int fr, int fq, bool second) const {
        const int col0 = u.pn * BM + wc * 32 + 8 * fq;
        const size_t r0 = (size_t)(u.pm * BM + wr * 64 + fr);
        const int on = second ? 2048 : 0, od = second ? 4096 : 2048;
        const float nfloor = second ? 1e-20f : 0.f;
        u32x4 gn[2][2], gd[2][2];
#pragma unroll
        for (int bj = 0; bj < 2; ++bj) { gn[0][bj] = *(const u32x4*)(GT + r0 * ldg + on + col0 + bj * HALF); gd[0][bj] = *(const u32x4*)(GT + r0 * ldg + od + col0 + bj * HALF); }
#pragma unroll
        for (int gi = 0; gi < 8; ++gi) {
            const int ai = gi >> 2, m = gi & 3;
            if (gi < 7) { const size_t row2 = r0 + ((gi + 1) >> 2) * HALF + ((gi + 1) & 3) * 16;
#pragma unroll
                for (int bj = 0; bj < 2; ++bj) { gn[(gi + 1) & 1][bj] = *(const u32x4*)(GT + row2 * ldg + on + col0 + bj * HALF); gd[(gi + 1) & 1][bj] = *(const u32x4*)(GT + row2 * ldg + od + col0 + bj * HALF); } }
            asm volatile("" ::: "memory");
#pragma unroll
            for (int bj = 0; bj < 2; ++bj) {
                f32x4 n0, n1, d0, d1; unpack(gn[gi & 1][bj], n0, n1); unpack(gd[gi & 1][bj], d0, d1);
#pragma unroll
                for (int j = 0; j < 4; ++j) {
                    acc[ai][bj][m][0][j] *= fmaxf(n0[j], nfloor) * __builtin_amdgcn_rcpf(fmaxf(d0[j], 1e-20f));
                    acc[ai][bj][m][1][j] *= fmaxf(n1[j], nfloor) * __builtin_amdgcn_rcpf(fmaxf(d1[j], 1e-20f)); }
            }
            asm volatile("" ::: "memory");
        }
    }
    __device__ __forceinline__ void operator()(const f32x4 (&acc)[2][2][4][2], const Unit& u, int wr, int wc, int fr, int fq) const {
        const int col0 = u.pn * BM + wc * 32 + 8 * fq;
        const size_t r0 = (size_t)(u.pm * BM + wr * 64 + fr);
        u32x4 gw[2][2];
#pragma unroll
        for (int bj = 0; bj < 2; ++bj) gw[0][bj] = *(const u32x4*)(GT + r0 * ldg + 4096 + col0 + bj * HALF);
#pragma unroll
        for (int gi = 0; gi < 8; ++gi) {
            const int ai = gi >> 2, m = gi & 3; const size_t row = r0 + ai * HALF + m * 16;
            if (gi < 7) { const size_t row2 = r0 + ((gi + 1) >> 2) * HALF + ((gi + 1) & 3) * 16;
#pragma unroll
                for (int bj = 0; bj < 2; ++bj) gw[(gi + 1) & 1][bj] = *(const u32x4*)(GT + row2 * ldg + 4096 + col0 + bj * HALF); }
            asm volatile("" ::: "memory");
#pragma unroll
            for (int bj = 0; bj < 2; ++bj) {
                f32x4 g0, g1; unpack(gw[gi & 1][bj], g0, g1);
                f32x4 v0, v1;
#pragma unroll
                for (int j = 0; j < 4; ++j) { v0[j] = acc[ai][bj][m][0][j] * fmaxf(g0[j], 1e-20f); v1[j] = acc[ai][bj][m][1][j] * fmaxf(g1[j], 1e-20f); }
                u32x4 w; w.x = cvt_pk_bf16(v0[0], v0[1]); w.y = cvt_pk_bf16(v0[2], v0[3]); w.z = cvt_pk_bf16(v1[0], v1[1]); w.w = cvt_pk_bf16(v1[2], v1[3]);
                *(u32x4*)(O + row * 2048 + col0 + bj * HALF) = w;
            }
            asm volatile("" ::: "memory");
        }
    }
};
template <int MODE> struct EpiLora {
    static constexpr bool PERM = true, AFTER_DRAIN = false;
    float* WD; bf16_t* OB; const float* bias; size_t dstride;
    __device__ __forceinline__ void operator()(const f32x4 (&acc)[2][2][4][2], const Unit& u, int wr, int wc, int fr, int fq) const {
        const int colg = u.pn * BM + wc * 32 + 8 * fq;
        f32x4 bv[2][2];
#pragma unroll
        for (int bj = 0; bj < 2; ++bj) { if (MODE != 2) { bv[bj][0] = *(const f32x4*)(bias + colg + bj * HALF); bv[bj][1] = *(const f32x4*)(bias + colg + bj * HALF + 4); } else { bv[bj][0] = (f32x4){0.f, 0.f, 0.f, 0.f}; bv[bj][1] = bv[bj][0]; } }
        EPI_ROWS_BEGIN
#pragma unroll
            for (int bj = 0; bj < 2; ++bj) { const int cg = colg + bj * HALF; const int dir = (MODE == 2) ? 0 : (cg >> 10); const int c = (MODE == 2) ? cg : (cg & 1023);
                f32x4 v0 = acc[ai][bj][m][0], v1 = acc[ai][bj][m][1];
                if (MODE != 2) { v0 += bv[bj][0]; v1 += bv[bj][1]; }
                if (MODE == 0) {
#pragma unroll
                    for (int j = 0; j < 4; ++j) { v0[j] = -__expf(-fsoftplus(-v0[j]) - 0.5f); v1[j] = -__expf(-fsoftplus(-v1[j]) - 0.5f); }
                    float* p = WD + (size_t)dir * dstride + (size_t)row * 1024 + c; *(f32x4*)p = v0; *(f32x4*)(p + 4) = v1;
                } else {
                    if (MODE == 1) {
#pragma unroll
                        for (int j = 0; j < 4; ++j) { v0[j] = fsigmoid(v0[j]); v1[j] = fsigmoid(v1[j]); } }
                    u32x4 w; w.x = cvt_pk_bf16(v0[0], v0[1]); w.y = cvt_pk_bf16(v0[2], v0[3]); w.z = cvt_pk_bf16(v1[0], v1[1]); w.w = cvt_pk_bf16(v1[2], v1[3]);
                    *(u32x4*)(OB + (size_t)dir * dstride + (size_t)row * 1024 + c) = w;
                }
            }
            asm volatile("" ::: "memory");
        EPI_ROWS_END
    }
};

template <class E, class = void> struct mid_hook { static constexpr bool value = false; };
template <class E> struct mid_hook<E, decltype((void)E::MID)> { static constexpr bool value = E::MID; };
template <class Epi, class Sched, bool ALIGN_EPI = false, bool SP2 = false>
__device__ __forceinline__ void gemm_phase(PG8_LAS unsigned char* lds, const Gemm g, const Sched& S, const Epi& E, int tid_in) {
    int tid_ = tid_in; asm volatile("" : "+v"(tid_));
    const int tid = tid_, wid = __builtin_amdgcn_readfirstlane(tid >> 6), lane = tid & 63, wr = wid >> 2, wc = wid & 3, fr = lane & 15, fq = lane >> 4;
    int K_ = g.K, lda_ = g.lda, ldb_ = g.ldb; asm volatile("" : "+s"(K_), "+s"(lda_), "+s"(ldb_));
    const int K = K_, nt = K / BK, lda = lda_, ldb = ldb_;
    int jt_ = g.jt, jb_ = g.jb; asm volatile("" : "+s"(jt_), "+s"(jb_));
    const int jt = jt_; const size_t jb = (size_t)jb_;
    unsigned voffA[2], voffB[2];
#pragma unroll
    for (int i = 0; i < 2; ++i) { int R, C; stage_rc(tid * 16 + i * 8192, R, C); const int Rb = Epi::PERM ? ((R & ~31) + perm32(R & 31)) : R;
        voffA[i] = (unsigned)(R * lda + C) * 2u; voffB[i] = (unsigned)(Rb * ldb + C) * 2u; }
    const size_t kstep = (size_t)(BK * 2);
    const size_t hsA = (size_t)HALF * lda * 2, hsB = (size_t)HALF * ldb * 2;
    const size_t tsA = 2 * hsA, tsB = 2 * hsB;
    const unsigned ldsw = (unsigned)wid * 1024u;
    const int aoff = lds_byte(wr * 64 + fr, fq * 8), boff = lds_byte(wc * 32 + fr, fq * 8);
#define PG8_SA(b, h) (((b) * 2 + (h)) * HTB)
#define PG8_SB(b, h) ((4 + (b) * 2 + (h)) * HTB)
#define PG8_STAGE(bufoff, gbase, voff) do { _Pragma("unroll") for (int _i = 0; _i < 2; ++_i) \
        __builtin_amdgcn_global_load_lds((const unsigned*)((const char*)(gbase) + (voff)[_i]), (PG8_LAS unsigned*)(lds + (bufoff) + ldsw + _i * 8192), 16, 0, 0); } while (0)
#define PG8_LDA(dst, b, h) do { _Pragma("unroll") for (int m = 0; m < 4; ++m) _Pragma("unroll") for (int k = 0; k < 2; ++k) dst[m][k] = *(const PG8_LAS bf16x8*)(lds + PG8_SA(b, h) + aoff + m * 2048 + k * 1024); } while (0)
#define PG8_LDB(dst, b, h) do { _Pragma("unroll") for (int n = 0; n < 2; ++n) _Pragma("unroll") for (int k = 0; k < 2; ++k) dst[n][k] = *(const PG8_LAS bf16x8*)(lds + PG8_SB(b, h) + boff + n * 2048 + k * 1024); } while (0)
#define PG8_MMA(ai, bj, At, Bt) do { __builtin_amdgcn_s_setprio(1); _Pragma("unroll") for (int m = 0; m < 4; ++m) _Pragma("unroll") for (int n = 0; n < 2; ++n) _Pragma("unroll") for (int k = 0; k < 2; ++k) \
        acc[ai][bj][m][n] = __builtin_amdgcn_mfma_f32_16x16x32_bf16(Bt[n][k], At[m][k], acc[ai][bj][m][n], 0, 0, 0); __builtin_amdgcn_s_setprio(0); } while (0)
#define PG8_WAIT_V(n) asm volatile("s_waitcnt vmcnt(" #n ")" ::: "memory")
#define PG8_WAIT_L(n) asm volatile("s_waitcnt lgkmcnt(" #n ")" ::: "memory")
#define PG8_BAR __builtin_amdgcn_s_barrier()
#define PG8_SCHED __builtin_amdgcn_sched_barrier(0)
    Unit cur, nxt; int ui = 0;
    if (!S.next(0, cur)) return;
    f32x4 acc[2][2][4][2];
#pragma unroll
    for (int a = 0; a < 2; ++a)
#pragma unroll
        for (int b = 0; b < 2; ++b)
#pragma unroll
            for (int m = 0; m < 4; ++m)
#pragma unroll
                for (int n = 0; n < 2; ++n) acc[a][b][m][n] = (f32x4){0.f, 0.f, 0.f, 0.f};
    bf16x8 At[4][2], B0[2][2], B1[2][2];
    const char* cA = (const char*)g.A + (size_t)cur.pm * tsA + (size_t)cur.kq * g.kqb; const char* cB = (const char*)g.Bt + (size_t)cur.pn * tsB + (size_t)cur.kq * g.kqb;
    S.a_ready(cur);
    if constexpr (SP2) {
        PG8_STAGE(PG8_SB(0, 0), cB, voffB); PG8_STAGE(PG8_SB(0, 1), cB + hsB, voffB); PG8_STAGE(PG8_SA(0, 0), cA, voffA); PG8_STAGE(PG8_SA(0, 1), cA + hsA, voffA);
        if (wr == 1) PG8_BAR;
        PG8_WAIT_V(2); PG8_BAR;
        PG8_STAGE(PG8_SB(1, 0), cB + kstep, voffB); PG8_STAGE(PG8_SA(1, 0), cA + kstep, voffA); PG8_STAGE(PG8_SB(1, 1), cB + hsB + kstep, voffB);
        PG8_WAIT_V(6); PG8_BAR;
    } else {
        PG8_STAGE(PG8_SB(0, 0), cB, voffB); PG8_STAGE(PG8_SA(0, 0), cA, voffA); PG8_STAGE(PG8_SB(0, 1), cB + hsB, voffB); PG8_STAGE(PG8_SA(0, 1), cA + hsA, voffA);
        if (wr == 1) PG8_BAR;
        PG8_WAIT_V(4); PG8_BAR;
        PG8_STAGE(PG8_SB(1, 0), cB + kstep, voffB); PG8_STAGE(PG8_SA(1, 0), cA + kstep, voffA); PG8_STAGE(PG8_SB(1, 1), cB + hsB + kstep, voffB);
        PG8_WAIT_V(6); PG8_BAR;
    }
    for (;;) {
        const bool has_next = S.next(ui + 1, nxt);
        const char* nA = has_next ? (const char*)g.A + (size_t)nxt.pm * tsA + (size_t)nxt.kq * g.kqb : cA; const char* nB = has_next ? (const char*)g.Bt + (size_t)nxt.pn * tsB + (size_t)nxt.kq * g.kqb : cB;
        for (int t = 0; t < nt; t += 2) {
            const bool last = (t == nt - 2);
            if constexpr (mid_hook<Epi>::value) { if (t == Epi::H1 || t == Epi::H2) E.mid(acc, cur, wr, wc, fr, fq, t == Epi::H2); }
            const char* a1 = cA + (size_t)(t + 1) * kstep + (t >= jt ? jb : 0);
            const char* a2 = last ? nA : cA + (size_t)(t + 2) * kstep + (t + 2 >= jt ? jb : 0); const char* b2 = last ? nB : cB + (size_t)(t + 2) * kstep;
            const char* a3 = a2 + kstep; const char* b3 = b2 + kstep;
            if (last && has_next) S.a_ready(nxt);
            if constexpr (SP2) {
            PG8_LDB(B0, 0, 0); PG8_LDB(B1, 0, 1); PG8_SCHED; PG8_LDA(At, 0, 0); PG8_STAGE(PG8_SA(1, 1), a1 + hsA, voffA);
            PG8_WAIT_V(8); PG8_WAIT_L(0); PG8_BAR; PG8_MMA(0, 0, At, B0); PG8_MMA(0, 1, At, B1); PG8_BAR; PG8_SCHED;
            PG8_LDA(At, 0, 1); PG8_STAGE(PG8_SB(0, 0), b2, voffB); PG8_STAGE(PG8_SB(0, 1), b2 + hsB, voffB); PG8_STAGE(PG8_SA(0, 0), a2, voffA);
            PG8_WAIT_V(8); PG8_WAIT_L(0); PG8_BAR; PG8_MMA(1, 0, At, B0); PG8_MMA(1, 1, At, B1); PG8_BAR; PG8_SCHED;
            PG8_LDB(B0, 1, 0); PG8_LDB(B1, 1, 1); PG8_SCHED; PG8_LDA(At, 1, 0); PG8_STAGE(PG8_SA(0, 1), a2 + hsA, voffA);
            PG8_WAIT_V(8); PG8_WAIT_L(0); PG8_BAR; PG8_MMA(0, 0, At, B0); PG8_MMA(0, 1, At, B1); PG8_BAR; PG8_SCHED;
            PG8_LDA(At, 1, 1); PG8_STAGE(PG8_SB(1, 0), b3, voffB); PG8_STAGE(PG8_SB(1, 1), b3 + hsB, voffB); PG8_STAGE(PG8_SA(1, 0), a3, voffA);
            PG8_WAIT_V(8); PG8_WAIT_L(0); PG8_BAR; PG8_MMA(1, 0, At, B0); PG8_MMA(1, 1, At, B1); PG8_BAR; PG8_SCHED;
            } else {
            PG8_LDB(B0, 0, 0); PG8_SCHED; PG8_LDA(At, 0, 0); PG8_STAGE(PG8_SA(1, 1), a1 + hsA, voffA);
            PG8_WAIT_L(8); PG8_BAR; PG8_WAIT_L(0); PG8_MMA(0, 0, At, B0); PG8_BAR; PG8_SCHED;
            PG8_LDB(B1, 0, 1); PG8_STAGE(PG8_SB(0, 0), b2, voffB);
            PG8_BAR; PG8_WAIT_L(0); PG8_MMA(0, 1, At, B1); PG8_BAR;
            PG8_LDA(At, 0, 1); PG8_STAGE(PG8_SA(0, 0), a2, voffA);
            PG8_BAR; PG8_WAIT_L(0); PG8_MMA(1, 0, At, B0); PG8_BAR; PG8_SCHED;
            PG8_STAGE(PG8_SB(0, 1), b2 + hsB, voffB);
            PG8_WAIT_V(6); PG8_BAR; PG8_MMA(1, 1, At, B1); PG8_BAR;
            PG8_LDB(B0, 1, 0); PG8_SCHED; PG8_LDA(At, 1, 0); PG8_STAGE(PG8_SA(0, 1), a2 + hsA, voffA);
            PG8_WAIT_L(8); PG8_BAR; PG8_WAIT_L(0); PG8_MMA(0, 0, At, B0); PG8_BAR; PG8_SCHED;
            PG8_LDB(B1, 1, 1); PG8_STAGE(PG8_SB(1, 0), b3, voffB);
            PG8_BAR; PG8_WAIT_L(0); PG8_MMA(0, 1, At, B1); PG8_BAR;
            PG8_LDA(At, 1, 1); PG8_STAGE(PG8_SA(1, 0), a3, voffA);
            PG8_BAR; PG8_WAIT_L(0); PG8_MMA(1, 0, At, B0); PG8_BAR; PG8_SCHED;
            PG8_STAGE(PG8_SB(1, 1), b3 + hsB, voffB);
            PG8_WAIT_V(6); PG8_BAR; PG8_MMA(1, 1, At, B1); PG8_BAR;
            }
        }
        if constexpr (ALIGN_EPI) { if (wr == 0) PG8_BAR; }
        if constexpr (!Epi::AFTER_DRAIN) { E(acc, cur, wr, wc, fr, fq); S.done(cur); }
        if (!has_next) break;
#pragma unroll
        for (int a = 0; a < 2; ++a)
#pragma unroll
            for (int b = 0; b < 2; ++b)
#pragma unroll
                for (int m = 0; m < 4; ++m)
#pragma unroll
                    for (int n = 0; n < 2; ++n) acc[a][b][m][n] = (f32x4){0.f, 0.f, 0.f, 0.f};
        cur = nxt; cA = nA; cB = nB; ++ui;
        if constexpr (ALIGN_EPI) { if (wr == 1) PG8_BAR; }
    }
    PG8_WAIT_V(0);
    if constexpr (!ALIGN_EPI) { if (wr == 0) PG8_BAR; }
    PG8_BAR;
    if constexpr (Epi::AFTER_DRAIN) { E.fused(acc, cur, wr, wc, fr, fq, lds, wid, lane); S.done(cur); }
#undef PG8_SA
#undef PG8_SB
#undef PG8_STAGE
#undef PG8_LDA
#undef PG8_LDB
#undef PG8_MMA
#undef PG8_WAIT_V
#undef PG8_WAIT_L
#undef PG8_BAR
#undef PG8_SCHED
}
}

#undef EPI_ROWS_BEGIN
#undef EPI_ROWS_END

constexpr int D = 2048, NB = 8, SEQ = 2048, CL = 256, ML = NB * SEQ, MC = NB * CL, MT = ML + MC;
constexpr int FF = 5632, NMOD = 9, DEPTH = 2;
constexpr int NIN_SRC = 17568;
constexpr int ZA_LD = 4608;
constexpr int OC_RW = 1536, OC_GL = 2560;
constexpr int ZA_W = 1536, ZR_W = 3840, ZG_W = 6144, GT_W = 6144, NMIX = ZA_W + ZR_W + ZG_W  , NIN = NMIX + GT_W  ;
constexpr int RW_COLS = 3712, LA_W = 768;
constexpr float LN_EPS = 1e-5f, ALPHA = 1.41421356237f;
static_assert(ALPHA == pg8::RES_ALPHA, "residual scale");
constexpr int NWAVES = 8, NTHR = 512;

constexpr size_t MiB = 1u << 20;
constexpr size_t WS_CTL = 0, CTL_ZERO_BYTES = 1 * MiB;
constexpr size_t WS_MODS = 1 * MiB;
constexpr size_t WS_STATS = 3 * MiB;
constexpr size_t WS_XC = 4 * MiB;
constexpr size_t WS_HB = 20 * MiB;
constexpr size_t WS_WM = 92 * MiB;
constexpr size_t WM_IN = 0, WM_BA = 69 * MiB, WM_BR = 73 * MiB, WM_BG = 77 * MiB, WM_OUT = 85 * MiB, WM_LW = 93 * MiB, WM_LA = 94 * MiB, WM_LG = 95 * MiB;
constexpr size_t WS_R = 188 * MiB;
constexpr size_t R_WGU = 0, R_WDN = 44 * MiB, R_H = 66 * MiB;
constexpr size_t R_ZA = 0;
constexpr size_t R_ZR = 162 * MiB;
constexpr size_t R_AA = 297 * MiB;
constexpr size_t R_Y = 369 * MiB;
constexpr size_t R_G = 513 * MiB;
constexpr size_t R_ZG = 549 * MiB;
constexpr size_t R_YG = 765 * MiB;
constexpr size_t R_QR = 909 * MiB;
constexpr size_t R_KR = 941 * MiB;
constexpr size_t R_LA = 949 * MiB;
constexpr size_t R_WDEC = 976 * MiB;
constexpr size_t R_GL = 1120 * MiB;
constexpr size_t R_GT = R_QR;
constexpr size_t R_MG = R_Y;
constexpr size_t R_PART = 600 * MiB;
constexpr size_t R_BS = 1192 * MiB;
constexpr size_t R_END = 1195 * MiB;
constexpr size_t WS_END = WS_R + R_END;
static_assert(R_GT + (size_t)MT * GT_W * 2 <= R_END, "GT overlay");
static_assert(WS_END <= (size_t)1408 * MiB, "workspace budget");
static_assert(R_H + (size_t)MT * FF * 2 <= R_END, "H fits");

#ifndef MK_EARLY_WB
#define MK_EARLY_WB 0
#endif
#define XB_TMO      128
#define XB_XCNT(j)  (256  + 64 * (j))
#define XB_XSUB(j)  (1280 + 64 * (j))
#define XB_XGEN(j)  (2304 + 64 * (j))
#define XB_TOP      3328
#define XB_TOPGEN   3392
#define XCD_BAR_WORDS 3456
#define XB_SPIN_CAP (1u << 18)
__device__ __forceinline__ unsigned xb_ld(unsigned* p)              { return __hip_atomic_load(p, __ATOMIC_RELAXED, __HIP_MEMORY_SCOPE_AGENT); }
__device__ __forceinline__ unsigned xb_add(unsigned* p, unsigned v) { return __hip_atomic_fetch_add(p, v, __ATOMIC_RELAXED, __HIP_MEMORY_SCOPE_AGENT); }
__device__ __forceinline__ unsigned xb_xcc_id() { return (unsigned)__builtin_amdgcn_s_getreg((3 << 11) | 20) & 0xFu; }
#define XB_SPIN(cond, bar) do { unsigned _sp = 0; while (cond) { __builtin_amdgcn_s_sleep(1); \
    if ((++_sp & 255u) == 0u) { if (xb_ld(&(bar)[XB_TMO])) break; if (_sp > XB_SPIN_CAP) { atomicAdd(&(bar)[XB_TMO], 1u); break; } } } } while (0)
struct XcdBarrier { unsigned* bar; unsigned x; volatile LAS unsigned* st; };
__device__ __forceinline__ XcdBarrier xcd_barrier_post(unsigned* bar, volatile LAS unsigned* st, int tid) {
    XcdBarrier b; b.bar = bar; b.x = xb_xcc_id(); b.st = st;
    if (tid == 0) (void)xb_add(&bar[XB_XCNT(b.x)], 1u);
    return b;
}
__device__ __forceinline__ void xcd_barrier_complete(unsigned* bar, unsigned x, unsigned& nloc, unsigned& nx) {
    const unsigned G = gridDim.x * gridDim.y * gridDim.z;
    unsigned sum, cnt, mine, sp = 0u;
    for (;;) {
        sum = 0u; cnt = 0u; mine = 0u;
#pragma unroll
        for (unsigned j = 0; j < 16; ++j) { const unsigned c = xb_ld(&bar[XB_XCNT(j)]); sum += c; cnt += (c > 0u) ? 1u : 0u; mine = (j == x) ? c : mine; }
        if (sum == G) break;
        __builtin_amdgcn_s_sleep(1);
        if ((++sp & 255u) == 0u) { if (xb_ld(&bar[XB_TMO])) break; if (sp > XB_SPIN_CAP) { atomicAdd(&bar[XB_TMO], 1u); break; } }
    }
    nloc = mine > 0u ? mine : 1u; nx = cnt > 0u ? cnt : 1u;
}
__device__ __forceinline__ void xcd_barrier(const XcdBarrier& b, int tid) {
    asm volatile("s_waitcnt vmcnt(0)" ::: "memory");
    __syncthreads();
    if (tid == 0) {
        unsigned* bar = b.bar; unsigned bx = b.x;
        asm volatile("" : "+s"(bar), "+s"(bx));
        __builtin_amdgcn_s_waitcnt(0);
        unsigned nloc = b.st[0], nx = b.st[1];
        if (nloc == 0u) { xcd_barrier_complete(bar, bx, nloc, nx); b.st[0] = nloc; b.st[1] = nx; }
#if MK_EARLY_WB
        __builtin_amdgcn_fence(__ATOMIC_RELEASE, "agent");
        asm volatile("s_waitcnt vmcnt(0)" ::: "memory");
#endif
        const unsigned old = xb_add(&bar[XB_XSUB(bx)], 1u);
        const unsigned gen = old / nloc;
        if (old + 1u == (gen + 1u) * nloc) {
            __builtin_amdgcn_fence(__ATOMIC_RELEASE, "agent");
            asm volatile("s_waitcnt vmcnt(0)" ::: "memory");
            const unsigned og = xb_add(&bar[XB_TOP], 1u);
            const unsigned tg = og / nx;
            if (og + 1u == (tg + 1u) * nx) xb_add(&bar[XB_TOPGEN], 1u);
            else XB_SPIN(xb_ld(&bar[XB_TOPGEN]) == tg, bar);
            __builtin_amdgcn_fence(__ATOMIC_ACQUIRE, "agent");
            xb_add(&bar[XB_XGEN(bx)], 1u);
            asm volatile("s_waitcnt vmcnt(0)" ::: "memory");
        } else {
            XB_SPIN(xb_ld(&bar[XB_XGEN(bx)]) == gen, bar);
            __builtin_amdgcn_fence(__ATOMIC_ACQUIRE, "agent");
            asm volatile("s_waitcnt vmcnt(0)" ::: "memory");
        }
    }
    __syncthreads();
}

constexpr int RING_BYTES = 143360;
constexpr int LDSCTL_OFF = RING_BYTES, MISC_OFF = LDSCTL_OFF + 320;
constexpr int LDS_BYTES = 147456;

struct Args { const float* in[30]; float* out; unsigned char* ws; int ph_lo, ph_hi; };
#define CAS __attribute__((address_space(4)))
typedef const CAS Args& ArgsRef;

struct Frame {
    LAS unsigned char* lds;
    int tid, lane, wave, G, bid;
    const float* const* in;
    GAS float* out; GAS unsigned char* ws;
};
#define AIN(i) ((const float*)(const GAS float*)A.in[i])
#define WSP(T, off) ((T*)(F.ws + (off)))
#define RGN(T, off) ((T*)(F.ws + WS_R + (off)))
__device__ __forceinline__ float* xrow(const Frame& F, int m) { return m < ML ? (float*)(F.out + (size_t)m * D) : WSP(float, WS_XC) + (size_t)(m - ML) * D; }

__device__ __forceinline__ void tr_item(const float* W, int N, bf16* WT, int ldk, int k0, int scol0, int drow0, LAS float* scr, int lane) {
    if (scol0 >= 0) {
#pragma unroll 8
        for (int i = 0; i < 32; ++i) { const int kk = 2 * i + (lane >> 5); scr[kk * 33 + (lane & 31)] = W[(size_t)(k0 + kk) * N + scol0 + (lane & 31)]; }
    } else {
#pragma unroll 8
        for (int i = 0; i < 32; ++i) { const int kk = 2 * i + (lane >> 5); scr[kk * 33 + (lane & 31)] = 0.f; }
    }
    asm volatile("s_waitcnt vmcnt(0) lgkmcnt(0)" ::: "memory");
    const int c = lane & 7;
#pragma unroll
    for (int j = 0; j < 4; ++j) { const int n = (lane >> 3) + 8 * j; const LAS float* s = scr + (8 * c) * 33 + n;
        v4u o; o.x = pk2(s[0 * 33], s[1 * 33]); o.y = pk2(s[2 * 33], s[3 * 33]); o.z = pk2(s[4 * 33], s[5 * 33]); o.w = pk2(s[6 * 33], s[7 * 33]);
        *(v4u*)(WT + (size_t)(drow0 + n) * ldk + k0 + 8 * c) = o; }
    asm volatile("s_waitcnt lgkmcnt(0)" ::: "memory");
}
struct MapIdent { __device__ __forceinline__ int operator()(int drow) const { return drow; } };
struct MapGU { __device__ __forceinline__ int operator()(int drow) const { const int pn = drow >> 8, bj = (drow >> 7) & 1, i = drow & 127; return bj * FF + pn * 128 + i; } };
struct MapWin { __device__ __forceinline__ int operator()(int drow) const {
    if (drow < 5248) return drow;
    if (drow < 5280) return 11392 + (drow - 5248);
    if (drow < 5376) return -1;
    if (drow < 11520) return 5248 + (drow - 5376);
    return 11424 + (drow - 11520);
} };
template <class MAP> __device__ __forceinline__ void conv_matrix(const Frame& F, const float* W, int K, int N, bf16* WT, int NT, const MAP& mp, int& item0, int gw, int NGW, int ldk = 0) {
    LAS float* scr = (LAS float*)(F.lds + F.wave * 16384);
    const int nblk = NT / 32, nitems = (K / 64) * nblk;
    int first = ((gw - item0) % NGW + NGW) % NGW;
    for (int it = first; it < nitems; it += NGW) { const int kb = it / nblk, nb = it % nblk; tr_item(W, N, WT, ldk ? ldk : K, kb * 64, mp(nb * 32), nb * 32, scr, F.lane); }
    item0 += nitems;
}

__device__ __forceinline__ int seq_row(int b, int dir, int p, int& idx, int& len) {
    if (p < CL) { idx = dir ? (CL - 1 - p) : p; len = CL; return ML + b * CL + idx; }
    const int q = p - CL; idx = dir ? (SEQ - 1 - q) : q; len = SEQ; return b * SEQ + idx;
}

__device__ __forceinline__ void phase_init(const Frame& F, ArgsRef A) {
    const float* c = AIN(1); const float* cctx = AIN(3); const float* ada_w = AIN(4); const float* ada_b = AIN(5);
    float* mods = WSP(float, WS_MODS);
    LAS float* sc = (LAS float*)F.lds;
    LAS float* red = sc + 9 * 2048;
    for (int i = F.tid; i < 9 * 2048; i += NTHR) { const int bs = i >> 11, k = i & 2047; const float v = bs < 8 ? c[bs * 2048 + k] : cctx[k]; sc[i] = fsilu(v); }
    __syncthreads();
    for (int item = F.bid; item < 2 * 144; item += F.G) {
        const int l = item / 144, cb = item % 144, col = cb * 128 + 2 * F.lane;
        float a0[9], a1[9];
#pragma unroll
        for (int bs = 0; bs < 9; ++bs) { a0[bs] = 0.f; a1[bs] = 0.f; }
        const float* wp = ada_w + ((size_t)l * 2048 + F.wave * 256) * 18432 + col;
        const LAS float* sp = sc + F.wave * 256;
#pragma unroll 8
        for (int k = 0; k < 256; ++k) { const f32x2 w = *(const f32x2*)(wp + (size_t)k * 18432);
#pragma unroll
            for (int bs = 0; bs < 9; ++bs) { const float s = sp[bs * 2048 + k]; a0[bs] += s * w.x; a1[bs] += s * w.y; } }
#pragma unroll
        for (int bs = 0; bs < 9; ++bs) { red[(F.wave * 9 + bs) * 128 + 2 * F.lane] = a0[bs]; red[(F.wave * 9 + bs) * 128 + 2 * F.lane + 1] = a1[bs]; }
        __syncthreads();
        for (int o = F.tid; o < 9 * 128; o += NTHR) { const int bs = o >> 7, cc = o & 127; float s = ada_b[l * 18432 + cb * 128 + cc];
#pragma unroll
            for (int w = 0; w < 8; ++w) s += red[(w * 9 + bs) * 128 + cc];
            mods[((size_t)l * 9 + bs) * 18432 + cb * 128 + cc] = s; }
        __syncthreads();
    }
}

template <bool POST, bool MODH, bool WX = false>
__device__ __forceinline__ void phase_ln(const Frame& F, int nrows, const float* g, const float* b, const float* mods_l, int kshift, int kscale, const float* part = nullptr, const float* pmod = nullptr, float pcoef = 0.f, const float* src_l = nullptr, const float* src_c = nullptr) {
    const int gw = F.bid * NWAVES + F.wave, NGW = F.G * NWAVES;
    bf16* HB = WSP(bf16, WS_HB);
    for (int m = gw; m < nrows; m += NGW) {
        float* xr = xrow(F, m);
        const float* xs = (m < ML) ? (src_l ? src_l + (size_t)m * D : xr) : (src_c ? src_c + (size_t)(m - ML) * D : xr);
        f32x4 v[8];
#pragma unroll
        for (int j = 0; j < 8; ++j) v[j] = ((const f32x4*)xs)[F.lane + 64 * j];
        if (POST && part != nullptr && m >= ML) {
            const f32x4* pp = (const f32x4*)(part + (size_t)(m - ML) * D);
#pragma unroll
            for (int j = 0; j < 8; ++j) { const int o = F.lane + 64 * j; const f32x4 ps = (pp[o] + pp[o + (size_t)MC * D / 4]) + (pp[o + 2 * ((size_t)MC * D / 4)] + pp[o + 3 * ((size_t)MC * D / 4)]);
                v[j] = v[j] * ALPHA + ((const f32x4*)pmod)[o] * pcoef * ps; }
        }
        if (POST) {
            float s = 0.f;
#pragma unroll
            for (int j = 0; j < 8; ++j) s += (v[j].x + v[j].y) + (v[j].z + v[j].w);
            const float mean = wave_sum(s) * (1.f / D); float s2 = 0.f;
#pragma unroll
            for (int j = 0; j < 8; ++j) { v[j] = v[j] - mean; s2 += (v[j].x * v[j].x + v[j].y * v[j].y) + (v[j].z * v[j].z + v[j].w * v[j].w); }
            const float rstd = 1.f / sqrtf(wave_sum(s2) * (1.f / D) + LN_EPS);
#pragma unroll
            for (int j = 0; j < 8; ++j) { const f32x4 gg = ((const f32x4*)g)[F.lane + 64 * j], bb = ((const f32x4*)b)[F.lane + 64 * j]; v[j] = v[j] * rstd * gg + bb; if (WX || m >= ML) ((f32x4*)xr)[F.lane + 64 * j] = v[j]; }
            if (!WX && m < ML && F.lane == 0) *(v2f*)(WSP(float, WS_STATS) + 2 * m) = (v2f){mean, rstd};
        }
        if (MODH) {
            float s = 0.f;
#pragma unroll
            for (int j = 0; j < 8; ++j) s += (v[j].x + v[j].y) + (v[j].z + v[j].w);
            const float mean = wave_sum(s) * (1.f / D); float s2 = 0.f;
#pragma unroll
            for (int j = 0; j < 8; ++j) { v[j] = v[j] - mean; s2 += (v[j].x * v[j].x + v[j].y * v[j].y) + (v[j].z * v[j].z + v[j].w * v[j].w); }
            const float rstd = 1.f / sqrtf(wave_sum(s2) * (1.f / D) + LN_EPS);
            const int bsel = m < ML ? (m >> 11) : 8;
            const f32x4* shp = (const f32x4*)(mods_l + (size_t)bsel * 18432 + kshift * 2048);
            const f32x4* scp = (const f32x4*)(mods_l + (size_t)bsel * 18432 + kscale * 2048);
            v2u* hp = (v2u*)(HB + (size_t)m * D);
#pragma unroll
            for (int j = 0; j < 8; ++j) { const f32x4 sh = shp[F.lane + 64 * j], scl = scp[F.lane + 64 * j]; const f32x4 o = v[j] * rstd * (scl + 1.0f) + sh;
                v2u w; w.x = pk2(o.x, o.y); w.y = pk2(o.z, o.w); hp[F.lane + 64 * j] = w; }
        }
    }
}

__device__ __forceinline__ void phase_convert(const Frame& F, ArgsRef A, int l, int ffn_i, int which) {
    const int gw = F.bid * NWAVES + F.wave, NGW = F.G * NWAVES; int item0 = 0;
    if (which & 1) {
        conv_matrix(F, AIN(8) + ((size_t)l * 2 + ffn_i) * D * (2 * FF), D, 2 * FF, RGN(bf16, R_WGU), 2 * FF, MapGU(), item0, gw, NGW);
        conv_matrix(F, AIN(9) + ((size_t)l * 2 + ffn_i) * FF * D, FF, D, RGN(bf16, R_WDN), D, MapIdent(), item0, gw, NGW);
    }
    if (which & 2) {
        conv_matrix(F, AIN(10) + (size_t)l * D * NIN_SRC, D, NIN_SRC, WSP(bf16, WS_WM + WM_IN), NIN, MapWin(), item0, gw, NGW);
        conv_matrix(F, AIN(26) + (size_t)l * 1024 * D, 1024, D, WSP(bf16, WS_WM + WM_BA), D, MapIdent(), item0, gw, NGW, 4096);
        conv_matrix(F, AIN(27) + (size_t)l * 1024 * D, 1024, D, WSP(bf16, WS_WM + WM_BA) + 1024, D, MapIdent(), item0, gw, NGW, 4096);
        conv_matrix(F, AIN(28) + (size_t)l * D * D, D, D, WSP(bf16, WS_WM + WM_BA) + 2048, D, MapIdent(), item0, gw, NGW, 4096);
        conv_matrix(F, AIN(29) + (size_t)l * D * D, D, D, WSP(bf16, WS_WM + WM_OUT), D, MapIdent(), item0, gw, NGW);
        const float* w2 = AIN(14) + (size_t)l * 2 * 96 * 1024; const float* a2 = AIN(16) + (size_t)l * 2 * 96 * 1024; const float* g2 = AIN(17) + (size_t)l * 256 * 1024;
        bf16* LW = WSP(bf16, WS_WM + WM_LW); bf16* LAw = WSP(bf16, WS_WM + WM_LA); bf16* LG = WSP(bf16, WS_WM + WM_LG);
        for (int e = F.bid * NTHR + F.tid; e < 2048 * 256; e += F.G * NTHR) { const int n = e >> 8, k = e & 255, dir = n >> 10, cc = n & 1023;
            const int kk = k - dir * 96; const bool liv = kk >= 0 && kk < 96;
            LW[e] = liv ? (bf16)f2bf(w2[((size_t)dir * 96 + kk) * 1024 + cc]) : (bf16)0;
            LAw[e] = liv ? (bf16)f2bf(a2[((size_t)dir * 96 + kk) * 1024 + cc]) : (bf16)0;
            if (n < 1024) LG[e] = (bf16)f2bf(g2[(size_t)k * 1024 + n]); }
    }
    __syncthreads();
}

__device__ __forceinline__ float red16s(float v) { v += dppf<0xB1, 0xF>(v); v += dppf<0x4E, 0xF>(v); v += dppf<0x141, 0xF>(v); v += dppf<0x140, 0xF>(v); return v; }
__device__ __forceinline__ void phase_prep(const Frame& F, ArgsRef A, int l) {
    const int gw = F.bid * NWAVES + F.wave, NGW = F.G * NWAVES, lane = F.lane;
    const bf16* ZA = RGN(bf16, R_ZA); bf16* QR = RGN(bf16, R_QR); bf16* KR = RGN(bf16, R_KR);
    const bf16* ZR = RGN(bf16, R_ZR); bf16* LA = RGN(bf16, R_LA); unsigned* GL = RGN(unsigned, R_GL);
    {
        const int f2 = 2 * (lane & 15), axis = (lane >> 4) & 1, hs = lane >> 5;
        const float invf0 = exp2f(-(float)f2 * (13.287712379549449f / 32.0f)), invf1 = exp2f(-(float)(f2 + 1) * (13.287712379549449f / 32.0f));
        for (int m = gw; m < ML; m += NGW) {
            const int t = m & (SEQ - 1);
            const float pos = axis == 0 ? (float)(t >> 6) : (float)(t & 63);
            const float a0 = pos * invf0, a1 = pos * invf1; const float sn0 = __sinf(a0), cs0 = __cosf(a0), sn1 = __sinf(a1), cs1 = __cosf(a1);
            const bf16* zr = ZA + (size_t)m * ZA_LD + hs * 128 + axis * 64 + f2;
#pragma unroll
            for (int hp = 0; hp < 5; ++hp) {
                const unsigned w1 = *(const unsigned*)(zr + hp * 256), w2 = *(const unsigned*)(zr + hp * 256 + 32);
                const float x10 = bflo(w1), x11 = bfhi(w1), x20 = bflo(w2), x21 = bfhi(w2);
                const unsigned o1 = pk2(x10 * cs0 - x20 * sn0, x11 * cs1 - x21 * sn1), o2 = pk2(x20 * cs0 + x10 * sn0, x21 * cs1 + x11 * sn1);
                const int hh = 2 * hp + hs;
                bf16* dst = hh < 8 ? QR + (size_t)m * 1024 + hh * 128 + axis * 64 + f2 : KR + (size_t)m * 256 + (hh - 8) * 128 + axis * 64 + f2;
                *(unsigned*)dst = o1; *(unsigned*)(dst + 32) = o2;
            }
        }
    }
    {
        const float* cw = AIN(12) + (size_t)l * 3 * RW_COLS;
        float t0[6][2], t1[6][2], t2[6][2]; int scol[6];
#pragma unroll
        for (int it = 0; it < 6; ++it) { const int j = 2 * (lane + 64 * it), sec = j >> 8, jj = j & 255; const bool live = sec == 2 || jj < 192;
            scol[it] = live ? (sec == 0 ? 3072 : sec == 1 ? 3264 : 3456) + jj : -1;
#pragma unroll
            for (int e = 0; e < 2; ++e) { t0[it][e] = live ? cw[scol[it] + e] : 0.f; t1[it][e] = live ? cw[RW_COLS + scol[it] + e] : 0.f; t2[it][e] = live ? cw[2 * RW_COLS + scol[it] + e] : 0.f; } }
        for (int m = gw; m < MT; m += NGW) {
            int idx, len; if (m < ML) { idx = m & (SEQ - 1); len = SEQ; } else { idx = (m - ML) & (CL - 1); len = CL; }
            const float fl = idx > 0 ? 1.f : 0.f, fr = idx < len - 1 ? 1.f : 0.f;
            const bf16* z0 = ZR + (size_t)m * ZR_W; const bf16* zl = idx > 0 ? z0 - ZR_W : z0; const bf16* zrr = idx < len - 1 ? z0 + ZR_W : z0;
#pragma unroll
            for (int it = 0; it < 6; ++it) {
                unsigned o = 0u;
                if (scol[it] >= 0) {
                    const unsigned wc = *(const unsigned*)(z0 + scol[it]), wl = *(const unsigned*)(zl + scol[it]), wr = *(const unsigned*)(zrr + scol[it]);
                    float c0 = bflo(wc) * t1[it][0] + fl * bflo(wl) * t0[it][0] + fr * bflo(wr) * t2[it][0];
                    float c1 = bfhi(wc) * t1[it][1] + fl * bfhi(wl) * t0[it][1] + fr * bfhi(wr) * t2[it][1];
                    const int sec = it >> 1;
                    if (sec == 0) { c0 = ftanh(c0); c1 = ftanh(c1); } else if (sec == 2) { c0 = fsigmoid(c0); c1 = fsigmoid(c1); }
                    o = pk2(c0, c1);
                }
                *(unsigned*)(LA + (size_t)m * LA_W + 2 * (lane + 64 * it)) = o;
            }
        }
    }
    {
        __syncthreads();
        LAS unsigned short* TW = (LAS unsigned short*)F.lds;
        LAS float* TB = (LAS float*)(F.lds + 65536);
        const float* wa2 = AIN(23) + (size_t)l * 2 * 16 * 1024; const float* ba = AIN(24) + (size_t)l * 2 * 1024;
        for (int e = F.tid; e < 2 * 16 * 1024; e += NTHR) { const int dr = e >> 10, cc = e & 1023, dir = dr >> 4, r = dr & 15; TW[(dir * 1024 + cc) * 16 + r] = (unsigned short)f2bf(wa2[e]); }
        for (int e = F.tid; e < 2048; e += NTHR) TB[e] = ba[e];
        __syncthreads();
        const int l16 = lane & 15, g = lane >> 4;
        bf16* GLb = RGN(bf16, R_GL);
        const f32x4 zero4 = (f32x4){0.f, 0.f, 0.f, 0.f};
        for (int item = gw; item < (MT / 16) * 4; item += NGW) {
            const int rb = item >> 2, qq = item & 3, m = rb * 16 + l16;
            const bf16x8 af = *(const bf16x8*)(ZR + (size_t)m * ZR_W + 3712 + 8 * g);
            const int dir = qq >> 1;
            const bool live = (g >> 1) == dir;
            bf16* gp = GLb + ((size_t)dir * MT + m) * 1024 + ((512 * qq) & 1023) + 8 * g;
#pragma unroll 4
            for (int q = 0; q < 16; ++q) {
                const int ch0 = 512 * qq + 32 * q;
                const unsigned wa_ = (unsigned)((ch0 + 8 * (l16 >> 2) + (l16 & 3)) * 32 + (g & 1) * 16);
                bf16x8 w0 = *(const LAS bf16x8*)((LAS unsigned char*)TW + wa_), w1 = *(const LAS bf16x8*)((LAS unsigned char*)TW + wa_ + 4 * 32);
                if (!live) { w0 = (bf16x8){0, 0, 0, 0, 0, 0, 0, 0}; w1 = w0; }
                const f32x4 d0 = __builtin_amdgcn_mfma_f32_16x16x32_bf16(w0, af, zero4, 0, 0, 0), d1 = __builtin_amdgcn_mfma_f32_16x16x32_bf16(w1, af, zero4, 0, 0, 0);
                const f32x4 b0 = *(const LAS f32x4*)(TB + ch0 + 8 * g), b1 = *(const LAS f32x4*)(TB + ch0 + 8 * g + 4);
                float o[8];
#pragma unroll
                for (int r = 0; r < 4; ++r) { o[r] = -fsoftplus(-(d0[r] + b0[r])) * 0.0625f; o[4 + r] = -fsoftplus(-(d1[r] + b1[r])) * 0.0625f; }
                *(v4u*)(gp + 32 * q) = (v4u){pk2(o[0], o[1]), pk2(o[2], o[3]), pk2(o[4], o[5]), pk2(o[6], o[7])};
            }
        }
        __syncthreads();
    }
}

__device__ __forceinline__ unsigned opq(unsigned x) { asm volatile("" : "+v"(x)); return x; }
__device__ __forceinline__ bf16x8 pack8(const f32x4& a, const f32x4& b) {
    v4u w; w.x = pg8::cvt_pk_bf16(a[0], a[1]); w.y = pg8::cvt_pk_bf16(a[2], a[3]); w.z = pg8::cvt_pk_bf16(b[0], b[1]); w.w = pg8::cvt_pk_bf16(b[2], b[3]);
    return __builtin_bit_cast(bf16x8, w);
}
typedef short s16x4 __attribute__((ext_vector_type(4)));
__device__ __forceinline__ bf16x8 tr8(LAS unsigned char* L, unsigned a0, unsigned a1) {
    const s16x4 x = __builtin_amdgcn_ds_read_tr16_b64_v4i16((LAS s16x4*)(L + a0)), y = __builtin_amdgcn_ds_read_tr16_b64_v4i16((LAS s16x4*)(L + a1));
    return __builtin_shufflevector(x, y, 0, 1, 2, 3, 4, 5, 6, 7);
}
constexpr int RC_LD = 72;
constexpr int RC_QP = 0, RC_RT = 9216, RC_KD = 18432, RC_KA = 27648, RC_KDT = 36864, RC_KAT = 46080, RC_VT = 55296, RC_MKA = 64512, RC_MKD = 73728, RC_NKA = 82944, RC_NKD = 92160,
              RC_DG = 101376, RC_TB = 105472, RC_EB = 107520, RC_TQ = 107776, RC_BI = 109824, RC_END = 126208;
static_assert(RC_END <= RING_BYTES, "RWKV LDS map");
#define LD_(T, addr) (*(const LAS T*)(L + (addr)))
#define ST_(T, addr) (*(LAS T*)(L + (addr)))
__device__ __forceinline__ bf16x8 kperm(LAS unsigned char* L, unsigned addr) {
    const v2u a0 = LD_(v2u, addr), a1 = LD_(v2u, addr + 32); return __builtin_bit_cast(bf16x8, (v4u){a0.x, a0.y, a1.x, a1.y}); }
__device__ __forceinline__ void rwkv_chunk_item(const Frame& F, ArgsRef A, int l, int item, bool last) {
    const int b = item >> 5, h = (item >> 1) & 15, dir = item & 1, tid = F.tid, lane = F.lane, w = F.wave, sgn = dir ? -1 : 1, l16 = lane & 15, g = lane >> 4;
    LAS unsigned char* L = F.lds;
    const bf16* ZR = RGN(bf16, R_ZR); const float* WLD = RGN(float, R_WDEC) + (size_t)dir * MT * 1024; const bf16* AA = RGN(bf16, R_AA) + (size_t)dir * MT * 1024;
    bf16* Y = RGN(bf16, R_Y) + (size_t)dir * MT * 1024;
    const float* cw = AIN(12) + (size_t)l * 3 * RW_COLS;
    const int j0 = 4 * l16, ch = h * 64 + j0;
    const int tA = dir ? 2 : 0, tB = dir ? 0 : 2;
    const f32x4 kkw = *(const f32x4*)(AIN(18) + l * 1024 + ch), kaw = *(const f32x4*)(AIN(19) + l * 1024 + ch);
    const int cj = tid & 63, ct8 = tid >> 6;
    const unsigned a_row = opq((unsigned)(((8 * w + g) * RC_LD + j0) * 2));
    const unsigned a_tr = opq((unsigned)((((lane & 15) >> 2) * RC_LD + 4 * (lane & 3)) * 2));
    const unsigned a_f8 = opq((unsigned)((l16 * RC_LD + 8 * g) * 2));
    const unsigned a_f4 = opq((unsigned)((l16 * RC_LD + 4 * g) * 2));

    f32x4 S[4];
#pragma unroll
    for (int t = 0; t < 4; ++t) S[t] = (f32x4){0.f, 0.f, 0.f, 0.f};
    v2u zz[2][3][3], za[2]; float pl[8];
#define RC_ISSUE(chunk) do { int idx_, len_; const int c_ = (chunk); const int r0_ = seq_row(b, dir, c_ * 64, idx_, len_); \
        const int plo_ = c_ < 4 ? 0 : CL, phi_ = c_ < 4 ? CL : CL + SEQ; \
        _Pragma("unroll") for (int p = 0; p < 2; ++p) { const int t_ = 8 * w + 4 * p + g; \
            _Pragma("unroll") for (int x = 0; x < 3; ++x) { const int pp_ = c_ * 64 + t_ + x - 1; const bool ok_ = pp_ >= plo_ && pp_ < phi_; \
                const GAS bf16* zp_ = (const GAS bf16*)(ZR + (size_t)(ok_ ? r0_ + sgn * (t_ + x - 1) : r0_) * ZR_W + ch); asm volatile("" : "+v"(zp_)); \
                const v2u q0_ = *(const GAS v2u*)zp_, q1_ = *(const GAS v2u*)(zp_ + 1024), q2_ = *(const GAS v2u*)(zp_ + 2048); const v2u zero_ = (v2u){0u, 0u}; \
                zz[p][x][0] = ok_ ? q0_ : zero_; zz[p][x][1] = ok_ ? q1_ : zero_; zz[p][x][2] = ok_ ? q2_ : zero_; } \
            za[p] = *(const GAS v2u*)(const GAS bf16*)(AA + (size_t)(r0_ + sgn * t_) * 1024 + ch); } \
        { const GAS float* wp_ = (const GAS float*)(WLD + (size_t)(r0_ + sgn * 8 * ct8) * 1024 + h * 64 + cj); const long st_ = (long)sgn * 1024; \
          _Pragma("unroll") for (int q = 0; q < 8; ++q) { asm volatile("" : "+v"(wp_)); pl[q] = *wp_; wp_ += st_; } } } while (0)
    RC_ISSUE(0);
    for (int chunk = 0; chunk < 36; ++chunk) {
        int idx0, len0; const int r0 = seq_row(b, dir, chunk * 64, idx0, len0);
        const unsigned a_tqs = opq((unsigned)(RC_TQ + (ct8 * 64 + cj) * 4)), a_tqr = opq((unsigned)(RC_TQ + cj * 4)), a_bis = opq((unsigned)(RC_BI + (8 * ct8 * 64 + cj) * 4));
        { float s = 0.f;
#pragma unroll
          for (int q = 0; q < 8; ++q) s += pl[q];
          ST_(float, a_tqs) = s; }
        __syncthreads();
        { float o = 0.f, tot = 0.f;
#pragma unroll
          for (int q = 0; q < 8; ++q) { const float tq = LD_(float, a_tqr + q * 256); if (q < ct8) o += tq; tot += tq; }
          if (ct8 == 0) ST_(float, RC_EB + cj * 4) = __expf(tot);
#pragma unroll
          for (int q = 0; q < 8; ++q) { o += pl[q]; ST_(float, a_bis + q * 256) = o; } }
        __syncthreads();
        f32x4 tp[3][3];
#pragma unroll
        for (int kind = 0; kind < 3; ++kind) { const GAS float* cp = (const GAS float*)(cw + kind * 1024 + ch); asm volatile("" : "+v"(cp));
            tp[0][kind] = *(const GAS f32x4*)(cp + tA * RW_COLS); tp[1][kind] = *(const GAS f32x4*)(cp + RW_COLS); tp[2][kind] = *(const GAS f32x4*)(cp + tB * RW_COLS); }
        const unsigned a_bir = opq((unsigned)(RC_BI + ((8 * w + g) * 64 + j0) * 4));
#pragma unroll
        for (int p = 0; p < 2; ++p) {
            const int t = 8 * w + 4 * p + g;
            f32x4 rkv[3];
#pragma unroll
            for (int kind = 0; kind < 3; ++kind) {
                const v2u wa = zz[p][0][kind], wc = zz[p][1][kind], wb = zz[p][2][kind];
                const f32x4 xa = (f32x4){bflo(wa.x), bfhi(wa.x), bflo(wa.y), bfhi(wa.y)}, xc = (f32x4){bflo(wc.x), bfhi(wc.x), bflo(wc.y), bfhi(wc.y)}, xb = (f32x4){bflo(wb.x), bfhi(wb.x), bflo(wb.y), bfhi(wb.y)};
                rkv[kind] = xa * tp[0][kind] + xc * tp[1][kind] + xb * tp[2][kind]; }
            const f32x4 r = rkv[0], k = rkv[1], v = rkv[2];
            const f32x4 kr = k * kkw;
            const float n2 = red16s((kr.x * kr.x + kr.y * kr.y) + (kr.z * kr.z + kr.w * kr.w));
            const f32x4 kk = kr * __builtin_amdgcn_rsqf(fmaxf(n2, 1e-24f));
            const f32x4 a = (f32x4){bflo(za[p].x), bfhi(za[p].x), bflo(za[p].y), bfhi(za[p].y)};
            const f32x4 kd = k * ((a - 1.0f) * kaw + 1.0f), kka = kk * a;
            {
              const GAS float* rp = (const GAS float*)(AIN(20) + l * 1024 + ch); asm volatile("" : "+v"(rp)); const f32x4 rkp = *(const GAS f32x4*)rp;
              const f32x4 pb = r * kd * rkp; const float bsum = red16s((pb.x + pb.y) + (pb.z + pb.w));
              if (l16 == 0) RGN(float, R_BS)[((size_t)dir * MT + (size_t)(r0 + sgn * t)) * 16 + h] = bsum; }
            const f32x4 bi = LD_(f32x4, a_bir + p * 1024);
            f32x4 bx = (f32x4){0.f, 0.f, 0.f, 0.f}; if (t > 0) bx = LD_(f32x4, a_bir + p * 1024 - 256);
            f32x4 ex, ei, en;
#pragma unroll
            for (int c = 0; c < 4; ++c) { ex[c] = __expf(bx[c]); ei[c] = __expf(bi[c]); en[c] = __expf(-bi[c]); }
            const f32x4 qp = kk * ex * -1.0f, rt = r * ei, kdn = kd * en, kan = kka * en;
            const unsigned ar = a_row + p * (4 * RC_LD * 2);
            ST_(v2u, RC_QP + ar) = (v2u){pg8::cvt_pk_bf16(qp.x, qp.y), pg8::cvt_pk_bf16(qp.z, qp.w)};
            ST_(v2u, RC_RT + ar) = (v2u){pg8::cvt_pk_bf16(rt.x, rt.y), pg8::cvt_pk_bf16(rt.z, rt.w)};
            const unsigned kd01 = pg8::cvt_pk_bf16(kdn.x, kdn.y), kd23 = pg8::cvt_pk_bf16(kdn.z, kdn.w), ka01 = pg8::cvt_pk_bf16(kan.x, kan.y), ka23 = pg8::cvt_pk_bf16(kan.z, kan.w);
            const unsigned v01 = pg8::cvt_pk_bf16(v.x, v.y), v23 = pg8::cvt_pk_bf16(v.z, v.w);
            ST_(v2u, RC_KD + ar) = (v2u){kd01, kd23}; ST_(v2u, RC_KA + ar) = (v2u){ka01, ka23};
            ST_(v2u, RC_VT + ar) = (v2u){v01, v23};
            asm volatile("" ::: "memory");
        }
        __syncthreads();
        if (chunk + 1 < 36) RC_ISSUE(chunk + 1);
        const unsigned a_dgs = opq((unsigned)(RC_DG + (l16 * 16 + 4 * g) * 4));
#pragma unroll
        for (int tt2 = 0; tt2 < 2; ++tt2) {
            const int id = 2 * w + tt2, st = id >> 2, tt = id & 3;
            f32x4 mka = (f32x4){0.f, 0.f, 0.f, 0.f}, mkd = mka, nka = mka, nkd = mka;
            if (st <= tt) {
                const unsigned as_ = a_f8 + st * (16 * RC_LD * 2), at_ = a_f8 + tt * (16 * RC_LD * 2);
#pragma unroll
                for (int ks = 0; ks < 2; ++ks) {
                    const bf16x8 fka = LD_(bf16x8, RC_KA + as_ + 64 * ks), fkd = LD_(bf16x8, RC_KD + as_ + 64 * ks), fqp = LD_(bf16x8, RC_QP + at_ + 64 * ks), frt = LD_(bf16x8, RC_RT + at_ + 64 * ks);
                    mka = __builtin_amdgcn_mfma_f32_16x16x32_bf16(fka, fqp, mka, 0, 0, 0); mkd = __builtin_amdgcn_mfma_f32_16x16x32_bf16(fkd, fqp, mkd, 0, 0, 0);
                    nka = __builtin_amdgcn_mfma_f32_16x16x32_bf16(fka, frt, nka, 0, 0, 0); nkd = __builtin_amdgcn_mfma_f32_16x16x32_bf16(fkd, frt, nkd, 0, 0, 0);
                }
            }
            const int t = 16 * tt + (int)opq((unsigned)l16), s0 = 16 * st + 4 * (int)opq((unsigned)g);
#pragma unroll
            for (int r = 0; r < 4; ++r) { const bool lt = (s0 + r) < t, le = (s0 + r) <= t; mka[r] = lt ? mka[r] : 0.f; mkd[r] = lt ? mkd[r] : 0.f; nka[r] = le ? nka[r] : 0.f; nkd[r] = le ? nkd[r] : 0.f; }
            const unsigned am = a_f4 + tt * (16 * RC_LD * 2) + st * 32;
            ST_(v2u, RC_MKA + am) = (v2u){pg8::cvt_pk_bf16(mka[0], mka[1]), pg8::cvt_pk_bf16(mka[2], mka[3])};
            ST_(v2u, RC_MKD + am) = (v2u){pg8::cvt_pk_bf16(mkd[0], mkd[1]), pg8::cvt_pk_bf16(mkd[2], mkd[3])};
            ST_(v2u, RC_NKA + am) = (v2u){pg8::cvt_pk_bf16(nka[0], nka[1]), pg8::cvt_pk_bf16(nka[2], nka[3])};
            ST_(v2u, RC_NKD + am) = (v2u){pg8::cvt_pk_bf16(nkd[0], nkd[1]), pg8::cvt_pk_bf16(nkd[2], nkd[3])};
            if (st == tt) ST_(f32x4, a_dgs + st * 1024) = mka;
        }
        __syncthreads();
        if (w == 4) {
            const unsigned a_dgb = opq((unsigned)(RC_DG + g * 1024)), a_tbs = opq((unsigned)(RC_TB + (g * 256 + l16) * 2));
            float tc[16]; const int lq = (int)opq((unsigned)l16);
#pragma unroll
            for (int t = 0; t < 16; ++t) {
                float acc = (t == lq) ? 1.f : 0.f;
                const f32x4 L0 = LD_(f32x4, a_dgb + t * 64), L1 = LD_(f32x4, a_dgb + t * 64 + 16), L2 = LD_(f32x4, a_dgb + t * 64 + 32), L3 = LD_(f32x4, a_dgb + t * 64 + 48);
                const float lr[16] = {L0[0], L0[1], L0[2], L0[3], L1[0], L1[1], L1[2], L1[3], L2[0], L2[1], L2[2], L2[3], L3[0], L3[1], L3[2], L3[3]};
#pragma unroll
                for (int s = 0; s < 16; ++s) if (s < t) acc += lr[s] * tc[s];
                tc[t] = acc;
                ST_(unsigned short, a_tbs + t * 32) = (unsigned short)f2bf(acc);
            }
        }
        f32x4 X[4], O[4], U[4];
        const f32x4 zero4 = (f32x4){0.f, 0.f, 0.f, 0.f};
        bf16x8 vb0, vb1;
        if (w < 4) {
            const bf16x8 sf0 = pack8(S[0], S[1]), sf1 = pack8(S[2], S[3]);
            { const unsigned av = RC_VT + a_tr + (8 * g) * (RC_LD * 2) + w * 32; vb0 = tr8(L, av, av + 4 * RC_LD * 2); vb1 = tr8(L, av + 32 * RC_LD * 2, av + 36 * RC_LD * 2); }
#pragma unroll
            for (int mt = 0; mt < 4; ++mt) {
                const unsigned o4 = a_f4 + mt * (16 * RC_LD * 2), o8 = a_f8 + mt * (16 * RC_LD * 2);
                X[mt] = __builtin_amdgcn_mfma_f32_16x16x32_bf16(kperm(L, RC_QP + o4), sf0, zero4, 0, 0, 0);
                X[mt] = __builtin_amdgcn_mfma_f32_16x16x32_bf16(kperm(L, RC_QP + o4 + 64), sf1, X[mt], 0, 0, 0);
                X[mt] = __builtin_amdgcn_mfma_f32_16x16x32_bf16(LD_(bf16x8, RC_MKD + o8), vb0, X[mt], 0, 0, 0);
                X[mt] = __builtin_amdgcn_mfma_f32_16x16x32_bf16(LD_(bf16x8, RC_MKD + o8 + 64), vb1, X[mt], 0, 0, 0);
                O[mt] = __builtin_amdgcn_mfma_f32_16x16x32_bf16(kperm(L, RC_RT + o4), sf0, zero4, 0, 0, 0);
                O[mt] = __builtin_amdgcn_mfma_f32_16x16x32_bf16(kperm(L, RC_RT + o4 + 64), sf1, O[mt], 0, 0, 0);
                O[mt] = __builtin_amdgcn_mfma_f32_16x16x32_bf16(LD_(bf16x8, RC_NKD + o8), vb0, O[mt], 0, 0, 0);
                O[mt] = __builtin_amdgcn_mfma_f32_16x16x32_bf16(LD_(bf16x8, RC_NKD + o8 + 64), vb1, O[mt], 0, 0, 0);
                asm volatile("" ::: "memory");
            }
#pragma unroll
            for (int jt = 0; jt < 4; ++jt) { const unsigned ak = RC_KD + a_tr + (8 * g) * (RC_LD * 2) + jt * 32;
                S[jt] = __builtin_amdgcn_mfma_f32_16x16x32_bf16(tr8(L, ak, ak + 4 * RC_LD * 2), vb0, S[jt], 0, 0, 0);
                S[jt] = __builtin_amdgcn_mfma_f32_16x16x32_bf16(tr8(L, ak + 32 * RC_LD * 2, ak + 36 * RC_LD * 2), vb1, S[jt], 0, 0, 0); }
        }
        __syncthreads();
        if (w < 4) {
            const unsigned a_tbf = opq((unsigned)(RC_TB + (l16 * 16 + 4 * g) * 2)), a_ebr = opq((unsigned)(RC_EB + 16 * g));
#define RC_TBF(tb) __builtin_bit_cast(bf16x8, (v4u){LD_(v2u, a_tbf + (tb) * 512).x, LD_(v2u, a_tbf + (tb) * 512).y, 0u, 0u})
            U[0] = __builtin_amdgcn_mfma_f32_16x16x32_bf16(RC_TBF(0), pack8(X[0], zero4), zero4, 0, 0, 0);
            X[1] = __builtin_amdgcn_mfma_f32_16x16x32_bf16(kperm(L, RC_MKA + a_f4 + 1 * (16 * RC_LD * 2)), pack8(U[0], zero4), X[1], 0, 0, 0);
            U[1] = __builtin_amdgcn_mfma_f32_16x16x32_bf16(RC_TBF(1), pack8(X[1], zero4), zero4, 0, 0, 0);
            const bf16x8 uf0 = pack8(U[0], U[1]);
            X[2] = __builtin_amdgcn_mfma_f32_16x16x32_bf16(kperm(L, RC_MKA + a_f4 + 2 * (16 * RC_LD * 2)), uf0, X[2], 0, 0, 0);
            U[2] = __builtin_amdgcn_mfma_f32_16x16x32_bf16(RC_TBF(2), pack8(X[2], zero4), zero4, 0, 0, 0);
            X[3] = __builtin_amdgcn_mfma_f32_16x16x32_bf16(kperm(L, RC_MKA + a_f4 + 3 * (16 * RC_LD * 2)), uf0, X[3], 0, 0, 0);
            X[3] = __builtin_amdgcn_mfma_f32_16x16x32_bf16(kperm(L, RC_MKA + a_f4 + 3 * (16 * RC_LD * 2) + 64), pack8(U[2], zero4), X[3], 0, 0, 0);
            U[3] = __builtin_amdgcn_mfma_f32_16x16x32_bf16(RC_TBF(3), pack8(X[3], zero4), zero4, 0, 0, 0);
            const bf16x8 uf1 = pack8(U[2], U[3]);
#undef RC_TBF
#pragma unroll
            for (int mt = 0; mt < 4; ++mt) { const unsigned o4 = a_f4 + mt * (16 * RC_LD * 2);
                O[mt] = __builtin_amdgcn_mfma_f32_16x16x32_bf16(kperm(L, RC_NKA + o4), uf0, O[mt], 0, 0, 0);
                O[mt] = __builtin_amdgcn_mfma_f32_16x16x32_bf16(kperm(L, RC_NKA + o4 + 64), uf1, O[mt], 0, 0, 0); }
#pragma unroll
            for (int jt = 0; jt < 4; ++jt) { const unsigned ak = RC_KA + a_tr + (4 * g) * (RC_LD * 2) + jt * 32;
                S[jt] = __builtin_amdgcn_mfma_f32_16x16x32_bf16(tr8(L, ak, ak + 16 * RC_LD * 2), uf0, S[jt], 0, 0, 0);
                S[jt] = __builtin_amdgcn_mfma_f32_16x16x32_bf16(tr8(L, ak + 32 * RC_LD * 2, ak + 48 * RC_LD * 2), uf1, S[jt], 0, 0, 0);
                S[jt] = S[jt] * LD_(f32x4, a_ebr + jt * 64); }
            if (!(last && chunk < 4)) {
                GAS bf16* yp = (GAS bf16*)(Y + (size_t)(r0 + sgn * 4 * g) * 1024 + h * 64 + 16 * w + l16);
                const long sy = (long)sgn * 1024;
#pragma unroll
                for (int mt = 0; mt < 4; ++mt) {
#pragma unroll
                    for (int r = 0; r < 4; ++r) { asm volatile("" : "+v"(yp)); yp[(long)r * sy] = (bf16)f2bf(O[mt][r]); }
                    yp += 16 * sy;
                }
            }
        }
        __syncthreads();
    }
#undef RC_ISSUE
}
#undef LD_
#undef ST_

constexpr int GQ_LD = 264, GT_LD = 72;
constexpr int GV_LD = 136;
constexpr int G_QD = 0, G_KI = G_QD + 64 * GQ_LD * 2, G_KT = G_KI + 64 * GQ_LD * 2, G_VT = G_KT + 256 * GT_LD * 2, G_AM = G_VT + 128 * GT_LD * 2, G_EBL = G_AM + 64 * GT_LD * 2, G_TQ = G_EBL + 1024, G_END = G_TQ + 4096;
static_assert(G_END <= RING_BYTES, "GLA LDS map");
#define LD_(T, addr) (*(const LAS T*)(L + (addr)))
#define ST_(T, addr) (*(LAS T*)(L + (addr)))
template <int VAR> __device__ __forceinline__ void gla_chunk_item(const Frame& F, int item, bool last) {
    const int b = item >> 5, h = (item >> 3) & 3, dir = (item >> 2) & 1, dvs = item & 3;
    LAS unsigned char* L = F.lds;
    const int tid = F.tid, lane = F.lane, w = F.wave, l16 = lane & 15, g = lane >> 4;
    const int dp = tid & 127, qt = tid >> 7;
    const int e8 = tid & 15, jj = tid >> 4;
    const bf16* ZG = RGN(bf16, R_ZG); const bf16* GL = RGN(bf16, R_GL) + (size_t)dir * MT * 1024;
    bf16* YG = RGN(bf16, R_YG) + (size_t)dir * MT * 2048;
    const int sgn = dir ? -1 : 1;
    f32x4 S[16];
#pragma unroll
    for (int t = 0; t < 16; ++t) S[t] = (f32x4){0.f, 0.f, 0.f, 0.f};
    unsigned rq[16], rk[16], rl[16]; v4u rv0, rv1;
#define GLA_ISSUE(chunk) do { int idx_, len_; const int r0_ = seq_row(b, dir, (chunk) * 64, idx_, len_); \
        const GAS bf16* pz_ = (const GAS bf16*)(ZG + (size_t)(r0_ + sgn * 16 * qt) * ZG_W + h * 256 + 2 * dp); const GAS bf16* pl_ = (const GAS bf16*)(GL + (size_t)(r0_ + sgn * 16 * qt) * 1024 + h * 256 + 2 * dp); \
        const long sz_ = (long)sgn * ZG_W, sl_ = (long)sgn * 1024; \
        _Pragma("unroll") for (int i = 0; i < 16; ++i) { asm volatile("" : "+v"(pz_), "+v"(pl_)); \
            rq[i] = *(const GAS unsigned*)pz_; rk[i] = *(const GAS unsigned*)(pz_ + 1024); rl[i] = *(const GAS unsigned*)pl_; pz_ += sz_; pl_ += sl_; } \
        const bf16* pv_ = ZG + (size_t)(r0_ + sgn * jj) * ZG_W + 2048 + h * 512 + dvs * 128 + 8 * e8; \
        rv0 = *(const v4u*)pv_; rv1 = *(const v4u*)(pv_ + sz_ * 32); } while (0)
    GLA_ISSUE(0);
    for (int chunk = 0; chunk < 36; ++chunk) {
        int idx0, len0; const int r0 = seq_row(b, dir, chunk * 64, idx0, len0);
        const unsigned a_ptq = opq(G_TQ + (2 * dp) * 4);
        {
            float s0 = 0.f, s1 = 0.f;
#pragma unroll
            for (int i = 0; i < 16; ++i) { s0 += bflo(rl[i]); s1 += bfhi(rl[i]); }
            ST_(f32x2, a_ptq + qt * 1024) = (f32x2){s0, s1};
        }
        __syncthreads();
        if (VAR != 2)
        {
            float o0 = 0.f, o1 = 0.f, t0 = 0.f, t1 = 0.f;
#pragma unroll
            for (int q = 0; q < 4; ++q) { const f32x2 tq = LD_(f32x2, a_ptq + q * 1024); if (q < qt) { o0 += tq.x; o1 += tq.y; } t0 += tq.x; t1 += tq.y; }
            if (qt == 0) ST_(f32x2, G_EBL + 2 * dp * 4) = (f32x2){__expf(t0), __expf(t1)};
            unsigned kt0[8], kt1[8];
            const unsigned a_pq = opq(G_QD + ((16 * qt) * GQ_LD + 2 * dp) * 2);
            const unsigned a_pkt = opq(G_KT + ((2 * dp) * GT_LD + 16 * qt) * 2);
        const unsigned a_pvt = opq(G_VT + (jj * GV_LD + 8 * e8) * 2);
#pragma unroll
            for (int i = 0; i < 16; ++i) {
                o0 += bflo(rl[i]); o1 += bfhi(rl[i]);
                const float e0 = __expf(o0), e1 = __expf(o1), n0 = __expf(-o0), n1 = __expf(-o1);
                const unsigned qd = pg8::cvt_pk_bf16(bflo(rq[i]) * 0.0625f * e0, bfhi(rq[i]) * 0.0625f * e1);
                const unsigned ki = pg8::cvt_pk_bf16(bflo(rk[i]) * n0, bfhi(rk[i]) * n1);
                ST_(unsigned, a_pq + i * GQ_LD * 2) = qd;
                ST_(unsigned, a_pq + (G_KI - G_QD) + i * GQ_LD * 2) = ki;
                if (i & 1) { kt0[i >> 1] |= (ki << 16); kt1[i >> 1] |= (ki & 0xffff0000u); }
                else { kt0[i >> 1] = ki & 0xffffu; kt1[i >> 1] = ki >> 16; }
                asm volatile("" ::: "memory");
            }
            ST_(v4u, a_pkt) = (v4u){kt0[0], kt0[1], kt0[2], kt0[3]};
            ST_(v4u, a_pkt + 16) = (v4u){kt0[4], kt0[5], kt0[6], kt0[7]};
            ST_(v4u, a_pkt + GT_LD * 2) = (v4u){kt1[0], kt1[1], kt1[2], kt1[3]};
            ST_(v4u, a_pkt + GT_LD * 2 + 16) = (v4u){kt1[4], kt1[5], kt1[6], kt1[7]};
            ST_(v4u, a_pvt) = rv0; ST_(v4u, a_pvt + 32 * GV_LD * 2) = rv1;
        }
        __syncthreads();
        if (chunk + 1 < 36 && VAR != 1) GLA_ISSUE(chunk + 1);
        const unsigned a_f8 = opq((l16 * GQ_LD + 8 * g) * 2);
#pragma unroll
        for (int tt = 0; tt < 2; ++tt) {
            const int t = 2 * w + tt, jt = t >> 2, it = t & 3;
            f32x4 acc = (f32x4){0.f, 0.f, 0.f, 0.f};
            if (jt <= it) {
                const unsigned ak = a_f8 + G_KI + jt * (16 * GQ_LD * 2), aq = a_f8 + G_QD + it * (16 * GQ_LD * 2);
#pragma unroll
                for (int s = 0; s < 8; ++s) {
                    const bf16x8 a = LD_(bf16x8, ak + 64 * s);
                    const bf16x8 bb = LD_(bf16x8, aq + 64 * s);
                    acc = __builtin_amdgcn_mfma_f32_16x16x32_bf16(a, bb, acc, 0, 0, 0);
                }
            }
            const int i = 16 * it + l16, j0 = 16 * jt + 4 * g;
            const float m0 = (j0 + 0 <= i) ? acc[0] : 0.f, m1 = (j0 + 1 <= i) ? acc[1] : 0.f, m2 = (j0 + 2 <= i) ? acc[2] : 0.f, m3 = (j0 + 3 <= i) ? acc[3] : 0.f;
            ST_(v2u, G_AM + (i * GT_LD + j0) * 2) = (v2u){pg8::cvt_pk_bf16(m0, m1), pg8::cvt_pk_bf16(m2, m3)};
        }
        __syncthreads();
        if (VAR != 3)
        {
            const unsigned a_f4 = opq(G_QD + (l16 * GQ_LD + 4 * g) * 2), a_t8 = opq((l16 * GT_LD + 8 * g) * 2), a_ebl = opq(G_EBL + 16 * g);
            const unsigned a_vtr = opq(G_VT + ((8 * g + (l16 >> 2)) * GV_LD + 16 * w + 4 * (l16 & 3)) * 2);
            const unsigned a_os = opq(G_KI + ((4 * g) * GV_LD + 16 * w + l16) * 2);
            f32x4 O[4];
#pragma unroll
            for (int mt = 0; mt < 4; ++mt) O[mt] = (f32x4){0.f, 0.f, 0.f, 0.f};
#pragma unroll
            for (int s = 0; s < 8; ++s) {
                const bf16x8 bs = pack8(S[2 * s], S[2 * s + 1]);
#pragma unroll
                for (int mt = 0; mt < 4; ++mt) {
                    const v2u a0 = LD_(v2u, a_f4 + (16 * mt * GQ_LD + 32 * s) * 2);
                    const v2u a1 = LD_(v2u, a_f4 + (16 * mt * GQ_LD + 32 * s + 16) * 2);
                    const bf16x8 a = __builtin_bit_cast(bf16x8, (v4u){a0.x, a0.y, a1.x, a1.y});
                    O[mt] = __builtin_amdgcn_mfma_f32_16x16x32_bf16(a, bs, O[mt], 0, 0, 0);
                }
                asm volatile("" ::: "memory");
            }
            const bf16x8 vb0 = tr8(L, a_vtr, a_vtr + 4 * GV_LD * 2);
            const bf16x8 vb1 = tr8(L, a_vtr + 32 * GV_LD * 2, a_vtr + 36 * GV_LD * 2);
#pragma unroll
            for (int mt = 0; mt < 4; ++mt) {
                const bf16x8 a0 = LD_(bf16x8, a_t8 + G_AM + mt * (16 * GT_LD * 2));
                O[mt] = __builtin_amdgcn_mfma_f32_16x16x32_bf16(a0, vb0, O[mt], 0, 0, 0);
                if (mt >= 2) { const bf16x8 a1 = LD_(bf16x8, a_t8 + G_AM + mt * (16 * GT_LD * 2) + 64);
                    O[mt] = __builtin_amdgcn_mfma_f32_16x16x32_bf16(a1, vb1, O[mt], 0, 0, 0); }
            }
            if (VAR == 0 && !(last && chunk < 4)) {
                const unsigned aos = a_os;
#pragma unroll
                for (int mt = 0; mt < 4; ++mt)
#pragma unroll
                    for (int r = 0; r < 4; ++r) ST_(unsigned short, aos + (16 * mt + r) * (GV_LD * 2)) = (unsigned short)f2bf(O[mt][r]);
            }
#pragma unroll
            for (int t = 0; t < 16; ++t) {
                const bf16x8 a0 = LD_(bf16x8, a_t8 + G_KT + t * (16 * GT_LD * 2));
                const bf16x8 a1 = LD_(bf16x8, a_t8 + G_KT + t * (16 * GT_LD * 2) + 64);
                S[t] = __builtin_amdgcn_mfma_f32_16x16x32_bf16(a0, vb0, S[t], 0, 0, 0);
                S[t] = __builtin_amdgcn_mfma_f32_16x16x32_bf16(a1, vb1, S[t], 0, 0, 0);
                const f32x4 eb = LD_(f32x4, a_ebl + 64 * t);
                S[t] = S[t] * eb;
                asm volatile("" ::: "memory");
            }
        }
        __syncthreads();
        if (VAR == 0 && !(last && chunk < 4)) {
            const unsigned a_or = opq(G_KI + ((tid >> 4) * GV_LD + 8 * (tid & 15)) * 2);
            const v4u o0 = LD_(v4u, a_or), o1 = LD_(v4u, a_or + 32 * GV_LD * 2);
            GAS bf16* yp = (GAS bf16*)(YG + (size_t)(r0 + sgn * (tid >> 4)) * 2048 + h * 512 + dvs * 128 + 8 * (tid & 15));
            *(GAS v4u*)yp = o0; *(GAS v4u*)(yp + (long)sgn * 32 * 2048) = o1;
        }
    }
#undef GLA_ISSUE
    if (VAR != 0) { float chk = 0.f;
#pragma unroll
        for (int t = 0; t < 16; ++t) chk += S[t][0] + S[t][1] + S[t][2] + S[t][3];
        chk += __uint_as_float(rq[0] ^ rk[3] ^ rl[7]);
        if (chk == 1.2345e-30f) YG[0] = (bf16)1; }
}
#undef LD_
#undef ST_

constexpr int AK_LD = 136, AV_LD = 136;
constexpr int A_K = 0, A_VT = A_K + 64 * AK_LD * 2, A_END = A_VT + 64 * AV_LD * 2;
static_assert(A_END <= RING_BYTES, "attention LDS map");
typedef float f32x16 __attribute__((ext_vector_type(16)));
#define LD_(T, addr) (*(const LAS T*)(L + (addr)))
#define ST_(T, addr) (*(LAS T*)(L + (addr)))
template <bool NOSTORE> __device__ __forceinline__ void attn_mfma_item(const Frame& F, ArgsRef A, int l, int item) {
    LAS unsigned char* L = F.lds;
    const int tid = F.tid, lane = F.lane, w = F.wave, l32 = lane & 31, g = lane >> 5;
    bf16* ZA = RGN(bf16, R_ZA); const bf16* QR = RGN(bf16, R_QR); const bf16* KR = RGN(bf16, R_KR);
    const bool isctx = item >= 512;
    int b, hk, t0;
    if (!isctx) { b = item >> 6; hk = (item >> 5) & 1; t0 = (item & 31) * 64; }
    else { const int it = item - 512; b = it >> 3; hk = (it >> 2) & 1; t0 = (it & 3) * 64; }
    const int hq = hk * 4 + (w >> 1), tq = t0 + 32 * (w & 1) + l32;
    const size_t qrow = isctx ? (size_t)(ML + b * CL + tq) : (size_t)(b * SEQ + tq);
    const float C2 = 0.08838834764831845f * 1.4426950408889634f;
    const int skey = tid >> 3, sc = tid & 7;
    const unsigned a_sk = opq(A_K + (skey * AK_LD + 8 * sc) * 2);
    const unsigned a_sv = opq(A_VT + (skey * AV_LD + 8 * sc) * 2);
    const unsigned a_kf = opq(A_K + (l32 * AK_LD + 8 * g) * 2);
    const unsigned a_vf = opq(A_VT + ((4 * g + ((lane & 15) >> 2)) * AV_LD + 16 * ((lane >> 4) & 1) + 4 * (lane & 3)) * 2);
    bf16x8 qf[8];
    {
        const bf16* qp = (isctx ? (const bf16*)ZA + qrow * ZA_LD : QR + qrow * 1024) + hq * 128 + 8 * g;
#pragma unroll
        for (int s = 0; s < 8; ++s) qf[s] = *(const bf16x8*)(qp + 16 * s);
    }
    float mrun = AIN(11)[l * 8 + hq] * 1.4426950408889634f, lsum = (g == 0) ? 1.f : 0.f;
    f32x16 O[4];
#pragma unroll
    for (int mt = 0; mt < 4; ++mt)
#pragma unroll
        for (int r = 0; r < 16; ++r) O[mt][r] = 0.f;
    int tfirst = isctx ? 5 : 0;
    if (!isctx) { while (t0 - 128 + 64 * tfirst < 0) ++tfirst; }
    v4u pk0, pk1, pv0, pv1;
#define ATT_PREFETCH(tile) do { const bf16 *kp_, *vp_; \
        if ((tile) < 5) { const size_t r_ = (size_t)(b * SEQ + t0 - 128 + 64 * (tile) + skey); kp_ = KR + r_ * 256 + hk * 128 + 8 * sc; vp_ = ZA + r_ * ZA_LD + 1280 + hk * 128 + 8 * sc; } \
        else { const size_t r_ = (size_t)(ML + b * CL + 64 * ((tile) - 5) + skey); kp_ = ZA + r_ * ZA_LD + 1024 + hk * 128 + 8 * sc; vp_ = kp_ + 256; } \
        pk0 = *(const v4u*)kp_; pk1 = *(const v4u*)(kp_ + 64); pv0 = *(const v4u*)vp_; pv1 = *(const v4u*)(vp_ + 64); } while (0)
    int tile = tfirst;
    ATT_PREFETCH(tile);
    bool plainq = isctx;
    while (tile < 9) {
        __syncthreads();
        ST_(v4u, a_sk) = pk0; ST_(v4u, a_sk + 128) = pk1;
        ST_(v4u, a_sv) = pv0; ST_(v4u, a_sv + 128) = pv1;
        __syncthreads();
        const int cur = tile;
        int nxt = cur + 1;
        if (nxt < 5 && t0 - 128 + 64 * nxt >= SEQ) nxt = 5;
        if (nxt < 9) ATT_PREFETCH(nxt);
        if (cur >= 5 && !plainq) {
            const bf16* qp = (const bf16*)ZA + qrow * ZA_LD + hq * 128 + 8 * g;
#pragma unroll
            for (int s = 0; s < 8; ++s) qf[s] = *(const bf16x8*)(qp + 16 * s);
            plainq = true;
        }
        f32x16 sc0, sc1;
#pragma unroll
        for (int r = 0; r < 16; ++r) { sc0[r] = 0.f; sc1[r] = 0.f; }
#pragma unroll
        for (int s = 0; s < 8; ++s) {
            const bf16x8 k0 = LD_(bf16x8, a_kf + 32 * s), k1 = LD_(bf16x8, a_kf + 32 * AK_LD * 2 + 32 * s);
            sc0 = __builtin_amdgcn_mfma_f32_32x32x16_bf16(k0, qf[s], sc0, 0, 0, 0);
            sc1 = __builtin_amdgcn_mfma_f32_32x32x16_bf16(k1, qf[s], sc1, 0, 0, 0);
        }
        float tmax = -3.0e38f;
        if (cur < 5) {
            const int kbase = t0 - 128 + 64 * cur - tq + 4 * g;
#pragma unroll
            for (int r = 0; r < 16; ++r) { const int d0 = kbase + 8 * (r >> 2) + (r & 3), d1 = d0 + 32;
                sc0[r] = (d0 >= -128 && d0 <= 128) ? sc0[r] * C2 : -1.0e30f; sc1[r] = (d1 >= -128 && d1 <= 128) ? sc1[r] * C2 : -1.0e30f; }
        } else {
#pragma unroll
            for (int r = 0; r < 16; ++r) { sc0[r] *= C2; sc1[r] *= C2; }
        }
#pragma unroll
        for (int r = 0; r < 16; ++r) tmax = fmaxf(tmax, fmaxf(sc0[r], sc1[r]));
        tmax = xhalf_max(tmax);
        const float mnew = fmaxf(mrun, tmax);
        const float corr = __builtin_amdgcn_exp2f(mrun - mnew);
        mrun = mnew;
        float ps = 0.f;
#pragma unroll
        for (int r = 0; r < 16; ++r) { sc0[r] = __builtin_amdgcn_exp2f(sc0[r] - mnew); sc1[r] = __builtin_amdgcn_exp2f(sc1[r] - mnew); ps += sc0[r] + sc1[r]; }
        lsum = lsum * corr + ps;
        if (__builtin_amdgcn_ballot_w64(corr != 1.0f) != 0ull) {
#pragma unroll
            for (int mt = 0; mt < 4; ++mt)
#pragma unroll
                for (int r = 0; r < 16; ++r) O[mt][r] *= corr;
        }
#pragma unroll
        for (int u = 0; u < 2; ++u)
#pragma unroll
            for (int s = 0; s < 2; ++s) {
                v4u pw;
                if (u == 0) { pw.x = pg8::cvt_pk_bf16(sc0[8 * s + 0], sc0[8 * s + 1]); pw.y = pg8::cvt_pk_bf16(sc0[8 * s + 2], sc0[8 * s + 3]); pw.z = pg8::cvt_pk_bf16(sc0[8 * s + 4], sc0[8 * s + 5]); pw.w = pg8::cvt_pk_bf16(sc0[8 * s + 6], sc0[8 * s + 7]); }
                else { pw.x = pg8::cvt_pk_bf16(sc1[8 * s + 0], sc1[8 * s + 1]); pw.y = pg8::cvt_pk_bf16(sc1[8 * s + 2], sc1[8 * s + 3]); pw.z = pg8::cvt_pk_bf16(sc1[8 * s + 4], sc1[8 * s + 5]); pw.w = pg8::cvt_pk_bf16(sc1[8 * s + 6], sc1[8 * s + 7]); }
                const bf16x8 pb = __builtin_bit_cast(bf16x8, pw);
#pragma unroll
                for (int mt = 0; mt < 4; ++mt) {
                    const bf16x8 av = tr8(L, a_vf + ((32 * u + 16 * s) * AV_LD + 32 * mt) * 2, a_vf + ((32 * u + 16 * s + 8) * AV_LD + 32 * mt) * 2);
                    O[mt] = __builtin_amdgcn_mfma_f32_32x32x16_bf16(av, pb, O[mt], 0, 0, 0);
                }
            }
        tile = nxt;
    }
#undef ATT_PREFETCH
    lsum = xhalf_sum(lsum);
    const float inv = 1.0f / lsum;
    bf16* op = ZA + qrow * ZA_LD + hq * 128 + 4 * g;
    if (NOSTORE) { float chk = inv;
#pragma unroll
        for (int mt = 0; mt < 4; ++mt) chk += O[mt][0] + O[mt][5] + O[mt][10] + O[mt][15];
        if (chk == 1.2345e-30f) op[0] = (bf16)1;
        return; }
#pragma unroll
    for (int mt = 0; mt < 4; ++mt)
#pragma unroll
        for (int i = 0; i < 4; ++i) {
            v2u o; o.x = pg8::cvt_pk_bf16(O[mt][4 * i] * inv, O[mt][4 * i + 1] * inv); o.y = pg8::cvt_pk_bf16(O[mt][4 * i + 2] * inv, O[mt][4 * i + 3] * inv);
            *(v2u*)(op + 32 * mt + 8 * i) = o;
        }
}
#undef LD_
#undef ST_

#ifndef MK_PROBE
#define MK_PROBE 0
#endif
#define PROBE_SPIN(bit, t0_) do { if ((MK_PROBE & (bit)) != 0) { asm volatile("s_waitcnt vmcnt(0) lgkmcnt(0)" ::: "memory"); const unsigned long long t1_ = __builtin_amdgcn_s_memrealtime(); \
        while (__builtin_amdgcn_s_memrealtime() - t1_ < t1_ - (t0_)) __builtin_amdgcn_s_sleep(8); } } while (0)
__device__ __forceinline__ void phase_mix(const Frame& F, ArgsRef A, int l, bool last) {
    unsigned long long tp = (MK_PROBE & 0x700) ? __builtin_amdgcn_s_memrealtime() : 0ull;
#if !defined(MIX_ONLY) || MIX_ONLY == 1
    for (int v = F.bid; v < 256; v += F.G) rwkv_chunk_item(F, A, l, ((v & 7) << 5) | (v >> 3), last);
#endif
    PROBE_SPIN(0x100, tp);
    if (MK_PROBE & 0x700) tp = __builtin_amdgcn_s_memrealtime();
#if !defined(MIX_ONLY) || MIX_ONLY == 2
    for (int v = F.bid; v < 256; v += F.G) { const int x = v & 7, y = v >> 3; gla_chunk_item<0>(F, ((x + 8 * (y >> 3)) << 3) | (y & 7), last); }

#endif
    PROBE_SPIN(0x200, tp);
    if (MK_PROBE & 0x700) tp = __builtin_amdgcn_s_memrealtime();
    {
        const int x = F.bid & 7; const unsigned nt = last ? 64u : 72u;
        unsigned* ctr = (unsigned*)(F.ws + WS_CTL) + 8192 + (l * 8 + x) * 64;
        volatile LAS unsigned* tk = (volatile LAS unsigned*)(F.lds + MISC_OFF) + 16;
        for (;;) {
            if (F.tid == 0) *tk = __hip_atomic_fetch_add(ctr, 1u, __ATOMIC_RELAXED, __HIP_MEMORY_SCOPE_AGENT);
            __syncthreads();
            const unsigned t = *tk;
            __syncthreads();
            if (t >= nt) break;
            const int item = t < 64u ? ((x << 6) | (int)t) : 512 + ((x << 3) | (int)(t - 64u));
#if !defined(MIX_ONLY) || MIX_ONLY == 3
            attn_mfma_item<false>(F, A, l, item);
#endif
        }
    }
    PROBE_SPIN(0x400, tp);
}

__device__ __forceinline__ void phase_mixout(const Frame& F, ArgsRef A, int l, int nrows) {
    const int gw = F.bid * NWAVES + F.wave, NGW = F.G * NWAVES, lane = F.lane;
    {
        const bf16* ZR = RGN(bf16, R_ZR); const bf16* Y = RGN(bf16, R_Y); const bf16* G = RGN(bf16, R_G); bf16* ORW = RGN(bf16, R_ZA) + OC_RW; const float* BS = RGN(float, R_BS);
        const float* cw = AIN(12) + (size_t)l * 3 * RW_COLS;
        const int cg = F.wave & 3, c0 = cg * 256 + lane * 4, hd = cg * 4 + (lane >> 4);
        f32x4 tpv[3];
#pragma unroll
        for (int tap = 0; tap < 3; ++tap) tpv[tap] = *(const f32x4*)(cw + tap * RW_COLS + 2 * 1024 + c0);
        const f32x4 lnw = *(const f32x4*)(AIN(21) + l * 1024 + c0), lnb = *(const f32x4*)(AIN(22) + l * 1024 + c0);
        for (int m = F.bid * 2 + (F.wave >> 2); m < nrows; m += 2 * F.G) {
            int idx, len; if (m < ML) { idx = m & (SEQ - 1); len = SEQ; } else { idx = (m - ML) & (CL - 1); len = CL; }
            const float fl = idx > 0 ? 1.f : 0.f, fr = idx < len - 1 ? 1.f : 0.f;
            const bf16* z0 = ZR + (size_t)m * ZR_W + 2 * 1024 + c0; const bf16* zl = idx > 0 ? z0 - ZR_W : z0; const bf16* zrr = idx < len - 1 ? z0 + ZR_W : z0;
            const v2u wc = *(const v2u*)z0, wl = *(const v2u*)zl, wr = *(const v2u*)zrr;
            const f32x4 xc = (f32x4){bflo(wc.x), bfhi(wc.x), bflo(wc.y), bfhi(wc.y)}, xl = (f32x4){bflo(wl.x), bfhi(wl.x), bflo(wl.y), bfhi(wl.y)}, xr = (f32x4){bflo(wr.x), bfhi(wr.x), bflo(wr.y), bfhi(wr.y)};
            const f32x4 v = xc * tpv[1] + xl * tpv[0] * fl + xr * tpv[2] * fr;
            const v2u yw0 = *(const v2u*)(Y + (size_t)m * 1024 + c0), yw1 = *(const v2u*)(Y + ((size_t)MT + m) * 1024 + c0);
            const f32x4 y0 = (f32x4){bflo(yw0.x), bfhi(yw0.x), bflo(yw0.y), bfhi(yw0.y)}, y1 = (f32x4){bflo(yw1.x), bfhi(yw1.x), bflo(yw1.y), bfhi(yw1.y)};
            const float bs = BS[(size_t)m * 16 + hd] + BS[((size_t)MT + m) * 16 + hd];
            const f32x4 o = y0 + y1;
            const float mean = red16s((o.x + o.y) + (o.z + o.w)) * (1.f / 64.f); const f32x4 dv = o - mean;
            const float var = red16s((dv.x * dv.x + dv.y * dv.y) + (dv.z * dv.z + dv.w * dv.w)) * (1.f / 64.f);
            const f32x4 on = dv * (1.f / sqrtf(var + 64e-5f)) * lnw + lnb;
            const v2u gw2 = *(const v2u*)(G + (size_t)m * 1024 + c0);
            const f32x4 gv = (f32x4){bflo(gw2.x), bfhi(gw2.x), bflo(gw2.y), bfhi(gw2.y)};
            const f32x4 res = (on + v * bs) * gv;
            *(v2u*)(ORW + (size_t)m * ZA_LD + c0) = (v2u){pk2(res.x, res.y), pk2(res.z, res.w)};
        }
    }
    {
        const bf16* YG = RGN(bf16, R_YG); const bf16* ZG = RGN(bf16, R_ZG); bf16* OGL = RGN(bf16, R_ZA) + OC_GL; const float* nw = AIN(25) + l * 512;
        const f32x4 nw0 = *(const f32x4*)(nw + lane * 8), nw1 = *(const f32x4*)(nw + lane * 8 + 4);
        for (int it = gw; it < nrows * 4; it += NGW) {
            const int m = it >> 2, h = it & 3;
            const v4u ya = *(const v4u*)(YG + (size_t)m * 2048 + h * 512 + lane * 8), yb = *(const v4u*)(YG + ((size_t)MT + m) * 2048 + h * 512 + lane * 8);
            f32x4 y0 = (f32x4){bflo(ya.x) + bflo(yb.x), bfhi(ya.x) + bfhi(yb.x), bflo(ya.y) + bflo(yb.y), bfhi(ya.y) + bfhi(yb.y)};
            f32x4 y1 = (f32x4){bflo(ya.z) + bflo(yb.z), bfhi(ya.z) + bfhi(yb.z), bflo(ya.w) + bflo(yb.w), bfhi(ya.w) + bfhi(yb.w)};
            const float ss = wave_sum((y0.x * y0.x + y0.y * y0.y) + (y0.z * y0.z + y0.w * y0.w) + (y1.x * y1.x + y1.y * y1.y) + (y1.z * y1.z + y1.w * y1.w));
            const float rs = 1.f / sqrtf(ss * (1.f / 512.f) + 1e-5f);
            const v4u gw4 = *(const v4u*)(ZG + (size_t)m * ZG_W + 4096 + h * 512 + lane * 8);
            const f32x4 g0 = (f32x4){bflo(gw4.x), bfhi(gw4.x), bflo(gw4.y), bfhi(gw4.y)}, g1 = (f32x4){bflo(gw4.z), bfhi(gw4.z), bflo(gw4.w), bfhi(gw4.w)};
            y0 = y0 * rs * nw0; y1 = y1 * rs * nw1;
            v4u w; w.x = pk2(y0.x * fsilu(g0.x), y0.y * fsilu(g0.y)); w.y = pk2(y0.z * fsilu(g0.z), y0.w * fsilu(g0.w));
            w.z = pk2(y1.x * fsilu(g1.x), y1.y * fsilu(g1.y)); w.w = pk2(y1.z * fsilu(g1.z), y1.w * fsilu(g1.w));
            *(v4u*)(OGL + (size_t)m * ZA_LD + h * 512 + lane * 8) = w;
        }
    }
}


#define NOPK
#ifndef MK_ONE_LAUNCH
#define MK_ONE_LAUNCH 1
#endif

template <int K> __device__ __forceinline__ void run_phase(const Frame& F, ArgsRef A, int l) {
    const float* mods = WSP(float, WS_MODS);
    bf16* HB = WSP(bf16, WS_HB);
    const bool last = (l == DEPTH - 1);
    const float* mods_l = mods + (size_t)l * 9 * 18432;
    const float* lng = AIN(6) + (size_t)l * 3 * D; const float* lnb = AIN(7) + (size_t)l * 3 * D;
    const int nrows = last ? ML : MT;
    if constexpr (K == -1) phase_init(F, A);
    if constexpr (K == 0) {
        if (l > 0) phase_ln<true, true>(F, MT, lng - D, lnb - D, mods_l, 0, 1, RGN(float, R_PART), mods_l - 9 * 18432 + 8 * 18432 + 8 * 2048, 0.5f);
        else phase_ln<false, true>(F, MT, nullptr, nullptr, mods_l, 0, 1, nullptr, nullptr, 0.f, AIN(0), AIN(2));
        phase_convert(F, A, l, 0, 3);
    }
    if constexpr (K == 1 || K == 12) { const int M = (K == 1) ? MT : nrows; pg8::Gemm g{HB, RGN(bf16, R_WGU), M, 2 * FF, D, D, D, 0}; pg8::StaticOrder S; S.init(M, 2 * FF, F.G, F.bid);
        pg8::EpiSwiglu E{RGN(bf16, R_H), FF}; pg8::gemm_phase<pg8::EpiSwiglu, pg8::StaticOrder, true, true>(F.lds, g, S, E, F.tid); }
    if constexpr (K == 2 || K == 13) { const int M = (K == 2) ? MT : nrows;
        { pg8::Gemm g{RGN(bf16, R_H), RGN(bf16, R_WDN), ML, D, FF, FF, FF, 0}; pg8::StaticOrder S; S.init(ML, D, F.G, F.bid);
          const bool first = (K == 2) && l == 0;
          const float* pg_ = (K == 2) ? (first ? lng : lng - D) : lng + D; const float* pb_ = (K == 2) ? (first ? lnb : lnb - D) : lnb + D;
          pg8::EpiResid<1> E{(float*)F.out, mods_l, first ? AIN(0) : (const float*)F.out, first ? nullptr : WSP(const float, WS_STATS), pg_, pb_, (K == 2) ? 2 : 8}; pg8::gemm_phase<pg8::EpiResid<1>, pg8::StaticOrder, true, true>(F.lds, g, S, E, F.tid); }
        if (M == MT) { pg8::Gemm g{RGN(bf16, R_H) + (size_t)ML * FF, RGN(bf16, R_WDN), MC, D, FF / 4, FF, FF, (FF / 4) * 2}; pg8::SplitKOrder S; S.init(MC, D, 4, F.G, F.bid);
          pg8::EpiPartial E{RGN(float, R_PART), D, (size_t)MC * D}; pg8::gemm_phase<pg8::EpiPartial, pg8::SplitKOrder, true, true>(F.lds, g, S, E, F.tid); }
    }
    if constexpr (K == 3) phase_ln<true, true>(F, MT, lng, lnb, mods_l, 3, 4, RGN(float, R_PART), mods_l + 8 * 18432 + 2 * 2048, 0.5f, nullptr, l == 0 ? AIN(2) : nullptr);
    if constexpr (K == 4) { pg8::Gemm g{HB, WSP(bf16, WS_WM + WM_IN), MT, NMIX, D, D, D, 0}; pg8::StaticOrder S; S.init(MT, NMIX, F.G, F.bid);
        typedef pg8::EpiBf16Seg<0, WS_R + R_ZA, WS_R + R_ZR, WS_R + R_ZG, 6, 21, ZA_LD, ZR_W, ZG_W> EpiWin; EpiWin E{(unsigned char*)F.ws};
        pg8::gemm_phase<EpiWin, pg8::StaticOrder, true, true>(F.lds, g, S, E, F.tid); }
    if constexpr (K == 5) { phase_prep(F, A, l);
#if (MK_PROBE & 0x100000)
        __syncthreads();
        for (int v = F.bid; v < 576; v += F.G) { const int item = v < 512 ? (((v & 7) << 6) | ((v >> 3) & 31) | ((v >> 8) << 5)) : 512 + ((((v - 512) & 7) << 3) | ((v - 512) >> 3)); attn_mfma_item<true>(F, A, l, item); }
#endif
#if (MK_PROBE & 0x200000)
        __syncthreads();
        for (int v = F.bid; v < 256; v += F.G) rwkv_chunk_item(F, A, l, ((v & 7) << 5) | (v >> 3), true);
#endif
#if (MK_PROBE & 0xF0000)
        __syncthreads();
        for (int v = F.bid; v < 256; v += F.G) { const int x = v & 7, y = v >> 3; gla_chunk_item<(MK_PROBE >> 16) & 15>(F, ((x + 8 * (y >> 3)) << 3) | (y & 7), true); }
#endif
    }
    if constexpr (K == 6) {
        { pg8::Gemm g{RGN(bf16, R_LA), WSP(bf16, WS_WM + WM_LW), MT, 2048, 256, LA_W, 256, 0}; pg8::StaticOrder S; S.init(MT, 2048, F.G, F.bid);
          pg8::EpiLora<0> E{RGN(float, R_WDEC), nullptr, AIN(13) + (size_t)l * 2048, (size_t)MT * 1024}; pg8::gemm_phase<pg8::EpiLora<0>, pg8::StaticOrder, true, true>(F.lds, g, S, E, F.tid); }
    }
    if constexpr (K == 15) {
        { pg8::Gemm g{RGN(bf16, R_LA) + 256, WSP(bf16, WS_WM + WM_LA), MT, 2048, 256, LA_W, 256, 0}; pg8::StaticOrder S; S.init(MT, 2048, F.G, F.bid);
          pg8::EpiLora<1> E{nullptr, RGN(bf16, R_AA), AIN(15) + (size_t)l * 2048, (size_t)MT * 1024}; pg8::gemm_phase<pg8::EpiLora<1>, pg8::StaticOrder, true, true>(F.lds, g, S, E, F.tid); }
    }
    if constexpr (K == 16) {
        { pg8::Gemm g{RGN(bf16, R_LA) + 512, WSP(bf16, WS_WM + WM_LG), MT, 1024, 256, LA_W, 256, 0}; pg8::StaticOrder S; S.init(MT, 1024, F.G, F.bid);
          pg8::EpiLora<2> E{nullptr, RGN(bf16, R_G), nullptr, 0}; pg8::gemm_phase<pg8::EpiLora<2>, pg8::StaticOrder, true, true>(F.lds, g, S, E, F.tid); }
    }
    if constexpr (K == 7) phase_mix(F, A, l, last);
    if constexpr (K == 8) {
        phase_mixout(F, A, l, nrows);
        __syncthreads();
        pg8::Gemm g{HB, WSP(bf16, WS_WM + WM_IN) + (size_t)NMIX * D, nrows, GT_W, D, D, D, 0}; pg8::StaticOrder S; S.init(nrows, GT_W, F.G, F.bid);
        typedef pg8::EpiBf16Seg<1, WS_R + R_GT, WS_R + R_GT, WS_R + R_GT, 1 << 20, 1 << 20, GT_W, GT_W, GT_W> EpiGate; EpiGate E{(unsigned char*)F.ws};
        pg8::gemm_phase<EpiGate, pg8::StaticOrder, true, true>(F.lds, g, S, E, F.tid);
    }
    if constexpr (K == 9) {
        pg8::Gemm g{RGN(bf16, R_ZA), WSP(bf16, WS_WM + WM_BA), nrows, D, 4096, ZA_LD, 4096, 0, 16, (OC_RW - 1024) * 2}; pg8::StaticOrder S; S.init(nrows, D, F.G, F.bid);
        pg8::EpiBranchFused E{RGN(bf16, R_GT), GT_W, RGN(bf16, R_MG)}; pg8::gemm_phase<pg8::EpiBranchFused, pg8::StaticOrder, true, true>(F.lds, g, S, E, F.tid);
    }
    if constexpr (K == 10) {
        { pg8::Gemm g{RGN(bf16, R_MG), WSP(bf16, WS_WM + WM_OUT), ML, D, D, D, D, 0}; pg8::StaticOrder S; S.init(ML, D, F.G, F.bid);
          pg8::EpiResid<2> E{(float*)F.out, mods_l, (const float*)F.out, WSP(const float, WS_STATS), lng, lnb, 5}; pg8::gemm_phase<pg8::EpiResid<2>, pg8::StaticOrder, true, true>(F.lds, g, S, E, F.tid); }
        if (nrows == MT) { pg8::Gemm g{RGN(bf16, R_MG) + (size_t)ML * D, WSP(bf16, WS_WM + WM_OUT), MC, D, D / 4, D, D, (D / 4) * 2}; pg8::SplitKOrder S; S.init(MC, D, 4, F.G, F.bid);
          pg8::EpiPartial E{RGN(float, R_PART), D, (size_t)MC * D}; pg8::gemm_phase<pg8::EpiPartial, pg8::SplitKOrder, true, true>(F.lds, g, S, E, F.tid); }
    }
    if constexpr (K == 11) { phase_ln<true, true>(F, nrows, lng + D, lnb + D, mods_l, 6, 7, RGN(float, R_PART), mods_l + 8 * 18432 + 5 * 2048, 1.0f); phase_convert(F, A, l, 1, 1); }
    if constexpr (K == 14) phase_ln<true, false, true>(F, ML, lng + 2 * D, lnb + 2 * D, nullptr, 0, 0);
}

__device__ __forceinline__ void frame_init(Frame& F, const Args& A, unsigned char* lds_raw) {
    F.lds = (LAS unsigned char*)lds_raw;
    F.tid = threadIdx.x; F.lane = F.tid & 63; F.wave = __builtin_amdgcn_readfirstlane(F.tid >> 6);
    F.G = gridDim.x; F.bid = blockIdx.x; F.out = (GAS float*)A.out; F.ws = (GAS unsigned char*)A.ws;
}

template <int K> __global__ void __launch_bounds__(NTHR, 2) NOPK fwd_phase(Args A) {
    extern __shared__ __attribute__((aligned(16))) unsigned char lds_raw[];
    Frame F; frame_init(F, A, lds_raw);
    const CAS Args* ap = (const CAS Args*)__builtin_amdgcn_kernarg_segment_ptr();
    run_phase<K>(F, *ap, A.ph_lo);
}


#ifndef MK_UNROLL_LAYERS
#define MK_UNROLL_LAYERS 0
#endif
__device__ __forceinline__ void launder(Frame& F, int& l) {
    asm volatile("" : "+s"(F.wave));
    { int ln; asm volatile("v_mbcnt_lo_u32_b32 %0, -1, 0\n\tv_mbcnt_hi_u32_b32 %0, -1, %0" : "=v"(ln)); F.lane = ln; }
    F.tid = F.wave * 64 + F.lane;
    asm volatile("" : "+s"(F.bid), "+s"(F.G), "+s"(l));
    asm volatile("" : "+s"(F.ws), "+s"(F.out));
}
template <int K> __device__ __forceinline__ constexpr int phase_group() { return (K == 1 || K == 2 || K == 4 || K == 6 || K == 15 || K == 16 || K == 9 || K == 10 || K == 12 || K == 13) ? 1 : (K == 7 ? 2 : (K == 8 ? 4 : (K == 5 ? 8 : (K == 0 || K == 11 ? 16 : (K == 3 || K == 14 ? 32 : 64))))); }
template <int K> __device__ __forceinline__ void run_phase_l(Frame F, int l) {
    if constexpr ((MK_PROBE & phase_group<K>()) != 0) {
        const unsigned long long t0 = __builtin_amdgcn_s_memrealtime();
        { Frame F2 = F; int l2 = l; launder(F2, l2); const CAS Args* ap = (const CAS Args*)__builtin_amdgcn_kernarg_segment_ptr(); asm volatile("" : "+s"(ap)); run_phase<K>(F2, *ap, l2); }
        asm volatile("s_waitcnt vmcnt(0) lgkmcnt(0)" ::: "memory");
        const unsigned long long t1 = __builtin_amdgcn_s_memrealtime();
        while (__builtin_amdgcn_s_memrealtime() - t1 < t1 - t0) __builtin_amdgcn_s_sleep(8);
        return;
    }
    launder(F, l); const CAS Args* ap = (const CAS Args*)__builtin_amdgcn_kernarg_segment_ptr(); asm volatile("" : "+s"(ap)); run_phase<K>(F, *ap, l); }
template <int L> __device__ __forceinline__ void run_layer(const Frame& F, int l, const XcdBarrier& bar) {
#if (MK_PROBE & 0x2000)
#define XBAR2(t_) do { const unsigned long long tb0_ = __builtin_amdgcn_s_memrealtime(); xcd_barrier(bar, (t_)); const unsigned long long tb1_ = __builtin_amdgcn_s_memrealtime(); \
    while (__builtin_amdgcn_s_memrealtime() - tb1_ < tb1_ - tb0_) __builtin_amdgcn_s_sleep(8); } while (0)
#elif (MK_PROBE & 0x1000)
#define XBAR2(t_) xcd_barrier(bar, (t_)); xcd_barrier(bar, (t_))
#else
#define XBAR2(t_) xcd_barrier(bar, (t_))
#endif
#define PB(K) run_phase_l<K>(F, l); { int ln_; asm volatile("v_mbcnt_lo_u32_b32 %0, -1, 0\n\tv_mbcnt_hi_u32_b32 %0, -1, %0" : "=v"(ln_)); XBAR2(F.wave * 64 + ln_); }
    PB(0) PB(1) PB(2) PB(3) PB(4) PB(5)
    run_phase_l<6>(F, l); run_phase_l<15>(F, l); run_phase_l<16>(F, l); { int ln_; asm volatile("v_mbcnt_lo_u32_b32 %0, -1, 0\n\tv_mbcnt_hi_u32_b32 %0, -1, %0" : "=v"(ln_)); XBAR2(F.wave * 64 + ln_); }
    PB(7) PB(8) PB(9) PB(10) PB(11) PB(12) PB(13)
#undef PB
}
__global__ void __launch_bounds__(NTHR, 2) NOPK fwd_all(Args A) {
    extern __shared__ __attribute__((aligned(16))) unsigned char lds_raw[];
    Frame F; frame_init(F, A, lds_raw);
    volatile LAS unsigned* MISC = (volatile LAS unsigned*)(F.lds + MISC_OFF);
    for (int u = F.tid; u < (LDS_BYTES - LDSCTL_OFF) / 4; u += NTHR) ((LAS unsigned*)(F.lds + LDSCTL_OFF))[u] = 0u;
    __syncthreads();
    const XcdBarrier bar = xcd_barrier_post((unsigned*)(F.ws + WS_CTL) + 4096, MISC + 8, F.tid);
    run_phase_l<-1>(F, 0); { int ln_; asm volatile("v_mbcnt_lo_u32_b32 %0, -1, 0\n\tv_mbcnt_hi_u32_b32 %0, -1, %0" : "=v"(ln_)); XBAR2(F.wave * 64 + ln_); }
#if MK_UNROLL_LAYERS
    run_layer<0>(F, 0, bar); run_layer<1>(F, 1, bar);
#else
    for (int l = 0; l < DEPTH; ++l) run_layer<0>(F, l, bar);
#endif
    run_phase_l<14>(F, DEPTH - 1);
}

template <int K> static void launch_phase(const Args& a, int l, int grid, hipStream_t stream) {
    static bool attr_done = false;
    if (!attr_done) { (void)hipFuncSetAttribute((const void*)fwd_phase<K>, hipFuncAttributeMaxDynamicSharedMemorySize, LDS_BYTES); attr_done = true; }
    Args b = a; b.ph_lo = l; b.ph_hi = 0;
    hipLaunchKernelGGL(fwd_phase<K>, dim3(grid), dim3(NTHR), LDS_BYTES, stream, b);
}

extern "C" void kernel_launch(void* const* d_in, const int* in_sizes, int n_in, void* d_out, int out_size, void* d_ws, size_t ws_size, hipStream_t stream) {
    static int grid = 0;
    if (grid == 0) {
        if (n_in != 30 || out_size != ML * D || ws_size < WS_END) { fprintf(stderr, "kernel_launch: unexpected shapes (n_in %d, out %d, ws %zu < %zu)\n", n_in, out_size, ws_size, (size_t)WS_END); grid = -1; return; }
        int dev = 0, cus = 0;
        if (hipGetDevice(&dev) != hipSuccess || hipDeviceGetAttribute(&cus, hipDeviceAttributeMultiprocessorCount, dev) != hipSuccess) { grid = -1; return; }
        grid = cus;
    }
    if (grid < 0) return;
    (void)hipMemsetAsync((char*)d_ws + WS_CTL, 0, CTL_ZERO_BYTES, stream);
    Args a{};
    for (int i = 0; i < 30; ++i) a.in[i] = (const float*)d_in[i];
    a.out = (float*)d_out; a.ws = (unsigned char*)d_ws;
#if MK_ONE_LAUNCH
    {
        static bool attr_done = false;
        if (!attr_done) { int per_cu = 0;
            if (hipFuncSetAttribute((const void*)fwd_all, hipFuncAttributeMaxDynamicSharedMemorySize, LDS_BYTES) != hipSuccess) { fprintf(stderr, "kernel_launch: hipFuncSetAttribute failed\n"); grid = -1; return; }
            if (hipOccupancyMaxActiveBlocksPerMultiprocessor(&per_cu, (const void*)fwd_all, NTHR, LDS_BYTES) != hipSuccess || per_cu < 1) { fprintf(stderr, "kernel_launch: occupancy query says %d blocks per CU; not launching\n", per_cu); (void)hipGetLastError(); grid = -1; return; }
            attr_done = true; }
        a.ph_lo = 0; a.ph_hi = 0;
        hipLaunchKernelGGL(fwd_all, dim3(grid), dim3(NTHR), LDS_BYTES, stream, a);
        return;
    }
#endif
    launch_phase<-1>(a, 0, grid, stream);
    for (int l = 0; l < DEPTH; ++l) {
        launch_phase<0>(a, l, grid, stream); launch_phase<1>(a, l, grid, stream); launch_phase<2>(a, l, grid, stream); launch_phase<3>(a, l, grid, stream);
        launch_phase<4>(a, l, grid, stream); launch_phase<5>(a, l, grid, stream); launch_phase<6>(a, l, grid, stream); launch_phase<15>(a, l, grid, stream); launch_phase<16>(a, l, grid, stream); launch_phase<7>(a, l, grid, stream);
        launch_phase<8>(a, l, grid, stream); launch_phase<9>(a, l, grid, stream); launch_phase<10>(a, l, grid, stream); launch_phase<11>(a, l, grid, stream);
        launch_phase<12>(a, l, grid, stream); launch_phase<13>(a, l, grid, stream);
    }
    launch_phase<14>(a, DEPTH - 1, grid, stream);
}
```

```cpp
#include <hip/hip_runtime.h>
#include <cstdio>
#include <cstdint>

#define GAS __attribute__((address_space(1)))
#define LAS __attribute__((address_space(3)))
typedef unsigned short bf16;
typedef unsigned v4u __attribute__((ext_vector_type(4)));
typedef unsigned v2u __attribute__((ext_vector_type(2)));
typedef float v2f __attribute__((ext_vector_type(2)));
typedef float f32x4 __attribute__((ext_vector_type(4)));
typedef float f32x2 __attribute__((ext_vector_type(2)));
typedef short bf16x8 __attribute__((ext_vector_type(8)));

__device__ __forceinline__ float bf2f(unsigned short b) { return __builtin_bit_cast(float, ((unsigned)b) << 16); }
__device__ __forceinline__ float bflo(unsigned w) { return __builtin_bit_cast(float, w << 16); }
__device__ __forceinline__ float bfhi(unsigned w) { return __builtin_bit_cast(float, w & 0xffff0000u); }
typedef __bf16 bf2n_t_ __attribute__((ext_vector_type(2)));
__device__ __forceinline__ unsigned pk2(float lo, float hi) { const f32x2 v = {lo, hi}; return __builtin_bit_cast(unsigned, __builtin_convertvector(v, bf2n_t_)); }
__device__ __forceinline__ unsigned f2bf(float f) { return pk2(f, 0.f) & 0xffffu; }
template <int CTRL, int ROW_MASK> __device__ __forceinline__ float dppf(float v) {
    return __builtin_bit_cast(float, __builtin_amdgcn_update_dpp(0, __builtin_bit_cast(int, v), CTRL, ROW_MASK, 0xF, false)); }
__device__ __forceinline__ float wave_sum(float v) {
    v += dppf<0xB1, 0xF>(v);
    v += dppf<0x4E, 0xF>(v);
    v += dppf<0x141, 0xF>(v);
    v += dppf<0x140, 0xF>(v);
    v += dppf<0x142, 0xA>(v);
    v += dppf<0x143, 0xC>(v);
    return __builtin_bit_cast(float, __builtin_amdgcn_readlane(__builtin_bit_cast(int, v), 63));
}
__device__ __forceinline__ void half_swap(float& a, float& b) { asm volatile("v_nop\n\tv_nop\n\tv_permlane32_swap_b32 %0, %1\n\tv_nop\n\tv_nop" : "+v"(a), "+v"(b)); }
__device__ __forceinline__ float xhalf_max(float v) { float a = v, b = v; half_swap(a, b); return fmaxf(a, b); }
__device__ __forceinline__ float xhalf_sum(float v) { float a = v, b = v; half_swap(a, b); return a + b; }
__device__ __forceinline__ float fexp(float x) { return __builtin_amdgcn_exp2f(x * 1.4426950408889634f); }
__device__ __forceinline__ float flog1p_pos(float e) { return __builtin_amdgcn_logf(1.0f + e) * 0.6931471805599453f; }
__device__ __forceinline__ float fsigmoid(float x) { return __builtin_amdgcn_rcpf(1.0f + fexp(-x)); }
__device__ __forceinline__ float fsilu(float x) { return x * __builtin_amdgcn_rcpf(1.0f + fexp(-x)); }
__device__ __forceinline__ float fsoftplus(float x) { return fmaxf(x, 0.f) + flog1p_pos(fexp(-fabsf(x))); }
__device__ __forceinline__ float ftanh(float x) { const float e = fexp(-2.0f * fabsf(x)); const float t = (1.0f - e) * __builtin_amdgcn_rcpf(1.0f + e); return x < 0.f ? -t : t; }

namespace pg8 {
#define PG8_LAS __attribute__((address_space(3)))
typedef unsigned short bf16_t;
typedef short bf16x8 __attribute__((ext_vector_type(8)));
typedef float f32x4 __attribute__((ext_vector_type(4)));
typedef unsigned u32x4 __attribute__((ext_vector_type(4)));
constexpr int BM = 256, BK = 64, HALF = 128, HTB = HALF * BK * 2  , STAGE_BYTES = 8 * HTB, NXCD = 8, WGM = 8;

__host__ __device__ __forceinline__ int lds_byte(int r, int c) { const int st = (r >> 4) * 2 + (c >> 5), rr = r & 15, cc = c & 31, ob = rr * 64 + cc * 2; return st * 1024 + (ob ^ (((ob >> 9) & 1) << 5)); }
__host__ __device__ __forceinline__ void stage_rc(int b, int& R, int& C) { const int st = b / 1024, sb = b % 1024, swz = sb ^ (((sb >> 9) & 1) << 5); R = (st >> 1) * 16 + swz / 64; C = (st & 1) * 32 + (swz % 64) / 2; }
__host__ __device__ __forceinline__ int perm32(int rho) { const int n = rho >> 4, i = rho & 15; return 8 * (i >> 2) + 4 * n + (i & 3); }

struct Unit { int pm, pn, kq; };
struct Gemm { const bf16_t* A; const bf16_t* Bt; int M, N, K, lda, ldb; int kqb; int jt, jb; };

struct StaticOrder {
    int nM, nN, nwg, G, c;
    __host__ __device__ void init(int M, int N, int G_, int c_) { nM = M / BM; nN = N / BM; nwg = nM * nN; G = G_; c = c_; }
    __host__ __device__ bool next(int i, Unit& u) const {
        const long L = (long)i * G + c; if (L >= nwg) return false;
        int wgid = (int)L; { const int q = nwg / NXCD, r = nwg % NXCD, xcd = wgid % NXCD, off = wgid / NXCD; wgid = (xcd < r ? xcd * (q + 1) : r * (q + 1) + (xcd - r) * q) + off; }
        const int nig = WGM * nN, gid = wgid / nig, fm = gid * WGM, gsz = (nM - fm) < WGM ? (nM - fm) : WGM;
        u.pm = fm + ((wgid % nig) % gsz); u.pn = (wgid % nig) / gsz; u.kq = 0; return true;
    }
    __device__ __forceinline__ void a_ready(const Unit&) const {}
    __device__ __forceinline__ void done(const Unit&) const {}
};

struct SplitKOrder {
    int nM, nN, nq, G, c;
    __host__ __device__ void init(int M, int N, int NQ, int G_, int c_) { nM = M / BM; nN = N / BM; nq = NQ; G = G_; c = c_; }
    __host__ __device__ bool next(int i, Unit& u) const { const long L = (long)i * G + c; if (L >= (long)nM * nN * nq) return false; const int t = (int)L / nq; u.kq = (int)L % nq; u.pm = t % nM; u.pn = t / nM; return true; }
    __device__ __forceinline__ void a_ready(const Unit&) const {}
    __device__ __forceinline__ void done(const Unit&) const {}
};
typedef __bf16 bf2_t_ __attribute__((ext_vector_type(2)));
typedef float f2_t_ __attribute__((ext_vector_type(2)));
__device__ __forceinline__ unsigned cvt_pk_bf16(float lo, float hi) { const f2_t_ v = {lo, hi}; return __builtin_bit_cast(unsigned, __builtin_convertvector(v, bf2_t_)); }

#define EPI_ROWS_BEGIN \
    _Pragma("unroll") for (int ai = 0; ai < 2; ++ai) _Pragma("unroll") for (int m = 0; m < 4; ++m) { const int row = u.pm * BM + ai * HALF + wr * 64 + m * 16 + fr;
#define EPI_ROWS_END }

template <int ACT, size_t O0, size_t O1, size_t O2, int T1, int T2, int L0, int L1, int L2> struct EpiBf16Seg {
    static constexpr bool PERM = true, AFTER_DRAIN = false;
    unsigned char* ws;
    __device__ __forceinline__ void operator()(const f32x4 (&acc)[2][2][4][2], const Unit& u, int wr, int wc, int fr, int fq) const {
        const size_t off = u.pn >= T2 ? O2 : (u.pn >= T1 ? O1 : O0); const int l = u.pn >= T2 ? L2 : (u.pn >= T1 ? L1 : L0), tb = u.pn >= T2 ? T2 : (u.pn >= T1 ? T1 : 0);
        bf16_t* base = (bf16_t*)(ws + off);
        const int col0 = (u.pn - tb) * BM + wc * 32 + 8 * fq;
        EPI_ROWS_BEGIN
            bf16_t* rowp = base + (size_t)row * l + col0;
#pragma unroll
            for (int bj = 0; bj < 2; ++bj) { f32x4 v0 = acc[ai][bj][m][0], v1 = acc[ai][bj][m][1];
                if (ACT == 1) {
#pragma unroll
                    for (int j = 0; j < 4; ++j) { v0[j] = fsigmoid(v0[j]); v1[j] = fsigmoid(v1[j]); } }
                u32x4 w; w.x = cvt_pk_bf16(v0[0], v0[1]); w.y = cvt_pk_bf16(v0[2], v0[3]); w.z = cvt_pk_bf16(v1[0], v1[1]); w.w = cvt_pk_bf16(v1[2], v1[3]);
                *(u32x4*)(rowp + bj * HALF) = w; }
        EPI_ROWS_END
    }
};
struct EpiSwiglu {
    static constexpr bool PERM = true, AFTER_DRAIN = false;
    bf16_t* H; int ldh;
    __device__ __forceinline__ void operator()(const f32x4 (&acc)[2][2][4][2], const Unit& u, int wr, int wc, int fr, int fq) const {
        const int col0 = u.pn * HALF + wc * 32 + 8 * fq;
        EPI_ROWS_BEGIN
            f32x4 g0 = acc[ai][0][m][0], g1 = acc[ai][0][m][1]; const f32x4 u0 = acc[ai][1][m][0], u1 = acc[ai][1][m][1];
#pragma unroll
            for (int j = 0; j < 4; ++j) { g0[j] = fsilu(g0[j]) * u0[j]; g1[j] = fsilu(g1[j]) * u1[j]; }
            u32x4 w; w.x = cvt_pk_bf16(g0[0], g0[1]); w.y = cvt_pk_bf16(g0[2], g0[3]); w.z = cvt_pk_bf16(g1[0], g1[1]); w.w = cvt_pk_bf16(g1[2], g1[3]);
            *(u32x4*)(H + (size_t)row * ldh + col0) = w;
        EPI_ROWS_END
    }
};
struct EpiPartial {
    static constexpr bool PERM = true, AFTER_DRAIN = false;
    float* P; int ldp; size_t qstride;
    __device__ __forceinline__ void operator()(const f32x4 (&acc)[2][2][4][2], const Unit& u, int wr, int wc, int fr, int fq) const {
        const int col0 = u.pn * BM + wc * 32 + 8 * fq; float* base = P + (size_t)u.kq * qstride;
        EPI_ROWS_BEGIN
            float* rowp = base + (size_t)row * ldp + col0;
#pragma unroll
            for (int bj = 0; bj < 2; ++bj)
#pragma unroll
                for (int n = 0; n < 2; ++n) *(f32x4*)(rowp + bj * HALF + 4 * n) = acc[ai][bj][m][n];
        EPI_ROWS_END
    }
};
constexpr float RES_ALPHA = 1.41421356237f;
template <int COEF2> struct EpiResid {
    static constexpr bool PERM = true, AFTER_DRAIN = false;
    float* xl; const float* mods; const float* sl; const float* st; const float* lg; const float* lb; int kmod;
    __device__ __forceinline__ void operator()(const f32x4 (&acc)[2][2][4][2], const Unit& u, int wr, int wc, int fr, int fq) const {
        const float* mp = mods + (size_t)(u.pm >> 3) * (9 * 2048) + kmod * 2048;
        const int col0 = u.pn * BM + wc * 32 + 8 * fq;
        const bool ln = st != nullptr; constexpr float al = RES_ALPHA, coef = 0.5f * COEF2;
        const float* stp = ln ? st : mods;
        const int row0 = u.pm * BM + wr * 64 + fr;
        const size_t rbase = (size_t)row0 * 2048 + col0;
#pragma unroll
        for (int bj = 0; bj < 2; ++bj) {
            f32x4 mv[2], ag[2], ab[2];
#pragma unroll
            for (int n = 0; n < 2; ++n) { mv[n] = *(const f32x4*)(mp + col0 + bj * HALF + 4 * n) * coef;
                const f32x4 g4 = *(const f32x4*)(lg + col0 + bj * HALF + 4 * n), b4 = *(const f32x4*)(lb + col0 + bj * HALF + 4 * n);
                const f32x4 g4s = ln ? g4 : (f32x4){1.f, 1.f, 1.f, 1.f}, b4s = ln ? b4 : (f32x4){0.f, 0.f, 0.f, 0.f};
                ag[n] = g4s * al; ab[n] = b4s * al; }
            f32x4 xa[3][2]; f2_t_ ms[3];
#define RES_LOADG(slot, g_) do { const int ro_ = ((g_) >> 2) * HALF + ((g_) & 3) * 16; \
                _Pragma("unroll") for (int n = 0; n < 2; ++n) xa[slot][n] = *(const f32x4*)(sl + rbase + (size_t)ro_ * 2048 + bj * HALF + 4 * n); \
                ms[slot] = *(const f2_t_*)(stp + 2 * (row0 + ro_)); } while (0)
            RES_LOADG(0, 0); RES_LOADG(1, 1);
#pragma unroll
            for (int gi = 0; gi < 8; ++gi) {
                const int ai = gi >> 2, m = gi & 3;
                if (gi + 2 < 8) RES_LOADG((gi + 2) % 3, gi + 2);
                asm volatile("" ::: "memory");
                float* rowp = xl + rbase + (size_t)(ai * HALF + m * 16) * 2048 + bj * HALF;
                const float mean = ln ? ms[gi % 3][0] : 0.f, rstd = ln ? ms[gi % 3][1] : 1.f;
#pragma unroll
                for (int n = 0; n < 2; ++n) { const f32x4 t = ag[n] * rstd;
                    *(f32x4*)(rowp + 4 * n) = (xa[gi % 3][n] - mean) * t + (ab[n] + mv[n] * acc[ai][bj][m][n]); }
                asm volatile("" ::: "memory");
            }
#undef RES_LOADG
        }
    }
};
template <int MODE> struct EpiBranch {
    static constexpr bool PERM = true, AFTER_DRAIN = false;
    const bf16_t* GT; int ldg, goff; float* T; bf16_t* O;
    __device__ __forceinline__ void operator()(const f32x4 (&acc)[2][2][4][2], const Unit& u, int wr, int wc, int fr, int fq) const {
        const int col0 = u.pn * BM + wc * 32 + 8 * fq;
        const size_t r0 = (size_t)(u.pm * BM + wr * 64 + fr);
        u32x4 gw[2][2]; f32x4 tv[2][2][2];
#pragma unroll
        for (int bj = 0; bj < 2; ++bj) { gw[0][bj] = *(const u32x4*)(GT + r0 * ldg + goff + col0 + bj * HALF);
            if (MODE >= 1) { const float* tp = T + r0 * 2048 + col0 + bj * HALF; tv[0][bj][0] = *(const f32x4*)tp; tv[0][bj][1] = *(const f32x4*)(tp + 4); } }
#pragma unroll
        for (int gi = 0; gi < 8; ++gi) {
            const int ai = gi >> 2, m = gi & 3; const size_t row = r0 + ai * HALF + m * 16;
            if (gi < 7) { const size_t row2 = r0 + ((gi + 1) >> 2) * HALF + ((gi + 1) & 3) * 16;
#pragma unroll
                for (int bj = 0; bj < 2; ++bj) { gw[(gi + 1) & 1][bj] = *(const u32x4*)(GT + row2 * ldg + goff + col0 + bj * HALF);
                    if (MODE >= 1) { const float* tp = T + row2 * 2048 + col0 + bj * HALF; tv[(gi + 1) & 1][bj][0] = *(const f32x4*)tp; tv[(gi + 1) & 1][bj][1] = *(const f32x4*)(tp + 4); } } }
            asm volatile("" ::: "memory");
#pragma unroll
            for (int bj = 0; bj < 2; ++bj) {
                const u32x4 g4 = gw[gi & 1][bj];
                const f32x4 g0 = (f32x4){bflo(g4.x), bfhi(g4.x), bflo(g4.y), bfhi(g4.y)}, g1 = (f32x4){bflo(g4.z), bfhi(g4.z), bflo(g4.w), bfhi(g4.w)};
                f32x4 v0 = g0 * acc[ai][bj][m][0], v1 = g1 * acc[ai][bj][m][1];
                float* tp = T + row * 2048 + col0 + bj * HALF;
                if (MODE >= 1) { v0 += tv[gi & 1][bj][0]; v1 += tv[gi & 1][bj][1]; }
                if (MODE <= 1) { *(f32x4*)tp = v0; *(f32x4*)(tp + 4) = v1; }
                else { u32x4 w; w.x = cvt_pk_bf16(v0[0], v0[1]); w.y = cvt_pk_bf16(v0[2], v0[3]); w.z = cvt_pk_bf16(v1[0], v1[1]); w.w = cvt_pk_bf16(v1[2], v1[3]);
                    *(u32x4*)(O + row * 2048 + col0 + bj * HALF) = w; }
            }
            asm volatile("" ::: "memory");
        }
    }
};
struct EpiBranchFused {
    static constexpr bool PERM = true, AFTER_DRAIN = false, MID = true;
    static constexpr int H1 = 16, H2 = 32;
    const bf16_t* GT; int ldg; bf16_t* O;
    static __device__ __forceinline__ void unpack(const u32x4 g4, f32x4& g0, f32x4& g1) { g0 = (f32x4){bflo(g4.x), bfhi(g4.x), bflo(g4.y), bfhi(g4.y)}; g1 = (f32x4){bflo(g4.z), bfhi(g4.z), bflo(g4.w), bfhi(g4.w)}; }
    __device__ __forceinline__ void mid(f32x4 (&acc)[2][2][4][2], const Unit& u, int wr, int wc, int fr, int fq, bool second) const {
        const int col0 = u.pn * BM + wc * 32 + 8 * fq;
        const size_t r0 = (size_t)(u.pm * BM + wr * 64 + fr);
        const int on = second ? 2048 : 0, od = second ? 4096 : 2048;
        const float nfloor = second ? 1e-20f : 0.f;
        u32x4 gn[2][2], gd[2][2];
#pragma unroll
        for (int bj = 0; bj < 2; ++bj) { gn[0][bj] = *(const u32x4*)(GT + r0 * ldg + on + col0 + bj * HALF); gd[0][bj] = *(const u32x4*)(GT + r0 * ldg + od + col0 + bj * HALF); }
#pragma unroll
        for (int gi = 0; gi < 8; ++gi) {
            const int ai = gi >> 2, m = gi & 3;
            if (gi < 7) { const size_t row2 = r0 + ((gi + 1) >> 2) * HALF + ((gi + 1) & 3) * 16;
#pragma unroll
                for (int bj = 0; bj < 2; ++bj) { gn[(gi + 1) & 1][bj] = *(const u32x4*)(GT + row2 * ldg + on + col0 + bj * HALF); gd[(gi + 1) & 1][bj] = *(const u32x4*)(GT + row2 * ldg + od + col0 + bj * HALF); } }
            asm volatile("" ::: "memory");
#pragma unroll
            for (int bj = 0; bj < 2; ++bj) {
                f32x4 n0, n1, d0, d1; unpack(gn[gi & 1][bj], n0, n1); unpack(gd[gi & 1][bj], d0, d1);
#pragma unroll
                for (int j = 0; j < 4; ++j) {
                    acc[ai][bj][m][0][j] *= fmaxf(n0[j], nfloor) * __builtin_amdgcn_rcpf(fmaxf(d0[j], 1e-20f));
                    acc[ai][bj][m][1][j] *= fmaxf(n1[j], nfloor) * __builtin_amdgcn_rcpf(fmaxf(d1[j], 1e-20f)); }
            }
            asm volatile("" ::: "memory");
        }
    }
    __device__ __forceinline__ void operator()(const f32x4 (&acc)[2][2][4][2], const Unit& u, int wr, int wc, int fr, int fq) const {
        const int col0 = u.pn * BM + wc * 32 + 8 * fq;
        const size_t r0 = (size_t)(u.pm * BM + wr * 64 + fr);
        u32x4 gw[2][2];
#pragma unroll
        for (int bj = 0; bj < 2; ++bj) gw[0][bj] = *(const u32x4*)(GT + r0 * ldg + 4096 + col0 + bj * HALF);
#pragma unroll
        for (int gi = 0; gi < 8; ++gi) {
            const int ai = gi >> 2, m = gi & 3; const size_t row = r0 + ai * HALF + m * 16;
            if (gi < 7) { const size_t row2 = r0 + ((gi + 1) >> 2) * HALF + ((gi + 1) & 3) * 16;
#pragma unroll
                for (int bj = 0; bj < 2; ++bj) gw[(gi + 1) & 1][bj] = *(const u32x4*)(GT + row2 * ldg + 4096 + col0 + bj * HALF); }
            asm volatile("" ::: "memory");
#pragma unroll
            for (int bj = 0; bj < 2; ++bj) {
                f32x4 g0, g1; unpack(gw[gi & 1][bj], g0, g1);
                f32x4 v0, v1;
#pragma unroll
                for (int j = 0; j < 4; ++j) { v0[j] = acc[ai][bj][m][0][j] * fmaxf(g0[j], 1e-20f); v1[j] = acc[ai][bj][m][1][j] * fmaxf(g1[j], 1e-20f); }
                u32x4 w; w.x = cvt_pk_bf16(v0[0], v0[1]); w.y = cvt_pk_bf16(v0[2], v0[3]); w.z = cvt_pk_bf16(v1[0], v1[1]); w.w = cvt_pk_bf16(v1[2], v1[3]);
                *(u32x4*)(O + row * 2048 + col0 + bj * HALF) = w;
            }
            asm volatile("" ::: "memory");
        }
    }
};
template <int MODE> struct EpiLora {
    static constexpr bool PERM = true, AFTER_DRAIN = false;
    float* WD; bf16_t* OB; const float* bias; size_t dstride;
    __device__ __forceinline__ void operator()(const f32x4 (&acc)[2][2][4][2], const Unit& u, int wr, int wc, int fr, int fq) const {
        const int colg = u.pn * BM + wc * 32 + 8 * fq;
        f32x4 bv[2][2];
#pragma unroll
        for (int bj = 0; bj < 2; ++bj) { if (MODE != 2) { bv[bj][0] = *(const f32x4*)(bias + colg + bj * HALF); bv[bj][1] = *(const f32x4*)(bias + colg + bj * HALF + 4); } else { bv[bj][0] = (f32x4){0.f, 0.f, 0.f, 0.f}; bv[bj][1] = bv[bj][0]; } }
        EPI_ROWS_BEGIN
#pragma unroll
            for (int bj = 0; bj < 2; ++bj) { const int cg = colg + bj * HALF; const int dir = (MODE == 2) ? 0 : (cg >> 10); const int c = (MODE == 2) ? cg : (cg & 1023);
                f32x4 v0 = acc[ai][bj][m][0], v1 = acc[ai][bj][m][1];
                if (MODE != 2) { v0 += bv[bj][0]; v1 += bv[bj][1]; }
                if (MODE == 0) {
#pragma unroll
                    for (int j = 0; j < 4; ++j) { v0[j] = -fexp(-fsoftplus(-v0[j]) - 0.5f); v1[j] = -fexp(-fsoftplus(-v1[j]) - 0.5f); }
                    float* p = WD + (size_t)dir * dstride + (size_t)row * 1024 + c; *(f32x4*)p = v0; *(f32x4*)(p + 4) = v1;
                } else {
                    if (MODE == 1) {
#pragma unroll
                        for (int j = 0; j < 4; ++j) { v0[j] = fsigmoid(v0[j]); v1[j] = fsigmoid(v1[j]); } }
                    u32x4 w; w.x = cvt_pk_bf16(v0[0], v0[1]); w.y = cvt_pk_bf16(v0[2], v0[3]); w.z = cvt_pk_bf16(v1[0], v1[1]); w.w = cvt_pk_bf16(v1[2], v1[3]);
                    *(u32x4*)(OB + (size_t)dir * dstride + (size_t)row * 1024 + c) = w;
                }
            }
            asm volatile("" ::: "memory");
        EPI_ROWS_END
    }
};

template <class E, class = void> struct mid_hook { static constexpr bool value = false; };
template <class E> struct mid_hook<E, decltype((void)E::MID)> { static constexpr bool value = E::MID; };
template <class Epi, class Sched, bool ALIGN_EPI = false, bool SP2 = false>
__device__ __forceinline__ void gemm_phase(PG8_LAS unsigned char* lds, const Gemm g, const Sched& S, const Epi& E, int tid_in) {
    int tid_ = tid_in; asm volatile("" : "+v"(tid_));
    const int tid = tid_, wid = __builtin_amdgcn_readfirstlane(tid >> 6), lane = tid & 63, wr = wid >> 2, wc = wid & 3, fr = lane & 15, fq = lane >> 4;
    int K_ = g.K, lda_ = g.lda, ldb_ = g.ldb; asm volatile("" : "+s"(K_), "+s"(lda_), "+s"(ldb_));
    const int K = K_, nt = K / BK, lda = lda_, ldb = ldb_;
    int jt_ = g.jt, jb_ = g.jb; asm volatile("" : "+s"(jt_), "+s"(jb_));
    const int jt = jt_; const size_t jb = (size_t)jb_;
    unsigned voffA[2], voffB[2];
#pragma unroll
    for (int i = 0; i < 2; ++i) { int R, C; stage_rc(tid * 16 + i * 8192, R, C); const int Rb = Epi::PERM ? ((R & ~31) + perm32(R & 31)) : R;
        voffA[i] = (unsigned)(R * lda + C) * 2u; voffB[i] = (unsigned)(Rb * ldb + C) * 2u; }
    const size_t kstep = (size_t)(BK * 2);
    const size_t hsA = (size_t)HALF * lda * 2, hsB = (size_t)HALF * ldb * 2;
    const size_t tsA = 2 * hsA, tsB = 2 * hsB;
    const unsigned ldsw = (unsigned)wid * 1024u;
    const int aoff = lds_byte(wr * 64 + fr, fq * 8), boff = lds_byte(wc * 32 + fr, fq * 8);
#define PG8_SA(b, h) (((b) * 2 + (h)) * HTB)
#define PG8_SB(b, h) ((4 + (b) * 2 + (h)) * HTB)
#define PG8_STAGE(bufoff, gbase, voff) do { _Pragma("unroll") for (int _i = 0; _i < 2; ++_i) \
        __builtin_amdgcn_global_load_lds((const unsigned*)((const char*)(gbase) + (voff)[_i]), (PG8_LAS unsigned*)(lds + (bufoff) + ldsw + _i * 8192), 16, 0, 0); } while (0)
#define PG8_LDA(dst, b, h) do { _Pragma("unroll") for (int m = 0; m < 4; ++m) _Pragma("unroll") for (int k = 0; k < 2; ++k) dst[m][k] = *(const PG8_LAS bf16x8*)(lds + PG8_SA(b, h) + aoff + m * 2048 + k * 1024); } while (0)
#define PG8_LDB(dst, b, h) do { _Pragma("unroll") for (int n = 0; n < 2; ++n) _Pragma("unroll") for (int k = 0; k < 2; ++k) dst[n][k] = *(const PG8_LAS bf16x8*)(lds + PG8_SB(b, h) + boff + n * 2048 + k * 1024); } while (0)
#define PG8_MMA(ai, bj, At, Bt) do { __builtin_amdgcn_s_setprio(1); _Pragma("unroll") for (int m = 0; m < 4; ++m) _Pragma("unroll") for (int n = 0; n < 2; ++n) _Pragma("unroll") for (int k = 0; k < 2; ++k) \
        acc[ai][bj][m][n] = __builtin_amdgcn_mfma_f32_16x16x32_bf16(Bt[n][k], At[m][k], acc[ai][bj][m][n], 0, 0, 0); __builtin_amdgcn_s_setprio(0); } while (0)
#define PG8_WAIT_V(n) asm volatile("s_waitcnt vmcnt(" #n ")" ::: "memory")
#define PG8_WAIT_L(n) asm volatile("s_waitcnt lgkmcnt(" #n ")" ::: "memory")
#define PG8_BAR __builtin_amdgcn_s_barrier()
#define PG8_SCHED __builtin_amdgcn_sched_barrier(0)
    Unit cur, nxt; int ui = 0;
    if (!S.next(0, cur)) return;
    f32x4 acc[2][2][4][2];
#pragma unroll
    for (int a = 0; a < 2; ++a)
#pragma unroll
        for (int b = 0; b < 2; ++b)
#pragma unroll
            for (int m = 0; m < 4; ++m)
#pragma unroll
                for (int n = 0; n < 2; ++n) acc[a][b][m][n] = (f32x4){0.f, 0.f, 0.f, 0.f};
    bf16x8 At[4][2], B0[2][2], B1[2][2];
    const char* cA = (const char*)g.A + (size_t)cur.pm * tsA + (size_t)cur.kq * g.kqb; const char* cB = (const char*)g.Bt + (size_t)cur.pn * tsB + (size_t)cur.kq * g.kqb;
    S.a_ready(cur);
    if constexpr (SP2) {
        PG8_STAGE(PG8_SB(0, 0), cB, voffB); PG8_STAGE(PG8_SB(0, 1), cB + hsB, voffB); PG8_STAGE(PG8_SA(0, 0), cA, voffA); PG8_STAGE(PG8_SA(0, 1), cA + hsA, voffA);
        if (wr == 1) PG8_BAR;
        PG8_WAIT_V(2); PG8_BAR;
        PG8_STAGE(PG8_SB(1, 0), cB + kstep, voffB); PG8_STAGE(PG8_SA(1, 0), cA + kstep, voffA); PG8_STAGE(PG8_SB(1, 1), cB + hsB + kstep, voffB);
        PG8_WAIT_V(6); PG8_BAR;
    } else {
        PG8_STAGE(PG8_SB(0, 0), cB, voffB); PG8_STAGE(PG8_SA(0, 0), cA, voffA); PG8_STAGE(PG8_SB(0, 1), cB + hsB, voffB); PG8_STAGE(PG8_SA(0, 1), cA + hsA, voffA);
        if (wr == 1) PG8_BAR;
        PG8_WAIT_V(4); PG8_BAR;
        PG8_STAGE(PG8_SB(1, 0), cB + kstep, voffB); PG8_STAGE(PG8_SA(1, 0), cA + kstep, voffA); PG8_STAGE(PG8_SB(1, 1), cB + hsB + kstep, voffB);
        PG8_WAIT_V(6); PG8_BAR;
    }
    for (;;) {
        const bool has_next = S.next(ui + 1, nxt);
        const char* nA = has_next ? (const char*)g.A + (size_t)nxt.pm * tsA + (size_t)nxt.kq * g.kqb : cA; const char* nB = has_next ? (const char*)g.Bt + (size_t)nxt.pn * tsB + (size_t)nxt.kq * g.kqb : cB;
        for (int t = 0; t < nt; t += 2) {
            const bool last = (t == nt - 2);
            if constexpr (mid_hook<Epi>::value) { if (t == Epi::H1 || t == Epi::H2) E.mid(acc, cur, wr, wc, fr, fq, t == Epi::H2); }
            const char* a1 = cA + (size_t)(t + 1) * kstep + (t >= jt ? jb : 0);
            const char* a2 = last ? nA : cA + (size_t)(t + 2) * kstep + (t + 2 >= jt ? jb : 0); const char* b2 = last ? nB : cB + (size_t)(t + 2) * kstep;
            const char* a3 = a2 + kstep; const char* b3 = b2 + kstep;
            if (last && has_next) S.a_ready(nxt);
            if constexpr (SP2) {
            PG8_LDB(B0, 0, 0); PG8_LDB(B1, 0, 1); PG8_SCHED; PG8_LDA(At, 0, 0); PG8_STAGE(PG8_SA(1, 1), a1 + hsA, voffA);
            PG8_WAIT_V(8); PG8_WAIT_L(0); PG8_BAR; PG8_MMA(0, 0, At, B0); PG8_MMA(0, 1, At, B1); PG8_BAR; PG8_SCHED;
            PG8_LDA(At, 0, 1); PG8_STAGE(PG8_SB(0, 0), b2, voffB); PG8_STAGE(PG8_SB(0, 1), b2 + hsB, voffB); PG8_STAGE(PG8_SA(0, 0), a2, voffA);
            PG8_WAIT_V(8); PG8_WAIT_L(0); PG8_BAR; PG8_MMA(1, 0, At, B0); PG8_MMA(1, 1, At, B1); PG8_BAR; PG8_SCHED;
            PG8_LDB(B0, 1, 0); PG8_LDB(B1, 1, 1); PG8_SCHED; PG8_LDA(At, 1, 0); PG8_STAGE(PG8_SA(0, 1), a2 + hsA, voffA);
            PG8_WAIT_V(8); PG8_WAIT_L(0); PG8_BAR; PG8_MMA(0, 0, At, B0); PG8_MMA(0, 1, At, B1); PG8_BAR; PG8_SCHED;
            PG8_LDA(At, 1, 1); PG8_STAGE(PG8_SB(1, 0), b3, voffB); PG8_STAGE(PG8_SB(1, 1), b3 + hsB, voffB); PG8_STAGE(PG8_SA(1, 0), a3, voffA);
            PG8_WAIT_V(8); PG8_WAIT_L(0); PG8_BAR; PG8_MMA(1, 0, At, B0); PG8_MMA(1, 1, At, B1); PG8_BAR; PG8_SCHED;
            } else {
            PG8_LDB(B0, 0, 0); PG8_SCHED; PG8_LDA(At, 0, 0); PG8_STAGE(PG8_SA(1, 1), a1 + hsA, voffA);
            PG8_WAIT_L(8); PG8_BAR; PG8_WAIT_L(0); PG8_MMA(0, 0, At, B0); PG8_BAR; PG8_SCHED;
            PG8_LDB(B1, 0, 1); PG8_STAGE(PG8_SB(0, 0), b2, voffB);
            PG8_BAR; PG8_WAIT_L(0); PG8_MMA(0, 1, At, B1); PG8_BAR;
            PG8_LDA(At, 0, 1); PG8_STAGE(PG8_SA(0, 0), a2, voffA);
            PG8_BAR; PG8_WAIT_L(0); PG8_MMA(1, 0, At, B0); PG8_BAR; PG8_SCHED;
            PG8_STAGE(PG8_SB(0, 1), b2 + hsB, voffB);
            PG8_WAIT_V(6); PG8_BAR; PG8_MMA(1, 1, At, B1); PG8_BAR;
            PG8_LDB(B0, 1, 0); PG8_SCHED; PG8_LDA(At, 1, 0); PG8_STAGE(PG8_SA(0, 1), a2 + hsA, voffA);
            PG8_WAIT_L(8); PG8_BAR; PG8_WAIT_L(0); PG8_MMA(0, 0, At, B0); PG8_BAR; PG8_SCHED;
            PG8_LDB(B1, 1, 1); PG8_STAGE(PG8_SB(1, 0), b3, voffB);
            PG8_BAR; PG8_WAIT_L(0); PG8_MMA(0, 1, At, B1); PG8_BAR;
            PG8_LDA(At, 1, 1); PG8_STAGE(PG8_SA(1, 0), a3, voffA);
            PG8_BAR; PG8_WAIT_L(0); PG8_MMA(1, 0, At, B0); PG8_BAR; PG8_SCHED;
            PG8_STAGE(PG8_SB(1, 1), b3 + hsB, voffB);
            PG8_WAIT_V(6); PG8_BAR; PG8_MMA(1, 1, At, B1); PG8_BAR;
            }
        }
        if constexpr (ALIGN_EPI) { if (wr == 0) PG8_BAR; }
        if constexpr (!Epi::AFTER_DRAIN) { E(acc, cur, wr, wc, fr, fq); S.done(cur); }
        if (!has_next) break;
#pragma unroll
        for (int a = 0; a < 2; ++a)
#pragma unroll
            for (int b = 0; b < 2; ++b)
#pragma unroll
                for (int m = 0; m < 4; ++m)
#pragma unroll
                    for (int n = 0; n < 2; ++n) acc[a][b][m][n] = (f32x4){0.f, 0.f, 0.f, 0.f};
        cur = nxt; cA = nA; cB = nB; ++ui;
        if constexpr (ALIGN_EPI) { if (wr == 1) PG8_BAR; }
    }
    PG8_WAIT_V(0);
    if constexpr (!ALIGN_EPI) { if (wr == 0) PG8_BAR; }
    PG8_BAR;
    if constexpr (Epi::AFTER_DRAIN) { E.fused(acc, cur, wr, wc, fr, fq, lds, wid, lane); S.done(cur); }
#undef PG8_SA
#undef PG8_SB
#undef PG8_STAGE
#undef PG8_LDA
#undef PG8_LDB
#undef PG8_MMA
#undef PG8_WAIT_V
#undef PG8_WAIT_L
#undef PG8_BAR
#undef PG8_SCHED
}
}

#undef EPI_ROWS_BEGIN
#undef EPI_ROWS_END

constexpr int D = 2048, NB = 8, SEQ = 2048, CL = 256, ML = NB * SEQ, MC = NB * CL, MT = ML + MC;
constexpr int FF = 5632, NMOD = 9, DEPTH = 2;
constexpr int NIN_SRC = 17568;
constexpr int ZA_LD = 4608;
constexpr int OC_RW = 1536, OC_GL = 2560;
constexpr int ZA_W = 1536, ZR_W = 3840, ZG_W = 6144, GT_W = 6144, NMIX = ZA_W + ZR_W + ZG_W  , NIN = NMIX + GT_W  ;
constexpr int RW_COLS = 3712, LA_W = 768;
constexpr float LN_EPS = 1e-5f, ALPHA = 1.41421356237f;
static_assert(ALPHA == pg8::RES_ALPHA, "residual scale");
constexpr int NWAVES = 8, NTHR = 512;

constexpr size_t MiB = 1u << 20;
constexpr size_t WS_CTL = 0, CTL_ZERO_BYTES = 1 * MiB;
constexpr size_t WS_MODS = 1 * MiB;
constexpr size_t WS_STATS = 3 * MiB;
constexpr size_t WS_XC = 4 * MiB;
constexpr size_t WS_HB = 20 * MiB;
constexpr size_t WS_WM = 92 * MiB;
constexpr size_t WM_IN = 0, WM_BA = 69 * MiB, WM_BR = 73 * MiB, WM_BG = 77 * MiB, WM_OUT = 85 * MiB, WM_LW = 93 * MiB, WM_LA = 94 * MiB, WM_LG = 95 * MiB;
constexpr size_t WS_R = 188 * MiB;
constexpr size_t R_WGU = 0, R_WDN = 44 * MiB, R_H = 66 * MiB;
constexpr size_t R_ZA = 0;
constexpr size_t R_ZR = 162 * MiB;
constexpr size_t R_AA = 297 * MiB;
constexpr size_t R_Y = 369 * MiB;
constexpr size_t R_G = 513 * MiB;
constexpr size_t R_ZG = 549 * MiB;
constexpr size_t R_YG = 765 * MiB;
constexpr size_t R_QR = 909 * MiB;
constexpr size_t R_KR = 941 * MiB;
constexpr size_t R_LA = 949 * MiB;
constexpr size_t R_WDEC = 976 * MiB;
constexpr size_t R_GL = 1120 * MiB;
constexpr size_t R_GT = R_QR;
constexpr size_t R_MG = R_Y;
constexpr size_t R_PART = 600 * MiB;
constexpr size_t R_BS = 1192 * MiB;
constexpr size_t R_END = 1195 * MiB;
constexpr size_t WS_END = WS_R + R_END;
static_assert(R_GT + (size_t)MT * GT_W * 2 <= R_END, "GT overlay");
static_assert(WS_END <= (size_t)1408 * MiB, "workspace budget");
static_assert(R_H + (size_t)MT * FF * 2 <= R_END, "H fits");

#ifndef MK_EARLY_WB
#define MK_EARLY_WB 0
#endif
#define XB_TMO      128
#define XB_XCNT(j)  (256  + 64 * (j))
#define XB_XSUB(j)  (1280 + 64 * (j))
#define XB_XGEN(j)  (2304 + 64 * (j))
#define XB_TOP      3328
#define XB_TOPGEN   3392
#define XCD_BAR_WORDS 3456
#define XB_SPIN_CAP (1u << 18)
__device__ __forceinline__ unsigned xb_ld(unsigned* p)              { return __hip_atomic_load(p, __ATOMIC_RELAXED, __HIP_MEMORY_SCOPE_AGENT); }
__device__ __forceinline__ unsigned xb_add(unsigned* p, unsigned v) { return __hip_atomic_fetch_add(p, v, __ATOMIC_RELAXED, __HIP_MEMORY_SCOPE_AGENT); }
__device__ __forceinline__ unsigned xb_xcc_id() { return (unsigned)__builtin_amdgcn_s_getreg((3 << 11) | 20) & 0xFu; }
#define XB_SPIN(cond, bar) do { unsigned _sp = 0; while (cond) { __builtin_amdgcn_s_sleep(1); \
    if ((++_sp & 255u) == 0u) { if (xb_ld(&(bar)[XB_TMO])) break; if (_sp > XB_SPIN_CAP) { atomicAdd(&(bar)[XB_TMO], 1u); break; } } } } while (0)
struct XcdBarrier { unsigned* bar; unsigned x; volatile LAS unsigned* st; };
__device__ __forceinline__ XcdBarrier xcd_barrier_post(unsigned* bar, volatile LAS unsigned* st, int tid) {
    XcdBarrier b; b.bar = bar; b.x = xb_xcc_id(); b.st = st;
    if (tid == 0) (void)xb_add(&bar[XB_XCNT(b.x)], 1u);
    return b;
}
__device__ __forceinline__ void xcd_barrier_complete(unsigned* bar, unsigned x, unsigned& nloc, unsigned& nx) {
    const unsigned G = gridDim.x * gridDim.y * gridDim.z;
    unsigned sum, cnt, mine, sp = 0u;
    for (;;) {
        sum = 0u; cnt = 0u; mine = 0u;
#pragma unroll
        for (unsigned j = 0; j < 16; ++j) { const unsigned c = xb_ld(&bar[XB_XCNT(j)]); sum += c; cnt += (c > 0u) ? 1u : 0u; mine = (j == x) ? c : mine; }
        if (sum == G) break;
        __builtin_amdgcn_s_sleep(1);
        if ((++sp & 255u) == 0u) { if (xb_ld(&bar[XB_TMO])) break; if (sp > XB_SPIN_CAP) { atomicAdd(&bar[XB_TMO], 1u); break; } }
    }
    nloc = mine > 0u ? mine : 1u; nx = cnt > 0u ? cnt : 1u;
}
__device__ __forceinline__ void xcd_barrier(const XcdBarrier& b, int tid) {
    asm volatile("s_waitcnt vmcnt(0)" ::: "memory");
    __syncthreads();
    if (tid == 0) {
        unsigned* bar = b.bar; unsigned bx = b.x;
        asm volatile("" : "+s"(bar), "+s"(bx));
        __builtin_amdgcn_s_waitcnt(0);
        unsigned nloc = b.st[0], nx = b.st[1];
        if (nloc == 0u) { xcd_barrier_complete(bar, bx, nloc, nx); b.st[0] = nloc; b.st[1] = nx; }
#if MK_EARLY_WB
        __builtin_amdgcn_fence(__ATOMIC_RELEASE, "agent");
        asm volatile("s_waitcnt vmcnt(0)" ::: "memory");
#endif
        const unsigned old = xb_add(&bar[XB_XSUB(bx)], 1u);
        const unsigned gen = old / nloc;
        if (old + 1u == (gen + 1u) * nloc) {
            __builtin_amdgcn_fence(__ATOMIC_RELEASE, "agent");
            asm volatile("s_waitcnt vmcnt(0)" ::: "memory");
            const unsigned og = xb_add(&bar[XB_TOP], 1u);
            const unsigned tg = og / nx;
            if (og + 1u == (tg + 1u) * nx) xb_add(&bar[XB_TOPGEN], 1u);
            else XB_SPIN(xb_ld(&bar[XB_TOPGEN]) == tg, bar);
            __builtin_amdgcn_fence(__ATOMIC_ACQUIRE, "agent");
            xb_add(&bar[XB_XGEN(bx)], 1u);
            asm volatile("s_waitcnt vmcnt(0)" ::: "memory");
        } else {
            XB_SPIN(xb_ld(&bar[XB_XGEN(bx)]) == gen, bar);
            __builtin_amdgcn_fence(__ATOMIC_ACQUIRE, "agent");
            asm volatile("s_waitcnt vmcnt(0)" ::: "memory");
        }
    }
    __syncthreads();
}

constexpr int RING_BYTES = 143360;
constexpr int LDSCTL_OFF = RING_BYTES, MISC_OFF = LDSCTL_OFF + 320;
constexpr int LDS_BYTES = 147456;

struct Args { const float* in[30]; float* out; unsigned char* ws; int ph_lo, ph_hi; };
#define CAS __attribute__((address_space(4)))
typedef const CAS Args& ArgsRef;

struct Frame {
    LAS unsigned char* lds;
    int tid, lane, wave, G, bid;
    const float* const* in;
    GAS float* out; GAS unsigned char* ws;
};
#define AIN(i) ((const float*)(const GAS float*)A.in[i])
#define WSP(T, off) ((T*)(F.ws + (off)))
#define RGN(T, off) ((T*)(F.ws + WS_R + (off)))
__device__ __forceinline__ float* xrow(const Frame& F, int m) { return m < ML ? (float*)(F.out + (size_t)m * D) : WSP(float, WS_XC) + (size_t)(m - ML) * D; }

__device__ __forceinline__ void tr_item(const float* W, int N, bf16* WT, int ldk, int k0, int scol0, int drow0, LAS float* scr, int lane) {
    if (scol0 >= 0) {
#pragma unroll 8
        for (int i = 0; i < 32; ++i) { const int kk = 2 * i + (lane >> 5); scr[kk * 33 + (lane & 31)] = W[(size_t)(k0 + kk) * N + scol0 + (lane & 31)]; }
    } else {
#pragma unroll 8
        for (int i = 0; i < 32; ++i) { const int kk = 2 * i + (lane >> 5); scr[kk * 33 + (lane & 31)] = 0.f; }
    }
    asm volatile("s_waitcnt vmcnt(0) lgkmcnt(0)" ::: "memory");
    const int c = lane & 7;
#pragma unroll
    for (int j = 0; j < 4; ++j) { const int n = (lane >> 3) + 8 * j; const LAS float* s = scr + (8 * c) * 33 + n;
        v4u o; o.x = pk2(s[0 * 33], s[1 * 33]); o.y = pk2(s[2 * 33], s[3 * 33]); o.z = pk2(s[4 * 33], s[5 * 33]); o.w = pk2(s[6 * 33], s[7 * 33]);
        *(v4u*)(WT + (size_t)(drow0 + n) * ldk + k0 + 8 * c) = o; }
    asm volatile("s_waitcnt lgkmcnt(0)" ::: "memory");
}
struct MapIdent { __device__ __forceinline__ int operator()(int drow) const { return drow; } };
struct MapGU { __device__ __forceinline__ int operator()(int drow) const { const int pn = drow >> 8, bj = (drow >> 7) & 1, i = drow & 127; return bj * FF + pn * 128 + i; } };
struct MapWin { __device__ __forceinline__ int operator()(int drow) const {
    if (drow < 5248) return drow;
    if (drow < 5280) return 11392 + (drow - 5248);
    if (drow < 5376) return -1;
    if (drow < 11520) return 5248 + (drow - 5376);
    return 11424 + (drow - 11520);
} };
template <class MAP> __device__ __forceinline__ void conv_matrix(const Frame& F, const float* W, int K, int N, bf16* WT, int NT, const MAP& mp, int& item0, int gw, int NGW, int ldk = 0) {
    LAS float* scr = (LAS float*)(F.lds + F.wave * 16384);
    const int nblk = NT / 32, nitems = (K / 64) * nblk;
    int first = ((gw - item0) % NGW + NGW) % NGW;
    for (int it = first; it < nitems; it += NGW) { const int kb = it / nblk, nb = it % nblk; tr_item(W, N, WT, ldk ? ldk : K, kb * 64, mp(nb * 32), nb * 32, scr, F.lane); }
    item0 += nitems;
}

__device__ __forceinline__ int seq_row(int b, int dir, int p, int& idx, int& len) {
    if (p < CL) { idx = dir ? (CL - 1 - p) : p; len = CL; return ML + b * CL + idx; }
    const int q = p - CL; idx = dir ? (SEQ - 1 - q) : q; len = SEQ; return b * SEQ + idx;
}

__device__ __forceinline__ void phase_init(const Frame& F, ArgsRef A) {
    const float* c = AIN(1); const float* cctx = AIN(3); const float* ada_w = AIN(4); const float* ada_b = AIN(5);
    float* mods = WSP(float, WS_MODS);
    LAS float* sc = (LAS float*)F.lds;
    LAS float* red = sc + 9 * 2048;
    for (int i = F.tid; i < 9 * 2048; i += NTHR) { const int bs = i >> 11, k = i & 2047; const float v = bs < 8 ? c[bs * 2048 + k] : cctx[k]; sc[i] = fsilu(v); }
    __syncthreads();
    for (int item = F.bid; item < 2 * 144; item += F.G) {
        const int l = item / 144, cb = item % 144, col = cb * 128 + 2 * F.lane;
        float a0[9], a1[9];
#pragma unroll
        for (int bs = 0; bs < 9; ++bs) { a0[bs] = 0.f; a1[bs] = 0.f; }
        const float* wp = ada_w + ((size_t)l * 2048 + F.wave * 256) * 18432 + col;
        const LAS float* sp = sc + F.wave * 256;
#pragma unroll 8
        for (int k = 0; k < 256; ++k) { const f32x2 w = *(const f32x2*)(wp + (size_t)k * 18432);
#pragma unroll
            for (int bs = 0; bs < 9; ++bs) { const float s = sp[bs * 2048 + k]; a0[bs] += s * w.x; a1[bs] += s * w.y; } }
#pragma unroll
        for (int bs = 0; bs < 9; ++bs) { red[(F.wave * 9 + bs) * 128 + 2 * F.lane] = a0[bs]; red[(F.wave * 9 + bs) * 128 + 2 * F.lane + 1] = a1[bs]; }
        __syncthreads();
        for (int o = F.tid; o < 9 * 128; o += NTHR) { const int bs = o >> 7, cc = o & 127; float s = ada_b[l * 18432 + cb * 128 + cc];
#pragma unroll
            for (int w = 0; w < 8; ++w) s += red[(w * 9 + bs) * 128 + cc];
            mods[((size_t)l * 9 + bs) * 18432 + cb * 128 + cc] = s; }
        __syncthreads();
    }
}

template <bool POST, bool MODH, bool WX = false>
__device__ __forceinline__ void phase_ln(const Frame& F, int nrows, const float* g, const float* b, const float* mods_l, int kshift, int kscale, const float* part = nullptr, const float* pmod = nullptr, float pcoef = 0.f, const float* src_l = nullptr, const float* src_c = nullptr) {
    const int gw = F.bid * NWAVES + F.wave, NGW = F.G * NWAVES;
    bf16* HB = WSP(bf16, WS_HB);
    for (int m = gw; m < nrows; m += NGW) {
        float* xr = xrow(F, m);
        const float* xs = (m < ML) ? (src_l ? src_l + (size_t)m * D : xr) : (src_c ? src_c + (size_t)(m - ML) * D : xr);
        f32x4 v[8];
#pragma unroll
        for (int j = 0; j < 8; ++j) v[j] = ((const f32x4*)xs)[F.lane + 64 * j];
        if (POST && part != nullptr && m >= ML) {
            const f32x4* pp = (const f32x4*)(part + (size_t)(m - ML) * D);
#pragma unroll
            for (int j = 0; j < 8; ++j) { const int o = F.lane + 64 * j; const f32x4 ps = (pp[o] + pp[o + (size_t)MC * D / 4]) + (pp[o + 2 * ((size_t)MC * D / 4)] + pp[o + 3 * ((size_t)MC * D / 4)]);
                v[j] = v[j] * ALPHA + ((const f32x4*)pmod)[o] * pcoef * ps; }
        }
        if (POST) {
            float s = 0.f;
#pragma unroll
            for (int j = 0; j < 8; ++j) s += (v[j].x + v[j].y) + (v[j].z + v[j].w);
            const float mean = wave_sum(s) * (1.f / D); float s2 = 0.f;
#pragma unroll
            for (int j = 0; j < 8; ++j) { v[j] = v[j] - mean; s2 += (v[j].x * v[j].x + v[j].y * v[j].y) + (v[j].z * v[j].z + v[j].w * v[j].w); }
            const float rstd = 1.f / sqrtf(wave_sum(s2) * (1.f / D) + LN_EPS);
#pragma unroll
            for (int j = 0; j < 8; ++j) { const f32x4 gg = ((const f32x4*)g)[F.lane + 64 * j], bb = ((const f32x4*)b)[F.lane + 64 * j]; v[j] = v[j] * rstd * gg + bb; if (WX || m >= ML) ((f32x4*)xr)[F.lane + 64 * j] = v[j]; }
            if (!WX && m < ML && F.lane == 0) *(v2f*)(WSP(float, WS_STATS) + 2 * m) = (v2f){mean, rstd};
        }
        if (MODH) {
            float s = 0.f;
#pragma unroll
            for (int j = 0; j < 8; ++j) s += (v[j].x + v[j].y) + (v[j].z + v[j].w);
            const float mean = wave_sum(s) * (1.f / D); float s2 = 0.f;
#pragma unroll
            for (int j = 0; j < 8; ++j) { v[j] = v[j] - mean; s2 += (v[j].x * v[j].x + v[j].y * v[j].y) + (v[j].z * v[j].z + v[j].w * v[j].w); }
            const float rstd = 1.f / sqrtf(wave_sum(s2) * (1.f / D) + LN_EPS);
            const int bsel = m < ML ? (m >> 11) : 8;
            const f32x4* shp = (const f32x4*)(mods_l + (size_t)bsel * 18432 + kshift * 2048);
            const f32x4* scp = (const f32x4*)(mods_l + (size_t)bsel * 18432 + kscale * 2048);
            v2u* hp = (v2u*)(HB + (size_t)m * D);
#pragma unroll
            for (int j = 0; j < 8; ++j) { const f32x4 sh = shp[F.lane + 64 * j], scl = scp[F.lane + 64 * j]; const f32x4 o = v[j] * rstd * (scl + 1.0f) + sh;
                v2u w; w.x = pk2(o.x, o.y); w.y = pk2(o.z, o.w); hp[F.lane + 64 * j] = w; }
        }
    }
}

__device__ __forceinline__ void phase_convert(const Frame& F, ArgsRef A, int l, int ffn_i, int which) {
    const int gw = F.bid * NWAVES + F.wave, NGW = F.G * NWAVES; int item0 = 0;
    if (which & 1) {
        conv_matrix(F, AIN(8) + ((size_t)l * 2 + ffn_i) * D * (2 * FF), D, 2 * FF, RGN(bf16, R_WGU), 2 * FF, MapGU(), item0, gw, NGW);
        conv_matrix(F, AIN(9) + ((size_t)l * 2 + ffn_i) * FF * D, FF, D, RGN(bf16, R_WDN), D, MapIdent(), item0, gw, NGW);
    }
    if (which & 2) {
        conv_matrix(F, AIN(10) + (size_t)l * D * NIN_SRC, D, NIN_SRC, WSP(bf16, WS_WM + WM_IN), NIN, MapWin(), item0, gw, NGW);
        conv_matrix(F, AIN(26) + (size_t)l * 1024 * D, 1024, D, WSP(bf16, WS_WM + WM_BA), D, MapIdent(), item0, gw, NGW, 4096);
        conv_matrix(F, AIN(27) + (size_t)l * 1024 * D, 1024, D, WSP(bf16, WS_WM + WM_BA) + 1024, D, MapIdent(), item0, gw, NGW, 4096);
        conv_matrix(F, AIN(28) + (size_t)l * D * D, D, D, WSP(bf16, WS_WM + WM_BA) + 2048, D, MapIdent(), item0, gw, NGW, 4096);
        conv_matrix(F, AIN(29) + (size_t)l * D * D, D, D, WSP(bf16, WS_WM + WM_OUT), D, MapIdent(), item0, gw, NGW);
        const float* w2 = AIN(14) + (size_t)l * 2 * 96 * 1024; const float* a2 = AIN(16) + (size_t)l * 2 * 96 * 1024; const float* g2 = AIN(17) + (size_t)l * 256 * 1024;
        bf16* LW = WSP(bf16, WS_WM + WM_LW); bf16* LAw = WSP(bf16, WS_WM + WM_LA); bf16* LG = WSP(bf16, WS_WM + WM_LG);
        for (int e = F.bid * NTHR + F.tid; e < 2048 * 256; e += F.G * NTHR) { const int n = e >> 8, k = e & 255, dir = n >> 10, cc = n & 1023;
            const int kk = k - dir * 96; const bool liv = kk >= 0 && kk < 96;
            LW[e] = liv ? (bf16)f2bf(w2[((size_t)dir * 96 + kk) * 1024 + cc]) : (bf16)0;
            LAw[e] = liv ? (bf16)f2bf(a2[((size_t)dir * 96 + kk) * 1024 + cc]) : (bf16)0;
            if (n < 1024) LG[e] = (bf16)f2bf(g2[(size_t)k * 1024 + n]); }
    }
    __syncthreads();
}

__device__ __forceinline__ float red16s(float v) { v += dppf<0xB1, 0xF>(v); v += dppf<0x4E, 0xF>(v); v += dppf<0x141, 0xF>(v); v += dppf<0x140, 0xF>(v); return v; }
__device__ __forceinline__ void phase_prep(const Frame& F, ArgsRef A, int l) {
    const int gw = F.bid * NWAVES + F.wave, NGW = F.G * NWAVES, lane = F.lane;
    const bf16* ZA = RGN(bf16, R_ZA); bf16* QR = RGN(bf16, R_QR); bf16* KR = RGN(bf16, R_KR);
    const bf16* ZR = RGN(bf16, R_ZR); bf16* LA = RGN(bf16, R_LA); unsigned* GL = RGN(unsigned, R_GL);
    {
        const int f2 = 2 * (lane & 15), axis = (lane >> 4) & 1, hs = lane >> 5;
        const float invf0 = exp2f(-(float)f2 * (13.287712379549449f / 32.0f)), invf1 = exp2f(-(float)(f2 + 1) * (13.287712379549449f / 32.0f));
        for (int m = gw; m < ML; m += NGW) {
            const int t = m & (SEQ - 1);
            const float pos = axis == 0 ? (float)(t >> 6) : (float)(t & 63);
            const float a0 = pos * invf0, a1 = pos * invf1; const float sn0 = __sinf(a0), cs0 = __cosf(a0), sn1 = __sinf(a1), cs1 = __cosf(a1);
            const bf16* zr = ZA + (size_t)m * ZA_LD + hs * 128 + axis * 64 + f2;
#pragma unroll
            for (int hp = 0; hp < 5; ++hp) {
                const unsigned w1 = *(const unsigned*)(zr + hp * 256), w2 = *(const unsigned*)(zr + hp * 256 + 32);
                const float x10 = bflo(w1), x11 = bfhi(w1), x20 = bflo(w2), x21 = bfhi(w2);
                const unsigned o1 = pk2(x10 * cs0 - x20 * sn0, x11 * cs1 - x21 * sn1), o2 = pk2(x20 * cs0 + x10 * sn0, x21 * cs1 + x11 * sn1);
                const int hh = 2 * hp + hs;
                bf16* dst = hh < 8 ? QR + (size_t)m * 1024 + hh * 128 + axis * 64 + f2 : KR + (size_t)m * 256 + (hh - 8) * 128 + axis * 64 + f2;
                *(unsigned*)dst = o1; *(unsigned*)(dst + 32) = o2;
            }
        }
    }
    {
        const float* cw = AIN(12) + (size_t)l * 3 * RW_COLS;
        float t0[6][2], t1[6][2], t2[6][2]; int scol[6];
#pragma unroll
        for (int it = 0; it < 6; ++it) { const int j = 2 * (lane + 64 * it), sec = j >> 8, jj = j & 255; const bool live = sec == 2 || jj < 192;
            scol[it] = live ? (sec == 0 ? 3072 : sec == 1 ? 3264 : 3456) + jj : -1;
#pragma unroll
            for (int e = 0; e < 2; ++e) { t0[it][e] = live ? cw[scol[it] + e] : 0.f; t1[it][e] = live ? cw[RW_COLS + scol[it] + e] : 0.f; t2[it][e] = live ? cw[2 * RW_COLS + scol[it] + e] : 0.f; } }
        for (int m = gw; m < MT; m += NGW) {
            int idx, len; if (m < ML) { idx = m & (SEQ - 1); len = SEQ; } else { idx = (m - ML) & (CL - 1); len = CL; }
            const float fl = idx > 0 ? 1.f : 0.f, fr = idx < len - 1 ? 1.f : 0.f;
            const bf16* z0 = ZR + (size_t)m * ZR_W; const bf16* zl = idx > 0 ? z0 - ZR_W : z0; const bf16* zrr = idx < len - 1 ? z0 + ZR_W : z0;
#pragma unroll
            for (int it = 0; it < 6; ++it) {
                unsigned o = 0u;
                if (scol[it] >= 0) {
                    const unsigned wc = *(const unsigned*)(z0 + scol[it]), wl = *(const unsigned*)(zl + scol[it]), wr = *(const unsigned*)(zrr + scol[it]);
                    float c0 = bflo(wc) * t1[it][0] + fl * bflo(wl) * t0[it][0] + fr * bflo(wr) * t2[it][0];
                    float c1 = bfhi(wc) * t1[it][1] + fl * bfhi(wl) * t0[it][1] + fr * bfhi(wr) * t2[it][1];
                    const int sec = it >> 1;
                    if (sec == 0) { c0 = ftanh(c0); c1 = ftanh(c1); } else if (sec == 2) { c0 = fsigmoid(c0); c1 = fsigmoid(c1); }
                    o = pk2(c0, c1);
                }
                *(unsigned*)(LA + (size_t)m * LA_W + 2 * (lane + 64 * it)) = o;
            }
        }
    }
    {
        __syncthreads();
        LAS unsigned short* TW = (LAS unsigned short*)F.lds;
        LAS float* TB = (LAS float*)(F.lds + 65536);
        const float* wa2 = AIN(23) + (size_t)l * 2 * 16 * 1024; const float* ba = AIN(24) + (size_t)l * 2 * 1024;
        for (int e = F.tid; e < 2 * 16 * 1024; e += NTHR) { const int dr = e >> 10, cc = e & 1023, dir = dr >> 4, r = dr & 15; TW[(dir * 1024 + cc) * 16 + r] = (unsigned short)f2bf(wa2[e]); }
        for (int e = F.tid; e < 2048; e += NTHR) TB[e] = ba[e];
        __syncthreads();
        const int l16 = lane & 15, g = lane >> 4;
        bf16* GLb = RGN(bf16, R_GL);
        const f32x4 zero4 = (f32x4){0.f, 0.f, 0.f, 0.f};
        for (int item = gw; item < (MT / 16) * 4; item += NGW) {
            const int rb = item >> 2, qq = item & 3, m = rb * 16 + l16;
            const bf16x8 af = *(const bf16x8*)(ZR + (size_t)m * ZR_W + 3712 + 8 * g);
            const int dir = qq >> 1;
            const bool live = (g >> 1) == dir;
            bf16* gp = GLb + ((size_t)dir * MT + m) * 1024 + ((512 * qq) & 1023) + 8 * g;
#pragma unroll 4
            for (int q = 0; q < 16; ++q) {
                const int ch0 = 512 * qq + 32 * q;
                const unsigned wa_ = (unsigned)((ch0 + 8 * (l16 >> 2) + (l16 & 3)) * 32 + (g & 1) * 16);
                bf16x8 w0 = *(const LAS bf16x8*)((LAS unsigned char*)TW + wa_), w1 = *(const LAS bf16x8*)((LAS unsigned char*)TW + wa_ + 4 * 32);
                if (!live) { w0 = (bf16x8){0, 0, 0, 0, 0, 0, 0, 0}; w1 = w0; }
                const f32x4 d0 = __builtin_amdgcn_mfma_f32_16x16x32_bf16(w0, af, zero4, 0, 0, 0), d1 = __builtin_amdgcn_mfma_f32_16x16x32_bf16(w1, af, zero4, 0, 0, 0);
                const f32x4 b0 = *(const LAS f32x4*)(TB + ch0 + 8 * g), b1 = *(const LAS f32x4*)(TB + ch0 + 8 * g + 4);
                float o[8];
#pragma unroll
                for (int r = 0; r < 4; ++r) { o[r] = -fsoftplus(-(d0[r] + b0[r])) * 0.0625f; o[4 + r] = -fsoftplus(-(d1[r] + b1[r])) * 0.0625f; }
                *(v4u*)(gp + 32 * q) = (v4u){pk2(o[0], o[1]), pk2(o[2], o[3]), pk2(o[4], o[5]), pk2(o[6], o[7])};
            }
        }
        __syncthreads();
    }
}

__device__ __forceinline__ unsigned opq(unsigned x) { asm volatile("" : "+v"(x)); return x; }
__device__ __forceinline__ bf16x8 pack8(const f32x4& a, const f32x4& b) {
    v4u w; w.x = pg8::cvt_pk_bf16(a[0], a[1]); w.y = pg8::cvt_pk_bf16(a[2], a[3]); w.z = pg8::cvt_pk_bf16(b[0], b[1]); w.w = pg8::cvt_pk_bf16(b[2], b[3]);
    return __builtin_bit_cast(bf16x8, w);
}
typedef short s16x4 __attribute__((ext_vector_type(4)));
__device__ __forceinline__ bf16x8 tr8(LAS unsigned char* L, unsigned a0, unsigned a1) {
    const s16x4 x = __builtin_amdgcn_ds_read_tr16_b64_v4i16((LAS s16x4*)(L + a0)), y = __builtin_amdgcn_ds_read_tr16_b64_v4i16((LAS s16x4*)(L + a1));
    return __builtin_shufflevector(x, y, 0, 1, 2, 3, 4, 5, 6, 7);
}
constexpr int RC_LD = 72;
constexpr int RC_QP = 0, RC_RT = 9216, RC_KD = 18432, RC_KA = 27648, RC_KDT = 36864, RC_KAT = 46080, RC_VT = 55296, RC_MKA = 64512, RC_MKD = 73728, RC_NKA = 82944, RC_NKD = 92160,
              RC_DG = 101376, RC_TB = 105472, RC_EB = 107520, RC_TQ = 107776, RC_BI = 109824, RC_END = 126208;
static_assert(RC_END <= RING_BYTES, "RWKV LDS map");
#define LD_(T, addr) (*(const LAS T*)(L + (addr)))
#define ST_(T, addr) (*(LAS T*)(L + (addr)))
__device__ __forceinline__ bf16x8 kperm(LAS unsigned char* L, unsigned addr) {
    const v2u a0 = LD_(v2u, addr), a1 = LD_(v2u, addr + 32); return __builtin_bit_cast(bf16x8, (v4u){a0.x, a0.y, a1.x, a1.y}); }
__device__ __forceinline__ void rwkv_chunk_item(const Frame& F, ArgsRef A, int l, int item, bool last) {
    const int b = item >> 5, h = (item >> 1) & 15, dir = item & 1, tid = F.tid, lane = F.lane, w = F.wave, sgn = dir ? -1 : 1, l16 = lane & 15, g = lane >> 4;
    LAS unsigned char* L = F.lds;
    const bf16* ZR = RGN(bf16, R_ZR); const float* WLD = RGN(float, R_WDEC) + (size_t)dir * MT * 1024; const bf16* AA = RGN(bf16, R_AA) + (size_t)dir * MT * 1024;
    bf16* Y = RGN(bf16, R_Y) + (size_t)dir * MT * 1024;
    const float* cw = AIN(12) + (size_t)l * 3 * RW_COLS;
    const int j0 = 4 * l16, ch = h * 64 + j0;
    const int tA = dir ? 2 : 0, tB = dir ? 0 : 2;
    const f32x4 kkw = *(const f32x4*)(AIN(18) + l * 1024 + ch), kaw = *(const f32x4*)(AIN(19) + l * 1024 + ch);
    const int cj = tid & 63, ct8 = tid >> 6;
    const unsigned a_row = opq((unsigned)(((8 * w + g) * RC_LD + j0) * 2));
    const unsigned a_tr = opq((unsigned)((((lane & 15) >> 2) * RC_LD + 4 * (lane & 3)) * 2));
    const unsigned a_f8 = opq((unsigned)((l16 * RC_LD + 8 * g) * 2));
    const unsigned a_f4 = opq((unsigned)((l16 * RC_LD + 4 * g) * 2));

    f32x4 S[4];
#pragma unroll
    for (int t = 0; t < 4; ++t) S[t] = (f32x4){0.f, 0.f, 0.f, 0.f};
    v2u zz[2][3][3], za[2]; float pl[8];
#define RC_ISSUE(chunk) do { int idx_, len_; const int c_ = (chunk); const int r0_ = seq_row(b, dir, c_ * 64, idx_, len_); \
        const int plo_ = c_ < 4 ? 0 : CL, phi_ = c_ < 4 ? CL : CL + SEQ; \
        _Pragma("unroll") for (int p = 0; p < 2; ++p) { const int t_ = 8 * w + 4 * p + g; \
            _Pragma("unroll") for (int x = 0; x < 3; ++x) { const int pp_ = c_ * 64 + t_ + x - 1; const bool ok_ = pp_ >= plo_ && pp_ < phi_; \
                const GAS bf16* zp_ = (const GAS bf16*)(ZR + (size_t)(ok_ ? r0_ + sgn * (t_ + x - 1) : r0_) * ZR_W + ch); asm volatile("" : "+v"(zp_)); \
                const v2u q0_ = *(const GAS v2u*)zp_, q1_ = *(const GAS v2u*)(zp_ + 1024), q2_ = *(const GAS v2u*)(zp_ + 2048); const v2u zero_ = (v2u){0u, 0u}; \
                zz[p][x][0] = ok_ ? q0_ : zero_; zz[p][x][1] = ok_ ? q1_ : zero_; zz[p][x][2] = ok_ ? q2_ : zero_; } \
            za[p] = *(const GAS v2u*)(const GAS bf16*)(AA + (size_t)(r0_ + sgn * t_) * 1024 + ch); } \
        { const GAS float* wp_ = (const GAS float*)(WLD + (size_t)(r0_ + sgn * 8 * ct8) * 1024 + h * 64 + cj); const long st_ = (long)sgn * 1024; \
          _Pragma("unroll") for (int q = 0; q < 8; ++q) { asm volatile("" : "+v"(wp_)); pl[q] = *wp_; wp_ += st_; } } } while (0)
    RC_ISSUE(0);
    for (int chunk = 0; chunk < 36; ++chunk) {
        int idx0, len0; const int r0 = seq_row(b, dir, chunk * 64, idx0, len0);
        const unsigned a_tqs = opq((unsigned)(RC_TQ + (ct8 * 64 + cj) * 4)), a_tqr = opq((unsigned)(RC_TQ + cj * 4)), a_bis = opq((unsigned)(RC_BI + (8 * ct8 * 64 + cj) * 4));
        { float s = 0.f;
#pragma unroll
          for (int q = 0; q < 8; ++q) s += pl[q];
          ST_(float, a_tqs) = s; }
        __syncthreads();
        { float o = 0.f, tot = 0.f;
#pragma unroll
          for (int q = 0; q < 8; ++q) { const float tq = LD_(float, a_tqr + q * 256); if (q < ct8) o += tq; tot += tq; }
          if (ct8 == 0) ST_(float, RC_EB + cj * 4) = fexp(tot);
#pragma unroll
          for (int q = 0; q < 8; ++q) { o += pl[q]; ST_(float, a_bis + q * 256) = o; } }
        __syncthreads();
        f32x4 tp[3][3];
#pragma unroll
        for (int kind = 0; kind < 3; ++kind) { const GAS float* cp = (const GAS float*)(cw + kind * 1024 + ch); asm volatile("" : "+v"(cp));
            tp[0][kind] = *(const GAS f32x4*)(cp + tA * RW_COLS); tp[1][kind] = *(const GAS f32x4*)(cp + RW_COLS); tp[2][kind] = *(const GAS f32x4*)(cp + tB * RW_COLS); }
        const unsigned a_bir = opq((unsigned)(RC_BI + ((8 * w + g) * 64 + j0) * 4));
#pragma unroll
        for (int p = 0; p < 2; ++p) {
            const int t = 8 * w + 4 * p + g;
            f32x4 rkv[3];
#pragma unroll
            for (int kind = 0; kind < 3; ++kind) {
                const v2u wa = zz[p][0][kind], wc = zz[p][1][kind], wb = zz[p][2][kind];
                const f32x4 xa = (f32x4){bflo(wa.x), bfhi(wa.x), bflo(wa.y), bfhi(wa.y)}, xc = (f32x4){bflo(wc.x), bfhi(wc.x), bflo(wc.y), bfhi(wc.y)}, xb = (f32x4){bflo(wb.x), bfhi(wb.x), bflo(wb.y), bfhi(wb.y)};
                rkv[kind] = xa * tp[0][kind] + xc * tp[1][kind] + xb * tp[2][kind]; }
            const f32x4 r = rkv[0], k = rkv[1], v = rkv[2];
            const f32x4 kr = k * kkw;
            const float n2 = red16s((kr.x * kr.x + kr.y * kr.y) + (kr.z * kr.z + kr.w * kr.w));
            const f32x4 kk = kr * __builtin_amdgcn_rsqf(fmaxf(n2, 1e-24f));
            const f32x4 a = (f32x4){bflo(za[p].x), bfhi(za[p].x), bflo(za[p].y), bfhi(za[p].y)};
            const f32x4 kd = k * ((a - 1.0f) * kaw + 1.0f), kka = kk * a;
            {
              const GAS float* rp = (const GAS float*)(AIN(20) + l * 1024 + ch); asm volatile("" : "+v"(rp)); const f32x4 rkp = *(const GAS f32x4*)rp;
              const f32x4 pb = r * kd * rkp; const float bsum = red16s((pb.x + pb.y) + (pb.z + pb.w));
              if (l16 == 0) RGN(float, R_BS)[((size_t)dir * MT + (size_t)(r0 + sgn * t)) * 16 + h] = bsum; }
            const f32x4 bi = LD_(f32x4, a_bir + p * 1024);
            f32x4 bx = (f32x4){0.f, 0.f, 0.f, 0.f}; if (t > 0) bx = LD_(f32x4, a_bir + p * 1024 - 256);
            f32x4 ex, ei, en;
#pragma unroll
            for (int c = 0; c < 4; ++c) { ex[c] = fexp(bx[c]); ei[c] = fexp(bi[c]); en[c] = fexp(-bi[c]); }
            const f32x4 qp = kk * ex * -1.0f, rt = r * ei, kdn = kd * en, kan = kka * en;
            const unsigned ar = a_row + p * (4 * RC_LD * 2);
            ST_(v2u, RC_QP + ar) = (v2u){pg8::cvt_pk_bf16(qp.x, qp.y), pg8::cvt_pk_bf16(qp.z, qp.w)};
            ST_(v2u, RC_RT + ar) = (v2u){pg8::cvt_pk_bf16(rt.x, rt.y), pg8::cvt_pk_bf16(rt.z, rt.w)};
            const unsigned kd01 = pg8::cvt_pk_bf16(kdn.x, kdn.y), kd23 = pg8::cvt_pk_bf16(kdn.z, kdn.w), ka01 = pg8::cvt_pk_bf16(kan.x, kan.y), ka23 = pg8::cvt_pk_bf16(kan.z, kan.w);
            const unsigned v01 = pg8::cvt_pk_bf16(v.x, v.y), v23 = pg8::cvt_pk_bf16(v.z, v.w);
            ST_(v2u, RC_KD + ar) = (v2u){kd01, kd23}; ST_(v2u, RC_KA + ar) = (v2u){ka01, ka23};
            ST_(v2u, RC_VT + ar) = (v2u){v01, v23};
            asm volatile("" ::: "memory");
        }
        __syncthreads();
        if (chunk + 1 < 36) RC_ISSUE(chunk + 1);
        const unsigned a_dgs = opq((unsigned)(RC_DG + (l16 * 16 + 4 * g) * 4));
#pragma unroll
        for (int tt2 = 0; tt2 < 2; ++tt2) {
            const int id = 2 * w + tt2, st = id >> 2, tt = id & 3;
            f32x4 mka = (f32x4){0.f, 0.f, 0.f, 0.f}, mkd = mka, nka = mka, nkd = mka;
            if (st <= tt) {
                const unsigned as_ = a_f8 + st * (16 * RC_LD * 2), at_ = a_f8 + tt * (16 * RC_LD * 2);
#pragma unroll
                for (int ks = 0; ks < 2; ++ks) {
                    const bf16x8 fka = LD_(bf16x8, RC_KA + as_ + 64 * ks), fkd = LD_(bf16x8, RC_KD + as_ + 64 * ks), fqp = LD_(bf16x8, RC_QP + at_ + 64 * ks), frt = LD_(bf16x8, RC_RT + at_ + 64 * ks);
                    mka = __builtin_amdgcn_mfma_f32_16x16x32_bf16(fka, fqp, mka, 0, 0, 0); mkd = __builtin_amdgcn_mfma_f32_16x16x32_bf16(fkd, fqp, mkd, 0, 0, 0);
                    nka = __builtin_amdgcn_mfma_f32_16x16x32_bf16(fka, frt, nka, 0, 0, 0); nkd = __builtin_amdgcn_mfma_f32_16x16x32_bf16(fkd, frt, nkd, 0, 0, 0);
                }
            }
            const int t = 16 * tt + (int)opq((unsigned)l16), s0 = 16 * st + 4 * (int)opq((unsigned)g);
#pragma unroll
            for (int r = 0; r < 4; ++r) { const bool lt = (s0 + r) < t, le = (s0 + r) <= t; mka[r] = lt ? mka[r] : 0.f; mkd[r] = lt ? mkd[r] : 0.f; nka[r] = le ? nka[r] : 0.f; nkd[r] = le ? nkd[r] : 0.f; }
            const unsigned am = a_f4 + tt * (16 * RC_LD * 2) + st * 32;
            ST_(v2u, RC_MKA + am) = (v2u){pg8::cvt_pk_bf16(mka[0], mka[1]), pg8::cvt_pk_bf16(mka[2], mka[3])};
            ST_(v2u, RC_MKD + am) = (v2u){pg8::cvt_pk_bf16(mkd[0], mkd[1]), pg8::cvt_pk_bf16(mkd[2], mkd[3])};
            ST_(v2u, RC_NKA + am) = (v2u){pg8::cvt_pk_bf16(nka[0], nka[1]), pg8::cvt_pk_bf16(nka[2], nka[3])};
            ST_(v2u, RC_NKD + am) = (v2u){pg8::cvt_pk_bf16(nkd[0], nkd[1]), pg8::cvt_pk_bf16(nkd[2], nkd[3])};
            if (st == tt) ST_(f32x4, a_dgs + st * 1024) = mka;
        }
        __syncthreads();
        if (w == 4) {
            const unsigned a_dgb = opq((unsigned)(RC_DG + g * 1024)), a_tbs = opq((unsigned)(RC_TB + (g * 256 + l16) * 2));
            float tc[16]; const int lq = (int)opq((unsigned)l16);
#pragma unroll
            for (int t = 0; t < 16; ++t) {
                float acc = (t == lq) ? 1.f : 0.f;
                const f32x4 L0 = LD_(f32x4, a_dgb + t * 64), L1 = LD_(f32x4, a_dgb + t * 64 + 16), L2 = LD_(f32x4, a_dgb + t * 64 + 32), L3 = LD_(f32x4, a_dgb + t * 64 + 48);
                const float lr[16] = {L0[0], L0[1], L0[2], L0[3], L1[0], L1[1], L1[2], L1[3], L2[0], L2[1], L2[2], L2[3], L3[0], L3[1], L3[2], L3[3]};
#pragma unroll
                for (int s = 0; s < 16; ++s) if (s < t) acc += lr[s] * tc[s];
                tc[t] = acc;
                ST_(unsigned short, a_tbs + t * 32) = (unsigned short)f2bf(acc);
            }
        }
        f32x4 X[4], O[4], U[4];
        const f32x4 zero4 = (f32x4){0.f, 0.f, 0.f, 0.f};
        bf16x8 vb0, vb1;
        if (w < 4) {
            const bf16x8 sf0 = pack8(S[0], S[1]), sf1 = pack8(S[2], S[3]);
            { const unsigned av = RC_VT + a_tr + (8 * g) * (RC_LD * 2) + w * 32; vb0 = tr8(L, av, av + 4 * RC_LD * 2); vb1 = tr8(L, av + 32 * RC_LD * 2, av + 36 * RC_LD * 2); }
#pragma unroll
            for (int mt = 0; mt < 4; ++mt) {
                const unsigned o4 = a_f4 + mt * (16 * RC_LD * 2), o8 = a_f8 + mt * (16 * RC_LD * 2);
                X[mt] = __builtin_amdgcn_mfma_f32_16x16x32_bf16(kperm(L, RC_QP + o4), sf0, zero4, 0, 0, 0);
                X[mt] = __builtin_amdgcn_mfma_f32_16x16x32_bf16(kperm(L, RC_QP + o4 + 64), sf1, X[mt], 0, 0, 0);
                X[mt] = __builtin_amdgcn_mfma_f32_16x16x32_bf16(LD_(bf16x8, RC_MKD + o8), vb0, X[mt], 0, 0, 0);
                X[mt] = __builtin_amdgcn_mfma_f32_16x16x32_bf16(LD_(bf16x8, RC_MKD + o8 + 64), vb1, X[mt], 0, 0, 0);
                O[mt] = __builtin_amdgcn_mfma_f32_16x16x32_bf16(kperm(L, RC_RT + o4), sf0, zero4, 0, 0, 0);
                O[mt] = __builtin_amdgcn_mfma_f32_16x16x32_bf16(kperm(L, RC_RT + o4 + 64), sf1, O[mt], 0, 0, 0);
                O[mt] = __builtin_amdgcn_mfma_f32_16x16x32_bf16(LD_(bf16x8, RC_NKD + o8), vb0, O[mt], 0, 0, 0);
                O[mt] = __builtin_amdgcn_mfma_f32_16x16x32_bf16(LD_(bf16x8, RC_NKD + o8 + 64), vb1, O[mt], 0, 0, 0);
                asm volatile("" ::: "memory");
            }
#pragma unroll
            for (int jt = 0; jt < 4; ++jt) { const unsigned ak = RC_KD + a_tr + (8 * g) * (RC_LD * 2) + jt * 32;
                S[jt] = __builtin_amdgcn_mfma_f32_16x16x32_bf16(tr8(L, ak, ak + 4 * RC_LD * 2), vb0, S[jt], 0, 0, 0);
                S[jt] = __builtin_amdgcn_mfma_f32_16x16x32_bf16(tr8(L, ak + 32 * RC_LD * 2, ak + 36 * RC_LD * 2), vb1, S[jt], 0, 0, 0); }
        }
        __syncthreads();
        if (w < 4) {
            const unsigned a_tbf = opq((unsigned)(RC_TB + (l16 * 16 + 4 * g) * 2)), a_ebr = opq((unsigned)(RC_EB + 16 * g));
#define RC_TBF(tb) __builtin_bit_cast(bf16x8, (v4u){LD_(v2u, a_tbf + (tb) * 512).x, LD_(v2u, a_tbf + (tb) * 512).y, 0u, 0u})
            U[0] = __builtin_amdgcn_mfma_f32_16x16x32_bf16(RC_TBF(0), pack8(X[0], zero4), zero4, 0, 0, 0);
            X[1] = __builtin_amdgcn_mfma_f32_16x16x32_bf16(kperm(L, RC_MKA + a_f4 + 1 * (16 * RC_LD * 2)), pack8(U[0], zero4), X[1], 0, 0, 0);
            U[1] = __builtin_amdgcn_mfma_f32_16x16x32_bf16(RC_TBF(1), pack8(X[1], zero4), zero4, 0, 0, 0);
            const bf16x8 uf0 = pack8(U[0], U[1]);
            X[2] = __builtin_amdgcn_mfma_f32_16x16x32_bf16(kperm(L, RC_MKA + a_f4 + 2 * (16 * RC_LD * 2)), uf0, X[2], 0, 0, 0);
            U[2] = __builtin_amdgcn_mfma_f32_16x16x32_bf16(RC_TBF(2), pack8(X[2], zero4), zero4, 0, 0, 0);
            X[3] = __builtin_amdgcn_mfma_f32_16x16x32_bf16(kperm(L, RC_MKA + a_f4 + 3 * (16 * RC_LD * 2)), uf0, X[3], 0, 0, 0);
            X[3] = __builtin_amdgcn_mfma_f32_16x16x32_bf16(kperm(L, RC_MKA + a_f4 + 3 * (16 * RC_LD * 2) + 64), pack8(U[2], zero4), X[3], 0, 0, 0);
            U[3] = __builtin_amdgcn_mfma_f32_16x16x32_bf16(RC_TBF(3), pack8(X[3], zero4), zero4, 0, 0, 0);
            const bf16x8 uf1 = pack8(U[2], U[3]);
#undef RC_TBF
#pragma unroll
            for (int mt = 0; mt < 4; ++mt) { const unsigned o4 = a_f4 + mt * (16 * RC_LD * 2);
                O[mt] = __builtin_amdgcn_mfma_f32_16x16x32_bf16(kperm(L, RC_NKA + o4), uf0, O[mt], 0, 0, 0);
                O[mt] = __builtin_amdgcn_mfma_f32_16x16x32_bf16(kperm(L, RC_NKA + o4 + 64), uf1, O[mt], 0, 0, 0); }
#pragma unroll
            for (int jt = 0; jt < 4; ++jt) { const unsigned ak = RC_KA + a_tr + (4 * g) * (RC_LD * 2) + jt * 32;
                S[jt] = __builtin_amdgcn_mfma_f32_16x16x32_bf16(tr8(L, ak, ak + 16 * RC_LD * 2), uf0, S[jt], 0, 0, 0);
                S[jt] = __builtin_amdgcn_mfma_f32_16x16x32_bf16(tr8(L, ak + 32 * RC_LD * 2, ak + 48 * RC_LD * 2), uf1, S[jt], 0, 0, 0);
                S[jt] = S[jt] * LD_(f32x4, a_ebr + jt * 64); }
            if (!(last && chunk < 4)) {
                GAS bf16* yp = (GAS bf16*)(Y + (size_t)(r0 + sgn * 4 * g) * 1024 + h * 64 + 16 * w + l16);
                const long sy = (long)sgn * 1024;
#pragma unroll
                for (int mt = 0; mt < 4; ++mt) {
#pragma unroll
                    for (int r = 0; r < 4; ++r) { asm volatile("" : "+v"(yp)); yp[(long)r * sy] = (bf16)f2bf(O[mt][r]); }
                    yp += 16 * sy;
                }
            }
        }
        __syncthreads();
    }
#undef RC_ISSUE
}
#undef LD_
#undef ST_

constexpr int GQ_LD = 264, GT_LD = 72;
constexpr int GV_LD = 136;
constexpr int G_QD = 0, G_KI = G_QD + 64 * GQ_LD * 2, G_KT = G_KI + 64 * GQ_LD * 2, G_VT = G_KT + 256 * GT_LD * 2, G_AM = G_VT + 128 * GT_LD * 2, G_EBL = G_AM + 64 * GT_LD * 2, G_TQ = G_EBL + 1024, G_END = G_TQ + 4096;
static_assert(G_END <= RING_BYTES, "GLA LDS map");
#define LD_(T, addr) (*(const LAS T*)(L + (addr)))
#define ST_(T, addr) (*(LAS T*)(L + (addr)))
template <int VAR> __device__ __forceinline__ void gla_chunk_item(const Frame& F, int item, bool last) {
    const int b = item >> 5, h = (item >> 3) & 3, dir = (item >> 2) & 1, dvs = item & 3;
    LAS unsigned char* L = F.lds;
    const int tid = F.tid, lane = F.lane, w = F.wave, l16 = lane & 15, g = lane >> 4;
    const int dp = tid & 127, qt = tid >> 7;
    const int e8 = tid & 15, jj = tid >> 4;
    const bf16* ZG = RGN(bf16, R_ZG); const bf16* GL = RGN(bf16, R_GL) + (size_t)dir * MT * 1024;
    bf16* YG = RGN(bf16, R_YG) + (size_t)dir * MT * 2048;
    const int sgn = dir ? -1 : 1;
    f32x4 S[16];
#pragma unroll
    for (int t = 0; t < 16; ++t) S[t] = (f32x4){0.f, 0.f, 0.f, 0.f};
    unsigned rq[16], rk[16], rl[16]; v4u rv0, rv1;
#define GLA_ISSUE(chunk) do { int idx_, len_; const int r0_ = seq_row(b, dir, (chunk) * 64, idx_, len_); \
        const GAS bf16* pz_ = (const GAS bf16*)(ZG + (size_t)(r0_ + sgn * 16 * qt) * ZG_W + h * 256 + 2 * dp); const GAS bf16* pl_ = (const GAS bf16*)(GL + (size_t)(r0_ + sgn * 16 * qt) * 1024 + h * 256 + 2 * dp); \
        const long sz_ = (long)sgn * ZG_W, sl_ = (long)sgn * 1024; \
        _Pragma("unroll") for (int i = 0; i < 16; ++i) { asm volatile("" : "+v"(pz_), "+v"(pl_)); \
            rq[i] = *(const GAS unsigned*)pz_; rk[i] = *(const GAS unsigned*)(pz_ + 1024); rl[i] = *(const GAS unsigned*)pl_; pz_ += sz_; pl_ += sl_; } \
        const bf16* pv_ = ZG + (size_t)(r0_ + sgn * jj) * ZG_W + 2048 + h * 512 + dvs * 128 + 8 * e8; \
        rv0 = *(const v4u*)pv_; rv1 = *(const v4u*)(pv_ + sz_ * 32); } while (0)
    GLA_ISSUE(0);
    for (int chunk = 0; chunk < 36; ++chunk) {
        int idx0, len0; const int r0 = seq_row(b, dir, chunk * 64, idx0, len0);
        const unsigned a_ptq = opq(G_TQ + (2 * dp) * 4);
        {
            float s0 = 0.f, s1 = 0.f;
#pragma unroll
            for (int i = 0; i < 16; ++i) { s0 += bflo(rl[i]); s1 += bfhi(rl[i]); }
            ST_(f32x2, a_ptq + qt * 1024) = (f32x2){s0, s1};
        }
        __syncthreads();
        if (VAR != 2)
        {
            float o0 = 0.f, o1 = 0.f, t0 = 0.f, t1 = 0.f;
#pragma unroll
            for (int q = 0; q < 4; ++q) { const f32x2 tq = LD_(f32x2, a_ptq + q * 1024); if (q < qt) { o0 += tq.x; o1 += tq.y; } t0 += tq.x; t1 += tq.y; }
            if (qt == 0) ST_(f32x2, G_EBL + 2 * dp * 4) = (f32x2){fexp(t0), fexp(t1)};
            unsigned kt0[8], kt1[8];
            const unsigned a_pq = opq(G_QD + ((16 * qt) * GQ_LD + 2 * dp) * 2);
            const unsigned a_pkt = opq(G_KT + ((2 * dp) * GT_LD + 16 * qt) * 2);
        const unsigned a_pvt = opq(G_VT + (jj * GV_LD + 8 * e8) * 2);
#pragma unroll
            for (int i = 0; i < 16; ++i) {
                o0 += bflo(rl[i]); o1 += bfhi(rl[i]);
                const float e0 = fexp(o0), e1 = fexp(o1), n0 = fexp(-o0), n1 = fexp(-o1);
                const unsigned qd = pg8::cvt_pk_bf16(bflo(rq[i]) * 0.0625f * e0, bfhi(rq[i]) * 0.0625f * e1);
                const unsigned ki = pg8::cvt_pk_bf16(bflo(rk[i]) * n0, bfhi(rk[i]) * n1);
                ST_(unsigned, a_pq + i * GQ_LD * 2) = qd;
                ST_(unsigned, a_pq + (G_KI - G_QD) + i * GQ_LD * 2) = ki;
                if (i & 1) { kt0[i >> 1] |= (ki << 16); kt1[i >> 1] |= (ki & 0xffff0000u); }
                else { kt0[i >> 1] = ki & 0xffffu; kt1[i >> 1] = ki >> 16; }
                asm volatile("" ::: "memory");
            }
            ST_(v4u, a_pkt) = (v4u){kt0[0], kt0[1], kt0[2], kt0[3]};
            ST_(v4u, a_pkt + 16) = (v4u){kt0[4], kt0[5], kt0[6], kt0[7]};
            ST_(v4u, a_pkt + GT_LD * 2) = (v4u){kt1[0], kt1[1], kt1[2], kt1[3]};
            ST_(v4u, a_pkt + GT_LD * 2 + 16) = (v4u){kt1[4], kt1[5], kt1[6], kt1[7]};
            ST_(v4u, a_pvt) = rv0; ST_(v4u, a_pvt + 32 * GV_LD * 2) = rv1;
        }
        __syncthreads();
        if (chunk + 1 < 36 && VAR != 1) GLA_ISSUE(chunk + 1);
        const unsigned a_f8 = opq((l16 * GQ_LD + 8 * g) * 2);
#pragma unroll
        for (int tt = 0; tt < 2; ++tt) {
            const int t = 2 * w + tt, jt = t >> 2, it = t & 3;
            f32x4 acc = (f32x4){0.f, 0.f, 0.f, 0.f};
            if (jt <= it) {
                const unsigned ak = a_f8 + G_KI + jt * (16 * GQ_LD * 2), aq = a_f8 + G_QD + it * (16 * GQ_LD * 2);
#pragma unroll
                for (int s = 0; s < 8; ++s) {
                    const bf16x8 a = LD_(bf16x8, ak + 64 * s);
                    const bf16x8 bb = LD_(bf16x8, aq + 64 * s);
                    acc = __builtin_amdgcn_mfma_f32_16x16x32_bf16(a, bb, acc, 0, 0, 0);
                }
            }
            const int i = 16 * it + l16, j0 = 16 * jt + 4 * g;
            const float m0 = (j0 + 0 <= i) ? acc[0] : 0.f, m1 = (j0 + 1 <= i) ? acc[1] : 0.f, m2 = (j0 + 2 <= i) ? acc[2] : 0.f, m3 = (j0 + 3 <= i) ? acc[3] : 0.f;
            ST_(v2u, G_AM + (i * GT_LD + j0) * 2) = (v2u){pg8::cvt_pk_bf16(m0, m1), pg8::cvt_pk_bf16(m2, m3)};
        }
        __syncthreads();
        if (VAR != 3)
        {
            const unsigned a_f4 = opq(G_QD + (l16 * GQ_LD + 4 * g) * 2), a_t8 = opq((l16 * GT_LD + 8 * g) * 2), a_ebl = opq(G_EBL + 16 * g);
            const unsigned a_vtr = opq(G_VT + ((8 * g + (l16 >> 2)) * GV_LD + 16 * w + 4 * (l16 & 3)) * 2);
            const unsigned a_os = opq(G_KI + ((4 * g) * GV_LD + 16 * w + l16) * 2);
            f32x4 O[4];
#pragma unroll
            for (int mt = 0; mt < 4; ++mt) O[mt] = (f32x4){0.f, 0.f, 0.f, 0.f};
#pragma unroll
            for (int s = 0; s < 8; ++s) {
                const bf16x8 bs = pack8(S[2 * s], S[2 * s + 1]);
#pragma unroll
                for (int mt = 0; mt < 4; ++mt) {
                    const v2u a0 = LD_(v2u, a_f4 + (16 * mt * GQ_LD + 32 * s) * 2);
                    const v2u a1 = LD_(v2u, a_f4 + (16 * mt * GQ_LD + 32 * s + 16) * 2);
                    const bf16x8 a = __builtin_bit_cast(bf16x8, (v4u){a0.x, a0.y, a1.x, a1.y});
                    O[mt] = __builtin_amdgcn_mfma_f32_16x16x32_bf16(a, bs, O[mt], 0, 0, 0);
                }
                asm volatile("" ::: "memory");
            }
            const bf16x8 vb0 = tr8(L, a_vtr, a_vtr + 4 * GV_LD * 2);
            const bf16x8 vb1 = tr8(L, a_vtr + 32 * GV_LD * 2, a_vtr + 36 * GV_LD * 2);
#pragma unroll
            for (int mt = 0; mt < 4; ++mt) {
                const bf16x8 a0 = LD_(bf16x8, a_t8 + G_AM + mt * (16 * GT_LD * 2));
                O[mt] = __builtin_amdgcn_mfma_f32_16x16x32_bf16(a0, vb0, O[mt], 0, 0, 0);
                if (mt >= 2) { const bf16x8 a1 = LD_(bf16x8, a_t8 + G_AM + mt * (16 * GT_LD * 2) + 64);
                    O[mt] = __builtin_amdgcn_mfma_f32_16x16x32_bf16(a1, vb1, O[mt], 0, 0, 0); }
            }
            if (VAR == 0 && !(last && chunk < 4)) {
                const unsigned aos = a_os;
#pragma unroll
                for (int mt = 0; mt < 4; ++mt)
#pragma unroll
                    for (int r = 0; r < 4; ++r) ST_(unsigned short, aos + (16 * mt + r) * (GV_LD * 2)) = (unsigned short)f2bf(O[mt][r]);
            }
#pragma unroll
            for (int t = 0; t < 16; ++t) {
                const bf16x8 a0 = LD_(bf16x8, a_t8 + G_KT + t * (16 * GT_LD * 2));
                const bf16x8 a1 = LD_(bf16x8, a_t8 + G_KT + t * (16 * GT_LD * 2) + 64);
                S[t] = __builtin_amdgcn_mfma_f32_16x16x32_bf16(a0, vb0, S[t], 0, 0, 0);
                S[t] = __builtin_amdgcn_mfma_f32_16x16x32_bf16(a1, vb1, S[t], 0, 0, 0);
                const f32x4 eb = LD_(f32x4, a_ebl + 64 * t);
                S[t] = S[t] * eb;
                asm volatile("" ::: "memory");
            }
        }
        __syncthreads();
        if (VAR == 0 && !(last && chunk < 4)) {
            const unsigned a_or = opq(G_KI + ((tid >> 4) * GV_LD + 8 * (tid & 15)) * 2);
            const v4u o0 = LD_(v4u, a_or), o1 = LD_(v4u, a_or + 32 * GV_LD * 2);
            GAS bf16* yp = (GAS bf16*)(YG + (size_t)(r0 + sgn * (tid >> 4)) * 2048 + h * 512 + dvs * 128 + 8 * (tid & 15));
            *(GAS v4u*)yp = o0; *(GAS v4u*)(yp + (long)sgn * 32 * 2048) = o1;
        }
    }
#undef GLA_ISSUE
    if (VAR != 0) { float chk = 0.f;
#pragma unroll
        for (int t = 0; t < 16; ++t) chk += S[t][0] + S[t][1] + S[t][2] + S[t][3];
        chk += __uint_as_float(rq[0] ^ rk[3] ^ rl[7]);
        if (chk == 1.2345e-30f) YG[0] = (bf16)1; }
}
#undef LD_
#undef ST_

constexpr int AK_LD = 136, AV_LD = 136;
constexpr int A_K = 0, A_VT = A_K + 64 * AK_LD * 2, A_END = A_VT + 64 * AV_LD * 2;
static_assert(A_END <= RING_BYTES, "attention LDS map");
typedef float f32x16 __attribute__((ext_vector_type(16)));
#define LD_(T, addr) (*(const LAS T*)(L + (addr)))
#define ST_(T, addr) (*(LAS T*)(L + (addr)))
template <bool NOSTORE> __device__ __forceinline__ void attn_mfma_item(const Frame& F, ArgsRef A, int l, int item) {
    LAS unsigned char* L = F.lds;
    const int tid = F.tid, lane = F.lane, w = F.wave, l32 = lane & 31, g = lane >> 5;
    bf16* ZA = RGN(bf16, R_ZA); const bf16* QR = RGN(bf16, R_QR); const bf16* KR = RGN(bf16, R_KR);
    const bool isctx = item >= 512;
    int b, hk, t0;
    if (!isctx) { b = item >> 6; hk = (item >> 5) & 1; t0 = (item & 31) * 64; }
    else { const int it = item - 512; b = it >> 3; hk = (it >> 2) & 1; t0 = (it & 3) * 64; }
    const int hq = hk * 4 + (w >> 1), tq = t0 + 32 * (w & 1) + l32;
    const size_t qrow = isctx ? (size_t)(ML + b * CL + tq) : (size_t)(b * SEQ + tq);
    const float C2 = 0.08838834764831845f * 1.4426950408889634f;
    const int skey = tid >> 3, sc = tid & 7;
    const unsigned a_sk = opq(A_K + (skey * AK_LD + 8 * sc) * 2);
    const unsigned a_sv = opq(A_VT + (skey * AV_LD + 8 * sc) * 2);
    const unsigned a_kf = opq(A_K + (l32 * AK_LD + 8 * g) * 2);
    const unsigned a_vf = opq(A_VT + ((4 * g + ((lane & 15) >> 2)) * AV_LD + 16 * ((lane >> 4) & 1) + 4 * (lane & 3)) * 2);
    bf16x8 qf[8];
    {
        const bf16* qp = (isctx ? (const bf16*)ZA + qrow * ZA_LD : QR + qrow * 1024) + hq * 128 + 8 * g;
#pragma unroll
        for (int s = 0; s < 8; ++s) qf[s] = *(const bf16x8*)(qp + 16 * s);
    }
    float mrun = AIN(11)[l * 8 + hq] * 1.4426950408889634f, lsum = (g == 0) ? 1.f : 0.f;
    f32x16 O[4];
#pragma unroll
    for (int mt = 0; mt < 4; ++mt)
#pragma unroll
        for (int r = 0; r < 16; ++r) O[mt][r] = 0.f;
    int tfirst = isctx ? 5 : 0;
    if (!isctx) { while (t0 - 128 + 64 * tfirst < 0) ++tfirst; }
    v4u pk0, pk1, pv0, pv1;
#define ATT_PREFETCH(tile) do { const bf16 *kp_, *vp_; \
        if ((tile) < 5) { const size_t r_ = (size_t)(b * SEQ + t0 - 128 + 64 * (tile) + skey); kp_ = KR + r_ * 256 + hk * 128 + 8 * sc; vp_ = ZA + r_ * ZA_LD + 1280 + hk * 128 + 8 * sc; } \
        else { const size_t r_ = (size_t)(ML + b * CL + 64 * ((tile) - 5) + skey); kp_ = ZA + r_ * ZA_LD + 1024 + hk * 128 + 8 * sc; vp_ = kp_ + 256; } \
        pk0 = *(const v4u*)kp_; pk1 = *(const v4u*)(kp_ + 64); pv0 = *(const v4u*)vp_; pv1 = *(const v4u*)(vp_ + 64); } while (0)
    int tile = tfirst;
    ATT_PREFETCH(tile);
    bool plainq = isctx;
    while (tile < 9) {
        __syncthreads();
        ST_(v4u, a_sk) = pk0; ST_(v4u, a_sk + 128) = pk1;
        ST_(v4u, a_sv) = pv0; ST_(v4u, a_sv + 128) = pv1;
        __syncthreads();
        const int cur = tile;
        int nxt = cur + 1;
        if (nxt < 5 && t0 - 128 + 64 * nxt >= SEQ) nxt = 5;
        if (nxt < 9) ATT_PREFETCH(nxt);
        if (cur >= 5 && !plainq) {
            const bf16* qp = (const bf16*)ZA + qrow * ZA_LD + hq * 128 + 8 * g;
#pragma unroll
            for (int s = 0; s < 8; ++s) qf[s] = *(const bf16x8*)(qp + 16 * s);
            plainq = true;
        }
        f32x16 sc0, sc1;
#pragma unroll
        for (int r = 0; r < 16; ++r) { sc0[r] = 0.f; sc1[r] = 0.f; }
#pragma unroll
        for (int s = 0; s < 8; ++s) {
            const bf16x8 k0 = LD_(bf16x8, a_kf + 32 * s), k1 = LD_(bf16x8, a_kf + 32 * AK_LD * 2 + 32 * s);
            sc0 = __builtin_amdgcn_mfma_f32_32x32x16_bf16(k0, qf[s], sc0, 0, 0, 0);
            sc1 = __builtin_amdgcn_mfma_f32_32x32x16_bf16(k1, qf[s], sc1, 0, 0, 0);
        }
        float tmax = -3.0e38f;
        if (cur < 5) {
            const int kbase = t0 - 128 + 64 * cur - tq + 4 * g;
#pragma unroll
            for (int r = 0; r < 16; ++r) { const int d0 = kbase + 8 * (r >> 2) + (r & 3), d1 = d0 + 32;
                sc0[r] = (d0 >= -128 && d0 <= 128) ? sc0[r] * C2 : -1.0e30f; sc1[r] = (d1 >= -128 && d1 <= 128) ? sc1[r] * C2 : -1.0e30f; }
        } else {
#pragma unroll
            for (int r = 0; r < 16; ++r) { sc0[r] *= C2; sc1[r] *= C2; }
        }
#pragma unroll
        for (int r = 0; r < 16; ++r) tmax = fmaxf(tmax, fmaxf(sc0[r], sc1[r]));
        tmax = xhalf_max(tmax);
        const float mnew = fmaxf(mrun, tmax);
        const float corr = __builtin_amdgcn_exp2f(mrun - mnew);
        mrun = mnew;
        float ps = 0.f;
#pragma unroll
        for (int r = 0; r < 16; ++r) { sc0[r] = __builtin_amdgcn_exp2f(sc0[r] - mnew); sc1[r] = __builtin_amdgcn_exp2f(sc1[r] - mnew); ps += sc0[r] + sc1[r]; }
        lsum = lsum * corr + ps;
        if (__builtin_amdgcn_ballot_w64(corr != 1.0f) != 0ull) {
#pragma unroll
            for (int mt = 0; mt < 4; ++mt)
#pragma unroll
                for (int r = 0; r < 16; ++r) O[mt][r] *= corr;
        }
#pragma unroll
        for (int u = 0; u < 2; ++u)
#pragma unroll
            for (int s = 0; s < 2; ++s) {
                v4u pw;
                if (u == 0) { pw.x = pg8::cvt_pk_bf16(sc0[8 * s + 0], sc0[8 * s + 1]); pw.y = pg8::cvt_pk_bf16(sc0[8 * s + 2], sc0[8 * s + 3]); pw.z = pg8::cvt_pk_bf16(sc0[8 * s + 4], sc0[8 * s + 5]); pw.w = pg8::cvt_pk_bf16(sc0[8 * s + 6], sc0[8 * s + 7]); }
                else { pw.x = pg8::cvt_pk_bf16(sc1[8 * s + 0], sc1[8 * s + 1]); pw.y = pg8::cvt_pk_bf16(sc1[8 * s + 2], sc1[8 * s + 3]); pw.z = pg8::cvt_pk_bf16(sc1[8 * s + 4], sc1[8 * s + 5]); pw.w = pg8::cvt_pk_bf16(sc1[8 * s + 6], sc1[8 * s + 7]); }
                const bf16x8 pb = __builtin_bit_cast(bf16x8, pw);
#pragma unroll
                for (int mt = 0; mt < 4; ++mt) {
                    const bf16x8 av = tr8(L, a_vf + ((32 * u + 16 * s) * AV_LD + 32 * mt) * 2, a_vf + ((32 * u + 16 * s + 8) * AV_LD + 32 * mt) * 2);
                    O[mt] = __builtin_amdgcn_mfma_f32_32x32x16_bf16(av, pb, O[mt], 0, 0, 0);
                }
            }
        tile = nxt;
    }
#undef ATT_PREFETCH
    lsum = xhalf_sum(lsum);
    const float inv = 1.0f / lsum;
    bf16* op = ZA + qrow * ZA_LD + hq * 128 + 4 * g;
    if (NOSTORE) { float chk = inv;
#pragma unroll
        for (int mt = 0; mt < 4; ++mt) chk += O[mt][0] + O[mt][5] + O[mt][10] + O[mt][15];
        if (chk == 1.2345e-30f) op[0] = (bf16)1;
        return; }
#pragma unroll
    for (int mt = 0; mt < 4; ++mt)
#pragma unroll
        for (int i = 0; i < 4; ++i) {
            v2u o; o.x = pg8::cvt_pk_bf16(O[mt][4 * i] * inv, O[mt][4 * i + 1] * inv); o.y = pg8::cvt_pk_bf16(O[mt][4 * i + 2] * inv, O[mt][4 * i + 3] * inv);
            *(v2u*)(op + 32 * mt + 8 * i) = o;
        }
}
#undef LD_
#undef ST_

#ifndef MK_PROBE
#define MK_PROBE 0
#endif
#define PROBE_SPIN(bit, t0_) do { if ((MK_PROBE & (bit)) != 0) { asm volatile("s_waitcnt vmcnt(0) lgkmcnt(0)" ::: "memory"); const unsigned long long t1_ = __builtin_amdgcn_s_memrealtime(); \
        while (__builtin_amdgcn_s_memrealtime() - t1_ < t1_ - (t0_)) __builtin_amdgcn_s_sleep(8); } } while (0)
__device__ __forceinline__ void phase_mix(const Frame& F, ArgsRef A, int l, bool last) {
    unsigned long long tp = (MK_PROBE & 0x700) ? __builtin_amdgcn_s_memrealtime() : 0ull;
#if !defined(MIX_ONLY) || MIX_ONLY == 1
    for (int v = F.bid; v < 256; v += F.G) rwkv_chunk_item(F, A, l, ((v & 7) << 5) | (v >> 3), last);
#endif
    PROBE_SPIN(0x100, tp);
    if (MK_PROBE & 0x700) tp = __builtin_amdgcn_s_memrealtime();
#if !defined(MIX_ONLY) || MIX_ONLY == 2
    for (int v = F.bid; v < 256; v += F.G) { const int x = v & 7, y = v >> 3; gla_chunk_item<0>(F, ((x + 8 * (y >> 3)) << 3) | (y & 7), last); }

#endif
    PROBE_SPIN(0x200, tp);
    if (MK_PROBE & 0x700) tp = __builtin_amdgcn_s_memrealtime();
    {
        const int x = F.bid & 7; const unsigned nt = last ? 64u : 72u;
        unsigned* ctr = (unsigned*)(F.ws + WS_CTL) + 8192 + (l * 8 + x) * 64;
        volatile LAS unsigned* tk = (volatile LAS unsigned*)(F.lds + MISC_OFF) + 16;
        for (;;) {
            if (F.tid == 0) *tk = __hip_atomic_fetch_add(ctr, 1u, __ATOMIC_RELAXED, __HIP_MEMORY_SCOPE_AGENT);
            __syncthreads();
            const unsigned t = *tk;
            __syncthreads();
            if (t >= nt) break;
            const int item = t < 64u ? ((x << 6) | (int)t) : 512 + ((x << 3) | (int)(t - 64u));
#if !defined(MIX_ONLY) || MIX_ONLY == 3
            attn_mfma_item<false>(F, A, l, item);
#endif
        }
    }
    PROBE_SPIN(0x400, tp);
}

__device__ __forceinline__ void phase_mixout(const Frame& F, ArgsRef A, int l, int nrows) {
    const int gw = F.bid * NWAVES + F.wave, NGW = F.G * NWAVES, lane = F.lane;
    {
        const bf16* ZR = RGN(bf16, R_ZR); const bf16* Y = RGN(bf16, R_Y); const bf16* G = RGN(bf16, R_G); bf16* ORW = RGN(bf16, R_ZA) + OC_RW; const float* BS = RGN(float, R_BS);
        const float* cw = AIN(12) + (size_t)l * 3 * RW_COLS;
        const int cg = F.wave & 3, c0 = cg * 256 + lane * 4, hd = cg * 4 + (lane >> 4);
        f32x4 tpv[3];
#pragma unroll
        for (int tap = 0; tap < 3; ++tap) tpv[tap] = *(const f32x4*)(cw + tap * RW_COLS + 2 * 1024 + c0);
        const f32x4 lnw = *(const f32x4*)(AIN(21) + l * 1024 + c0), lnb = *(const f32x4*)(AIN(22) + l * 1024 + c0);
        for (int m = F.bid * 2 + (F.wave >> 2); m < nrows; m += 2 * F.G) {
            int idx, len; if (m < ML) { idx = m & (SEQ - 1); len = SEQ; } else { idx = (m - ML) & (CL - 1); len = CL; }
            const float fl = idx > 0 ? 1.f : 0.f, fr = idx < len - 1 ? 1.f : 0.f;
            const bf16* z0 = ZR + (size_t)m * ZR_W + 2 * 1024 + c0; const bf16* zl = idx > 0 ? z0 - ZR_W : z0; const bf16* zrr = idx < len - 1 ? z0 + ZR_W : z0;
            const v2u wc = *(const v2u*)z0, wl = *(const v2u*)zl, wr = *(const v2u*)zrr;
            const f32x4 xc = (f32x4){bflo(wc.x), bfhi(wc.x), bflo(wc.y), bfhi(wc.y)}, xl = (f32x4){bflo(wl.x), bfhi(wl.x), bflo(wl.y), bfhi(wl.y)}, xr = (f32x4){bflo(wr.x), bfhi(wr.x), bflo(wr.y), bfhi(wr.y)};
            const f32x4 v = xc * tpv[1] + xl * tpv[0] * fl + xr * tpv[2] * fr;
            const v2u yw0 = *(const v2u*)(Y + (size_t)m * 1024 + c0), yw1 = *(const v2u*)(Y + ((size_t)MT + m) * 1024 + c0);
            const f32x4 y0 = (f32x4){bflo(yw0.x), bfhi(yw0.x), bflo(yw0.y), bfhi(yw0.y)}, y1 = (f32x4){bflo(yw1.x), bfhi(yw1.x), bflo(yw1.y), bfhi(yw1.y)};
            const float bs = BS[(size_t)m * 16 + hd] + BS[((size_t)MT + m) * 16 + hd];
            const f32x4 o = y0 + y1;
            const float mean = red16s((o.x + o.y) + (o.z + o.w)) * (1.f / 64.f); const f32x4 dv = o - mean;
            const float var = red16s((dv.x * dv.x + dv.y * dv.y) + (dv.z * dv.z + dv.w * dv.w)) * (1.f / 64.f);
            const f32x4 on = dv * (1.f / sqrtf(var + 64e-5f)) * lnw + lnb;
            const v2u gw2 = *(const v2u*)(G + (size_t)m * 1024 + c0);
            const f32x4 gv = (f32x4){bflo(gw2.x), bfhi(gw2.x), bflo(gw2.y), bfhi(gw2.y)};
            const f32x4 res = (on + v * bs) * gv;
            *(v2u*)(ORW + (size_t)m * ZA_LD + c0) = (v2u){pk2(res.x, res.y), pk2(res.z, res.w)};
        }
    }
    {
        const bf16* YG = RGN(bf16, R_YG); const bf16* ZG = RGN(bf16, R_ZG); bf16* OGL = RGN(bf16, R_ZA) + OC_GL; const float* nw = AIN(25) + l * 512;
        const f32x4 nw0 = *(const f32x4*)(nw + lane * 8), nw1 = *(const f32x4*)(nw + lane * 8 + 4);
        for (int it = gw; it < nrows * 4; it += NGW) {
            const int m = it >> 2, h = it & 3;
            const v4u ya = *(const v4u*)(YG + (size_t)m * 2048 + h * 512 + lane * 8), yb = *(const v4u*)(YG + ((size_t)MT + m) * 2048 + h * 512 + lane * 8);
            f32x4 y0 = (f32x4){bflo(ya.x) + bflo(yb.x), bfhi(ya.x) + bfhi(yb.x), bflo(ya.y) + bflo(yb.y), bfhi(ya.y) + bfhi(yb.y)};
            f32x4 y1 = (f32x4){bflo(ya.z) + bflo(yb.z), bfhi(ya.z) + bfhi(yb.z), bflo(ya.w) + bflo(yb.w), bfhi(ya.w) + bfhi(yb.w)};
            const float ss = wave_sum((y0.x * y0.x + y0.y * y0.y) + (y0.z * y0.z + y0.w * y0.w) + (y1.x * y1.x + y1.y * y1.y) + (y1.z * y1.z + y1.w * y1.w));
            const float rs = 1.f / sqrtf(ss * (1.f / 512.f) + 1e-5f);
            const v4u gw4 = *(const v4u*)(ZG + (size_t)m * ZG_W + 4096 + h * 512 + lane * 8);
            const f32x4 g0 = (f32x4){bflo(gw4.x), bfhi(gw4.x), bflo(gw4.y), bfhi(gw4.y)}, g1 = (f32x4){bflo(gw4.z), bfhi(gw4.z), bflo(gw4.w), bfhi(gw4.w)};
            y0 = y0 * rs * nw0; y1 = y1 * rs * nw1;
            v4u w; w.x = pk2(y0.x * fsilu(g0.x), y0.y * fsilu(g0.y)); w.y = pk2(y0.z * fsilu(g0.z), y0.w * fsilu(g0.w));
            w.z = pk2(y1.x * fsilu(g1.x), y1.y * fsilu(g1.y)); w.w = pk2(y1.z * fsilu(g1.z), y1.w * fsilu(g1.w));
            *(v4u*)(OGL + (size_t)m * ZA_LD + h * 512 + lane * 8) = w;
        }
    }
}


#define NOPK
#ifndef MK_ONE_LAUNCH
#define MK_ONE_LAUNCH 1
#endif

template <int K> __device__ __forceinline__ void run_phase(const Frame& F, ArgsRef A, int l) {
    const float* mods = WSP(float, WS_MODS);
    bf16* HB = WSP(bf16, WS_HB);
    const bool last = (l == DEPTH - 1);
    const float* mods_l = mods + (size_t)l * 9 * 18432;
    const float* lng = AIN(6) + (size_t)l * 3 * D; const float* lnb = AIN(7) + (size_t)l * 3 * D;
    const int nrows = last ? ML : MT;
    if constexpr (K == -1) phase_init(F, A);
    if constexpr (K == 0) {
        if (l > 0) phase_ln<true, true>(F, MT, lng - D, lnb - D, mods_l, 0, 1, RGN(float, R_PART), mods_l - 9 * 18432 + 8 * 18432 + 8 * 2048, 0.5f);
        else phase_ln<false, true>(F, MT, nullptr, nullptr, mods_l, 0, 1, nullptr, nullptr, 0.f, AIN(0), AIN(2));
        phase_convert(F, A, l, 0, 3);
    }
    if constexpr (K == 1 || K == 12) { const int M = (K == 1) ? MT : nrows; pg8::Gemm g{HB, RGN(bf16, R_WGU), M, 2 * FF, D, D, D, 0}; pg8::StaticOrder S; S.init(M, 2 * FF, F.G, F.bid);
        pg8::EpiSwiglu E{RGN(bf16, R_H), FF}; pg8::gemm_phase<pg8::EpiSwiglu, pg8::StaticOrder, true, true>(F.lds, g, S, E, F.tid); }
    if constexpr (K == 2 || K == 13) { const int M = (K == 2) ? MT : nrows;
        { pg8::Gemm g{RGN(bf16, R_H), RGN(bf16, R_WDN), ML, D, FF, FF, FF, 0}; pg8::StaticOrder S; S.init(ML, D, F.G, F.bid);
          const bool first = (K == 2) && l == 0;
          const float* pg_ = (K == 2) ? (first ? lng : lng - D) : lng + D; const float* pb_ = (K == 2) ? (first ? lnb : lnb - D) : lnb + D;
          pg8::EpiResid<1> E{(float*)F.out, mods_l, first ? AIN(0) : (const float*)F.out, first ? nullptr : WSP(const float, WS_STATS), pg_, pb_, (K == 2) ? 2 : 8}; pg8::gemm_phase<pg8::EpiResid<1>, pg8::StaticOrder, true, true>(F.lds, g, S, E, F.tid); }
        if (M == MT) { pg8::Gemm g{RGN(bf16, R_H) + (size_t)ML * FF, RGN(bf16, R_WDN), MC, D, FF / 4, FF, FF, (FF / 4) * 2}; pg8::SplitKOrder S; S.init(MC, D, 4, F.G, F.bid);
          pg8::EpiPartial E{RGN(float, R_PART), D, (size_t)MC * D}; pg8::gemm_phase<pg8::EpiPartial, pg8::SplitKOrder, true, true>(F.lds, g, S, E, F.tid); }
    }
    if constexpr (K == 3) phase_ln<true, true>(F, MT, lng, lnb, mods_l, 3, 4, RGN(float, R_PART), mods_l + 8 * 18432 + 2 * 2048, 0.5f, nullptr, l == 0 ? AIN(2) : nullptr);
    if constexpr (K == 4) { pg8::Gemm g{HB, WSP(bf16, WS_WM + WM_IN), MT, NMIX, D, D, D, 0}; pg8::StaticOrder S; S.init(MT, NMIX, F.G, F.bid);
        typedef pg8::EpiBf16Seg<0, WS_R + R_ZA, WS_R + R_ZR, WS_R + R_ZG, 6, 21, ZA_LD, ZR_W, ZG_W> EpiWin; EpiWin E{(unsigned char*)F.ws};
        pg8::gemm_phase<EpiWin, pg8::StaticOrder, true, true>(F.lds, g, S, E, F.tid); }
    if constexpr (K == 5) { phase_prep(F, A, l);
#if (MK_PROBE & 0x100000)
        __syncthreads();
        for (int v = F.bid; v < 576; v += F.G) { const int item = v < 512 ? (((v & 7) << 6) | ((v >> 3) & 31) | ((v >> 8) << 5)) : 512 + ((((v - 512) & 7) << 3) | ((v - 512) >> 3)); attn_mfma_item<true>(F, A, l, item); }
#endif
#if (MK_PROBE & 0x200000)
        __syncthreads();
        for (int v = F.bid; v < 256; v += F.G) rwkv_chunk_item(F, A, l, ((v & 7) << 5) | (v >> 3), true);
#endif
#if (MK_PROBE & 0xF0000)
        __syncthreads();
        for (int v = F.bid; v < 256; v += F.G) { const int x = v & 7, y = v >> 3; gla_chunk_item<(MK_PROBE >> 16) & 15>(F, ((x + 8 * (y >> 3)) << 3) | (y & 7), true); }
#endif
    }
    if constexpr (K == 6) {
        { pg8::Gemm g{RGN(bf16, R_LA), WSP(bf16, WS_WM + WM_LW), MT, 2048, 256, LA_W, 256, 0}; pg8::StaticOrder S; S.init(MT, 2048, F.G, F.bid);
          pg8::EpiLora<0> E{RGN(float, R_WDEC), nullptr, AIN(13) + (size_t)l * 2048, (size_t)MT * 1024}; pg8::gemm_phase<pg8::EpiLora<0>, pg8::StaticOrder, true, true>(F.lds, g, S, E, F.tid); }
    }
    if constexpr (K == 15) {
        { pg8::Gemm g{RGN(bf16, R_LA) + 256, WSP(bf16, WS_WM + WM_LA), MT, 2048, 256, LA_W, 256, 0}; pg8::StaticOrder S; S.init(MT, 2048, F.G, F.bid);
          pg8::EpiLora<1> E{nullptr, RGN(bf16, R_AA), AIN(15) + (size_t)l * 2048, (size_t)MT * 1024}; pg8::gemm_phase<pg8::EpiLora<1>, pg8::StaticOrder, true, true>(F.lds, g, S, E, F.tid); }
    }
    if constexpr (K == 16) {
        { pg8::Gemm g{RGN(bf16, R_LA) + 512, WSP(bf16, WS_WM + WM_LG), MT, 1024, 256, LA_W, 256, 0}; pg8::StaticOrder S; S.init(MT, 1024, F.G, F.bid);
          pg8::EpiLora<2> E{nullptr, RGN(bf16, R_G), nullptr, 0}; pg8::gemm_phase<pg8::EpiLora<2>, pg8::StaticOrder, true, true>(F.lds, g, S, E, F.tid); }
    }
    if constexpr (K == 7) phase_mix(F, A, l, last);
    if constexpr (K == 8) {
        phase_mixout(F, A, l, nrows);
        __syncthreads();
        pg8::Gemm g{HB, WSP(bf16, WS_WM + WM_IN) + (size_t)NMIX * D, nrows, GT_W, D, D, D, 0}; pg8::StaticOrder S; S.init(nrows, GT_W, F.G, F.bid);
        typedef pg8::EpiBf16Seg<1, WS_R + R_GT, WS_R + R_GT, WS_R + R_GT, 1 << 20, 1 << 20, GT_W, GT_W, GT_W> EpiGate; EpiGate E{(unsigned char*)F.ws};
        pg8::gemm_phase<EpiGate, pg8::StaticOrder, true, true>(F.lds, g, S, E, F.tid);
    }
    if constexpr (K == 9) {
        pg8::Gemm g{RGN(bf16, R_ZA), WSP(bf16, WS_WM + WM_BA), nrows, D, 4096, ZA_LD, 4096, 0, 16, (OC_RW - 1024) * 2}; pg8::StaticOrder S; S.init(nrows, D, F.G, F.bid);
        pg8::EpiBranchFused E{RGN(bf16, R_GT), GT_W, RGN(bf16, R_MG)}; pg8::gemm_phase<pg8::EpiBranchFused, pg8::StaticOrder, true, true>(F.lds, g, S, E, F.tid);
    }
    if constexpr (K == 10) {
        { pg8::Gemm g{RGN(bf16, R_MG), WSP(bf16, WS_WM + WM_OUT), ML, D, D, D, D, 0}; pg8::StaticOrder S; S.init(ML, D, F.G, F.bid);
          pg8::EpiResid<2> E{(float*)F.out, mods_l, (const float*)F.out, WSP(const float, WS_STATS), lng, lnb, 5}; pg8::gemm_phase<pg8::EpiResid<2>, pg8::StaticOrder, true, true>(F.lds, g, S, E, F.tid); }
        if (nrows == MT) { pg8::Gemm g{RGN(bf16, R_MG) + (size_t)ML * D, WSP(bf16, WS_WM + WM_OUT), MC, D, D / 4, D, D, (D / 4) * 2}; pg8::SplitKOrder S; S.init(MC, D, 4, F.G, F.bid);
          pg8::EpiPartial E{RGN(float, R_PART), D, (size_t)MC * D}; pg8::gemm_phase<pg8::EpiPartial, pg8::SplitKOrder, true, true>(F.lds, g, S, E, F.tid); }
    }
    if constexpr (K == 11) { phase_ln<true, true>(F, nrows, lng + D, lnb + D, mods_l, 6, 7, RGN(float, R_PART), mods_l + 8 * 18432 + 5 * 2048, 1.0f); phase_convert(F, A, l, 1, 1); }
    if constexpr (K == 14) phase_ln<true, false, true>(F, ML, lng + 2 * D, lnb + 2 * D, nullptr, 0, 0);
}

__device__ __forceinline__ void frame_init(Frame& F, const Args& A, unsigned char* lds_raw) {
    F.lds = (LAS unsigned char*)lds_raw;
    F.tid = threadIdx.x; F.lane = F.tid & 63; F.wave = __builtin_amdgcn_readfirstlane(F.tid >> 6);
    F.G = gridDim.x; F.bid = blockIdx.x; F.out = (GAS float*)A.out; F.ws = (GAS unsigned char*)A.ws;
}

template <int K> __global__ void __launch_bounds__(NTHR, 2) NOPK fwd_phase(Args A) {
    extern __shared__ __attribute__((aligned(16))) unsigned char lds_raw[];
    Frame F; frame_init(F, A, lds_raw);
    const CAS Args* ap = (const CAS Args*)__builtin_amdgcn_kernarg_segment_ptr();
    run_phase<K>(F, *ap, A.ph_lo);
}


#ifndef MK_UNROLL_LAYERS
#define MK_UNROLL_LAYERS 0
#endif
__device__ __forceinline__ void launder(Frame& F, int& l) {
    asm volatile("" : "+s"(F.wave));
    { int ln; asm volatile("v_mbcnt_lo_u32_b32 %0, -1, 0\n\tv_mbcnt_hi_u32_b32 %0, -1, %0" : "=v"(ln)); F.lane = ln; }
    F.tid = F.wave * 64 + F.lane;
    asm volatile("" : "+s"(F.bid), "+s"(F.G), "+s"(l));
    asm volatile("" : "+s"(F.ws), "+s"(F.out));
}
template <int K> __device__ __forceinline__ constexpr int phase_group() { return (K == 1 || K == 2 || K == 4 || K == 6 || K == 15 || K == 16 || K == 9 || K == 10 || K == 12 || K == 13) ? 1 : (K == 7 ? 2 : (K == 8 ? 4 : (K == 5 ? 8 : (K == 0 || K == 11 ? 16 : (K == 3 || K == 14 ? 32 : 64))))); }
template <int K> __device__ __forceinline__ void run_phase_l(Frame F, int l) {
    if constexpr ((MK_PROBE & phase_group<K>()) != 0) {
        const unsigned long long t0 = __builtin_amdgcn_s_memrealtime();
        { Frame F2 = F; int l2 = l; launder(F2, l2); const CAS Args* ap = (const CAS Args*)__builtin_amdgcn_kernarg_segment_ptr(); asm volatile("" : "+s"(ap)); run_phase<K>(F2, *ap, l2); }
        asm volatile("s_waitcnt vmcnt(0) lgkmcnt(0)" ::: "memory");
        const unsigned long long t1 = __builtin_amdgcn_s_memrealtime();
        while (__builtin_amdgcn_s_memrealtime() - t1 < t1 - t0) __builtin_amdgcn_s_sleep(8);
        return;
    }
    launder(F, l); const CAS Args* ap = (const CAS Args*)__builtin_amdgcn_kernarg_segment_ptr(); asm volatile("" : "+s"(ap)); run_phase<K>(F, *ap, l); }
template <int L> __device__ __forceinline__ void run_layer(const Frame& F, int l, const XcdBarrier& bar) {
#if (MK_PROBE & 0x2000)
#define XBAR2(t_) do { const unsigned long long tb0_ = __builtin_amdgcn_s_memrealtime(); xcd_barrier(bar, (t_)); const unsigned long long tb1_ = __builtin_amdgcn_s_memrealtime(); \
    while (__builtin_amdgcn_s_memrealtime() - tb1_ < tb1_ - tb0_) __builtin_amdgcn_s_sleep(8); } while (0)
#elif (MK_PROBE & 0x1000)
#define XBAR2(t_) xcd_barrier(bar, (t_)); xcd_barrier(bar, (t_))
#else
#define XBAR2(t_) xcd_barrier(bar, (t_))
#endif
#define PB(K) run_phase_l<K>(F, l); { int ln_; asm volatile("v_mbcnt_lo_u32_b32 %0, -1, 0\n\tv_mbcnt_hi_u32_b32 %0, -1, %0" : "=v"(ln_)); XBAR2(F.wave * 64 + ln_); }
    PB(0) PB(1) PB(2) PB(3) PB(4) PB(5)
    run_phase_l<6>(F, l); run_phase_l<15>(F, l); run_phase_l<16>(F, l); { int ln_; asm volatile("v_mbcnt_lo_u32_b32 %0, -1, 0\n\tv_mbcnt_hi_u32_b32 %0, -1, %0" : "=v"(ln_)); XBAR2(F.wave * 64 + ln_); }
    PB(7) PB(8) PB(9) PB(10) PB(11) PB(12) PB(13)
#undef PB
}
__global__ void __launch_bounds__(NTHR, 2) NOPK fwd_all(Args A) {
    extern __shared__ __attribute__((aligned(16))) unsigned char lds_raw[];
    Frame F; frame_init(F, A, lds_raw);
    volatile LAS unsigned* MISC = (volatile LAS unsigned*)(F.lds + MISC_OFF);
    for (int u = F.tid; u < (LDS_BYTES - LDSCTL_OFF) / 4; u += NTHR) ((LAS unsigned*)(F.lds + LDSCTL_OFF))[u] = 0u;
    __syncthreads();
    const XcdBarrier bar = xcd_barrier_post((unsigned*)(F.ws + WS_CTL) + 4096, MISC + 8, F.tid);
    run_phase_l<-1>(F, 0); { int ln_; asm volatile("v_mbcnt_lo_u32_b32 %0, -1, 0\n\tv_mbcnt_hi_u32_b32 %0, -1, %0" : "=v"(ln_)); XBAR2(F.wave * 64 + ln_); }
#if MK_UNROLL_LAYERS
    run_layer<0>(F, 0, bar); run_layer<1>(F, 1, bar);
#else
    for (int l = 0; l < DEPTH; ++l) run_layer<0>(F, l, bar);
#endif
    run_phase_l<14>(F, DEPTH - 1);
}

template <int K> static void launch_phase(const Args& a, int l, int grid, hipStream_t stream) {
    static bool attr_done = false;
    if (!attr_done) { (void)hipFuncSetAttribute((const void*)fwd_phase<K>, hipFuncAttributeMaxDynamicSharedMemorySize, LDS_BYTES); attr_done = true; }
    Args b = a; b.ph_lo = l; b.ph_hi = 0;
    hipLaunchKernelGGL(fwd_phase<K>, dim3(grid), dim3(NTHR), LDS_BYTES, stream, b);
}

extern "C" void kernel_launch(void* const* d_in, const int* in_sizes, int n_in, void* d_out, int out_size, void* d_ws, size_t ws_size, hipStream_t stream) {
    static int grid = 0;
    if (grid == 0) {
        if (n_in != 30 || out_size != ML * D || ws_size < WS_END) { fprintf(stderr, "kernel_launch: unexpected shapes (n_in %d, out %d, ws %zu < %zu)\n", n_in, out_size, ws_size, (size_t)WS_END); grid = -1; return; }
        int dev = 0, cus = 0;
        if (hipGetDevice(&dev) != hipSuccess || hipDeviceGetAttribute(&cus, hipDeviceAttributeMultiprocessorCount, dev) != hipSuccess) { grid = -1; return; }
        grid = cus;
    }
    if (grid < 0) return;
    (void)hipMemsetAsync((char*)d_ws + WS_CTL, 0, CTL_ZERO_BYTES, stream);
    Args a{};
    for (int i = 0; i < 30; ++i) a.in[i] = (const float*)d_in[i];
    a.out = (float*)d_out; a.ws = (unsigned char*)d_ws;
#if MK_ONE_LAUNCH
    {
        static bool attr_done = false;
        if (!attr_done) { int per_cu = 0;
            if (hipFuncSetAttribute((const void*)fwd_all, hipFuncAttributeMaxDynamicSharedMemorySize, LDS_BYTES) != hipSuccess) { fprintf(stderr, "kernel_launch: hipFuncSetAttribute failed\n"); grid = -1; return; }
            if (hipOccupancyMaxActiveBlocksPerMultiprocessor(&per_cu, (const void*)fwd_all, NTHR, LDS_BYTES) != hipSuccess || per_cu < 1) { fprintf(stderr, "kernel_launch: occupancy query says %d blocks per CU; not launching\n", per_cu); (void)hipGetLastError(); grid = -1; return; }
            attr_done = true; }
        a.ph_lo = 0; a.ph_hi = 0;
        hipLaunchKernelGGL(fwd_all, dim3(grid), dim3(NTHR), LDS_BYTES, stream, a);
        return;
    }
#endif
    launch_phase<-1>(a, 0, grid, stream);
    for (int l = 0; l < DEPTH; ++l) {
        launch_phase<0>(a, l, grid, stream); launch_phase<1>(a, l, grid, stream); launch_phase<2>(a, l, grid, stream); launch_phase<3>(a, l, grid, stream);
        launch_phase<4>(a, l, grid, stream); launch_phase<5>(a, l, grid, stream); launch_phase<6>(a, l, grid, stream); launch_phase<15>(a, l, grid, stream); launch_phase<16>(a, l, grid, stream); launch_phase<7>(a, l, grid, stream);
        launch_phase<8>(a, l, grid, stream); launch_phase<9>(a, l, grid, stream); launch_phase<10>(a, l, grid, stream); launch_phase<11>(a, l, grid, stream);
        launch_phase<12>(a, l, grid, stream); launch_phase<13>(a, l, grid, stream);
    }
    launch_phase<14>(a, DEPTH - 1, grid, stream);
}
```

```cpp
#include <hip/hip_runtime.h>
#include <cstdio>
#include <cstdint>

#define GAS __attribute__((address_space(1)))
#define LAS __attribute__((address_space(3)))
typedef unsigned short bf16;
typedef unsigned v4u __attribute__((ext_vector_type(4)));
typedef unsigned v2u __attribute__((ext_vector_type(2)));
typedef float v2f __attribute__((ext_vector_type(2)));
typedef float f32x4 __attribute__((ext_vector_type(4)));
typedef float f32x2 __attribute__((ext_vector_type(2)));
typedef short bf16x8 __attribute__((ext_vector_type(8)));

__device__ __forceinline__ float bf2f(unsigned short b) { return __builtin_bit_cast(float, ((unsigned)b) << 16); }
__device__ __forceinline__ float bflo(unsigned w) { return __builtin_bit_cast(float, w << 16); }
__device__ __forceinline__ float bfhi(unsigned w) { return __builtin_bit_cast(float, w & 0xffff0000u); }
typedef __bf16 bf2n_t_ __attribute__((ext_vector_type(2)));
__device__ __forceinline__ unsigned pk2(float lo, float hi) { const f32x2 v = {lo, hi}; return __builtin_bit_cast(unsigned, __builtin_convertvector(v, bf2n_t_)); }
__device__ __forceinline__ unsigned f2bf(float f) { return pk2(f, 0.f) & 0xffffu; }
template <int CTRL, int ROW_MASK> __device__ __forceinline__ float dppf(float v) {
    return __builtin_bit_cast(float, __builtin_amdgcn_update_dpp(0, __builtin_bit_cast(int, v), CTRL, ROW_MASK, 0xF, false)); }
__device__ __forceinline__ float wave_sum(float v) {
    v += dppf<0xB1, 0xF>(v);
    v += dppf<0x4E, 0xF>(v);
    v += dppf<0x141, 0xF>(v);
    v += dppf<0x140, 0xF>(v);
    v += dppf<0x142, 0xA>(v);
    v += dppf<0x143, 0xC>(v);
    return __builtin_bit_cast(float, __builtin_amdgcn_readlane(__builtin_bit_cast(int, v), 63));
}
__device__ __forceinline__ void half_swap(float& a, float& b) { asm volatile("v_nop\n\tv_nop\n\tv_permlane32_swap_b32 %0, %1\n\tv_nop\n\tv_nop" : "+v"(a), "+v"(b)); }
__device__ __forceinline__ float xhalf_max(float v) { float a = v, b = v; half_swap(a, b); return fmaxf(a, b); }
__device__ __forceinline__ float xhalf_sum(float v) { float a = v, b = v; half_swap(a, b); return a + b; }
__device__ __forceinline__ float fexp(float x) { return __builtin_amdgcn_exp2f(x * 1.4426950408889634f); }
__device__ __forceinline__ float flog1p_pos(float e) { return __builtin_amdgcn_logf(1.0f + e) * 0.6931471805599453f; }
__device__ __forceinline__ float fsigmoid(float x) { return __builtin_amdgcn_rcpf(1.0f + fexp(-x)); }
__device__ __forceinline__ float fsilu(float x) { return x * __builtin_amdgcn_rcpf(1.0f + fexp(-x)); }
__device__ __forceinline__ float fsoftplus(float x) { return fmaxf(x, 0.f) + flog1p_pos(fexp(-fabsf(x))); }
__device__ __forceinline__ float ftanh(float x) { const float e = fexp(-2.0f * fabsf(x)); const float t = (1.0f - e) * __builtin_amdgcn_rcpf(1.0f + e); return x < 0.f ? -t : t; }

namespace pg8 {
#define PG8_LAS __attribute__((address_space(3)))
typedef unsigned short bf16_t;
typedef short bf16x8 __attribute__((ext_vector_type(8)));
typedef float f32x4 __attribute__((ext_vector_type(4)));
typedef unsigned u32x4 __attribute__((ext_vector_type(4)));
constexpr int BM = 256, BK = 64, HALF = 128, HTB = HALF * BK * 2  , STAGE_BYTES = 8 * HTB, NXCD = 8, WGM = 8;

__host__ __device__ __forceinline__ int lds_byte(int r, int c) { const int st = (r >> 4) * 2 + (c >> 5), rr = r & 15, cc = c & 31, ob = rr * 64 + cc * 2; return st * 1024 + (ob ^ (((ob >> 9) & 1) << 5)); }
__host__ __device__ __forceinline__ void stage_rc(int b, int& R, int& C) { const int st = b / 1024, sb = b % 1024, swz = sb ^ (((sb >> 9) & 1) << 5); R = (st >> 1) * 16 + swz / 64; C = (st & 1) * 32 + (swz % 64) / 2; }
__host__ __device__ __forceinline__ int perm32(int rho) { const int n = rho >> 4, i = rho & 15; return 8 * (i >> 2) + 4 * n + (i & 3); }

struct Unit { int pm, pn, kq; };
struct Gemm { const bf16_t* A; const bf16_t* Bt; int M, N, K, lda, ldb; int kqb; int jt, jb; };

struct StaticOrder {
    int nM, nN, nwg, G, c;
    __host__ __device__ void init(int M, int N, int G_, int c_) { nM = M / BM; nN = N / BM; nwg = nM * nN; G = G_; c = c_; }
    __host__ __device__ bool next(int i, Unit& u) const {
        const long L = (long)i * G + c; if (L >= nwg) return false;
        int wgid = (int)L; { const int q = nwg / NXCD, r = nwg % NXCD, xcd = wgid % NXCD, off = wgid / NXCD; wgid = (xcd < r ? xcd * (q + 1) : r * (q + 1) + (xcd - r) * q) + off; }
        const int nig = WGM * nN, gid = wgid / nig, fm = gid * WGM, gsz = (nM - fm) < WGM ? (nM - fm) : WGM;
        u.pm = fm + ((wgid % nig) % gsz); u.pn = (wgid % nig) / gsz; u.kq = 0; return true;
    }
    __device__ __forceinline__ void a_ready(const Unit&) const {}
    __device__ __forceinline__ void done(const Unit&) const {}
};

struct SplitKOrder {
    int nM, nN, nq, G, c;
    __host__ __device__ void init(int M, int N, int NQ, int G_, int c_) { nM = M / BM; nN = N / BM; nq = NQ; G = G_; c = c_; }
    __host__ __device__ bool next(int i, Unit& u) const { const long L = (long)i * G + c; if (L >= (long)nM * nN * nq) return false; const int t = (int)L / nq; u.kq = (int)L % nq; u.pm = t % nM; u.pn = t / nM; return true; }
    __device__ __forceinline__ void a_ready(const Unit&) const {}
    __device__ __forceinline__ void done(const Unit&) const {}
};
typedef __bf16 bf2_t_ __attribute__((ext_vector_type(2)));
typedef float f2_t_ __attribute__((ext_vector_type(2)));
__device__ __forceinline__ unsigned cvt_pk_bf16(float lo, float hi) { const f2_t_ v = {lo, hi}; return __builtin_bit_cast(unsigned, __builtin_convertvector(v, bf2_t_)); }

#define EPI_ROWS_BEGIN \
    _Pragma("unroll") for (int ai = 0; ai < 2; ++ai) _Pragma("unroll") for (int m = 0; m < 4; ++m) { const int row = u.pm * BM + ai * HALF + wr * 64 + m * 16 + fr;
#define EPI_ROWS_END }

template <int ACT, size_t O0, size_t O1, size_t O2, int T1, int T2, int L0, int L1, int L2> struct EpiBf16Seg {
    static constexpr bool PERM = true, AFTER_DRAIN = false;
    unsigned char* ws;
    __device__ __forceinline__ void operator()(const f32x4 (&acc)[2][2][4][2], const Unit& u, int wr, int wc, int fr, int fq) const {
        const size_t off = u.pn >= T2 ? O2 : (u.pn >= T1 ? O1 : O0); const int l = u.pn >= T2 ? L2 : (u.pn >= T1 ? L1 : L0), tb = u.pn >= T2 ? T2 : (u.pn >= T1 ? T1 : 0);
        bf16_t* base = (bf16_t*)(ws + off);
        const int col0 = (u.pn - tb) * BM + wc * 32 + 8 * fq;
        EPI_ROWS_BEGIN
            bf16_t* rowp = base + (size_t)row * l + col0;
#pragma unroll
            for (int bj = 0; bj < 2; ++bj) { f32x4 v0 = acc[ai][bj][m][0], v1 = acc[ai][bj][m][1];
                if (ACT == 1) {
#pragma unroll
                    for (int j = 0; j < 4; ++j) { v0[j] = fsigmoid(v0[j]); v1[j] = fsigmoid(v1[j]); } }
                u32x4 w; w.x = cvt_pk_bf16(v0[0], v0[1]); w.y = cvt_pk_bf16(v0[2], v0[3]); w.z = cvt_pk_bf16(v1[0], v1[1]); w.w = cvt_pk_bf16(v1[2], v1[3]);
                *(u32x4*)(rowp + bj * HALF) = w; }
        EPI_ROWS_END
    }
};
struct EpiSwiglu {
    static constexpr bool PERM = true, AFTER_DRAIN = false;
    bf16_t* H; int ldh;
    __device__ __forceinline__ void operator()(const f32x4 (&acc)[2][2][4][2], const Unit& u, int wr, int wc, int fr, int fq) const {
        const int col0 = u.pn * HALF + wc * 32 + 8 * fq;
        EPI_ROWS_BEGIN
            f32x4 g0 = acc[ai][0][m][0], g1 = acc[ai][0][m][1]; const f32x4 u0 = acc[ai][1][m][0], u1 = acc[ai][1][m][1];
#pragma unroll
            for (int j = 0; j < 4; ++j) { g0[j] = fsilu(g0[j]) * u0[j]; g1[j] = fsilu(g1[j]) * u1[j]; }
            u32x4 w; w.x = cvt_pk_bf16(g0[0], g0[1]); w.y = cvt_pk_bf16(g0[2], g0[3]); w.z = cvt_pk_bf16(g1[0], g1[1]); w.w = cvt_pk_bf16(g1[2], g1[3]);
            *(u32x4*)(H + (size_t)row * ldh + col0) = w;
        EPI_ROWS_END
    }
};
struct EpiPartial {
    static constexpr bool PERM = true, AFTER_DRAIN = false;
    bf16_t* P; int ldp; size_t qstride;
    __device__ __forceinline__ void operator()(const f32x4 (&acc)[2][2][4][2], const Unit& u, int wr, int wc, int fr, int fq) const {
        const int col0 = u.pn * BM + wc * 32 + 8 * fq; bf16_t* base = P + (size_t)u.kq * qstride;
        EPI_ROWS_BEGIN
            bf16_t* rowp = base + (size_t)row * ldp + col0;
#pragma unroll
            for (int bj = 0; bj < 2; ++bj) { const f32x4 v0 = acc[ai][bj][m][0], v1 = acc[ai][bj][m][1];
                u32x4 w; w.x = cvt_pk_bf16(v0[0], v0[1]); w.y = cvt_pk_bf16(v0[2], v0[3]); w.z = cvt_pk_bf16(v1[0], v1[1]); w.w = cvt_pk_bf16(v1[2], v1[3]);
                *(u32x4*)(rowp + bj * HALF) = w; }
        EPI_ROWS_END
    }
};
constexpr float RES_ALPHA = 1.41421356237f;
template <int COEF2> struct EpiResid {
    static constexpr bool PERM = true, AFTER_DRAIN = false;
    float* xl; const float* mods; const float* sl; const float* st; const float* lg; const float* lb; int kmod;
    __device__ __forceinline__ void operator()(const f32x4 (&acc)[2][2][4][2], const Unit& u, int wr, int wc, int fr, int fq) const {
        const float* mp = mods + (size_t)(u.pm >> 3) * (9 * 2048) + kmod * 2048;
        const int col0 = u.pn * BM + wc * 32 + 8 * fq;
        const bool ln = st != nullptr; constexpr float al = RES_ALPHA, coef = 0.5f * COEF2;
        const float* stp = ln ? st : mods;
        const int row0 = u.pm * BM + wr * 64 + fr;
        const size_t rbase = (size_t)row0 * 2048 + col0;
#pragma unroll
        for (int bj = 0; bj < 2; ++bj) {
            f32x4 mv[2], ag[2], ab[2];
#pragma unroll
            for (int n = 0; n < 2; ++n) { mv[n] = *(const f32x4*)(mp + col0 + bj * HALF + 4 * n) * coef;
                const f32x4 g4 = *(const f32x4*)(lg + col0 + bj * HALF + 4 * n), b4 = *(const f32x4*)(lb + col0 + bj * HALF + 4 * n);
                const f32x4 g4s = ln ? g4 : (f32x4){1.f, 1.f, 1.f, 1.f}, b4s = ln ? b4 : (f32x4){0.f, 0.f, 0.f, 0.f};
                ag[n] = g4s * al; ab[n] = b4s * al; }
            f32x4 xa[3][2]; f2_t_ ms[3];
#define RES_LOADG(slot, g_) do { const int ro_ = ((g_) >> 2) * HALF + ((g_) & 3) * 16; \
                _Pragma("unroll") for (int n = 0; n < 2; ++n) xa[slot][n] = *(const f32x4*)(sl + rbase + (size_t)ro_ * 2048 + bj * HALF + 4 * n); \
                ms[slot] = *(const f2_t_*)(stp + 2 * (row0 + ro_)); } while (0)
            RES_LOADG(0, 0); RES_LOADG(1, 1);
#pragma unroll
            for (int gi = 0; gi < 8; ++gi) {
                const int ai = gi >> 2, m = gi & 3;
                if (gi + 2 < 8) RES_LOADG((gi + 2) % 3, gi + 2);
                asm volatile("" ::: "memory");
                float* rowp = xl + rbase + (size_t)(ai * HALF + m * 16) * 2048 + bj * HALF;
                const float mean = ln ? ms[gi % 3][0] : 0.f, rstd = ln ? ms[gi % 3][1] : 1.f;
#pragma unroll
                for (int n = 0; n < 2; ++n) { const f32x4 t = ag[n] * rstd;
                    *(f32x4*)(rowp + 4 * n) = (xa[gi % 3][n] - mean) * t + (ab[n] + mv[n] * acc[ai][bj][m][n]); }
                asm volatile("" ::: "memory");
            }
#undef RES_LOADG
        }
    }
};
template <int MODE> struct EpiBranch {
    static constexpr bool PERM = true, AFTER_DRAIN = false;
    const bf16_t* GT; int ldg, goff; float* T; bf16_t* O;
    __device__ __forceinline__ void operator()(const f32x4 (&acc)[2][2][4][2], const Unit& u, int wr, int wc, int fr, int fq) const {
        const int col0 = u.pn * BM + wc * 32 + 8 * fq;
        const size_t r0 = (size_t)(u.pm * BM + wr * 64 + fr);
        u32x4 gw[2][2]; f32x4 tv[2][2][2];
#pragma unroll
        for (int bj = 0; bj < 2; ++bj) { gw[0][bj] = *(const u32x4*)(GT + r0 * ldg + goff + col0 + bj * HALF);
            if (MODE >= 1) { const float* tp = T + r0 * 2048 + col0 + bj * HALF; tv[0][bj][0] = *(const f32x4*)tp; tv[0][bj][1] = *(const f32x4*)(tp + 4); } }
#pragma unroll
        for (int gi = 0; gi < 8; ++gi) {
            const int ai = gi >> 2, m = gi & 3; const size_t row = r0 + ai * HALF + m * 16;
            if (gi < 7) { const size_t row2 = r0 + ((gi + 1) >> 2) * HALF + ((gi + 1) & 3) * 16;
#pragma unroll
                for (int bj = 0; bj < 2; ++bj) { gw[(gi + 1) & 1][bj] = *(const u32x4*)(GT + row2 * ldg + goff + col0 + bj * HALF);
                    if (MODE >= 1) { const float* tp = T + row2 * 2048 + col0 + bj * HALF; tv[(gi + 1) & 1][bj][0] = *(const f32x4*)tp; tv[(gi + 1) & 1][bj][1] = *(const f32x4*)(tp + 4); } } }
            asm volatile("" ::: "memory");
#pragma unroll
            for (int bj = 0; bj < 2; ++bj) {
                const u32x4 g4 = gw[gi & 1][bj];
                const f32x4 g0 = (f32x4){bflo(g4.x), bfhi(g4.x), bflo(g4.y), bfhi(g4.y)}, g1 = (f32x4){bflo(g4.z), bfhi(g4.z), bflo(g4.w), bfhi(g4.w)};
                f32x4 v0 = g0 * acc[ai][bj][m][0], v1 = g1 * acc[ai][bj][m][1];
                float* tp = T + row * 2048 + col0 + bj * HALF;
                if (MODE >= 1) { v0 += tv[gi & 1][bj][0]; v1 += tv[gi & 1][bj][1]; }
                if (MODE <= 1) { *(f32x4*)tp = v0; *(f32x4*)(tp + 4) = v1; }
                else { u32x4 w; w.x = cvt_pk_bf16(v0[0], v0[1]); w.y = cvt_pk_bf16(v0[2], v0[3]); w.z = cvt_pk_bf16(v1[0], v1[1]); w.w = cvt_pk_bf16(v1[2], v1[3]);
                    *(u32x4*)(O + row * 2048 + col0 + bj * HALF) = w; }
            }
            asm volatile("" ::: "memory");
        }
    }
};
struct EpiBranchFused {
    static constexpr bool PERM = true, AFTER_DRAIN = false, MID = true;
    static constexpr int H1 = 16, H2 = 32;
    const bf16_t* GT; int ldg; bf16_t* O;
    static __device__ __forceinline__ void unpack(const u32x4 g4, f32x4& g0, f32x4& g1) { g0 = (f32x4){bflo(g4.x), bfhi(g4.x), bflo(g4.y), bfhi(g4.y)}; g1 = (f32x4){bflo(g4.z), bfhi(g4.z), bflo(g4.w), bfhi(g4.w)}; }
    __device__ __forceinline__ void mid(f32x4 (&acc)[2][2][4][2], const Unit& u, int wr, int wc, int fr, int fq, bool second) const {
        const int col0 = u.pn * BM + wc * 32 + 8 * fq;
        const size_t r0 = (size_t)(u.pm * BM + wr * 64 + fr);
        const int on = second ? 2048 : 0, od = second ? 4096 : 2048;
        const float nfloor = second ? 1e-20f : 0.f;
        u32x4 gn[2][2], gd[2][2];
#pragma unroll
        for (int bj = 0; bj < 2; ++bj) { gn[0][bj] = *(const u32x4*)(GT + r0 * ldg + on + col0 + bj * HALF); gd[0][bj] = *(const u32x4*)(GT + r0 * ldg + od + col0 + bj * HALF); }
#pragma unroll
        for (int gi = 0; gi < 8; ++gi) {
            const int ai = gi >> 2, m = gi & 3;
            if (gi < 7) { const size_t row2 = r0 + ((gi + 1) >> 2) * HALF + ((gi + 1) & 3) * 16;
#pragma unroll
                for (int bj = 0; bj < 2; ++bj) { gn[(gi + 1) & 1][bj] = *(const u32x4*)(GT + row2 * ldg + on + col0 + bj * HALF); gd[(gi + 1) & 1][bj] = *(const u32x4*)(GT + row2 * ldg + od + col0 + bj * HALF); } }
            asm volatile("" ::: "memory");
#pragma unroll
            for (int bj = 0; bj < 2; ++bj) {
                f32x4 n0, n1, d0, d1; unpack(gn[gi & 1][bj], n0, n1); unpack(gd[gi & 1][bj], d0, d1);
#pragma unroll
                for (int j = 0; j < 4; ++j) {
                    acc[ai][bj][m][0][j] *= fmaxf(n0[j], nfloor) * __builtin_amdgcn_rcpf(fmaxf(d0[j], 1e-20f));
                    acc[ai][bj][m][1][j] *= fmaxf(n1[j], nfloor) * __builtin_amdgcn_rcpf(fmaxf(d1[j], 1e-20f)); }
            }
            asm volatile("" ::: "memory");
        }
    }
    __device__ __forceinline__ void operator()(const f32x4 (&acc)[2][2][4][2], const Unit& u, int wr, int wc, int fr, int fq) const {
        const int col0 = u.pn * BM + wc * 32 + 8 * fq;
        const size_t r0 = (size_t)(u.pm * BM + wr * 64 + fr);
        u32x4 gw[2][2];
#pragma unroll
        for (int bj = 0; bj < 2; ++bj) gw[0][bj] = *(const u32x4*)(GT + r0 * ldg + 4096 + col0 + bj * HALF);
#pragma unroll
        for (int gi = 0; gi < 8; ++gi) {
            const int ai = gi >> 2, m = gi & 3; const size_t row = r0 + ai * HALF + m * 16;
            if (gi < 7) { const size_t row2 = r0 + ((gi + 1) >> 2) * HALF + ((gi + 1) & 3) * 16;
#pragma unroll
                for (int bj = 0; bj < 2; ++bj) gw[(gi + 1) & 1][bj] = *(const u32x4*)(GT + row2 * ldg + 4096 + col0 + bj * HALF); }
            asm volatile("" ::: "memory");
#pragma unroll
            for (int bj = 0; bj < 2; ++bj) {
                f32x4 g0, g1; unpack(gw[gi & 1][bj], g0, g1);
                f32x4 v0, v1;
#pragma unroll
                for (int j = 0; j < 4; ++j) { v0[j] = acc[ai][bj][m][0][j] * fmaxf(g0[j], 1e-20f); v1[j] = acc[ai][bj][m][1][j] * fmaxf(g1[j], 1e-20f); }
                u32x4 w; w.x = cvt_pk_bf16(v0[0], v0[1]); w.y = cvt_pk_bf16(v0[2], v0[3]); w.z = cvt_pk_bf16(v1[0], v1[1]); w.w = cvt_pk_bf16(v1[2], v1[3]);
                *(u32x4*)(O + row * 2048 + col0 + bj * HALF) = w;
            }
            asm volatile("" ::: "memory");
        }
    }
};
template <int MODE> struct EpiLora {
    static constexpr bool PERM = true, AFTER_DRAIN = false;
    float* WD; bf16_t* OB; const float* bias; size_t dstride;
    __device__ __forceinline__ void operator()(const f32x4 (&acc)[2][2][4][2], const Unit& u, int wr, int wc, int fr, int fq) const {
        const int colg = u.pn * BM + wc * 32 + 8 * fq;
        f32x4 bv[2][2];
#pragma unroll
        for (int bj = 0; bj < 2; ++bj) { if (MODE != 2) { bv[bj][0] = *(const f32x4*)(bias + colg + bj * HALF); bv[bj][1] = *(const f32x4*)(bias + colg + bj * HALF + 4); } else { bv[bj][0] = (f32x4){0.f, 0.f, 0.f, 0.f}; bv[bj][1] = bv[bj][0]; } }
        EPI_ROWS_BEGIN
#pragma unroll
            for (int bj = 0; bj < 2; ++bj) { const int cg = colg + bj * HALF; const int dir = (MODE == 2) ? 0 : (cg >> 10); const int c = (MODE == 2) ? cg : (cg & 1023);
                f32x4 v0 = acc[ai][bj][m][0], v1 = acc[ai][bj][m][1];
                if (MODE != 2) { v0 += bv[bj][0]; v1 += bv[bj][1]; }
                if (MODE == 0) {
#pragma unroll
                    for (int j = 0; j < 4; ++j) { v0[j] = -fexp(-fsoftplus(-v0[j]) - 0.5f); v1[j] = -fexp(-fsoftplus(-v1[j]) - 0.5f); }
                    float* p = WD + (size_t)dir * dstride + (size_t)row * 1024 + c; *(f32x4*)p = v0; *(f32x4*)(p + 4) = v1;
                } else {
                    if (MODE == 1) {
#pragma unroll
                        for (int j = 0; j < 4; ++j) { v0[j] = fsigmoid(v0[j]); v1[j] = fsigmoid(v1[j]); } }
                    u32x4 w; w.x = cvt_pk_bf16(v0[0], v0[1]); w.y = cvt_pk_bf16(v0[2], v0[3]); w.z = cvt_pk_bf16(v1[0], v1[1]); w.w = cvt_pk_bf16(v1[2], v1[3]);
                    *(u32x4*)(OB + (size_t)dir * dstride + (size_t)row * 1024 + c) = w;
                }
            }
            asm volatile("" ::: "memory");
        EPI_ROWS_END
    }
};

template <class E, class = void> struct mid_hook { static constexpr bool value = false; };
template <class E> struct mid_hook<E, decltype((void)E::MID)> { static constexpr bool value = E::MID; };
template <class Epi, class Sched, bool ALIGN_EPI = false, bool SP2 = false>
__device__ __forceinline__ void gemm_phase(PG8_LAS unsigned char* lds, const Gemm g, const Sched& S, const Epi& E, int tid_in) {
    int tid_ = tid_in; asm volatile("" : "+v"(tid_));
    const int tid = tid_, wid = __builtin_amdgcn_readfirstlane(tid >> 6), lane = tid & 63, wr = wid >> 2, wc = wid & 3, fr = lane & 15, fq = lane >> 4;
    int K_ = g.K, lda_ = g.lda, ldb_ = g.ldb; asm volatile("" : "+s"(K_), "+s"(lda_), "+s"(ldb_));
    const int K = K_, nt = K / BK, lda = lda_, ldb = ldb_;
    int jt_ = g.jt, jb_ = g.jb; asm volatile("" : "+s"(jt_), "+s"(jb_));
    const int jt = jt_; const size_t jb = (size_t)jb_;
    unsigned voffA[2], voffB[2];
#pragma unroll
    for (int i = 0; i < 2; ++i) { int R, C; stage_rc(tid * 16 + i * 8192, R, C); const int Rb = Epi::PERM ? ((R & ~31) + perm32(R & 31)) : R;
        voffA[i] = (unsigned)(R * lda + C) * 2u; voffB[i] = (unsigned)(Rb * ldb + C) * 2u; }
    const size_t kstep = (size_t)(BK * 2);
    const size_t hsA = (size_t)HALF * lda * 2, hsB = (size_t)HALF * ldb * 2;
    const size_t tsA = 2 * hsA, tsB = 2 * hsB;
    const unsigned ldsw = (unsigned)wid * 1024u;
    const int aoff = lds_byte(wr * 64 + fr, fq * 8), boff = lds_byte(wc * 32 + fr, fq * 8);
#define PG8_SA(b, h) (((b) * 2 + (h)) * HTB)
#define PG8_SB(b, h) ((4 + (b) * 2 + (h)) * HTB)
#define PG8_STAGE(bufoff, gbase, voff) do { _Pragma("unroll") for (int _i = 0; _i < 2; ++_i) \
        __builtin_amdgcn_global_load_lds((const unsigned*)((const char*)(gbase) + (voff)[_i]), (PG8_LAS unsigned*)(lds + (bufoff) + ldsw + _i * 8192), 16, 0, 0); } while (0)
#define PG8_LDA(dst, b, h) do { _Pragma("unroll") for (int m = 0; m < 4; ++m) _Pragma("unroll") for (int k = 0; k < 2; ++k) dst[m][k] = *(const PG8_LAS bf16x8*)(lds + PG8_SA(b, h) + aoff + m * 2048 + k * 1024); } while (0)
#define PG8_LDB(dst, b, h) do { _Pragma("unroll") for (int n = 0; n < 2; ++n) _Pragma("unroll") for (int k = 0; k < 2; ++k) dst[n][k] = *(const PG8_LAS bf16x8*)(lds + PG8_SB(b, h) + boff + n * 2048 + k * 1024); } while (0)
#define PG8_MMA(ai, bj, At, Bt) do { __builtin_amdgcn_s_setprio(1); _Pragma("unroll") for (int m = 0; m < 4; ++m) _Pragma("unroll") for (int n = 0; n < 2; ++n) _Pragma("unroll") for (int k = 0; k < 2; ++k) \
        acc[ai][bj][m][n] = __builtin_amdgcn_mfma_f32_16x16x32_bf16(Bt[n][k], At[m][k], acc[ai][bj][m][n], 0, 0, 0); __builtin_amdgcn_s_setprio(0); } while (0)
#define PG8_WAIT_V(n) asm volatile("s_waitcnt vmcnt(" #n ")" ::: "memory")
#define PG8_WAIT_L(n) asm volatile("s_waitcnt lgkmcnt(" #n ")" ::: "memory")
#define PG8_BAR __builtin_amdgcn_s_barrier()
#define PG8_SCHED __builtin_amdgcn_sched_barrier(0)
    Unit cur, nxt; int ui = 0;
    if (!S.next(0, cur)) return;
    f32x4 acc[2][2][4][2];
#pragma unroll
    for (int a = 0; a < 2; ++a)
#pragma unroll
        for (int b = 0; b < 2; ++b)
#pragma unroll
            for (int m = 0; m < 4; ++m)
#pragma unroll
                for (int n = 0; n < 2; ++n) acc[a][b][m][n] = (f32x4){0.f, 0.f, 0.f, 0.f};
    bf16x8 At[4][2], B0[2][2], B1[2][2];
    const char* cA = (const char*)g.A + (size_t)cur.pm * tsA + (size_t)cur.kq * g.kqb; const char* cB = (const char*)g.Bt + (size_t)cur.pn * tsB + (size_t)cur.kq * g.kqb;
    S.a_ready(cur);
    if constexpr (SP2) {
        PG8_STAGE(PG8_SB(0, 0), cB, voffB); PG8_STAGE(PG8_SB(0, 1), cB + hsB, voffB); PG8_STAGE(PG8_SA(0, 0), cA, voffA); PG8_STAGE(PG8_SA(0, 1), cA + hsA, voffA);
        if (wr == 1) PG8_BAR;
        PG8_WAIT_V(2); PG8_BAR;
        PG8_STAGE(PG8_SB(1, 0), cB + kstep, voffB); PG8_STAGE(PG8_SA(1, 0), cA + kstep, voffA); PG8_STAGE(PG8_SB(1, 1), cB + hsB + kstep, voffB);
        PG8_WAIT_V(6); PG8_BAR;
    } else {
        PG8_STAGE(PG8_SB(0, 0), cB, voffB); PG8_STAGE(PG8_SA(0, 0), cA, voffA); PG8_STAGE(PG8_SB(0, 1), cB + hsB, voffB); PG8_STAGE(PG8_SA(0, 1), cA + hsA, voffA);
        if (wr == 1) PG8_BAR;
        PG8_WAIT_V(4); PG8_BAR;
        PG8_STAGE(PG8_SB(1, 0), cB + kstep, voffB); PG8_STAGE(PG8_SA(1, 0), cA + kstep, voffA); PG8_STAGE(PG8_SB(1, 1), cB + hsB + kstep, voffB);
        PG8_WAIT_V(6); PG8_BAR;
    }
    for (;;) {
        const bool has_next = S.next(ui + 1, nxt);
        const char* nA = has_next ? (const char*)g.A + (size_t)nxt.pm * tsA + (size_t)nxt.kq * g.kqb : cA; const char* nB = has_next ? (const char*)g.Bt + (size_t)nxt.pn * tsB + (size_t)nxt.kq * g.kqb : cB;
        for (int t = 0; t < nt; t += 2) {
            const bool last = (t == nt - 2);
            if constexpr (mid_hook<Epi>::value) { if (t == Epi::H1 || t == Epi::H2) E.mid(acc, cur, wr, wc, fr, fq, t == Epi::H2); }
            const char* a1 = cA + (size_t)(t + 1) * kstep + (t >= jt ? jb : 0);
            const char* a2 = last ? nA : cA + (size_t)(t + 2) * kstep + (t + 2 >= jt ? jb : 0); const char* b2 = last ? nB : cB + (size_t)(t + 2) * kstep;
            const char* a3 = a2 + kstep; const char* b3 = b2 + kstep;
            if (last && has_next) S.a_ready(nxt);
            if constexpr (SP2) {
            PG8_LDB(B0, 0, 0); PG8_LDB(B1, 0, 1); PG8_SCHED; PG8_LDA(At, 0, 0); PG8_STAGE(PG8_SA(1, 1), a1 + hsA, voffA);
            PG8_WAIT_V(8); PG8_WAIT_L(0); PG8_BAR; PG8_MMA(0, 0, At, B0); PG8_MMA(0, 1, At, B1); PG8_BAR; PG8_SCHED;
            PG8_LDA(At, 0, 1); PG8_STAGE(PG8_SB(0, 0), b2, voffB); PG8_STAGE(PG8_SB(0, 1), b2 + hsB, voffB); PG8_STAGE(PG8_SA(0, 0), a2, voffA);
            PG8_WAIT_V(8); PG8_WAIT_L(0); PG8_BAR; PG8_MMA(1, 0, At, B0); PG8_MMA(1, 1, At, B1); PG8_BAR; PG8_SCHED;
            PG8_LDB(B0, 1, 0); PG8_LDB(B1, 1, 1); PG8_SCHED; PG8_LDA(At, 1, 0); PG8_STAGE(PG8_SA(0, 1), a2 + hsA, voffA);
            PG8_WAIT_V(8); PG8_WAIT_L(0); PG8_BAR; PG8_MMA(0, 0, At, B0); PG8_MMA(0, 1, At, B1); PG8_BAR; PG8_SCHED;
            PG8_LDA(At, 1, 1); PG8_STAGE(PG8_SB(1, 0), b3, voffB); PG8_STAGE(PG8_SB(1, 1), b3 + hsB, voffB); PG8_STAGE(PG8_SA(1, 0), a3, voffA);
            PG8_WAIT_V(8); PG8_WAIT_L(0); PG8_BAR; PG8_MMA(1, 0, At, B0); PG8_MMA(1, 1, At, B1); PG8_BAR; PG8_SCHED;
            } else {
            PG8_LDB(B0, 0, 0); PG8_SCHED; PG8_LDA(At, 0, 0); PG8_STAGE(PG8_SA(1, 1), a1 + hsA, voffA);
            PG8_WAIT_L(8); PG8_BAR; PG8_WAIT_L(0); PG8_MMA(0, 0, At, B0); PG8_BAR; PG8_SCHED;
            PG8_LDB(B1, 0, 1); PG8_STAGE(PG8_SB(0, 0), b2, voffB);
            PG8_BAR; PG8_WAIT_L(0); PG8_MMA(0, 1, At, B1); PG8_BAR;
            PG8_LDA(At, 0, 1); PG8_STAGE(PG8_SA(0, 0), a2, voffA);
            PG8_BAR; PG8_WAIT_L(0); PG8_MMA(1, 0, At, B0); PG8_BAR; PG8_SCHED;
            PG8_STAGE(PG8_SB(0, 1), b2 + hsB, voffB);
            PG8_WAIT_V(6); PG8_BAR; PG8_MMA(1, 1, At, B1); PG8_BAR;
            PG8_LDB(B0, 1, 0); PG8_SCHED; PG8_LDA(At, 1, 0); PG8_STAGE(PG8_SA(0, 1), a2 + hsA, voffA);
            PG8_WAIT_L(8); PG8_BAR; PG8_WAIT_L(0); PG8_MMA(0, 0, At, B0); PG8_BAR; PG8_SCHED;
            PG8_LDB(B1, 1, 1); PG8_STAGE(PG8_SB(1, 0), b3, voffB);
            PG8_BAR; PG8_WAIT_L(0); PG8_MMA(0, 1, At, B1); PG8_BAR;
            PG8_LDA(At, 1, 1); PG8_STAGE(PG8_SA(1, 0), a3, voffA);
            PG8_BAR; PG8_WAIT_L(0); PG8_MMA(1, 0, At, B0); PG8_BAR; PG8_SCHED;
            PG8_STAGE(PG8_SB(1, 1), b3 + hsB, voffB);
            PG8_WAIT_V(6); PG8_BAR; PG8_MMA(1, 1, At, B1); PG8_BAR;
            }
        }
        if constexpr (ALIGN_EPI) { if (wr == 0) PG8_BAR; }
        if constexpr (!Epi::AFTER_DRAIN) { E(acc, cur, wr, wc, fr, fq); S.done(cur); }
        if (!has_next) break;
#pragma unroll
        for (int a = 0; a < 2; ++a)
#pragma unroll
            for (int b = 0; b < 2; ++b)
#pragma unroll
                for (int m = 0; m < 4; ++m)
#pragma unroll
                    for (int n = 0; n < 2; ++n) acc[a][b][m][n] = (f32x4){0.f, 0.f, 0.f, 0.f};
        cur = nxt; cA = nA; cB = nB; ++ui;
        if constexpr (ALIGN_EPI) { if (wr == 1) PG8_BAR; }
    }
    PG8_WAIT_V(0);
    if constexpr (!ALIGN_EPI) { if (wr == 0) PG8_BAR; }
    PG8_BAR;
    if constexpr (Epi::AFTER_DRAIN) { E.fused(acc, cur, wr, wc, fr, fq, lds, wid, lane); S.done(cur); }
#undef PG8_SA
#undef PG8_SB
#undef PG8_STAGE
#undef PG8_LDA
#undef PG8_LDB
#undef PG8_MMA
#undef PG8_WAIT_V
#undef PG8_WAIT_L
#undef PG8_BAR
#undef PG8_SCHED
}
}

#undef EPI_ROWS_BEGIN
#undef EPI_ROWS_END

constexpr int D = 2048, NB = 8, SEQ = 2048, CL = 256, ML = NB * SEQ, MC = NB * CL, MT = ML + MC;
constexpr int FF = 5632, NMOD = 9, DEPTH = 2;
constexpr int NIN_SRC = 17568;
constexpr int ZA_LD = 4608;
constexpr int OC_RW = 1536, OC_GL = 2560;
constexpr int ZA_W = 1536, ZR_W = 3840, ZG_W = 6144, GT_W = 6144, NMIX = ZA_W + ZR_W + ZG_W  , NIN = NMIX + GT_W  ;
constexpr int RW_COLS = 3712, LA_W = 768;
constexpr float LN_EPS = 1e-5f, ALPHA = 1.41421356237f;
static_assert(ALPHA == pg8::RES_ALPHA, "residual scale");
constexpr int NWAVES = 8, NTHR = 512;

constexpr size_t MiB = 1u << 20;
constexpr size_t WS_CTL = 0, CTL_ZERO_BYTES = 1 * MiB;
constexpr size_t WS_MODS = 1 * MiB;
constexpr size_t WS_STATS = 3 * MiB;
constexpr size_t WS_XC = 4 * MiB;
constexpr size_t WS_HB = 20 * MiB;
constexpr size_t WS_WM = 92 * MiB;
constexpr size_t WM_IN = 0, WM_BA = 69 * MiB, WM_BR = 73 * MiB, WM_BG = 77 * MiB, WM_OUT = 85 * MiB, WM_LW = 93 * MiB, WM_LA = 94 * MiB, WM_LG = 95 * MiB;
constexpr size_t WS_R = 188 * MiB;
constexpr size_t R_WGU = 0, R_WDN = 44 * MiB, R_H = 66 * MiB;
constexpr size_t R_ZA = 0;
constexpr size_t R_ZR = 162 * MiB;
constexpr size_t R_AA = 297 * MiB;
constexpr size_t R_Y = 369 * MiB;
constexpr size_t R_G = 513 * MiB;
constexpr size_t R_ZG = 549 * MiB;
constexpr size_t R_YG = 765 * MiB;
constexpr size_t R_QR = 909 * MiB;
constexpr size_t R_KR = 941 * MiB;
constexpr size_t R_LA = 949 * MiB;
constexpr size_t R_WDEC = 976 * MiB;
constexpr size_t R_GL = 1120 * MiB;
constexpr size_t R_GT = R_QR;
constexpr size_t R_MG = R_Y;
constexpr size_t R_PART = 600 * MiB;
constexpr size_t R_BS = 1192 * MiB;
constexpr size_t R_END = 1195 * MiB;
constexpr size_t WS_END = WS_R + R_END;
static_assert(R_GT + (size_t)MT * GT_W * 2 <= R_END, "GT overlay");
static_assert(WS_END <= (size_t)1408 * MiB, "workspace budget");
static_assert(R_H + (size_t)MT * FF * 2 <= R_END, "H fits");

#ifndef MK_EARLY_WB
#define MK_EARLY_WB 0
#endif
#define XB_TMO      128
#define XB_XCNT(j)  (256  + 64 * (j))
#define XB_XSUB(j)  (1280 + 64 * (j))
#define XB_XGEN(j)  (2304 + 64 * (j))
#define XB_TOP      3328
#define XB_TOPGEN   3392
#define XCD_BAR_WORDS 3456
#define XB_SPIN_CAP (1u << 18)
__device__ __forceinline__ unsigned xb_ld(unsigned* p)              { return __hip_atomic_load(p, __ATOMIC_RELAXED, __HIP_MEMORY_SCOPE_AGENT); }
__device__ __forceinline__ unsigned xb_add(unsigned* p, unsigned v) { return __hip_atomic_fetch_add(p, v, __ATOMIC_RELAXED, __HIP_MEMORY_SCOPE_AGENT); }
__device__ __forceinline__ unsigned xb_xcc_id() { return (unsigned)__builtin_amdgcn_s_getreg((3 << 11) | 20) & 0xFu; }
#define XB_SPIN(cond, bar) do { unsigned _sp = 0; while (cond) { __builtin_amdgcn_s_sleep(1); \
    if ((++_sp & 255u) == 0u) { if (xb_ld(&(bar)[XB_TMO])) break; if (_sp > XB_SPIN_CAP) { atomicAdd(&(bar)[XB_TMO], 1u); break; } } } } while (0)
struct XcdBarrier { unsigned* bar; unsigned x; volatile LAS unsigned* st; };
__device__ __forceinline__ XcdBarrier xcd_barrier_post(unsigned* bar, volatile LAS unsigned* st, int tid) {
    XcdBarrier b; b.bar = bar; b.x = xb_xcc_id(); b.st = st;
    if (tid == 0) (void)xb_add(&bar[XB_XCNT(b.x)], 1u);
    return b;
}
__device__ __forceinline__ void xcd_barrier_complete(unsigned* bar, unsigned x, unsigned& nloc, unsigned& nx) {
    const unsigned G = gridDim.x * gridDim.y * gridDim.z;
    unsigned sum, cnt, mine, sp = 0u;
    for (;;) {
        sum = 0u; cnt = 0u; mine = 0u;
#pragma unroll
        for (unsigned j = 0; j < 16; ++j) { const unsigned c = xb_ld(&bar[XB_XCNT(j)]); sum += c; cnt += (c > 0u) ? 1u : 0u; mine = (j == x) ? c : mine; }
        if (sum == G) break;
        __builtin_amdgcn_s_sleep(1);
        if ((++sp & 255u) == 0u) { if (xb_ld(&bar[XB_TMO])) break; if (sp > XB_SPIN_CAP) { atomicAdd(&bar[XB_TMO], 1u); break; } }
    }
    nloc = mine > 0u ? mine : 1u; nx = cnt > 0u ? cnt : 1u;
}
__device__ __forceinline__ void xcd_barrier(const XcdBarrier& b, int tid) {
    asm volatile("s_waitcnt vmcnt(0)" ::: "memory");
    __syncthreads();
    if (tid == 0) {
        unsigned* bar = b.bar; unsigned bx = b.x;
        asm volatile("" : "+s"(bar), "+s"(bx));
        __builtin_amdgcn_s_waitcnt(0);
        unsigned nloc = b.st[0], nx = b.st[1];
        if (nloc == 0u) { xcd_barrier_complete(bar, bx, nloc, nx); b.st[0] = nloc; b.st[1] = nx; }
#if MK_EARLY_WB
        __builtin_amdgcn_fence(__ATOMIC_RELEASE, "agent");
        asm volatile("s_waitcnt vmcnt(0)" ::: "memory");
#endif
        const unsigned old = xb_add(&bar[XB_XSUB(bx)], 1u);
        const unsigned gen = old / nloc;
        if (old + 1u == (gen + 1u) * nloc) {
            __builtin_amdgcn_fence(__ATOMIC_RELEASE, "agent");
            asm volatile("s_waitcnt vmcnt(0)" ::: "memory");
            const unsigned og = xb_add(&bar[XB_TOP], 1u);
            const unsigned tg = og / nx;
            if (og + 1u == (tg + 1u) * nx) xb_add(&bar[XB_TOPGEN], 1u);
            else XB_SPIN(xb_ld(&bar[XB_TOPGEN]) == tg, bar);
            __builtin_amdgcn_fence(__ATOMIC_ACQUIRE, "agent");
            xb_add(&bar[XB_XGEN(bx)], 1u);
            asm volatile("s_waitcnt vmcnt(0)" ::: "memory");
        } else {
            XB_SPIN(xb_ld(&bar[XB_XGEN(bx)]) == gen, bar);
            __builtin_amdgcn_fence(__ATOMIC_ACQUIRE, "agent");
            asm volatile("s_waitcnt vmcnt(0)" ::: "memory");
        }
    }
    __syncthreads();
}

constexpr int RING_BYTES = 143360;
constexpr int LDSCTL_OFF = RING_BYTES, MISC_OFF = LDSCTL_OFF + 320;
constexpr int LDS_BYTES = 147456;

struct Args { const float* in[30]; float* out; unsigned char* ws; int ph_lo, ph_hi; };
#define CAS __attribute__((address_space(4)))
typedef const CAS Args& ArgsRef;

struct Frame {
    LAS unsigned char* lds;
    int tid, lane, wave, G, bid;
    const float* const* in;
    GAS float* out; GAS unsigned char* ws;
};
#define AIN(i) ((const float*)(const GAS float*)A.in[i])
#define WSP(T, off) ((T*)(F.ws + (off)))
#define RGN(T, off) ((T*)(F.ws + WS_R + (off)))
__device__ __forceinline__ float* xrow(const Frame& F, int m) { return m < ML ? (float*)(F.out + (size_t)m * D) : WSP(float, WS_XC) + (size_t)(m - ML) * D; }

__device__ __forceinline__ void tr_item(const float* W, int N, bf16* WT, int ldk, int k0, int scol0, int drow0, LAS float* scr, int lane) {
    if (scol0 >= 0) {
#pragma unroll 8
        for (int i = 0; i < 32; ++i) { const int kk = 2 * i + (lane >> 5); scr[kk * 33 + (lane & 31)] = W[(size_t)(k0 + kk) * N + scol0 + (lane & 31)]; }
    } else {
#pragma unroll 8
        for (int i = 0; i < 32; ++i) { const int kk = 2 * i + (lane >> 5); scr[kk * 33 + (lane & 31)] = 0.f; }
    }
    asm volatile("s_waitcnt vmcnt(0) lgkmcnt(0)" ::: "memory");
    const int c = lane & 7;
#pragma unroll
    for (int j = 0; j < 4; ++j) { const int n = (lane >> 3) + 8 * j; const LAS float* s = scr + (8 * c) * 33 + n;
        v4u o; o.x = pk2(s[0 * 33], s[1 * 33]); o.y = pk2(s[2 * 33], s[3 * 33]); o.z = pk2(s[4 * 33], s[5 * 33]); o.w = pk2(s[6 * 33], s[7 * 33]);
        *(v4u*)(WT + (size_t)(drow0 + n) * ldk + k0 + 8 * c) = o; }
    asm volatile("s_waitcnt lgkmcnt(0)" ::: "memory");
}
struct MapIdent { __device__ __forceinline__ int operator()(int drow) const { return drow; } };
struct MapGU { __device__ __forceinline__ int operator()(int drow) const { const int pn = drow >> 8, bj = (drow >> 7) & 1, i = drow & 127; return bj * FF + pn * 128 + i; } };
struct MapWin { __device__ __forceinline__ int operator()(int drow) const {
    if (drow < 5248) return drow;
    if (drow < 5280) return 11392 + (drow - 5248);
    if (drow < 5376) return -1;
    if (drow < 11520) return 5248 + (drow - 5376);
    return 11424 + (drow - 11520);
} };
template <class MAP> __device__ __forceinline__ void conv_matrix(const Frame& F, const float* W, int K, int N, bf16* WT, int NT, const MAP& mp, int& item0, int gw, int NGW, int ldk = 0) {
    LAS float* scr = (LAS float*)(F.lds + F.wave * 16384);
    const int nblk = NT / 32, nitems = (K / 64) * nblk;
    int first = ((gw - item0) % NGW + NGW) % NGW;
    for (int it = first; it < nitems; it += NGW) { const int kb = it / nblk, nb = it % nblk; tr_item(W, N, WT, ldk ? ldk : K, kb * 64, mp(nb * 32), nb * 32, scr, F.lane); }
    item0 += nitems;
}

__device__ __forceinline__ int seq_row(int b, int dir, int p, int& idx, int& len) {
    if (p < CL) { idx = dir ? (CL - 1 - p) : p; len = CL; return ML + b * CL + idx; }
    const int q = p - CL; idx = dir ? (SEQ - 1 - q) : q; len = SEQ; return b * SEQ + idx;
}

__device__ __forceinline__ void phase_init(const Frame& F, ArgsRef A) {
    const float* c = AIN(1); const float* cctx = AIN(3); const float* ada_w = AIN(4); const float* ada_b = AIN(5);
    float* mods = WSP(float, WS_MODS);
    LAS float* sc = (LAS float*)F.lds;
    LAS float* red = sc + 9 * 2048;
    for (int i = F.tid; i < 9 * 2048; i += NTHR) { const int bs = i >> 11, k = i & 2047; const float v = bs < 8 ? c[bs * 2048 + k] : cctx[k]; sc[i] = fsilu(v); }
    __syncthreads();
    for (int item = F.bid; item < 2 * 144; item += F.G) {
        const int l = item / 144, cb = item % 144, col = cb * 128 + 2 * F.lane;
        float a0[9], a1[9];
#pragma unroll
        for (int bs = 0; bs < 9; ++bs) { a0[bs] = 0.f; a1[bs] = 0.f; }
        const float* wp = ada_w + ((size_t)l * 2048 + F.wave * 256) * 18432 + col;
        const LAS float* sp = sc + F.wave * 256;
#pragma unroll 8
        for (int k = 0; k < 256; ++k) { const f32x2 w = *(const f32x2*)(wp + (size_t)k * 18432);
#pragma unroll
            for (int bs = 0; bs < 9; ++bs) { const float s = sp[bs * 2048 + k]; a0[bs] += s * w.x; a1[bs] += s * w.y; } }
#pragma unroll
        for (int bs = 0; bs < 9; ++bs) { red[(F.wave * 9 + bs) * 128 + 2 * F.lane] = a0[bs]; red[(F.wave * 9 + bs) * 128 + 2 * F.lane + 1] = a1[bs]; }
        __syncthreads();
        for (int o = F.tid; o < 9 * 128; o += NTHR) { const int bs = o >> 7, cc = o & 127; float s = ada_b[l * 18432 + cb * 128 + cc];
#pragma unroll
            for (int w = 0; w < 8; ++w) s += red[(w * 9 + bs) * 128 + cc];
            mods[((size_t)l * 9 + bs) * 18432 + cb * 128 + cc] = s; }
        __syncthreads();
    }
}

template <bool POST, bool MODH, bool WX = false>
__device__ __forceinline__ void phase_ln(const Frame& F, int nrows, const float* g, const float* b, const float* mods_l, int kshift, int kscale, const bf16* part = nullptr, const float* pmod = nullptr, float pcoef = 0.f, const float* src_l = nullptr, const float* src_c = nullptr) {
    const int gw = F.bid * NWAVES + F.wave, NGW = F.G * NWAVES;
    bf16* HB = WSP(bf16, WS_HB);
    for (int m = gw; m < nrows; m += NGW) {
        float* xr = xrow(F, m);
        const float* xs = (m < ML) ? (src_l ? src_l + (size_t)m * D : xr) : (src_c ? src_c + (size_t)(m - ML) * D : xr);
        f32x4 v[8];
#pragma unroll
        for (int j = 0; j < 8; ++j) v[j] = ((const f32x4*)xs)[F.lane + 64 * j];
        if (POST && part != nullptr && m >= ML) {
            const v2u* pp = (const v2u*)(part + (size_t)(m - ML) * D);
#pragma unroll
            for (int j = 0; j < 8; ++j) { const int o = F.lane + 64 * j; const v2u p0 = pp[o], p1 = pp[o + (size_t)MC * D / 4], p2 = pp[o + 2 * ((size_t)MC * D / 4)], p3 = pp[o + 3 * ((size_t)MC * D / 4)];
                const f32x4 ps = ((f32x4){bflo(p0.x), bfhi(p0.x), bflo(p0.y), bfhi(p0.y)} + (f32x4){bflo(p1.x), bfhi(p1.x), bflo(p1.y), bfhi(p1.y)}) + ((f32x4){bflo(p2.x), bfhi(p2.x), bflo(p2.y), bfhi(p2.y)} + (f32x4){bflo(p3.x), bfhi(p3.x), bflo(p3.y), bfhi(p3.y)});
                v[j] = v[j] * ALPHA + ((const f32x4*)pmod)[o] * pcoef * ps; }
        }
        if (POST) {
            float s = 0.f;
#pragma unroll
            for (int j = 0; j < 8; ++j) s += (v[j].x + v[j].y) + (v[j].z + v[j].w);
            const float mean = wave_sum(s) * (1.f / D); float s2 = 0.f;
#pragma unroll
            for (int j = 0; j < 8; ++j) { v[j] = v[j] - mean; s2 += (v[j].x * v[j].x + v[j].y * v[j].y) + (v[j].z * v[j].z + v[j].w * v[j].w); }
            const float rstd = 1.f / sqrtf(wave_sum(s2) * (1.f / D) + LN_EPS);
#pragma unroll
            for (int j = 0; j < 8; ++j) { const f32x4 gg = ((const f32x4*)g)[F.lane + 64 * j], bb = ((const f32x4*)b)[F.lane + 64 * j]; v[j] = v[j] * rstd * gg + bb; if (WX || m >= ML) ((f32x4*)xr)[F.lane + 64 * j] = v[j]; }
            if (!WX && m < ML && F.lane == 0) *(v2f*)(WSP(float, WS_STATS) + 2 * m) = (v2f){mean, rstd};
        }
        if (MODH) {
            float s = 0.f;
#pragma unroll
            for (int j = 0; j < 8; ++j) s += (v[j].x + v[j].y) + (v[j].z + v[j].w);
            const float mean = wave_sum(s) * (1.f / D); float s2 = 0.f;
#pragma unroll
            for (int j = 0; j < 8; ++j) { v[j] = v[j] - mean; s2 += (v[j].x * v[j].x + v[j].y * v[j].y) + (v[j].z * v[j].z + v[j].w * v[j].w); }
            const float rstd = 1.f / sqrtf(wave_sum(s2) * (1.f / D) + LN_EPS);
            const int bsel = m < ML ? (m >> 11) : 8;
            const f32x4* shp = (const f32x4*)(mods_l + (size_t)bsel * 18432 + kshift * 2048);
            const f32x4* scp = (const f32x4*)(mods_l + (size_t)bsel * 18432 + kscale * 2048);
            v2u* hp = (v2u*)(HB + (size_t)m * D);
#pragma unroll
            for (int j = 0; j < 8; ++j) { const f32x4 sh = shp[F.lane + 64 * j], scl = scp[F.lane + 64 * j]; const f32x4 o = v[j] * rstd * (scl + 1.0f) + sh;
                v2u w; w.x = pk2(o.x, o.y); w.y = pk2(o.z, o.w); hp[F.lane + 64 * j] = w; }
        }
    }
}

__device__ __forceinline__ void phase_convert(const Frame& F, ArgsRef A, int l, int ffn_i, int which) {
    const int gw = F.bid * NWAVES + F.wave, NGW = F.G * NWAVES; int item0 = 0;
    if (which & 1) {
        conv_matrix(F, AIN(8) + ((size_t)l * 2 + ffn_i) * D * (2 * FF), D, 2 * FF, RGN(bf16, R_WGU), 2 * FF, MapGU(), item0, gw, NGW);
        conv_matrix(F, AIN(9) + ((size_t)l * 2 + ffn_i) * FF * D, FF, D, RGN(bf16, R_WDN), D, MapIdent(), item0, gw, NGW);
    }
    if (which & 2) {
        conv_matrix(F, AIN(10) + (size_t)l * D * NIN_SRC, D, NIN_SRC, WSP(bf16, WS_WM + WM_IN), NIN, MapWin(), item0, gw, NGW);
        conv_matrix(F, AIN(26) + (size_t)l * 1024 * D, 1024, D, WSP(bf16, WS_WM + WM_BA), D, MapIdent(), item0, gw, NGW, 4096);
        conv_matrix(F, AIN(27) + (size_t)l * 1024 * D, 1024, D, WSP(bf16, WS_WM + WM_BA) + 1024, D, MapIdent(), item0, gw, NGW, 4096);
        conv_matrix(F, AIN(28) + (size_t)l * D * D, D, D, WSP(bf16, WS_WM + WM_BA) + 2048, D, MapIdent(), item0, gw, NGW, 4096);
        conv_matrix(F, AIN(29) + (size_t)l * D * D, D, D, WSP(bf16, WS_WM + WM_OUT), D, MapIdent(), item0, gw, NGW);
        const float* w2 = AIN(14) + (size_t)l * 2 * 96 * 1024; const float* a2 = AIN(16) + (size_t)l * 2 * 96 * 1024; const float* g2 = AIN(17) + (size_t)l * 256 * 1024;
        bf16* LW = WSP(bf16, WS_WM + WM_LW); bf16* LAw = WSP(bf16, WS_WM + WM_LA); bf16* LG = WSP(bf16, WS_WM + WM_LG);
        for (int e = F.bid * NTHR + F.tid; e < 2048 * 256; e += F.G * NTHR) { const int n = e >> 8, k = e & 255, dir = n >> 10, cc = n & 1023;
            const int kk = k - dir * 96; const bool liv = kk >= 0 && kk < 96;
            LW[e] = liv ? (bf16)f2bf(w2[((size_t)dir * 96 + kk) * 1024 + cc]) : (bf16)0;
            LAw[e] = liv ? (bf16)f2bf(a2[((size_t)dir * 96 + kk) * 1024 + cc]) : (bf16)0;
            if (n < 1024) LG[e] = (bf16)f2bf(g2[(size_t)k * 1024 + n]); }
    }
    __syncthreads();
}

__device__ __forceinline__ float red16s(float v) { v += dppf<0xB1, 0xF>(v); v += dppf<0x4E, 0xF>(v); v += dppf<0x141, 0xF>(v); v += dppf<0x140, 0xF>(v); return v; }
__device__ __forceinline__ void phase_prep(const Frame& F, ArgsRef A, int l) {
    const int gw = F.bid * NWAVES + F.wave, NGW = F.G * NWAVES, lane = F.lane;
    const bf16* ZA = RGN(bf16, R_ZA); bf16* QR = RGN(bf16, R_QR); bf16* KR = RGN(bf16, R_KR);
    const bf16* ZR = RGN(bf16, R_ZR); bf16* LA = RGN(bf16, R_LA); unsigned* GL = RGN(unsigned, R_GL);
    {
        const int f2 = 2 * (lane & 15), axis = (lane >> 4) & 1, hs = lane >> 5;
        const float invf0 = exp2f(-(float)f2 * (13.287712379549449f / 32.0f)), invf1 = exp2f(-(float)(f2 + 1) * (13.287712379549449f / 32.0f));
        for (int m = gw; m < ML; m += NGW) {
            const int t = m & (SEQ - 1);
            const float pos = axis == 0 ? (float)(t >> 6) : (float)(t & 63);
            const float a0 = pos * invf0, a1 = pos * invf1; const float sn0 = __sinf(a0), cs0 = __cosf(a0), sn1 = __sinf(a1), cs1 = __cosf(a1);
            const bf16* zr = ZA + (size_t)m * ZA_LD + hs * 128 + axis * 64 + f2;
#pragma unroll
            for (int hp = 0; hp < 5; ++hp) {
                const unsigned w1 = *(const unsigned*)(zr + hp * 256), w2 = *(const unsigned*)(zr + hp * 256 + 32);
                const float x10 = bflo(w1), x11 = bfhi(w1), x20 = bflo(w2), x21 = bfhi(w2);
                const unsigned o1 = pk2(x10 * cs0 - x20 * sn0, x11 * cs1 - x21 * sn1), o2 = pk2(x20 * cs0 + x10 * sn0, x21 * cs1 + x11 * sn1);
                const int hh = 2 * hp + hs;
                bf16* dst = hh < 8 ? QR + (size_t)m * 1024 + hh * 128 + axis * 64 + f2 : KR + (size_t)m * 256 + (hh - 8) * 128 + axis * 64 + f2;
                *(unsigned*)dst = o1; *(unsigned*)(dst + 32) = o2;
            }
        }
    }
    {
        const float* cw = AIN(12) + (size_t)l * 3 * RW_COLS;
        float t0[6][2], t1[6][2], t2[6][2]; int scol[6];
#pragma unroll
        for (int it = 0; it < 6; ++it) { const int j = 2 * (lane + 64 * it), sec = j >> 8, jj = j & 255; const bool live = sec == 2 || jj < 192;
            scol[it] = live ? (sec == 0 ? 3072 : sec == 1 ? 3264 : 3456) + jj : -1;
#pragma unroll
            for (int e = 0; e < 2; ++e) { t0[it][e] = live ? cw[scol[it] + e] : 0.f; t1[it][e] = live ? cw[RW_COLS + scol[it] + e] : 0.f; t2[it][e] = live ? cw[2 * RW_COLS + scol[it] + e] : 0.f; } }
        for (int m = gw; m < MT; m += NGW) {
            int idx, len; if (m < ML) { idx = m & (SEQ - 1); len = SEQ; } else { idx = (m - ML) & (CL - 1); len = CL; }
            const float fl = idx > 0 ? 1.f : 0.f, fr = idx < len - 1 ? 1.f : 0.f;
            const bf16* z0 = ZR + (size_t)m * ZR_W; const bf16* zl = idx > 0 ? z0 - ZR_W : z0; const bf16* zrr = idx < len - 1 ? z0 + ZR_W : z0;
#pragma unroll
            for (int it = 0; it < 6; ++it) {
                unsigned o = 0u;
                if (scol[it] >= 0) {
                    const unsigned wc = *(const unsigned*)(z0 + scol[it]), wl = *(const unsigned*)(zl + scol[it]), wr = *(const unsigned*)(zrr + scol[it]);
                    float c0 = bflo(wc) * t1[it][0] + fl * bflo(wl) * t0[it][0] + fr * bflo(wr) * t2[it][0];
                    float c1 = bfhi(wc) * t1[it][1] + fl * bfhi(wl) * t0[it][1] + fr * bfhi(wr) * t2[it][1];
                    const int sec = it >> 1;
                    if (sec == 0) { c0 = ftanh(c0); c1 = ftanh(c1); } else if (sec == 2) { c0 = fsigmoid(c0); c1 = fsigmoid(c1); }
                    o = pk2(c0, c1);
                }
                *(unsigned*)(LA + (size_t)m * LA_W + 2 * (lane + 64 * it)) = o;
            }
        }
    }
    {
        __syncthreads();
        LAS unsigned short* TW = (LAS unsigned short*)F.lds;
        LAS float* TB = (LAS float*)(F.lds + 65536);
        const float* wa2 = AIN(23) + (size_t)l * 2 * 16 * 1024; const float* ba = AIN(24) + (size_t)l * 2 * 1024;
        for (int e = F.tid; e < 2 * 16 * 1024; e += NTHR) { const int dr = e >> 10, cc = e & 1023, dir = dr >> 4, r = dr & 15; TW[(dir * 1024 + cc) * 16 + r] = (unsigned short)f2bf(wa2[e]); }
        for (int e = F.tid; e < 2048; e += NTHR) TB[e] = ba[e];
        __syncthreads();
        const int l16 = lane & 15, g = lane >> 4;
        bf16* GLb = RGN(bf16, R_GL);
        const f32x4 zero4 = (f32x4){0.f, 0.f, 0.f, 0.f};
        for (int item = gw; item < (MT / 16) * 4; item += NGW) {
            const int rb = item >> 2, qq = item & 3, m = rb * 16 + l16;
            const bf16x8 af = *(const bf16x8*)(ZR + (size_t)m * ZR_W + 3712 + 8 * g);
            const int dir = qq >> 1;
            const bool live = (g >> 1) == dir;
            bf16* gp = GLb + ((size_t)dir * MT + m) * 1024 + ((512 * qq) & 1023) + 8 * g;
#pragma unroll 4
            for (int q = 0; q < 16; ++q) {
                const int ch0 = 512 * qq + 32 * q;
                const unsigned wa_ = (unsigned)((ch0 + 8 * (l16 >> 2) + (l16 & 3)) * 32 + (g & 1) * 16);
                bf16x8 w0 = *(const LAS bf16x8*)((LAS unsigned char*)TW + wa_), w1 = *(const LAS bf16x8*)((LAS unsigned char*)TW + wa_ + 4 * 32);
                if (!live) { w0 = (bf16x8){0, 0, 0, 0, 0, 0, 0, 0}; w1 = w0; }
                const f32x4 d0 = __builtin_amdgcn_mfma_f32_16x16x32_bf16(w0, af, zero4, 0, 0, 0), d1 = __builtin_amdgcn_mfma_f32_16x16x32_bf16(w1, af, zero4, 0, 0, 0);
                const f32x4 b0 = *(const LAS f32x4*)(TB + ch0 + 8 * g), b1 = *(const LAS f32x4*)(TB + ch0 + 8 * g + 4);
                float o[8];
#pragma unroll
                for (int r = 0; r < 4; ++r) { o[r] = -fsoftplus(-(d0[r] + b0[r])) * 0.0625f; o[4 + r] = -fsoftplus(-(d1[r] + b1[r])) * 0.0625f; }
                *(v4u*)(gp + 32 * q) = (v4u){pk2(o[0], o[1]), pk2(o[2], o[3]), pk2(o[4], o[5]), pk2(o[6], o[7])};
            }
        }
        __syncthreads();
    }
}

__device__ __forceinline__ unsigned opq(unsigned x) { asm volatile("" : "+v"(x)); return x; }
__device__ __forceinline__ bf16x8 pack8(const f32x4& a, const f32x4& b) {
    v4u w; w.x = pg8::cvt_pk_bf16(a[0], a[1]); w.y = pg8::cvt_pk_bf16(a[2], a[3]); w.z = pg8::cvt_pk_bf16(b[0], b[1]); w.w = pg8::cvt_pk_bf16(b[2], b[3]);
    return __builtin_bit_cast(bf16x8, w);
}
typedef short s16x4 __attribute__((ext_vector_type(4)));
__device__ __forceinline__ bf16x8 tr8(LAS unsigned char* L, unsigned a0, unsigned a1) {
    const s16x4 x = __builtin_amdgcn_ds_read_tr16_b64_v4i16((LAS s16x4*)(L + a0)), y = __builtin_amdgcn_ds_read_tr16_b64_v4i16((LAS s16x4*)(L + a1));
    return __builtin_shufflevector(x, y, 0, 1, 2, 3, 4, 5, 6, 7);
}
constexpr int RC_LD = 72;
constexpr int RC_QP = 0, RC_RT = 9216, RC_KD = 18432, RC_KA = 27648, RC_KDT = 36864, RC_KAT = 46080, RC_VT = 55296, RC_MKA = 64512, RC_MKD = 73728, RC_NKA = 82944, RC_NKD = 92160,
              RC_DG = 101376, RC_TB = 105472, RC_EB = 107520, RC_TQ = 107776, RC_BI = 109824, RC_END = 126208;
static_assert(RC_END <= RING_BYTES, "RWKV LDS map");
#define LD_(T, addr) (*(const LAS T*)(L + (addr)))
#define ST_(T, addr) (*(LAS T*)(L + (addr)))
__device__ __forceinline__ bf16x8 kperm(LAS unsigned char* L, unsigned addr) {
    const v2u a0 = LD_(v2u, addr), a1 = LD_(v2u, addr + 32); return __builtin_bit_cast(bf16x8, (v4u){a0.x, a0.y, a1.x, a1.y}); }
__device__ __forceinline__ void rwkv_chunk_item(const Frame& F, ArgsRef A, int l, int item, bool last) {
    const int b = item >> 5, h = (item >> 1) & 15, dir = item & 1, tid = F.tid, lane = F.lane, w = F.wave, sgn = dir ? -1 : 1, l16 = lane & 15, g = lane >> 4;
    LAS unsigned char* L = F.lds;
    const bf16* ZR = RGN(bf16, R_ZR); const float* WLD = RGN(float, R_WDEC) + (size_t)dir * MT * 1024; const bf16* AA = RGN(bf16, R_AA) + (size_t)dir * MT * 1024;
    bf16* Y = RGN(bf16, R_Y) + (size_t)dir * MT * 1024;
    const float* cw = AIN(12) + (size_t)l * 3 * RW_COLS;
    const int j0 = 4 * l16, ch = h * 64 + j0;
    const int tA = dir ? 2 : 0, tB = dir ? 0 : 2;
    const f32x4 kkw = *(const f32x4*)(AIN(18) + l * 1024 + ch), kaw = *(const f32x4*)(AIN(19) + l * 1024 + ch);
    const int cj = tid & 63, ct8 = tid >> 6;
    const unsigned a_row = opq((unsigned)(((8 * w + g) * RC_LD + j0) * 2));
    const unsigned a_tr = opq((unsigned)((((lane & 15) >> 2) * RC_LD + 4 * (lane & 3)) * 2));
    const unsigned a_f8 = opq((unsigned)((l16 * RC_LD + 8 * g) * 2));
    const unsigned a_f4 = opq((unsigned)((l16 * RC_LD + 4 * g) * 2));

    f32x4 S[4];
#pragma unroll
    for (int t = 0; t < 4; ++t) S[t] = (f32x4){0.f, 0.f, 0.f, 0.f};
    v2u zz[2][3][3], za[2]; float pl[8];
#define RC_ISSUE(chunk) do { int idx_, len_; const int c_ = (chunk); const int r0_ = seq_row(b, dir, c_ * 64, idx_, len_); \
        const int plo_ = c_ < 4 ? 0 : CL, phi_ = c_ < 4 ? CL : CL + SEQ; \
        _Pragma("unroll") for (int p = 0; p < 2; ++p) { const int t_ = 8 * w + 4 * p + g; \
            _Pragma("unroll") for (int x = 0; x < 3; ++x) { const int pp_ = c_ * 64 + t_ + x - 1; const bool ok_ = pp_ >= plo_ && pp_ < phi_; \
                const GAS bf16* zp_ = (const GAS bf16*)(ZR + (size_t)(ok_ ? r0_ + sgn * (t_ + x - 1) : r0_) * ZR_W + ch); asm volatile("" : "+v"(zp_)); \
                const v2u q0_ = *(const GAS v2u*)zp_, q1_ = *(const GAS v2u*)(zp_ + 1024), q2_ = *(const GAS v2u*)(zp_ + 2048); const v2u zero_ = (v2u){0u, 0u}; \
                zz[p][x][0] = ok_ ? q0_ : zero_; zz[p][x][1] = ok_ ? q1_ : zero_; zz[p][x][2] = ok_ ? q2_ : zero_; } \
            za[p] = *(const GAS v2u*)(const GAS bf16*)(AA + (size_t)(r0_ + sgn * t_) * 1024 + ch); } \
        { const GAS float* wp_ = (const GAS float*)(WLD + (size_t)(r0_ + sgn * 8 * ct8) * 1024 + h * 64 + cj); const long st_ = (long)sgn * 1024; \
          _Pragma("unroll") for (int q = 0; q < 8; ++q) { asm volatile("" : "+v"(wp_)); pl[q] = *wp_; wp_ += st_; } } } while (0)
    RC_ISSUE(0);
    for (int chunk = 0; chunk < 36; ++chunk) {
        int idx0, len0; const int r0 = seq_row(b, dir, chunk * 64, idx0, len0);
        const unsigned a_tqs = opq((unsigned)(RC_TQ + (ct8 * 64 + cj) * 4)), a_tqr = opq((unsigned)(RC_TQ + cj * 4)), a_bis = opq((unsigned)(RC_BI + (8 * ct8 * 64 + cj) * 4));
        { float s = 0.f;
#pragma unroll
          for (int q = 0; q < 8; ++q) s += pl[q];
          ST_(float, a_tqs) = s; }
        __syncthreads();
        { float o = 0.f, tot = 0.f;
#pragma unroll
          for (int q = 0; q < 8; ++q) { const float tq = LD_(float, a_tqr + q * 256); if (q < ct8) o += tq; tot += tq; }
          if (ct8 == 0) ST_(float, RC_EB + cj * 4) = fexp(tot);
#pragma unroll
          for (int q = 0; q < 8; ++q) { o += pl[q]; ST_(float, a_bis + q * 256) = o; } }
        __syncthreads();
        f32x4 tp[3][3];
#pragma unroll
        for (int kind = 0; kind < 3; ++kind) { const GAS float* cp = (const GAS float*)(cw + kind * 1024 + ch); asm volatile("" : "+v"(cp));
            tp[0][kind] = *(const GAS f32x4*)(cp + tA * RW_COLS); tp[1][kind] = *(const GAS f32x4*)(cp + RW_COLS); tp[2][kind] = *(const GAS f32x4*)(cp + tB * RW_COLS); }
        const unsigned a_bir = opq((unsigned)(RC_BI + ((8 * w + g) * 64 + j0) * 4));
#pragma unroll
        for (int p = 0; p < 2; ++p) {
            const int t = 8 * w + 4 * p + g;
            f32x4 rkv[3];
#pragma unroll
            for (int kind = 0; kind < 3; ++kind) {
                const v2u wa = zz[p][0][kind], wc = zz[p][1][kind], wb = zz[p][2][kind];
                const f32x4 xa = (f32x4){bflo(wa.x), bfhi(wa.x), bflo(wa.y), bfhi(wa.y)}, xc = (f32x4){bflo(wc.x), bfhi(wc.x), bflo(wc.y), bfhi(wc.y)}, xb = (f32x4){bflo(wb.x), bfhi(wb.x), bflo(wb.y), bfhi(wb.y)};
                rkv[kind] = xa * tp[0][kind] + xc * tp[1][kind] + xb * tp[2][kind]; }
            const f32x4 r = rkv[0], k = rkv[1], v = rkv[2];
            const f32x4 kr = k * kkw;
            const float n2 = red16s((kr.x * kr.x + kr.y * kr.y) + (kr.z * kr.z + kr.w * kr.w));
            const f32x4 kk = kr * __builtin_amdgcn_rsqf(fmaxf(n2, 1e-24f));
            const f32x4 a = (f32x4){bflo(za[p].x), bfhi(za[p].x), bflo(za[p].y), bfhi(za[p].y)};
            const f32x4 kd = k * ((a - 1.0f) * kaw + 1.0f), kka = kk * a;
            {
              const GAS float* rp = (const GAS float*)(AIN(20) + l * 1024 + ch); asm volatile("" : "+v"(rp)); const f32x4 rkp = *(const GAS f32x4*)rp;
              const f32x4 pb = r * kd * rkp; const float bsum = red16s((pb.x + pb.y) + (pb.z + pb.w));
              if (l16 == 0) RGN(float, R_BS)[((size_t)dir * MT + (size_t)(r0 + sgn * t)) * 16 + h] = bsum; }
            const f32x4 bi = LD_(f32x4, a_bir + p * 1024);
            f32x4 bx = (f32x4){0.f, 0.f, 0.f, 0.f}; if (t > 0) bx = LD_(f32x4, a_bir + p * 1024 - 256);
            f32x4 ex, ei, en;
#pragma unroll
            for (int c = 0; c < 4; ++c) { ex[c] = fexp(bx[c]); ei[c] = fexp(bi[c]); en[c] = fexp(-bi[c]); }
            const f32x4 qp = kk * ex * -1.0f, rt = r * ei, kdn = kd * en, kan = kka * en;
            const unsigned ar = a_row + p * (4 * RC_LD * 2);
            ST_(v2u, RC_QP + ar) = (v2u){pg8::cvt_pk_bf16(qp.x, qp.y), pg8::cvt_pk_bf16(qp.z, qp.w)};
            ST_(v2u, RC_RT + ar) = (v2u){pg8::cvt_pk_bf16(rt.x, rt.y), pg8::cvt_pk_bf16(rt.z, rt.w)};
            const unsigned kd01 = pg8::cvt_pk_bf16(kdn.x, kdn.y), kd23 = pg8::cvt_pk_bf16(kdn.z, kdn.w), ka01 = pg8::cvt_pk_bf16(kan.x, kan.y), ka23 = pg8::cvt_pk_bf16(kan.z, kan.w);
            const unsigned v01 = pg8::cvt_pk_bf16(v.x, v.y), v23 = pg8::cvt_pk_bf16(v.z, v.w);
            ST_(v2u, RC_KD + ar) = (v2u){kd01, kd23}; ST_(v2u, RC_KA + ar) = (v2u){ka01, ka23};
            ST_(v2u, RC_VT + ar) = (v2u){v01, v23};
            asm volatile("" ::: "memory");
        }
        __syncthreads();
        if (chunk + 1 < 36) RC_ISSUE(chunk + 1);
        const unsigned a_dgs = opq((unsigned)(RC_DG + (l16 * 16 + 4 * g) * 4));
#pragma unroll
        for (int tt2 = 0; tt2 < 2; ++tt2) {
            const int id = 2 * w + tt2, st = id >> 2, tt = id & 3;
            f32x4 mka = (f32x4){0.f, 0.f, 0.f, 0.f}, mkd = mka, nka = mka, nkd = mka;
            if (st <= tt) {
                const unsigned as_ = a_f8 + st * (16 * RC_LD * 2), at_ = a_f8 + tt * (16 * RC_LD * 2);
#pragma unroll
                for (int ks = 0; ks < 2; ++ks) {
                    const bf16x8 fka = LD_(bf16x8, RC_KA + as_ + 64 * ks), fkd = LD_(bf16x8, RC_KD + as_ + 64 * ks), fqp = LD_(bf16x8, RC_QP + at_ + 64 * ks), frt = LD_(bf16x8, RC_RT + at_ + 64 * ks);
                    mka = __builtin_amdgcn_mfma_f32_16x16x32_bf16(fka, fqp, mka, 0, 0, 0); mkd = __builtin_amdgcn_mfma_f32_16x16x32_bf16(fkd, fqp, mkd, 0, 0, 0);
                    nka = __builtin_amdgcn_mfma_f32_16x16x32_bf16(fka, frt, nka, 0, 0, 0); nkd = __builtin_amdgcn_mfma_f32_16x16x32_bf16(fkd, frt, nkd, 0, 0, 0);
                }
            }
            const int t = 16 * tt + (int)opq((unsigned)l16), s0 = 16 * st + 4 * (int)opq((unsigned)g);
#pragma unroll
            for (int r = 0; r < 4; ++r) { const bool lt = (s0 + r) < t, le = (s0 + r) <= t; mka[r] = lt ? mka[r] : 0.f; mkd[r] = lt ? mkd[r] : 0.f; nka[r] = le ? nka[r] : 0.f; nkd[r] = le ? nkd[r] : 0.f; }
            const unsigned am = a_f4 + tt * (16 * RC_LD * 2) + st * 32;
            ST_(v2u, RC_MKA + am) = (v2u){pg8::cvt_pk_bf16(mka[0], mka[1]), pg8::cvt_pk_bf16(mka[2], mka[3])};
            ST_(v2u, RC_MKD + am) = (v2u){pg8::cvt_pk_bf16(mkd[0], mkd[1]), pg8::cvt_pk_bf16(mkd[2], mkd[3])};
            ST_(v2u, RC_NKA + am) = (v2u){pg8::cvt_pk_bf16(nka[0], nka[1]), pg8::cvt_pk_bf16(nka[2], nka[3])};
            ST_(v2u, RC_NKD + am) = (v2u){pg8::cvt_pk_bf16(nkd[0], nkd[1]), pg8::cvt_pk_bf16(nkd[2], nkd[3])};
            if (st == tt) ST_(f32x4, a_dgs + st * 1024) = mka;
        }
        __syncthreads();
        if (w == 4) {
            const unsigned a_dgb = opq((unsigned)(RC_DG + g * 1024)), a_tbs = opq((unsigned)(RC_TB + (g * 256 + l16) * 2));
            float tc[16]; const int lq = (int)opq((unsigned)l16);
#pragma unroll
            for (int t = 0; t < 16; ++t) {
                float acc = (t == lq) ? 1.f : 0.f;
                const f32x4 L0 = LD_(f32x4, a_dgb + t * 64), L1 = LD_(f32x4, a_dgb + t * 64 + 16), L2 = LD_(f32x4, a_dgb + t * 64 + 32), L3 = LD_(f32x4, a_dgb + t * 64 + 48);
                const float lr[16] = {L0[0], L0[1], L0[2], L0[3], L1[0], L1[1], L1[2], L1[3], L2[0], L2[1], L2[2], L2[3], L3[0], L3[1], L3[2], L3[3]};
#pragma unroll
                for (int s = 0; s < 16; ++s) if (s < t) acc += lr[s] * tc[s];
                tc[t] = acc;
                ST_(unsigned short, a_tbs + t * 32) = (unsigned short)f2bf(acc);
            }
        }
        f32x4 X[4], O[4], U[4];
        const f32x4 zero4 = (f32x4){0.f, 0.f, 0.f, 0.f};
        bf16x8 vb0, vb1;
        if (w < 4) {
            const bf16x8 sf0 = pack8(S[0], S[1]), sf1 = pack8(S[2], S[3]);
            { const unsigned av = RC_VT + a_tr + (8 * g) * (RC_LD * 2) + w * 32; vb0 = tr8(L, av, av + 4 * RC_LD * 2); vb1 = tr8(L, av + 32 * RC_LD * 2, av + 36 * RC_LD * 2); }
#pragma unroll
            for (int mt = 0; mt < 4; ++mt) {
                const unsigned o4 = a_f4 + mt * (16 * RC_LD * 2), o8 = a_f8 + mt * (16 * RC_LD * 2);
                X[mt] = __builtin_amdgcn_mfma_f32_16x16x32_bf16(kperm(L, RC_QP + o4), sf0, zero4, 0, 0, 0);
                X[mt] = __builtin_amdgcn_mfma_f32_16x16x32_bf16(kperm(L, RC_QP + o4 + 64), sf1, X[mt], 0, 0, 0);
                X[mt] = __builtin_amdgcn_mfma_f32_16x16x32_bf16(LD_(bf16x8, RC_MKD + o8), vb0, X[mt], 0, 0, 0);
                X[mt] = __builtin_amdgcn_mfma_f32_16x16x32_bf16(LD_(bf16x8, RC_MKD + o8 + 64), vb1, X[mt], 0, 0, 0);
                O[mt] = __builtin_amdgcn_mfma_f32_16x16x32_bf16(kperm(L, RC_RT + o4), sf0, zero4, 0, 0, 0);
                O[mt] = __builtin_amdgcn_mfma_f32_16x16x32_bf16(kperm(L, RC_RT + o4 + 64), sf1, O[mt], 0, 0, 0);
                O[mt] = __builtin_amdgcn_mfma_f32_16x16x32_bf16(LD_(bf16x8, RC_NKD + o8), vb0, O[mt], 0, 0, 0);
                O[mt] = __builtin_amdgcn_mfma_f32_16x16x32_bf16(LD_(bf16x8, RC_NKD + o8 + 64), vb1, O[mt], 0, 0, 0);
                asm volatile("" ::: "memory");
            }
#pragma unroll
            for (int jt = 0; jt < 4; ++jt) { const unsigned ak = RC_KD + a_tr + (8 * g) * (RC_LD * 2) + jt * 32;
                S[jt] = __builtin_amdgcn_mfma_f32_16x16x32_bf16(tr8(L, ak, ak + 4 * RC_LD * 2), vb0, S[jt], 0, 0, 0);
                S[jt] = __builtin_amdgcn_mfma_f32_16x16x32_bf16(tr8(L, ak + 32 * RC_LD * 2, ak + 36 * RC_LD * 2), vb1, S[jt], 0, 0, 0); }
        }
        __syncthreads();
        if (w < 4) {
            const unsigned a_tbf = opq((unsigned)(RC_TB + (l16 * 16 + 4 * g) * 2)), a_ebr = opq((unsigned)(RC_EB + 16 * g));
#define RC_TBF(tb) __builtin_bit_cast(bf16x8, (v4u){LD_(v2u, a_tbf + (tb) * 512).x, LD_(v2u, a_tbf + (tb) * 512).y, 0u, 0u})
            U[0] = __builtin_amdgcn_mfma_f32_16x16x32_bf16(RC_TBF(0), pack8(X[0], zero4), zero4, 0, 0, 0);
            X[1] = __builtin_amdgcn_mfma_f32_16x16x32_bf16(kperm(L, RC_MKA + a_f4 + 1 * (16 * RC_LD * 2)), pack8(U[0], zero4), X[1], 0, 0, 0);
            U[1] = __builtin_amdgcn_mfma_f32_16x16x32_bf16(RC_TBF(1), pack8(X[1], zero4), zero4, 0, 0, 0);
            const bf16x8 uf0 = pack8(U[0], U[1]);
            X[2] = __builtin_amdgcn_mfma_f32_16x16x32_bf16(kperm(L, RC_MKA + a_f4 + 2 * (16 * RC_LD * 2)), uf0, X[2], 0, 0, 0);
            U[2] = __builtin_amdgcn_mfma_f32_16x16x32_bf16(RC_TBF(2), pack8(X[2], zero4), zero4, 0, 0, 0);
            X[3] = __builtin_amdgcn_mfma_f32_16x16x32_bf16(kperm(L, RC_MKA + a_f4 + 3 * (16 * RC_LD * 2)), uf0, X[3], 0, 0, 0);
            X[3] = __builtin_amdgcn_mfma_f32_16x16x32_bf16(kperm(L, RC_MKA + a_f4 + 3 * (16 * RC_LD * 2) + 64), pack8(U[2], zero4), X[3], 0, 0, 0);
            U[3] = __builtin_amdgcn_mfma_f32_16x16x32_bf16(RC_TBF(3), pack8(X[3], zero4), zero4, 0, 0, 0);
            const bf16x8 uf1 = pack8(U[2], U[3]);
#undef RC_TBF
#pragma unroll
            for (int mt = 0; mt < 4; ++mt) { const unsigned o4 = a_f4 + mt * (16 * RC_LD * 2);
                O[mt] = __builtin_amdgcn_mfma_f32_16x16x32_bf16(kperm(L, RC_NKA + o4), uf0, O[mt], 0, 0, 0);
                O[mt] = __builtin_amdgcn_mfma_f32_16x16x32_bf16(kperm(L, RC_NKA + o4 + 64), uf1, O[mt], 0, 0, 0); }
#pragma unroll
            for (int jt = 0; jt < 4; ++jt) { const unsigned ak = RC_KA + a_tr + (4 * g) * (RC_LD * 2) + jt * 32;
                S[jt] = __builtin_amdgcn_mfma_f32_16x16x32_bf16(tr8(L, ak, ak + 16 * RC_LD * 2), uf0, S[jt], 0, 0, 0);
                S[jt] = __builtin_amdgcn_mfma_f32_16x16x32_bf16(tr8(L, ak + 32 * RC_LD * 2, ak + 48 * RC_LD * 2), uf1, S[jt], 0, 0, 0);
                S[jt] = S[jt] * LD_(f32x4, a_ebr + jt * 64); }
            if (!(last && chunk < 4)) {
                GAS bf16* yp = (GAS bf16*)(Y + (size_t)(r0 + sgn * 4 * g) * 1024 + h * 64 + 16 * w + l16);
                const long sy = (long)sgn * 1024;
#pragma unroll
                for (int mt = 0; mt < 4; ++mt) {
#pragma unroll
                    for (int r = 0; r < 4; ++r) { asm volatile("" : "+v"(yp)); yp[(long)r * sy] = (bf16)f2bf(O[mt][r]); }
                    yp += 16 * sy;
                }
            }
        }
        __syncthreads();
    }
#undef RC_ISSUE
}
#undef LD_
#undef ST_

constexpr int GQ_LD = 264, GT_LD = 72;
constexpr int GV_LD = 136;
constexpr int G_QD = 0, G_KI = G_QD + 64 * GQ_LD * 2, G_KT = G_KI + 64 * GQ_LD * 2, G_VT = G_KT + 256 * GT_LD * 2, G_AM = G_VT + 128 * GT_LD * 2, G_EBL = G_AM + 64 * GT_LD * 2, G_TQ = G_EBL + 1024, G_END = G_TQ + 4096;
static_assert(G_END <= RING_BYTES, "GLA LDS map");
#define LD_(T, addr) (*(const LAS T*)(L + (addr)))
#define ST_(T, addr) (*(LAS T*)(L + (addr)))
template <int VAR> __device__ __forceinline__ void gla_chunk_item(const Frame& F, int item, bool last) {
    const int b = item >> 5, h = (item >> 3) & 3, dir = (item >> 2) & 1, dvs = item & 3;
    LAS unsigned char* L = F.lds;
    const int tid = F.tid, lane = F.lane, w = F.wave, l16 = lane & 15, g = lane >> 4;
    const int dp = tid & 127, qt = tid >> 7;
    const int e8 = tid & 15, jj = tid >> 4;
    const bf16* ZG = RGN(bf16, R_ZG); const bf16* GL = RGN(bf16, R_GL) + (size_t)dir * MT * 1024;
    bf16* YG = RGN(bf16, R_YG) + (size_t)dir * MT * 2048;
    const int sgn = dir ? -1 : 1;
    f32x4 S[16];
#pragma unroll
    for (int t = 0; t < 16; ++t) S[t] = (f32x4){0.f, 0.f, 0.f, 0.f};
    unsigned rq[16], rk[16], rl[16]; v4u rv0, rv1;
#define GLA_ISSUE(chunk) do { int idx_, len_; const int r0_ = seq_row(b, dir, (chunk) * 64, idx_, len_); \
        const GAS bf16* pz_ = (const GAS bf16*)(ZG + (size_t)(r0_ + sgn * 16 * qt) * ZG_W + h * 256 + 2 * dp); const GAS bf16* pl_ = (const GAS bf16*)(GL + (size_t)(r0_ + sgn * 16 * qt) * 1024 + h * 256 + 2 * dp); \
        const long sz_ = (long)sgn * ZG_W, sl_ = (long)sgn * 1024; \
        _Pragma("unroll") for (int i = 0; i < 16; ++i) { asm volatile("" : "+v"(pz_), "+v"(pl_)); \
            rq[i] = *(const GAS unsigned*)pz_; rk[i] = *(const GAS unsigned*)(pz_ + 1024); rl[i] = *(const GAS unsigned*)pl_; pz_ += sz_; pl_ += sl_; } \
        const bf16* pv_ = ZG + (size_t)(r0_ + sgn * jj) * ZG_W + 2048 + h * 512 + dvs * 128 + 8 * e8; \
        rv0 = *(const v4u*)pv_; rv1 = *(const v4u*)(pv_ + sz_ * 32); } while (0)
    GLA_ISSUE(0);
    for (int chunk = 0; chunk < 36; ++chunk) {
        int idx0, len0; const int r0 = seq_row(b, dir, chunk * 64, idx0, len0);
        const unsigned a_ptq = opq(G_TQ + (2 * dp) * 4);
        {
            float s0 = 0.f, s1 = 0.f;
#pragma unroll
            for (int i = 0; i < 16; ++i) { s0 += bflo(rl[i]); s1 += bfhi(rl[i]); }
            ST_(f32x2, a_ptq + qt * 1024) = (f32x2){s0, s1};
        }
        __syncthreads();
        if (VAR != 2)
        {
            float o0 = 0.f, o1 = 0.f, t0 = 0.f, t1 = 0.f;
#pragma unroll
            for (int q = 0; q < 4; ++q) { const f32x2 tq = LD_(f32x2, a_ptq + q * 1024); if (q < qt) { o0 += tq.x; o1 += tq.y; } t0 += tq.x; t1 += tq.y; }
            if (qt == 0) ST_(f32x2, G_EBL + 2 * dp * 4) = (f32x2){fexp(t0), fexp(t1)};
            unsigned kt0[8], kt1[8];
            const unsigned a_pq = opq(G_QD + ((16 * qt) * GQ_LD + 2 * dp) * 2);
            const unsigned a_pkt = opq(G_KT + ((2 * dp) * GT_LD + 16 * qt) * 2);
        const unsigned a_pvt = opq(G_VT + (jj * GV_LD + 8 * e8) * 2);
#pragma unroll
            for (int i = 0; i < 16; ++i) {
                o0 += bflo(rl[i]); o1 += bfhi(rl[i]);
                const float e0 = fexp(o0), e1 = fexp(o1), n0 = fexp(-o0), n1 = fexp(-o1);
                const unsigned qd = pg8::cvt_pk_bf16(bflo(rq[i]) * 0.0625f * e0, bfhi(rq[i]) * 0.0625f * e1);
                const unsigned ki = pg8::cvt_pk_bf16(bflo(rk[i]) * n0, bfhi(rk[i]) * n1);
                ST_(unsigned, a_pq + i * GQ_LD * 2) = qd;
                ST_(unsigned, a_pq + (G_KI - G_QD) + i * GQ_LD * 2) = ki;
                if (i & 1) { kt0[i >> 1] |= (ki << 16); kt1[i >> 1] |= (ki & 0xffff0000u); }
                else { kt0[i >> 1] = ki & 0xffffu; kt1[i >> 1] = ki >> 16; }
                asm volatile("" ::: "memory");
            }
            ST_(v4u, a_pkt) = (v4u){kt0[0], kt0[1], kt0[2], kt0[3]};
            ST_(v4u, a_pkt + 16) = (v4u){kt0[4], kt0[5], kt0[6], kt0[7]};
            ST_(v4u, a_pkt + GT_LD * 2) = (v4u){kt1[0], kt1[1], kt1[2], kt1[3]};
            ST_(v4u, a_pkt + GT_LD * 2 + 16) = (v4u){kt1[4], kt1[5], kt1[6], kt1[7]};
            ST_(v4u, a_pvt) = rv0; ST_(v4u, a_pvt + 32 * GV_LD * 2) = rv1;
        }
        __syncthreads();
        if (chunk + 1 < 36 && VAR != 1) GLA_ISSUE(chunk + 1);
        const unsigned a_f8 = opq((l16 * GQ_LD + 8 * g) * 2);
#pragma unroll
        for (int tt = 0; tt < 2; ++tt) {
            const int t = 2 * w + tt, jt = t >> 2, it = t & 3;
            f32x4 acc = (f32x4){0.f, 0.f, 0.f, 0.f};
            if (jt <= it) {
                const unsigned ak = a_f8 + G_KI + jt * (16 * GQ_LD * 2), aq = a_f8 + G_QD + it * (16 * GQ_LD * 2);
#pragma unroll
                for (int s = 0; s < 8; ++s) {
                    const bf16x8 a = LD_(bf16x8, ak + 64 * s);
                    const bf16x8 bb = LD_(bf16x8, aq + 64 * s);
                    acc = __builtin_amdgcn_mfma_f32_16x16x32_bf16(a, bb, acc, 0, 0, 0);
                }
            }
            const int i = 16 * it + l16, j0 = 16 * jt + 4 * g;
            const float m0 = (j0 + 0 <= i) ? acc[0] : 0.f, m1 = (j0 + 1 <= i) ? acc[1] : 0.f, m2 = (j0 + 2 <= i) ? acc[2] : 0.f, m3 = (j0 + 3 <= i) ? acc[3] : 0.f;
            ST_(v2u, G_AM + (i * GT_LD + j0) * 2) = (v2u){pg8::cvt_pk_bf16(m0, m1), pg8::cvt_pk_bf16(m2, m3)};
        }
        __syncthreads();
        if (VAR != 3)
        {
            const unsigned a_f4 = opq(G_QD + (l16 * GQ_LD + 4 * g) * 2), a_t8 = opq((l16 * GT_LD + 8 * g) * 2), a_ebl = opq(G_EBL + 16 * g);
            const unsigned a_vtr = opq(G_VT + ((8 * g + (l16 >> 2)) * GV_LD + 16 * w + 4 * (l16 & 3)) * 2);
            const unsigned a_os = opq(G_KI + ((4 * g) * GV_LD + 16 * w + l16) * 2);
            f32x4 O[4];
#pragma unroll
            for (int mt = 0; mt < 4; ++mt) O[mt] = (f32x4){0.f, 0.f, 0.f, 0.f};
#pragma unroll
            for (int s = 0; s < 8; ++s) {
                const bf16x8 bs = pack8(S[2 * s], S[2 * s + 1]);
#pragma unroll
                for (int mt = 0; mt < 4; ++mt) {
                    const v2u a0 = LD_(v2u, a_f4 + (16 * mt * GQ_LD + 32 * s) * 2);
                    const v2u a1 = LD_(v2u, a_f4 + (16 * mt * GQ_LD + 32 * s + 16) * 2);
                    const bf16x8 a = __builtin_bit_cast(bf16x8, (v4u){a0.x, a0.y, a1.x, a1.y});
                    O[mt] = __builtin_amdgcn_mfma_f32_16x16x32_bf16(a, bs, O[mt], 0, 0, 0);
                }
                asm volatile("" ::: "memory");
            }
            const bf16x8 vb0 = tr8(L, a_vtr, a_vtr + 4 * GV_LD * 2);
            const bf16x8 vb1 = tr8(L, a_vtr + 32 * GV_LD * 2, a_vtr + 36 * GV_LD * 2);
#pragma unroll
            for (int mt = 0; mt < 4; ++mt) {
                const bf16x8 a0 = LD_(bf16x8, a_t8 + G_AM + mt * (16 * GT_LD * 2));
                O[mt] = __builtin_amdgcn_mfma_f32_16x16x32_bf16(a0, vb0, O[mt], 0, 0, 0);
                if (mt >= 2) { const bf16x8 a1 = LD_(bf16x8, a_t8 + G_AM + mt * (16 * GT_LD * 2) + 64);
                    O[mt] = __builtin_amdgcn_mfma_f32_16x16x32_bf16(a1, vb1, O[mt], 0, 0, 0); }
            }
            if (VAR == 0 && !(last && chunk < 4)) {
                const unsigned aos = a_os;
#pragma unroll
                for (int mt = 0; mt < 4; ++mt)
#pragma unroll
                    for (int r = 0; r < 4; ++r) ST_(unsigned short, aos + (16 * mt + r) * (GV_LD * 2)) = (unsigned short)f2bf(O[mt][r]);
            }
#pragma unroll
            for (int t = 0; t < 16; ++t) {
                const bf16x8 a0 = LD_(bf16x8, a_t8 + G_KT + t * (16 * GT_LD * 2));
                const bf16x8 a1 = LD_(bf16x8, a_t8 + G_KT + t * (16 * GT_LD * 2) + 64);
                S[t] = __builtin_amdgcn_mfma_f32_16x16x32_bf16(a0, vb0, S[t], 0, 0, 0);
                S[t] = __builtin_amdgcn_mfma_f32_16x16x32_bf16(a1, vb1, S[t], 0, 0, 0);
                const f32x4 eb = LD_(f32x4, a_ebl + 64 * t);
                S[t] = S[t] * eb;
                asm volatile("" ::: "memory");
            }
        }
        __syncthreads();
        if (VAR == 0 && !(last && chunk < 4)) {
            const unsigned a_or = opq(G_KI + ((tid >> 4) * GV_LD + 8 * (tid & 15)) * 2);
            const v4u o0 = LD_(v4u, a_or), o1 = LD_(v4u, a_or + 32 * GV_LD * 2);
            GAS bf16* yp = (GAS bf16*)(YG + (size_t)(r0 + sgn * (tid >> 4)) * 2048 + h * 512 + dvs * 128 + 8 * (tid & 15));
            *(GAS v4u*)yp = o0; *(GAS v4u*)(yp + (long)sgn * 32 * 2048) = o1;
        }
    }
#undef GLA_ISSUE
    if (VAR != 0) { float chk = 0.f;
#pragma unroll
        for (int t = 0; t < 16; ++t) chk += S[t][0] + S[t][1] + S[t][2] + S[t][3];
        chk += __uint_as_float(rq[0] ^ rk[3] ^ rl[7]);
        if (chk == 1.2345e-30f) YG[0] = (bf16)1; }
}
#undef LD_
#undef ST_

constexpr int AK_LD = 136, AV_LD = 136;
constexpr int A_K = 0, A_VT = A_K + 64 * AK_LD * 2, A_END = A_VT + 64 * AV_LD * 2;
static_assert(A_END <= RING_BYTES, "attention LDS map");
typedef float f32x16 __attribute__((ext_vector_type(16)));
#define LD_(T, addr) (*(const LAS T*)(L + (addr)))
#define ST_(T, addr) (*(LAS T*)(L + (addr)))
template <bool NOSTORE> __device__ __forceinline__ void attn_mfma_item(const Frame& F, ArgsRef A, int l, int item) {
    LAS unsigned char* L = F.lds;
    const int tid = F.tid, lane = F.lane, w = F.wave, l32 = lane & 31, g = lane >> 5;
    bf16* ZA = RGN(bf16, R_ZA); const bf16* QR = RGN(bf16, R_QR); const bf16* KR = RGN(bf16, R_KR);
    const bool isctx = item >= 512;
    int b, hk, t0;
    if (!isctx) { b = item >> 6; hk = (item >> 5) & 1; t0 = (item & 31) * 64; }
    else { const int it = item - 512; b = it >> 3; hk = (it >> 2) & 1; t0 = (it & 3) * 64; }
    const int hq = hk * 4 + (w >> 1), tq = t0 + 32 * (w & 1) + l32;
    const size_t qrow = isctx ? (size_t)(ML + b * CL + tq) : (size_t)(b * SEQ + tq);
    const float C2 = 0.08838834764831845f * 1.4426950408889634f;
    const int skey = tid >> 3, sc = tid & 7;
    const unsigned a_sk = opq(A_K + (skey * AK_LD + 8 * sc) * 2);
    const unsigned a_sv = opq(A_VT + (skey * AV_LD + 8 * sc) * 2);
    const unsigned a_kf = opq(A_K + (l32 * AK_LD + 8 * g) * 2);
    const unsigned a_vf = opq(A_VT + ((4 * g + ((lane & 15) >> 2)) * AV_LD + 16 * ((lane >> 4) & 1) + 4 * (lane & 3)) * 2);
    bf16x8 qf[8];
    {
        const bf16* qp = (isctx ? (const bf16*)ZA + qrow * ZA_LD : QR + qrow * 1024) + hq * 128 + 8 * g;
#pragma unroll
        for (int s = 0; s < 8; ++s) qf[s] = *(const bf16x8*)(qp + 16 * s);
    }
    float mrun = AIN(11)[l * 8 + hq] * 1.4426950408889634f, lsum = (g == 0) ? 1.f : 0.f;
    f32x16 O[4];
#pragma unroll
    for (int mt = 0; mt < 4; ++mt)
#pragma unroll
        for (int r = 0; r < 16; ++r) O[mt][r] = 0.f;
    int tfirst = isctx ? 5 : 0;
    if (!isctx) { while (t0 - 128 + 64 * tfirst < 0) ++tfirst; }
    v4u pk0, pk1, pv0, pv1;
#define ATT_PREFETCH(tile) do { const bf16 *kp_, *vp_; \
        if ((tile) < 5) { const size_t r_ = (size_t)(b * SEQ + t0 - 128 + 64 * (tile) + skey); kp_ = KR + r_ * 256 + hk * 128 + 8 * sc; vp_ = ZA + r_ * ZA_LD + 1280 + hk * 128 + 8 * sc; } \
        else { const size_t r_ = (size_t)(ML + b * CL + 64 * ((tile) - 5) + skey); kp_ = ZA + r_ * ZA_LD + 1024 + hk * 128 + 8 * sc; vp_ = kp_ + 256; } \
        pk0 = *(const v4u*)kp_; pk1 = *(const v4u*)(kp_ + 64); pv0 = *(const v4u*)vp_; pv1 = *(const v4u*)(vp_ + 64); } while (0)
    int tile = tfirst;
    ATT_PREFETCH(tile);
    bool plainq = isctx;
    while (tile < 9) {
        __syncthreads();
        ST_(v4u, a_sk) = pk0; ST_(v4u, a_sk + 128) = pk1;
        ST_(v4u, a_sv) = pv0; ST_(v4u, a_sv + 128) = pv1;
        __syncthreads();
        const int cur = tile;
        int nxt = cur + 1;
        if (nxt < 5 && t0 - 128 + 64 * nxt >= SEQ) nxt = 5;
        if (nxt < 9) ATT_PREFETCH(nxt);
        if (cur >= 5 && !plainq) {
            const bf16* qp = (const bf16*)ZA + qrow * ZA_LD + hq * 128 + 8 * g;
#pragma unroll
            for (int s = 0; s < 8; ++s) qf[s] = *(const bf16x8*)(qp + 16 * s);
            plainq = true;
        }
        f32x16 sc0, sc1;
#pragma unroll
        for (int r = 0; r < 16; ++r) { sc0[r] = 0.f; sc1[r] = 0.f; }
#pragma unroll
        for (int s = 0; s < 8; ++s) {
            const bf16x8 k0 = LD_(bf16x8, a_kf + 32 * s), k1 = LD_(bf16x8, a_kf + 32 * AK_LD * 2 + 32 * s);
            sc0 = __builtin_amdgcn_mfma_f32_32x32x16_bf16(k0, qf[s], sc0, 0, 0, 0);
            sc1 = __builtin_amdgcn_mfma_f32_32x32x16_bf16(k1, qf[s], sc1, 0, 0, 0);
        }
        float tmax = -3.0e38f;
        if (cur < 5) {
            const int kbase = t0 - 128 + 64 * cur - tq + 4 * g;
#pragma unroll
            for (int r = 0; r < 16; ++r) { const int d0 = kbase + 8 * (r >> 2) + (r & 3), d1 = d0 + 32;
                sc0[r] = (d0 >= -128 && d0 <= 128) ? sc0[r] * C2 : -1.0e30f; sc1[r] = (d1 >= -128 && d1 <= 128) ? sc1[r] * C2 : -1.0e30f; }
        } else {
#pragma unroll
            for (int r = 0; r < 16; ++r) { sc0[r] *= C2; sc1[r] *= C2; }
        }
#pragma unroll
        for (int r = 0; r < 16; ++r) tmax = fmaxf(tmax, fmaxf(sc0[r], sc1[r]));
        tmax = xhalf_max(tmax);
        const float mnew = fmaxf(mrun, tmax);
        const float corr = __builtin_amdgcn_exp2f(mrun - mnew);
        mrun = mnew;
        float ps = 0.f;
#pragma unroll
        for (int r = 0; r < 16; ++r) { sc0[r] = __builtin_amdgcn_exp2f(sc0[r] - mnew); sc1[r] = __builtin_amdgcn_exp2f(sc1[r] - mnew); ps += sc0[r] + sc1[r]; }
        lsum = lsum * corr + ps;
        if (__builtin_amdgcn_ballot_w64(corr != 1.0f) != 0ull) {
#pragma unroll
            for (int mt = 0; mt < 4; ++mt)
#pragma unroll
                for (int r = 0; r < 16; ++r) O[mt][r] *= corr;
        }
#pragma unroll
        for (int u = 0; u < 2; ++u)
#pragma unroll
            for (int s = 0; s < 2; ++s) {
                v4u pw;
                if (u == 0) { pw.x = pg8::cvt_pk_bf16(sc0[8 * s + 0], sc0[8 * s + 1]); pw.y = pg8::cvt_pk_bf16(sc0[8 * s + 2], sc0[8 * s + 3]); pw.z = pg8::cvt_pk_bf16(sc0[8 * s + 4], sc0[8 * s + 5]); pw.w = pg8::cvt_pk_bf16(sc0[8 * s + 6], sc0[8 * s + 7]); }
                else { pw.x = pg8::cvt_pk_bf16(sc1[8 * s + 0], sc1[8 * s + 1]); pw.y = pg8::cvt_pk_bf16(sc1[8 * s + 2], sc1[8 * s + 3]); pw.z = pg8::cvt_pk_bf16(sc1[8 * s + 4], sc1[8 * s + 5]); pw.w = pg8::cvt_pk_bf16(sc1[8 * s + 6], sc1[8 * s + 7]); }
                const bf16x8 pb = __builtin_bit_cast(bf16x8, pw);
#pragma unroll
                for (int mt = 0; mt < 4; ++mt) {
                    const bf16x8 av = tr8(L, a_vf + ((32 * u + 16 * s) * AV_LD + 32 * mt) * 2, a_vf + ((32 * u + 16 * s + 8) * AV_LD + 32 * mt) * 2);
                    O[mt] = __builtin_amdgcn_mfma_f32_32x32x16_bf16(av, pb, O[mt], 0, 0, 0);
                }
            }
        tile = nxt;
    }
#undef ATT_PREFETCH
    lsum = xhalf_sum(lsum);
    const float inv = 1.0f / lsum;
    bf16* op = ZA + qrow * ZA_LD + hq * 128 + 4 * g;
    if (NOSTORE) { float chk = inv;
#pragma unroll
        for (int mt = 0; mt < 4; ++mt) chk += O[mt][0] + O[mt][5] + O[mt][10] + O[mt][15];
        if (chk == 1.2345e-30f) op[0] = (bf16)1;
        return; }
#pragma unroll
    for (int mt = 0; mt < 4; ++mt)
#pragma unroll
        for (int i = 0; i < 4; ++i) {
            v2u o; o.x = pg8::cvt_pk_bf16(O[mt][4 * i] * inv, O[mt][4 * i + 1] * inv); o.y = pg8::cvt_pk_bf16(O[mt][4 * i + 2] * inv, O[mt][4 * i + 3] * inv);
            *(v2u*)(op + 32 * mt + 8 * i) = o;
        }
}
#undef LD_
#undef ST_

#ifndef MK_PROBE
#define MK_PROBE 0
#endif
#define PROBE_SPIN(bit, t0_) do { if ((MK_PROBE & (bit)) != 0) { asm volatile("s_waitcnt vmcnt(0) lgkmcnt(0)" ::: "memory"); const unsigned long long t1_ = __builtin_amdgcn_s_memrealtime(); \
        while (__builtin_amdgcn_s_memrealtime() - t1_ < t1_ - (t0_)) __builtin_amdgcn_s_sleep(8); } } while (0)
__device__ __forceinline__ void phase_mix(const Frame& F, ArgsRef A, int l, bool last) {
    unsigned long long tp = (MK_PROBE & 0x700) ? __builtin_amdgcn_s_memrealtime() : 0ull;
#if !defined(MIX_ONLY) || MIX_ONLY == 1
    for (int v = F.bid; v < 256; v += F.G) rwkv_chunk_item(F, A, l, ((v & 7) << 5) | (v >> 3), last);
#endif
    PROBE_SPIN(0x100, tp);
    if (MK_PROBE & 0x700) tp = __builtin_amdgcn_s_memrealtime();
#if !defined(MIX_ONLY) || MIX_ONLY == 2
    for (int v = F.bid; v < 256; v += F.G) { const int x = v & 7, y = v >> 3; gla_chunk_item<0>(F, ((x + 8 * (y >> 3)) << 3) | (y & 7), last); }

#endif
    PROBE_SPIN(0x200, tp);
    if (MK_PROBE & 0x700) tp = __builtin_amdgcn_s_memrealtime();
    {
        const int x = F.bid & 7; const unsigned nt = last ? 64u : 72u;
        unsigned* ctr = (unsigned*)(F.ws + WS_CTL) + 8192 + (l * 8 + x) * 64;
        volatile LAS unsigned* tk = (volatile LAS unsigned*)(F.lds + MISC_OFF) + 16;
        for (;;) {
            if (F.tid == 0) *tk = __hip_atomic_fetch_add(ctr, 1u, __ATOMIC_RELAXED, __HIP_MEMORY_SCOPE_AGENT);
            __syncthreads();
            const unsigned t = *tk;
            __syncthreads();
            if (t >= nt) break;
            const int item = t < 64u ? ((x << 6) | (int)t) : 512 + ((x << 3) | (int)(t - 64u));
#if !defined(MIX_ONLY) || MIX_ONLY == 3
            attn_mfma_item<false>(F, A, l, item);
#endif
        }
    }
    PROBE_SPIN(0x400, tp);
}

__device__ __forceinline__ void phase_mixout(const Frame& F, ArgsRef A, int l, int nrows) {
    const int gw = F.bid * NWAVES + F.wave, NGW = F.G * NWAVES, lane = F.lane;
    {
        const bf16* ZR = RGN(bf16, R_ZR); const bf16* Y = RGN(bf16, R_Y); const bf16* G = RGN(bf16, R_G); bf16* ORW = RGN(bf16, R_ZA) + OC_RW; const float* BS = RGN(float, R_BS);
        const float* cw = AIN(12) + (size_t)l * 3 * RW_COLS;
        const int cg = F.wave & 3, c0 = cg * 256 + lane * 4, hd = cg * 4 + (lane >> 4);
        f32x4 tpv[3];
#pragma unroll
        for (int tap = 0; tap < 3; ++tap) tpv[tap] = *(const f32x4*)(cw + tap * RW_COLS + 2 * 1024 + c0);
        const f32x4 lnw = *(const f32x4*)(AIN(21) + l * 1024 + c0), lnb = *(const f32x4*)(AIN(22) + l * 1024 + c0);
        for (int m = F.bid * 2 + (F.wave >> 2); m < nrows; m += 2 * F.G) {
            int idx, len; if (m < ML) { idx = m & (SEQ - 1); len = SEQ; } else { idx = (m - ML) & (CL - 1); len = CL; }
            const float fl = idx > 0 ? 1.f : 0.f, fr = idx < len - 1 ? 1.f : 0.f;
            const bf16* z0 = ZR + (size_t)m * ZR_W + 2 * 1024 + c0; const bf16* zl = idx > 0 ? z0 - ZR_W : z0; const bf16* zrr = idx < len - 1 ? z0 + ZR_W : z0;
            const v2u wc = *(const v2u*)z0, wl = *(const v2u*)zl, wr = *(const v2u*)zrr;
            const f32x4 xc = (f32x4){bflo(wc.x), bfhi(wc.x), bflo(wc.y), bfhi(wc.y)}, xl = (f32x4){bflo(wl.x), bfhi(wl.x), bflo(wl.y), bfhi(wl.y)}, xr = (f32x4){bflo(wr.x), bfhi(wr.x), bflo(wr.y), bfhi(wr.y)};
            const f32x4 v = xc * tpv[1] + xl * tpv[0] * fl + xr * tpv[2] * fr;
            const v2u yw0 = *(const v2u*)(Y + (size_t)m * 1024 + c0), yw1 = *(const v2u*)(Y + ((size_t)MT + m) * 1024 + c0);
            const f32x4 y0 = (f32x4){bflo(yw0.x), bfhi(yw0.x), bflo(yw0.y), bfhi(yw0.y)}, y1 = (f32x4){bflo(yw1.x), bfhi(yw1.x), bflo(yw1.y), bfhi(yw1.y)};
            const float bs = BS[(size_t)m * 16 + hd] + BS[((size_t)MT + m) * 16 + hd];
            const f32x4 o = y0 + y1;
            const float mean = red16s((o.x + o.y) + (o.z + o.w)) * (1.f / 64.f); const f32x4 dv = o - mean;
            const float var = red16s((dv.x * dv.x + dv.y * dv.y) + (dv.z * dv.z + dv.w * dv.w)) * (1.f / 64.f);
            const f32x4 on = dv * (1.f / sqrtf(var + 64e-5f)) * lnw + lnb;
            const v2u gw2 = *(const v2u*)(G + (size_t)m * 1024 + c0);
            const f32x4 gv = (f32x4){bflo(gw2.x), bfhi(gw2.x), bflo(gw2.y), bfhi(gw2.y)};
            const f32x4 res = (on + v * bs) * gv;
            *(v2u*)(ORW + (size_t)m * ZA_LD + c0) = (v2u){pk2(res.x, res.y), pk2(res.z, res.w)};
        }
    }
    {
        const bf16* YG = RGN(bf16, R_YG); const bf16* ZG = RGN(bf16, R_ZG); bf16* OGL = RGN(bf16, R_ZA) + OC_GL; const float* nw = AIN(25) + l * 512;
        const f32x4 nw0 = *(const f32x4*)(nw + lane * 8), nw1 = *(const f32x4*)(nw + lane * 8 + 4);
        for (int it = gw; it < nrows * 4; it += NGW) {
            const int m = it >> 2, h = it & 3;
            const v4u ya = *(const v4u*)(YG + (size_t)m * 2048 + h * 512 + lane * 8), yb = *(const v4u*)(YG + ((size_t)MT + m) * 2048 + h * 512 + lane * 8);
            f32x4 y0 = (f32x4){bflo(ya.x) + bflo(yb.x), bfhi(ya.x) + bfhi(yb.x), bflo(ya.y) + bflo(yb.y), bfhi(ya.y) + bfhi(yb.y)};
            f32x4 y1 = (f32x4){bflo(ya.z) + bflo(yb.z), bfhi(ya.z) + bfhi(yb.z), bflo(ya.w) + bflo(yb.w), bfhi(ya.w) + bfhi(yb.w)};
            const float ss = wave_sum((y0.x * y0.x + y0.y * y0.y) + (y0.z * y0.z + y0.w * y0.w) + (y1.x * y1.x + y1.y * y1.y) + (y1.z * y1.z + y1.w * y1.w));
            const float rs = 1.f / sqrtf(ss * (1.f / 512.f) + 1e-5f);
            const v4u gw4 = *(const v4u*)(ZG + (size_t)m * ZG_W + 4096 + h * 512 + lane * 8);
            const f32x4 g0 = (f32x4){bflo(gw4.x), bfhi(gw4.x), bflo(gw4.y), bfhi(gw4.y)}, g1 = (f32x4){bflo(gw4.z), bfhi(gw4.z), bflo(gw4.w), bfhi(gw4.w)};
            y0 = y0 * rs * nw0; y1 = y1 * rs * nw1;
            v4u w; w.x = pk2(y0.x * fsilu(g0.x), y0.y * fsilu(g0.y)); w.y = pk2(y0.z * fsilu(g0.z), y0.w * fsilu(g0.w));
            w.z = pk2(y1.x * fsilu(g1.x), y1.y * fsilu(g1.y)); w.w = pk2(y1.z * fsilu(g1.z), y1.w * fsilu(g1.w));
            *(v4u*)(OGL + (size_t)m * ZA_LD + h * 512 + lane * 8) = w;
        }
    }
}


#define NOPK
#ifndef MK_ONE_LAUNCH
#define MK_ONE_LAUNCH 1
#endif

template <int K> __device__ __forceinline__ void run_phase(const Frame& F, ArgsRef A, int l) {
    const float* mods = WSP(float, WS_MODS);
    bf16* HB = WSP(bf16, WS_HB);
    const bool last = (l == DEPTH - 1);
    const float* mods_l = mods + (size_t)l * 9 * 18432;
    const float* lng = AIN(6) + (size_t)l * 3 * D; const float* lnb = AIN(7) + (size_t)l * 3 * D;
    const int nrows = last ? ML : MT;
    if constexpr (K == -1) phase_init(F, A);
    if constexpr (K == 0) {
        if (l > 0) phase_ln<true, true>(F, MT, lng - D, lnb - D, mods_l, 0, 1, RGN(bf16, R_PART), mods_l - 9 * 18432 + 8 * 18432 + 8 * 2048, 0.5f);
        else phase_ln<false, true>(F, MT, nullptr, nullptr, mods_l, 0, 1, nullptr, nullptr, 0.f, AIN(0), AIN(2));
        phase_convert(F, A, l, 0, 3);
    }
    if constexpr (K == 1 || K == 12) { const int M = (K == 1) ? MT : nrows; pg8::Gemm g{HB, RGN(bf16, R_WGU), M, 2 * FF, D, D, D, 0}; pg8::StaticOrder S; S.init(M, 2 * FF, F.G, F.bid);
        pg8::EpiSwiglu E{RGN(bf16, R_H), FF}; pg8::gemm_phase<pg8::EpiSwiglu, pg8::StaticOrder, true, true>(F.lds, g, S, E, F.tid); }
    if constexpr (K == 2 || K == 13) { const int M = (K == 2) ? MT : nrows;
        { pg8::Gemm g{RGN(bf16, R_H), RGN(bf16, R_WDN), ML, D, FF, FF, FF, 0}; pg8::StaticOrder S; S.init(ML, D, F.G, F.bid);
          const bool first = (K == 2) && l == 0;
          const float* pg_ = (K == 2) ? (first ? lng : lng - D) : lng + D; const float* pb_ = (K == 2) ? (first ? lnb : lnb - D) : lnb + D;
          pg8::EpiResid<1> E{(float*)F.out, mods_l, first ? AIN(0) : (const float*)F.out, first ? nullptr : WSP(const float, WS_STATS), pg_, pb_, (K == 2) ? 2 : 8}; pg8::gemm_phase<pg8::EpiResid<1>, pg8::StaticOrder, true, true>(F.lds, g, S, E, F.tid); }
        if (M == MT) { pg8::Gemm g{RGN(bf16, R_H) + (size_t)ML * FF, RGN(bf16, R_WDN), MC, D, FF / 4, FF, FF, (FF / 4) * 2}; pg8::SplitKOrder S; S.init(MC, D, 4, F.G, F.bid);
          pg8::EpiPartial E{RGN(bf16, R_PART), D, (size_t)MC * D}; pg8::gemm_phase<pg8::EpiPartial, pg8::SplitKOrder, true, true>(F.lds, g, S, E, F.tid); }
    }
    if constexpr (K == 3) phase_ln<true, true>(F, MT, lng, lnb, mods_l, 3, 4, RGN(bf16, R_PART), mods_l + 8 * 18432 + 2 * 2048, 0.5f, nullptr, l == 0 ? AIN(2) : nullptr);
    if constexpr (K == 4) { pg8::Gemm g{HB, WSP(bf16, WS_WM + WM_IN), MT, NMIX, D, D, D, 0}; pg8::StaticOrder S; S.init(MT, NMIX, F.G, F.bid);
        typedef pg8::EpiBf16Seg<0, WS_R + R_ZA, WS_R + R_ZR, WS_R + R_ZG, 6, 21, ZA_LD, ZR_W, ZG_W> EpiWin; EpiWin E{(unsigned char*)F.ws};
        pg8::gemm_phase<EpiWin, pg8::StaticOrder, true, true>(F.lds, g, S, E, F.tid); }
    if constexpr (K == 5) { phase_prep(F, A, l);
#if (MK_PROBE & 0x100000)
        __syncthreads();
        for (int v = F.bid; v < 576; v += F.G) { const int item = v < 512 ? (((v & 7) << 6) | ((v >> 3) & 31) | ((v >> 8) << 5)) : 512 + ((((v - 512) & 7) << 3) | ((v - 512) >> 3)); attn_mfma_item<true>(F, A, l, item); }
#endif
#if (MK_PROBE & 0x200000)
        __syncthreads();
        for (int v = F.bid; v < 256; v += F.G) rwkv_chunk_item(F, A, l, ((v & 7) << 5) | (v >> 3), true);
#endif
#if (MK_PROBE & 0xF0000)
        __syncthreads();
        for (int v = F.bid; v < 256; v += F.G) { const int x = v & 7, y = v >> 3; gla_chunk_item<(MK_PROBE >> 16) & 15>(F, ((x + 8 * (y >> 3)) << 3) | (y & 7), true); }
#endif
    }
    if constexpr (K == 6) {
        { pg8::Gemm g{RGN(bf16, R_LA), WSP(bf16, WS_WM + WM_LW), MT, 2048, 256, LA_W, 256, 0}; pg8::StaticOrder S; S.init(MT, 2048, F.G, F.bid);
          pg8::EpiLora<0> E{RGN(float, R_WDEC), nullptr, AIN(13) + (size_t)l * 2048, (size_t)MT * 1024}; pg8::gemm_phase<pg8::EpiLora<0>, pg8::StaticOrder, true, true>(F.lds, g, S, E, F.tid); }
    }
    if constexpr (K == 15) {
        { pg8::Gemm g{RGN(bf16, R_LA) + 256, WSP(bf16, WS_WM + WM_LA), MT, 2048, 256, LA_W, 256, 0}; pg8::StaticOrder S; S.init(MT, 2048, F.G, F.bid);
          pg8::EpiLora<1> E{nullptr, RGN(bf16, R_AA), AIN(15) + (size_t)l * 2048, (size_t)MT * 1024}; pg8::gemm_phase<pg8::EpiLora<1>, pg8::StaticOrder, true, true>(F.lds, g, S, E, F.tid); }
    }
    if constexpr (K == 16) {
        { pg8::Gemm g{RGN(bf16, R_LA) + 512, WSP(bf16, WS_WM + WM_LG), MT, 1024, 256, LA_W, 256, 0}; pg8::StaticOrder S; S.init(MT, 1024, F.G, F.bid);
          pg8::EpiLora<2> E{nullptr, RGN(bf16, R_G), nullptr, 0}; pg8::gemm_phase<pg8::EpiLora<2>, pg8::StaticOrder, true, true>(F.lds, g, S, E, F.tid); }
    }
    if constexpr (K == 7) phase_mix(F, A, l, last);
    if constexpr (K == 8) {
        phase_mixout(F, A, l, nrows);
        __syncthreads();
        pg8::Gemm g{HB, WSP(bf16, WS_WM + WM_IN) + (size_t)NMIX * D, nrows, GT_W, D, D, D, 0}; pg8::StaticOrder S; S.init(nrows, GT_W, F.G, F.bid);
        typedef pg8::EpiBf16Seg<1, WS_R + R_GT, WS_R + R_GT, WS_R + R_GT, 1 << 20, 1 << 20, GT_W, GT_W, GT_W> EpiGate; EpiGate E{(unsigned char*)F.ws};
        pg8::gemm_phase<EpiGate, pg8::StaticOrder, true, true>(F.lds, g, S, E, F.tid);
    }
    if constexpr (K == 9) {
        pg8::Gemm g{RGN(bf16, R_ZA), WSP(bf16, WS_WM + WM_BA), nrows, D, 4096, ZA_LD, 4096, 0, 16, (OC_RW - 1024) * 2}; pg8::StaticOrder S; S.init(nrows, D, F.G, F.bid);
        pg8::EpiBranchFused E{RGN(bf16, R_GT), GT_W, RGN(bf16, R_MG)}; pg8::gemm_phase<pg8::EpiBranchFused, pg8::StaticOrder, true, true>(F.lds, g, S, E, F.tid);
    }
    if constexpr (K == 10) {
        { pg8::Gemm g{RGN(bf16, R_MG), WSP(bf16, WS_WM + WM_OUT), ML, D, D, D, D, 0}; pg8::StaticOrder S; S.init(ML, D, F.G, F.bid);
          pg8::EpiResid<2> E{(float*)F.out, mods_l, (const float*)F.out, WSP(const float, WS_STATS), lng, lnb, 5}; pg8::gemm_phase<pg8::EpiResid<2>, pg8::StaticOrder, true, true>(F.lds, g, S, E, F.tid); }
        if (nrows == MT) { pg8::Gemm g{RGN(bf16, R_MG) + (size_t)ML * D, WSP(bf16, WS_WM + WM_OUT), MC, D, D / 4, D, D, (D / 4) * 2}; pg8::SplitKOrder S; S.init(MC, D, 4, F.G, F.bid);
          pg8::EpiPartial E{RGN(bf16, R_PART), D, (size_t)MC * D}; pg8::gemm_phase<pg8::EpiPartial, pg8::SplitKOrder, true, true>(F.lds, g, S, E, F.tid); }
    }
    if constexpr (K == 11) { phase_ln<true, true>(F, nrows, lng + D, lnb + D, mods_l, 6, 7, RGN(bf16, R_PART), mods_l + 8 * 18432 + 5 * 2048, 1.0f); phase_convert(F, A, l, 1, 1); }
    if constexpr (K == 14) phase_ln<true, false, true>(F, ML, lng + 2 * D, lnb + 2 * D, nullptr, 0, 0);
}

__device__ __forceinline__ void frame_init(Frame& F, const Args& A, unsigned char* lds_raw) {
    F.lds = (LAS unsigned char*)lds_raw;
    F.tid = threadIdx.x; F.lane = F.tid & 63; F.wave = __builtin_amdgcn_readfirstlane(F.tid >> 6);
    F.G = gridDim.x; F.bid = blockIdx.x; F.out = (GAS float*)A.out; F.ws = (GAS unsigned char*)A.ws;
}

template <int K> __global__ void __launch_bounds__(NTHR, 2) NOPK fwd_phase(Args A) {
    extern __shared__ __attribute__((aligned(16))) unsigned char lds_raw[];
    Frame F; frame_init(F, A, lds_raw);
    const CAS Args* ap = (const CAS Args*)__builtin_amdgcn_kernarg_segment_ptr();
    run_phase<K>(F, *ap, A.ph_lo);
}


#ifndef MK_UNROLL_LAYERS
#define MK_UNROLL_LAYERS 0
#endif
__device__ __forceinline__ void launder(Frame& F, int& l) {
    asm volatile("" : "+s"(F.wave));
    { int ln; asm volatile("v_mbcnt_lo_u32_b32 %0, -1, 0\n\tv_mbcnt_hi_u32_b32 %0, -1, %0" : "=v"(ln)); F.lane = ln; }
    F.tid = F.wave * 64 + F.lane;
    asm volatile("" : "+s"(F.bid), "+s"(F.G), "+s"(l));
    asm volatile("" : "+s"(F.ws), "+s"(F.out));
}
template <int K> __device__ __forceinline__ constexpr int phase_group() { return (K == 1 || K == 2 || K == 4 || K == 6 || K == 15 || K == 16 || K == 9 || K == 10 || K == 12 || K == 13) ? 1 : (K == 7 ? 2 : (K == 8 ? 4 : (K == 5 ? 8 : (K == 0 || K == 11 ? 16 : (K == 3 || K == 14 ? 32 : 64))))); }
template <int K> __device__ __forceinline__ void run_phase_l(Frame F, int l) {
    if constexpr ((MK_PROBE & phase_group<K>()) != 0) {
        const unsigned long long t0 = __builtin_amdgcn_s_memrealtime();
        { Frame F2 = F; int l2 = l; launder(F2, l2); const CAS Args* ap = (const CAS Args*)__builtin_amdgcn_kernarg_segment_ptr(); asm volatile("" : "+s"(ap)); run_phase<K>(F2, *ap, l2); }
        asm volatile("s_waitcnt vmcnt(0) lgkmcnt(0)" ::: "memory");
        const unsigned long long t1 = __builtin_amdgcn_s_memrealtime();
        while (__builtin_amdgcn_s_memrealtime() - t1 < t1 - t0) __builtin_amdgcn_s_sleep(8);
        return;
    }
    launder(F, l); const CAS Args* ap = (const CAS Args*)__builtin_amdgcn_kernarg_segment_ptr(); asm volatile("" : "+s"(ap)); run_phase<K>(F, *ap, l); }
template <int L> __device__ __forceinline__ void run_layer(const Frame& F, int l, const XcdBarrier& bar) {
#if (MK_PROBE & 0x2000)
#define XBAR2(t_) do { const unsigned long long tb0_ = __builtin_amdgcn_s_memrealtime(); xcd_barrier(bar, (t_)); const unsigned long long tb1_ = __builtin_amdgcn_s_memrealtime(); \
    while (__builtin_amdgcn_s_memrealtime() - tb1_ < tb1_ - tb0_) __builtin_amdgcn_s_sleep(8); } while (0)
#elif (MK_PROBE & 0x1000)
#define XBAR2(t_) xcd_barrier(bar, (t_)); xcd_barrier(bar, (t_))
#else
#define XBAR2(t_) xcd_barrier(bar, (t_))
#endif
#define PB(K) run_phase_l<K>(F, l); { int ln_; asm volatile("v_mbcnt_lo_u32_b32 %0, -1, 0\n\tv_mbcnt_hi_u32_b32 %0, -1, %0" : "=v"(ln_)); XBAR2(F.wave * 64 + ln_); }
    PB(0) PB(1) PB(2) PB(3) PB(4) PB(5)
    run_phase_l<6>(F, l); run_phase_l<15>(F, l); run_phase_l<16>(F, l); { int ln_; asm volatile("v_mbcnt_lo_u32_b32 %0, -1, 0\n\tv_mbcnt_hi_u32_b32 %0, -1, %0" : "=v"(ln_)); XBAR2(F.wave * 64 + ln_); }
    PB(7) PB(8) PB(9) PB(10) PB(11) PB(12) PB(13)
#undef PB
}
__global__ void __launch_bounds__(NTHR, 2) NOPK fwd_all(Args A) {
    extern __shared__ __attribute__((aligned(16))) unsigned char lds_raw[];
    Frame F; frame_init(F, A, lds_raw);
    volatile LAS unsigned* MISC = (volatile LAS unsigned*)(F.lds + MISC_OFF);
    for (int u = F.tid; u < (LDS_BYTES - LDSCTL_OFF) / 4; u += NTHR) ((LAS unsigned*)(F.lds + LDSCTL_OFF))[u] = 0u;
    __syncthreads();
    const XcdBarrier bar = xcd_barrier_post((unsigned*)(F.ws + WS_CTL) + 4096, MISC + 8, F.tid);
    run_phase_l<-1>(F, 0); { int ln_; asm volatile("v_mbcnt_lo_u32_b32 %0, -1, 0\n\tv_mbcnt_hi_u32_b32 %0, -1, %0" : "=v"(ln_)); XBAR2(F.wave * 64 + ln_); }
#if MK_UNROLL_LAYERS
    run_layer<0>(F, 0, bar); run_layer<1>(F, 1, bar);
#else
    for (int l = 0; l < DEPTH; ++l) run_layer<0>(F, l, bar);
#endif
    run_phase_l<14>(F, DEPTH - 1);
}

template <int K> static void launch_phase(const Args& a, int l, int grid, hipStream_t stream) {
    static bool attr_done = false;
    if (!attr_done) { (void)hipFuncSetAttribute((const void*)fwd_phase<K>, hipFuncAttributeMaxDynamicSharedMemorySize, LDS_BYTES); attr_done = true; }
    Args b = a; b.ph_lo = l; b.ph_hi = 0;
    hipLaunchKernelGGL(fwd_phase<K>, dim3(grid), dim3(NTHR), LDS_BYTES, stream, b);
}

extern "C" void kernel_launch(void* const* d_in, const int* in_sizes, int n_in, void* d_out, int out_size, void* d_ws, size_t ws_size, hipStream_t stream) {
    static int grid = 0;
    if (grid == 0) {
        if (n_in != 30 || out_size != ML * D || ws_size < WS_END) { fprintf(stderr, "kernel_launch: unexpected shapes (n_in %d, out %d, ws %zu < %zu)\n", n_in, out_size, ws_size, (size_t)WS_END); grid = -1; return; }
        int dev = 0, cus = 0;
        if (hipGetDevice(&dev) != hipSuccess || hipDeviceGetAttribute(&cus, hipDeviceAttributeMultiprocessorCount, dev) != hipSuccess) { grid = -1; return; }
        grid = cus;
    }
    if (grid < 0) return;
    (void)hipMemsetAsync((char*)d_ws + WS_CTL, 0, CTL_ZERO_BYTES, stream);
    Args a{};
    for (int i = 0; i < 30; ++i) a.in[i] = (const float*)d_in[i];
    a.out = (float*)d_out; a.ws = (unsigned char*)d_ws;
#if MK_ONE_LAUNCH
    {
        static bool attr_done = false;
        if (!attr_done) { int per_cu = 0;
            if (hipFuncSetAttribute((const void*)fwd_all, hipFuncAttributeMaxDynamicSharedMemorySize, LDS_BYTES) != hipSuccess) { fprintf(stderr, "kernel_launch: hipFuncSetAttribute failed\n"); grid = -1; return; }
            if (hipOccupancyMaxActiveBlocksPerMultiprocessor(&per_cu, (const void*)fwd_all, NTHR, LDS_BYTES) != hipSuccess || per_cu < 1) { fprintf(stderr, "kernel_launch: occupancy query says %d blocks per CU; not launching\n", per_cu); (void)hipGetLastError(); grid = -1; return; }
            attr_done = true; }
        a.ph_lo = 0; a.ph_hi = 0;
        hipLaunchKernelGGL(fwd_all, dim3(grid), dim3(NTHR), LDS_BYTES, stream, a);
        return;
    }
#endif
    launch_phase<-1>(a, 0, grid, stream);
    for (int l = 0; l < DEPTH; ++l) {
        launch_phase<0>(a, l, grid, stream); launch_phase<1>(a, l, grid, stream); launch_phase<2>(a, l, grid, stream); launch_phase<3>(a, l, grid, stream);
        launch_phase<4>(a, l, grid, stream); launch_phase<5>(a, l, grid, stream); launch_phase<6>(a, l, grid, stream); launch_phase<15>(a, l, grid, stream); launch_phase<16>(a, l, grid, stream); launch_phase<7>(a, l, grid, stream);
        launch_phase<8>(a, l, grid, stream); launch_phase<9>(a, l, grid, stream); launch_phase<10>(a, l, grid, stream); launch_phase<11>(a, l, grid, stream);
        launch_phase<12>(a, l, grid, stream); launch_phase<13>(a, l, grid, stream);
    }
    launch_phase<14>(a, DEPTH - 1, grid, stream);
}
```

```cpp
#include <hip/hip_runtime.h>
#include <cstdio>
#include <cstdint>

#define GAS __attribute__((address_space(1)))
#define LAS __attribute__((address_space(3)))
typedef unsigned short bf16;
typedef unsigned v4u __attribute__((ext_vector_type(4)));
typedef unsigned v2u __attribute__((ext_vector_type(2)));
typedef float v2f __attribute__((ext_vector_type(2)));
typedef float f32x4 __attribute__((ext_vector_type(4)));
typedef float f32x2 __attribute__((ext_vector_type(2)));
typedef short bf16x8 __attribute__((ext_vector_type(8)));

__device__ __forceinline__ float bf2f(unsigned short b) { return __builtin_bit_cast(float, ((unsigned)b) << 16); }
__device__ __forceinline__ float bflo(unsigned w) { return __builtin_bit_cast(float, w << 16); }
__device__ __forceinline__ float bfhi(unsigned w) { return __builtin_bit_cast(float, w & 0xffff0000u); }
typedef __bf16 bf2n_t_ __attribute__((ext_vector_type(2)));
__device__ __forceinline__ unsigned pk2(float lo, float hi) { const f32x2 v = {lo, hi}; return __builtin_bit_cast(unsigned, __builtin_convertvector(v, bf2n_t_)); }
__device__ __forceinline__ unsigned f2bf(float f) { return pk2(f, 0.f) & 0xffffu; }
template <int CTRL, int ROW_MASK> __device__ __forceinline__ float dppf(float v) {
    return __builtin_bit_cast(float, __builtin_amdgcn_update_dpp(0, __builtin_bit_cast(int, v), CTRL, ROW_MASK, 0xF, false)); }
__device__ __forceinline__ float wave_sum(float v) {
    v += dppf<0xB1, 0xF>(v);
    v += dppf<0x4E, 0xF>(v);
    v += dppf<0x141, 0xF>(v);
    v += dppf<0x140, 0xF>(v);
    v += dppf<0x142, 0xA>(v);
    v += dppf<0x143, 0xC>(v);
    return __builtin_bit_cast(float, __builtin_amdgcn_readlane(__builtin_bit_cast(int, v), 63));
}
__device__ __forceinline__ void half_swap(float& a, float& b) { asm volatile("v_nop\n\tv_nop\n\tv_permlane32_swap_b32 %0, %1\n\tv_nop\n\tv_nop" : "+v"(a), "+v"(b)); }
__device__ __forceinline__ float xhalf_max(float v) { float a = v, b = v; half_swap(a, b); return fmaxf(a, b); }
__device__ __forceinline__ float xhalf_sum(float v) { float a = v, b = v; half_swap(a, b); return a + b; }
__device__ __forceinline__ float fexp(float x) { return __builtin_amdgcn_exp2f(x * 1.4426950408889634f); }
__device__ __forceinline__ float flog1p_pos(float e) { return __builtin_amdgcn_logf(1.0f + e) * 0.6931471805599453f; }
__device__ __forceinline__ float fsigmoid(float x) { return __builtin_amdgcn_rcpf(1.0f + fexp(-x)); }
__device__ __forceinline__ float fsilu(float x) { return x * __builtin_amdgcn_rcpf(1.0f + fexp(-x)); }
__device__ __forceinline__ float fsoftplus(float x) { return fmaxf(x, 0.f) + flog1p_pos(fexp(-fabsf(x))); }
__device__ __forceinline__ float ftanh(float x) { const float e = fexp(-2.0f * fabsf(x)); const float t = (1.0f - e) * __builtin_amdgcn_rcpf(1.0f + e); return x < 0.f ? -t : t; }

namespace pg8 {
#define PG8_LAS __attribute__((address_space(3)))
typedef unsigned short bf16_t;
typedef short bf16x8 __attribute__((ext_vector_type(8)));
typedef float f32x4 __attribute__((ext_vector_type(4)));
typedef unsigned u32x4 __attribute__((ext_vector_type(4)));
constexpr int BM = 256, BK = 64, HALF = 128, HTB = HALF * BK * 2  , STAGE_BYTES = 8 * HTB, NXCD = 8, WGM = 8;

__host__ __device__ __forceinline__ int lds_byte(int r, int c) { const int st = (r >> 4) * 2 + (c >> 5), rr = r & 15, cc = c & 31, ob = rr * 64 + cc * 2; return st * 1024 + (ob ^ (((ob >> 9) & 1) << 5)); }
__host__ __device__ __forceinline__ void stage_rc(int b, int& R, int& C) { const int st = b / 1024, sb = b % 1024, swz = sb ^ (((sb >> 9) & 1) << 5); R = (st >> 1) * 16 + swz / 64; C = (st & 1) * 32 + (swz % 64) / 2; }
__host__ __device__ __forceinline__ int perm32(int rho) { const int n = rho >> 4, i = rho & 15; return 8 * (i >> 2) + 4 * n + (i & 3); }

struct Unit { int pm, pn, kq; };
struct Gemm { const bf16_t* A; const bf16_t* Bt; int M, N, K, lda, ldb; int kqb; int jt, jb; };

struct StaticOrder {
    int nM, nN, nwg, G, c;
    __host__ __device__ void init(int M, int N, int G_, int c_) { nM = M / BM; nN = N / BM; nwg = nM * nN; G = G_; c = c_; }
    __host__ __device__ bool next(int i, Unit& u) const {
        const long L = (long)i * G + c; if (L >= nwg) return false;
        int wgid = (int)L; { const int q = nwg / NXCD, r = nwg % NXCD, xcd = wgid % NXCD, off = wgid / NXCD; wgid = (xcd < r ? xcd * (q + 1) : r * (q + 1) + (xcd - r) * q) + off; }
        const int nig = WGM * nN, gid = wgid / nig, fm = gid * WGM, gsz = (nM - fm) < WGM ? (nM - fm) : WGM;
        u.pm = fm + ((wgid % nig) % gsz); u.pn = (wgid % nig) / gsz; u.kq = 0; return true;
    }
    __device__ __forceinline__ void a_ready(const Unit&) const {}
    __device__ __forceinline__ void done(const Unit&) const {}
};

struct SplitKOrder {
    int nM, nN, nq, G, c;
    __host__ __device__ void init(int M, int N, int NQ, int G_, int c_) { nM = M / BM; nN = N / BM; nq = NQ; G = G_; c = c_; }
    __host__ __device__ bool next(int i, Unit& u) const { const long L = (long)i * G + c; if (L >= (long)nM * nN * nq) return false; const int t = (int)L / nq; u.kq = (int)L % nq; u.pm = t % nM; u.pn = t / nM; return true; }
    __device__ __forceinline__ void a_ready(const Unit&) const {}
    __device__ __forceinline__ void done(const Unit&) const {}
};
typedef __bf16 bf2_t_ __attribute__((ext_vector_type(2)));
typedef float f2_t_ __attribute__((ext_vector_type(2)));
__device__ __forceinline__ unsigned cvt_pk_bf16(float lo, float hi) { const f2_t_ v = {lo, hi}; return __builtin_bit_cast(unsigned, __builtin_convertvector(v, bf2_t_)); }

#define EPI_ROWS_BEGIN \
    _Pragma("unroll") for (int ai = 0; ai < 2; ++ai) _Pragma("unroll") for (int m = 0; m < 4; ++m) { const int row = u.pm * BM + ai * HALF + wr * 64 + m * 16 + fr;
#define EPI_ROWS_END }

template <int ACT, size_t O0, size_t O1, size_t O2, int T1, int T2, int L0, int L1, int L2> struct EpiBf16Seg {
    static constexpr bool PERM = true, AFTER_DRAIN = false;
    unsigned char* ws;
    __device__ __forceinline__ void operator()(const f32x4 (&acc)[2][2][4][2], const Unit& u, int wr, int wc, int fr, int fq) const {
        const size_t off = u.pn >= T2 ? O2 : (u.pn >= T1 ? O1 : O0); const int l = u.pn >= T2 ? L2 : (u.pn >= T1 ? L1 : L0), tb = u.pn >= T2 ? T2 : (u.pn >= T1 ? T1 : 0);
        bf16_t* base = (bf16_t*)(ws + off);
        const int col0 = (u.pn - tb) * BM + wc * 32 + 8 * fq;
        EPI_ROWS_BEGIN
            bf16_t* rowp = base + (size_t)row * l + col0;
#pragma unroll
            for (int bj = 0; bj < 2; ++bj) { f32x4 v0 = acc[ai][bj][m][0], v1 = acc[ai][bj][m][1];
                if (ACT == 1) {
#pragma unroll
                    for (int j = 0; j < 4; ++j) { v0[j] = fsigmoid(v0[j]); v1[j] = fsigmoid(v1[j]); } }
                u32x4 w; w.x = cvt_pk_bf16(v0[0], v0[1]); w.y = cvt_pk_bf16(v0[2], v0[3]); w.z = cvt_pk_bf16(v1[0], v1[1]); w.w = cvt_pk_bf16(v1[2], v1[3]);
                *(u32x4*)(rowp + bj * HALF) = w; }
        EPI_ROWS_END
    }
};
struct EpiSwiglu {
    static constexpr bool PERM = true, AFTER_DRAIN = false;
    bf16_t* H; int ldh;
    __device__ __forceinline__ void operator()(const f32x4 (&acc)[2][2][4][2], const Unit& u, int wr, int wc, int fr, int fq) const {
        const int col0 = u.pn * HALF + wc * 32 + 8 * fq;
        EPI_ROWS_BEGIN
            f32x4 g0 = acc[ai][0][m][0], g1 = acc[ai][0][m][1]; const f32x4 u0 = acc[ai][1][m][0], u1 = acc[ai][1][m][1];
#pragma unroll
            for (int j = 0; j < 4; ++j) { g0[j] = fsilu(g0[j]) * u0[j]; g1[j] = fsilu(g1[j]) * u1[j]; }
            u32x4 w; w.x = cvt_pk_bf16(g0[0], g0[1]); w.y = cvt_pk_bf16(g0[2], g0[3]); w.z = cvt_pk_bf16(g1[0], g1[1]); w.w = cvt_pk_bf16(g1[2], g1[3]);
            *(u32x4*)(H + (size_t)row * ldh + col0) = w;
        EPI_ROWS_END
    }
};
struct EpiPartial {
    static constexpr bool PERM = true, AFTER_DRAIN = false;
    bf16_t* P; int ldp; size_t qstride;
    __device__ __forceinline__ void operator()(const f32x4 (&acc)[2][2][4][2], const Unit& u, int wr, int wc, int fr, int fq) const {
        const int col0 = u.pn * BM + wc * 32 + 8 * fq; bf16_t* base = P + (size_t)u.kq * qstride;
        EPI_ROWS_BEGIN
            bf16_t* rowp = base + (size_t)row * ldp + col0;
#pragma unroll
            for (int bj = 0; bj < 2; ++bj) { const f32x4 v0 = acc[ai][bj][m][0], v1 = acc[ai][bj][m][1];
                u32x4 w; w.x = cvt_pk_bf16(v0[0], v0[1]); w.y = cvt_pk_bf16(v0[2], v0[3]); w.z = cvt_pk_bf16(v1[0], v1[1]); w.w = cvt_pk_bf16(v1[2], v1[3]);
                *(u32x4*)(rowp + bj * HALF) = w; }
        EPI_ROWS_END
    }
};
constexpr float RES_ALPHA = 1.41421356237f;
template <int COEF2> struct EpiResid {
    static constexpr bool PERM = true, AFTER_DRAIN = false;
    float* xl; const float* mods; const float* sl; const float* st; const float* lg; const float* lb; int kmod;
    __device__ __forceinline__ void operator()(const f32x4 (&acc)[2][2][4][2], const Unit& u, int wr, int wc, int fr, int fq) const {
        const float* mp = mods + (size_t)(u.pm >> 3) * (9 * 2048) + kmod * 2048;
        const int col0 = u.pn * BM + wc * 32 + 8 * fq;
        const bool ln = st != nullptr; constexpr float al = RES_ALPHA, coef = 0.5f * COEF2;
        const float* stp = ln ? st : mods;
        const int row0 = u.pm * BM + wr * 64 + fr;
        const size_t rbase = (size_t)row0 * 2048 + col0;
#pragma unroll
        for (int bj = 0; bj < 2; ++bj) {
            f32x4 mv[2], ag[2], ab[2];
#pragma unroll
            for (int n = 0; n < 2; ++n) { mv[n] = *(const f32x4*)(mp + col0 + bj * HALF + 4 * n) * coef;
                const f32x4 g4 = *(const f32x4*)(lg + col0 + bj * HALF + 4 * n), b4 = *(const f32x4*)(lb + col0 + bj * HALF + 4 * n);
                const f32x4 g4s = ln ? g4 : (f32x4){1.f, 1.f, 1.f, 1.f}, b4s = ln ? b4 : (f32x4){0.f, 0.f, 0.f, 0.f};
                ag[n] = g4s * al; ab[n] = b4s * al; }
            f32x4 xa[3][2]; f2_t_ ms[3];
#define RES_LOADG(slot, g_) do { const int ro_ = ((g_) >> 2) * HALF + ((g_) & 3) * 16; \
                _Pragma("unroll") for (int n = 0; n < 2; ++n) xa[slot][n] = *(const f32x4*)(sl + rbase + (size_t)ro_ * 2048 + bj * HALF + 4 * n); \
                ms[slot] = *(const f2_t_*)(stp + 2 * (row0 + ro_)); } while (0)
            RES_LOADG(0, 0); RES_LOADG(1, 1);
#pragma unroll
            for (int gi = 0; gi < 8; ++gi) {
                const int ai = gi >> 2, m = gi & 3;
                if (gi + 2 < 8) RES_LOADG((gi + 2) % 3, gi + 2);
                asm volatile("" ::: "memory");
                float* rowp = xl + rbase + (size_t)(ai * HALF + m * 16) * 2048 + bj * HALF;
                const float mean = ln ? ms[gi % 3][0] : 0.f, rstd = ln ? ms[gi % 3][1] : 1.f;
#pragma unroll
                for (int n = 0; n < 2; ++n) { const f32x4 t = ag[n] * rstd;
                    *(f32x4*)(rowp + 4 * n) = (xa[gi % 3][n] - mean) * t + (ab[n] + mv[n] * acc[ai][bj][m][n]); }
                asm volatile("" ::: "memory");
            }
#undef RES_LOADG
        }
    }
};
template <int MODE> struct EpiBranch {
    static constexpr bool PERM = true, AFTER_DRAIN = false;
    const bf16_t* GT; int ldg, goff; float* T; bf16_t* O;
    __device__ __forceinline__ void operator()(const f32x4 (&acc)[2][2][4][2], const Unit& u, int wr, int wc, int fr, int fq) const {
        const int col0 = u.pn * BM + wc * 32 + 8 * fq;
        const size_t r0 = (size_t)(u.pm * BM + wr * 64 + fr);
        u32x4 gw[2][2]; f32x4 tv[2][2][2];
#pragma unroll
        for (int bj = 0; bj < 2; ++bj) { gw[0][bj] = *(const u32x4*)(GT + r0 * ldg + goff + col0 + bj * HALF);
            if (MODE >= 1) { const float* tp = T + r0 * 2048 + col0 + bj * HALF; tv[0][bj][0] = *(const f32x4*)tp; tv[0][bj][1] = *(const f32x4*)(tp + 4); } }
#pragma unroll
        for (int gi = 0; gi < 8; ++gi) {
            const int ai = gi >> 2, m = gi & 3; const size_t row = r0 + ai * HALF + m * 16;
            if (gi < 7) { const size_t row2 = r0 + ((gi + 1) >> 2) * HALF + ((gi + 1) & 3) * 16;
#pragma unroll
                for (int bj = 0; bj < 2; ++bj) { gw[(gi + 1) & 1][bj] = *(const u32x4*)(GT + row2 * ldg + goff + col0 + bj * HALF);
                    if (MODE >= 1) { const float* tp = T + row2 * 2048 + col0 + bj * HALF; tv[(gi + 1) & 1][bj][0] = *(const f32x4*)tp; tv[(gi + 1) & 1][bj][1] = *(const f32x4*)(tp + 4); } } }
            asm volatile("" ::: "memory");
#pragma unroll
            for (int bj = 0; bj < 2; ++bj) {
                const u32x4 g4 = gw[gi & 1][bj];
                const f32x4 g0 = (f32x4){bflo(g4.x), bfhi(g4.x), bflo(g4.y), bfhi(g4.y)}, g1 = (f32x4){bflo(g4.z), bfhi(g4.z), bflo(g4.w), bfhi(g4.w)};
                f32x4 v0 = g0 * acc[ai][bj][m][0], v1 = g1 * acc[ai][bj][m][1];
                float* tp = T + row * 2048 + col0 + bj * HALF;
                if (MODE >= 1) { v0 += tv[gi & 1][bj][0]; v1 += tv[gi & 1][bj][1]; }
                if (MODE <= 1) { *(f32x4*)tp = v0; *(f32x4*)(tp + 4) = v1; }
                else { u32x4 w; w.x = cvt_pk_bf16(v0[0], v0[1]); w.y = cvt_pk_bf16(v0[2], v0[3]); w.z = cvt_pk_bf16(v1[0], v1[1]); w.w = cvt_pk_bf16(v1[2], v1[3]);
                    *(u32x4*)(O + row * 2048 + col0 + bj * HALF) = w; }
            }
            asm volatile("" ::: "memory");
        }
    }
};
struct EpiBranchFused {
    static constexpr bool PERM = true, AFTER_DRAIN = false, MID = true;
    static constexpr int H1 = 16, H2 = 32;
    const bf16_t* GT; int ldg; bf16_t* O;
    static __device__ __forceinline__ void unpack(const u32x4 g4, f32x4& g0, f32x4& g1) { g0 = (f32x4){bflo(g4.x), bfhi(g4.x), bflo(g4.y), bfhi(g4.y)}; g1 = (f32x4){bflo(g4.z), bfhi(g4.z), bflo(g4.w), bfhi(g4.w)}; }
    __device__ __forceinline__ void mid(f32x4 (&acc)[2][2][4][2], const Unit& u, int wr, int wc, int fr, int fq, bool second) const {
        const int col0 = u.pn * BM + wc * 32 + 8 * fq;
        const size_t r0 = (size_t)(u.pm * BM + wr * 64 + fr);
        const int on = second ? 2048 : 0, od = second ? 4096 : 2048;
        const float nfloor = second ? 1e-20f : 0.f;
        u32x4 gn[2][2], gd[2][2];
#pragma unroll
        for (int bj = 0; bj < 2; ++bj) { gn[0][bj] = *(const u32x4*)(GT + r0 * ldg + on + col0 + bj * HALF); gd[0][bj] = *(const u32x4*)(GT + r0 * ldg + od + col0 + bj * HALF); }
#pragma unroll
        for (int gi = 0; gi < 8; ++gi) {
            const int ai = gi >> 2, m = gi & 3;
            if (gi < 7) { const size_t row2 = r0 + ((gi + 1) >> 2) * HALF + ((gi + 1) & 3) * 16;
#pragma unroll
                for (int bj = 0; bj < 2; ++bj) { gn[(gi + 1) & 1][bj] = *(const u32x4*)(GT + row2 * ldg + on + col0 + bj * HALF); gd[(gi + 1) & 1][bj] = *(const u32x4*)(GT + row2 * ldg + od + col0 + bj * HALF); } }
            asm volatile("" ::: "memory");
#pragma unroll
            for (int bj = 0; bj < 2; ++bj) {
                f32x4 n0, n1, d0, d1; unpack(gn[gi & 1][bj], n0, n1); unpack(gd[gi & 1][bj], d0, d1);
#pragma unroll
                for (int j = 0; j < 4; ++j) {
                    acc[ai][bj][m][0][j] *= fmaxf(n0[j], nfloor) * __builtin_amdgcn_rcpf(fmaxf(d0[j], 1e-20f));
                    acc[ai][bj][m][1][j] *= fmaxf(n1[j], nfloor) * __builtin_amdgcn_rcpf(fmaxf(d1[j], 1e-20f)); }
            }
            asm volatile("" ::: "memory");
        }
    }
    __device__ __forceinline__ void operator()(const f32x4 (&acc)[2][2][4][2], const Unit& u, int wr, int wc, int fr, int fq) const {
        const int col0 = u.pn * BM + wc * 32 + 8 * fq;
        const size_t r0 = (size_t)(u.pm * BM + wr * 64 + fr);
        u32x4 gw[2][2];
#pragma unroll
        for (int bj = 0; bj < 2; ++bj) gw[0][bj] = *(const u32x4*)(GT + r0 * ldg + 4096 + col0 + bj * HALF);
#pragma unroll
        for (int gi = 0; gi < 8; ++gi) {
            const int ai = gi >> 2, m = gi & 3; const size_t row = r0 + ai * HALF + m * 16;
            if (gi < 7) { const size_t row2 = r0 + ((gi + 1) >> 2) * HALF + ((gi + 1) & 3) * 16;
#pragma unroll
                for (int bj = 0; bj < 2; ++bj) gw[(gi + 1) & 1][bj] = *(const u32x4*)(GT + row2 * ldg + 4096 + col0 + bj * HALF); }
            asm volatile("" ::: "memory");
#pragma unroll
            for (int bj = 0; bj < 2; ++bj) {
                f32x4 g0, g1; unpack(gw[gi & 1][bj], g0, g1);
                f32x4 v0, v1;
#pragma unroll
                for (int j = 0; j < 4; ++j) { v0[j] = acc[ai][bj][m][0][j] * fmaxf(g0[j], 1e-20f); v1[j] = acc[ai][bj][m][1][j] * fmaxf(g1[j], 1e-20f); }
                u32x4 w; w.x = cvt_pk_bf16(v0[0], v0[1]); w.y = cvt_pk_bf16(v0[2], v0[3]); w.z = cvt_pk_bf16(v1[0], v1[1]); w.w = cvt_pk_bf16(v1[2], v1[3]);
                *(u32x4*)(O + row * 2048 + col0 + bj * HALF) = w;
            }
            asm volatile("" ::: "memory");
        }
    }
};
typedef _Float16 h2_t_ __attribute__((ext_vector_type(2)));
__device__ __forceinline__ unsigned cvt_pk_f16(float lo, float hi) { const f2_t_ v = {lo, hi}; return __builtin_bit_cast(unsigned, __builtin_convertvector(v, h2_t_)); }
template <int MODE> struct EpiLora {
    static constexpr bool PERM = true, AFTER_DRAIN = false;
    float* WD; bf16_t* OB; const float* bias; size_t dstride;
    __device__ __forceinline__ void operator()(const f32x4 (&acc)[2][2][4][2], const Unit& u, int wr, int wc, int fr, int fq) const {
        const int colg = u.pn * BM + wc * 32 + 8 * fq;
        f32x4 bv[2][2];
#pragma unroll
        for (int bj = 0; bj < 2; ++bj) { if (MODE != 2) { bv[bj][0] = *(const f32x4*)(bias + colg + bj * HALF); bv[bj][1] = *(const f32x4*)(bias + colg + bj * HALF + 4); } else { bv[bj][0] = (f32x4){0.f, 0.f, 0.f, 0.f}; bv[bj][1] = bv[bj][0]; } }
        EPI_ROWS_BEGIN
#pragma unroll
            for (int bj = 0; bj < 2; ++bj) { const int cg = colg + bj * HALF; const int dir = (MODE == 2) ? 0 : (cg >> 10); const int c = (MODE == 2) ? cg : (cg & 1023);
                f32x4 v0 = acc[ai][bj][m][0], v1 = acc[ai][bj][m][1];
                if (MODE != 2) { v0 += bv[bj][0]; v1 += bv[bj][1]; }
                if (MODE == 0) {
#pragma unroll
                    for (int j = 0; j < 4; ++j) { v0[j] = -fexp(-fsoftplus(-v0[j]) - 0.5f); v1[j] = -fexp(-fsoftplus(-v1[j]) - 0.5f); }
                    u32x4 w; w.x = cvt_pk_f16(v0[0], v0[1]); w.y = cvt_pk_f16(v0[2], v0[3]); w.z = cvt_pk_f16(v1[0], v1[1]); w.w = cvt_pk_f16(v1[2], v1[3]);
                    *(u32x4*)((unsigned short*)WD + (size_t)dir * dstride + (size_t)row * 1024 + c) = w;
                } else {
                    if (MODE == 1) {
#pragma unroll
                        for (int j = 0; j < 4; ++j) { v0[j] = fsigmoid(v0[j]); v1[j] = fsigmoid(v1[j]); } }
                    u32x4 w; w.x = cvt_pk_bf16(v0[0], v0[1]); w.y = cvt_pk_bf16(v0[2], v0[3]); w.z = cvt_pk_bf16(v1[0], v1[1]); w.w = cvt_pk_bf16(v1[2], v1[3]);
                    *(u32x4*)(OB + (size_t)dir * dstride + (size_t)row * 1024 + c) = w;
                }
            }
            asm volatile("" ::: "memory");
        EPI_ROWS_END
    }
};

template <class E, class = void> struct mid_hook { static constexpr bool value = false; };
template <class E> struct mid_hook<E, decltype((void)E::MID)> { static constexpr bool value = E::MID; };
template <class Epi, class Sched, bool ALIGN_EPI = false, bool SP2 = false>
__device__ __forceinline__ void gemm_phase(PG8_LAS unsigned char* lds, const Gemm g, const Sched& S, const Epi& E, int tid_in) {
    int tid_ = tid_in; asm volatile("" : "+v"(tid_));
    const int tid = tid_, wid = __builtin_amdgcn_readfirstlane(tid >> 6), lane = tid & 63, wr = wid >> 2, wc = wid & 3, fr = lane & 15, fq = lane >> 4;
    int K_ = g.K, lda_ = g.lda, ldb_ = g.ldb; asm volatile("" : "+s"(K_), "+s"(lda_), "+s"(ldb_));
    const int K = K_, nt = K / BK, lda = lda_, ldb = ldb_;
    int jt_ = g.jt, jb_ = g.jb; asm volatile("" : "+s"(jt_), "+s"(jb_));
    const int jt = jt_; const size_t jb = (size_t)jb_;
    unsigned voffA[2], voffB[2];
#pragma unroll
    for (int i = 0; i < 2; ++i) { int R, C; stage_rc(tid * 16 + i * 8192, R, C); const int Rb = Epi::PERM ? ((R & ~31) + perm32(R & 31)) : R;
        voffA[i] = (unsigned)(R * lda + C) * 2u; voffB[i] = (unsigned)(Rb * ldb + C) * 2u; }
    const size_t kstep = (size_t)(BK * 2);
    const size_t hsA = (size_t)HALF * lda * 2, hsB = (size_t)HALF * ldb * 2;
    const size_t tsA = 2 * hsA, tsB = 2 * hsB;
    const unsigned ldsw = (unsigned)wid * 1024u;
    const int aoff = lds_byte(wr * 64 + fr, fq * 8), boff = lds_byte(wc * 32 + fr, fq * 8);
#define PG8_SA(b, h) (((b) * 2 + (h)) * HTB)
#define PG8_SB(b, h) ((4 + (b) * 2 + (h)) * HTB)
#define PG8_STAGE(bufoff, gbase, voff) do { _Pragma("unroll") for (int _i = 0; _i < 2; ++_i) \
        __builtin_amdgcn_global_load_lds((const unsigned*)((const char*)(gbase) + (voff)[_i]), (PG8_LAS unsigned*)(lds + (bufoff) + ldsw + _i * 8192), 16, 0, 0); } while (0)
#define PG8_LDA(dst, b, h) do { _Pragma("unroll") for (int m = 0; m < 4; ++m) _Pragma("unroll") for (int k = 0; k < 2; ++k) dst[m][k] = *(const PG8_LAS bf16x8*)(lds + PG8_SA(b, h) + aoff + m * 2048 + k * 1024); } while (0)
#define PG8_LDB(dst, b, h) do { _Pragma("unroll") for (int n = 0; n < 2; ++n) _Pragma("unroll") for (int k = 0; k < 2; ++k) dst[n][k] = *(const PG8_LAS bf16x8*)(lds + PG8_SB(b, h) + boff + n * 2048 + k * 1024); } while (0)
#define PG8_MMA(ai, bj, At, Bt) do { __builtin_amdgcn_s_setprio(1); _Pragma("unroll") for (int m = 0; m < 4; ++m) _Pragma("unroll") for (int n = 0; n < 2; ++n) _Pragma("unroll") for (int k = 0; k < 2; ++k) \
        acc[ai][bj][m][n] = __builtin_amdgcn_mfma_f32_16x16x32_bf16(Bt[n][k], At[m][k], acc[ai][bj][m][n], 0, 0, 0); __builtin_amdgcn_s_setprio(0); } while (0)
#define PG8_WAIT_V(n) asm volatile("s_waitcnt vmcnt(" #n ")" ::: "memory")
#define PG8_WAIT_L(n) asm volatile("s_waitcnt lgkmcnt(" #n ")" ::: "memory")
#define PG8_BAR __builtin_amdgcn_s_barrier()
#define PG8_SCHED __builtin_amdgcn_sched_barrier(0)
    Unit cur, nxt; int ui = 0;
    if (!S.next(0, cur)) return;
    f32x4 acc[2][2][4][2];
#pragma unroll
    for (int a = 0; a < 2; ++a)
#pragma unroll
        for (int b = 0; b < 2; ++b)
#pragma unroll
            for (int m = 0; m < 4; ++m)
#pragma unroll
                for (int n = 0; n < 2; ++n) acc[a][b][m][n] = (f32x4){0.f, 0.f, 0.f, 0.f};
    bf16x8 At[4][2], B0[2][2], B1[2][2];
    const char* cA = (const char*)g.A + (size_t)cur.pm * tsA + (size_t)cur.kq * g.kqb; const char* cB = (const char*)g.Bt + (size_t)cur.pn * tsB + (size_t)cur.kq * g.kqb;
    S.a_ready(cur);
    if constexpr (SP2) {
        PG8_STAGE(PG8_SB(0, 0), cB, voffB); PG8_STAGE(PG8_SB(0, 1), cB + hsB, voffB); PG8_STAGE(PG8_SA(0, 0), cA, voffA); PG8_STAGE(PG8_SA(0, 1), cA + hsA, voffA);
        if (wr == 1) PG8_BAR;
        PG8_WAIT_V(2); PG8_BAR;
        PG8_STAGE(PG8_SB(1, 0), cB + kstep, voffB); PG8_STAGE(PG8_SA(1, 0), cA + kstep, voffA); PG8_STAGE(PG8_SB(1, 1), cB + hsB + kstep, voffB);
        PG8_WAIT_V(6); PG8_BAR;
    } else {
        PG8_STAGE(PG8_SB(0, 0), cB, voffB); PG8_STAGE(PG8_SA(0, 0), cA, voffA); PG8_STAGE(PG8_SB(0, 1), cB + hsB, voffB); PG8_STAGE(PG8_SA(0, 1), cA + hsA, voffA);
        if (wr == 1) PG8_BAR;
        PG8_WAIT_V(4); PG8_BAR;
        PG8_STAGE(PG8_SB(1, 0), cB + kstep, voffB); PG8_STAGE(PG8_SA(1, 0), cA + kstep, voffA); PG8_STAGE(PG8_SB(1, 1), cB + hsB + kstep, voffB);
        PG8_WAIT_V(6); PG8_BAR;
    }
    for (;;) {
        const bool has_next = S.next(ui + 1, nxt);
        const char* nA = has_next ? (const char*)g.A + (size_t)nxt.pm * tsA + (size_t)nxt.kq * g.kqb : cA; const char* nB = has_next ? (const char*)g.Bt + (size_t)nxt.pn * tsB + (size_t)nxt.kq * g.kqb : cB;
        for (int t = 0; t < nt; t += 2) {
            const bool last = (t == nt - 2);
            if constexpr (mid_hook<Epi>::value) { if (t == Epi::H1 || t == Epi::H2) E.mid(acc, cur, wr, wc, fr, fq, t == Epi::H2); }
            const char* a1 = cA + (size_t)(t + 1) * kstep + (t >= jt ? jb : 0);
            const char* a2 = last ? nA : cA + (size_t)(t + 2) * kstep + (t + 2 >= jt ? jb : 0); const char* b2 = last ? nB : cB + (size_t)(t + 2) * kstep;
            const char* a3 = a2 + kstep; const char* b3 = b2 + kstep;
            if (last && has_next) S.a_ready(nxt);
            if constexpr (SP2) {
            PG8_LDB(B0, 0, 0); PG8_LDB(B1, 0, 1); PG8_SCHED; PG8_LDA(At, 0, 0); PG8_STAGE(PG8_SA(1, 1), a1 + hsA, voffA);
            PG8_WAIT_V(8); PG8_WAIT_L(0); PG8_BAR; PG8_MMA(0, 0, At, B0); PG8_MMA(0, 1, At, B1); PG8_BAR; PG8_SCHED;
            PG8_LDA(At, 0, 1); PG8_STAGE(PG8_SB(0, 0), b2, voffB); PG8_STAGE(PG8_SB(0, 1), b2 + hsB, voffB); PG8_STAGE(PG8_SA(0, 0), a2, voffA);
            PG8_WAIT_V(8); PG8_WAIT_L(0); PG8_BAR; PG8_MMA(1, 0, At, B0); PG8_MMA(1, 1, At, B1); PG8_BAR; PG8_SCHED;
            PG8_LDB(B0, 1, 0); PG8_LDB(B1, 1, 1); PG8_SCHED; PG8_LDA(At, 1, 0); PG8_STAGE(PG8_SA(0, 1), a2 + hsA, voffA);
            PG8_WAIT_V(8); PG8_WAIT_L(0); PG8_BAR; PG8_MMA(0, 0, At, B0); PG8_MMA(0, 1, At, B1); PG8_BAR; PG8_SCHED;
            PG8_LDA(At, 1, 1); PG8_STAGE(PG8_SB(1, 0), b3, voffB); PG8_STAGE(PG8_SB(1, 1), b3 + hsB, voffB); PG8_STAGE(PG8_SA(1, 0), a3, voffA);
            PG8_WAIT_V(8); PG8_WAIT_L(0); PG8_BAR; PG8_MMA(1, 0, At, B0); PG8_MMA(1, 1, At, B1); PG8_BAR; PG8_SCHED;
            } else {
            PG8_LDB(B0, 0, 0); PG8_SCHED; PG8_LDA(At, 0, 0); PG8_STAGE(PG8_SA(1, 1), a1 + hsA, voffA);
            PG8_WAIT_L(8); PG8_BAR; PG8_WAIT_L(0); PG8_MMA(0, 0, At, B0); PG8_BAR; PG8_SCHED;
            PG8_LDB(B1, 0, 1); PG8_STAGE(PG8_SB(0, 0), b2, voffB);
            PG8_BAR; PG8_WAIT_L(0); PG8_MMA(0, 1, At, B1); PG8_BAR;
            PG8_LDA(At, 0, 1); PG8_STAGE(PG8_SA(0, 0), a2, voffA);
            PG8_BAR; PG8_WAIT_L(0); PG8_MMA(1, 0, At, B0); PG8_BAR; PG8_SCHED;
            PG8_STAGE(PG8_SB(0, 1), b2 + hsB, voffB);
            PG8_WAIT_V(6); PG8_BAR; PG8_MMA(1, 1, At, B1); PG8_BAR;
            PG8_LDB(B0, 1, 0); PG8_SCHED; PG8_LDA(At, 1, 0); PG8_STAGE(PG8_SA(0, 1), a2 + hsA, voffA);
            PG8_WAIT_L(8); PG8_BAR; PG8_WAIT_L(0); PG8_MMA(0, 0, At, B0); PG8_BAR; PG8_SCHED;
            PG8_LDB(B1, 1, 1); PG8_STAGE(PG8_SB(1, 0), b3, voffB);
            PG8_BAR; PG8_WAIT_L(0); PG8_MMA(0, 1, At, B1); PG8_BAR;
            PG8_LDA(At, 1, 1); PG8_STAGE(PG8_SA(1, 0), a3, voffA);
            PG8_BAR; PG8_WAIT_L(0); PG8_MMA(1, 0, At, B0); PG8_BAR; PG8_SCHED;
            PG8_STAGE(PG8_SB(1, 1), b3 + hsB, voffB);
            PG8_WAIT_V(6); PG8_BAR; PG8_MMA(1, 1, At, B1); PG8_BAR;
            }
        }
        if constexpr (ALIGN_EPI) { if (wr == 0) PG8_BAR; }
        if constexpr (!Epi::AFTER_DRAIN) { E(acc, cur, wr, wc, fr, fq); S.done(cur); }
        if (!has_next) break;
#pragma unroll
        for (int a = 0; a < 2; ++a)
#pragma unroll
            for (int b = 0; b < 2; ++b)
#pragma unroll
                for (int m = 0; m < 4; ++m)
#pragma unroll
                    for (int n = 0; n < 2; ++n) acc[a][b][m][n] = (f32x4){0.f, 0.f, 0.f, 0.f};
        cur = nxt; cA = nA; cB = nB; ++ui;
        if constexpr (ALIGN_EPI) { if (wr == 1) PG8_BAR; }
    }
    PG8_WAIT_V(0);
    if constexpr (!ALIGN_EPI) { if (wr == 0) PG8_BAR; }
    PG8_BAR;
    if constexpr (Epi::AFTER_DRAIN) { E.fused(acc, cur, wr, wc, fr, fq, lds, wid, lane); S.done(cur); }
#undef PG8_SA
#undef PG8_SB
#undef PG8_STAGE
#undef PG8_LDA
#undef PG8_LDB
#undef PG8_MMA
#undef PG8_WAIT_V
#undef PG8_WAIT_L
#undef PG8_BAR
#undef PG8_SCHED
}
}

#undef EPI_ROWS_BEGIN
#undef EPI_ROWS_END

constexpr int D = 2048, NB = 8, SEQ = 2048, CL = 256, ML = NB * SEQ, MC = NB * CL, MT = ML + MC;
constexpr int FF = 5632, NMOD = 9, DEPTH = 2;
constexpr int NIN_SRC = 17568;
constexpr int ZA_LD = 4608;
constexpr int OC_RW = 1536, OC_GL = 2560;
constexpr int ZA_W = 1536, ZR_W = 3840, ZG_W = 6144, GT_W = 6144, NMIX = ZA_W + ZR_W + ZG_W  , NIN = NMIX + GT_W  ;
constexpr int RW_COLS = 3712, LA_W = 768;
constexpr float LN_EPS = 1e-5f, ALPHA = 1.41421356237f;
static_assert(ALPHA == pg8::RES_ALPHA, "residual scale");
constexpr int NWAVES = 8, NTHR = 512;

constexpr size_t MiB = 1u << 20;
constexpr size_t WS_CTL = 0, CTL_ZERO_BYTES = 1 * MiB;
constexpr size_t WS_MODS = 1 * MiB;
constexpr size_t WS_STATS = 3 * MiB;
constexpr size_t WS_XC = 4 * MiB;
constexpr size_t WS_HB = 20 * MiB;
constexpr size_t WS_WM = 92 * MiB;
constexpr size_t WM_IN = 0, WM_BA = 69 * MiB, WM_BR = 73 * MiB, WM_BG = 77 * MiB, WM_OUT = 85 * MiB, WM_LW = 93 * MiB, WM_LA = 94 * MiB, WM_LG = 95 * MiB;
constexpr size_t WS_R = 188 * MiB;
constexpr size_t R_WGU = 0, R_WDN = 44 * MiB, R_H = 66 * MiB;
constexpr size_t R_ZA = 0;
constexpr size_t R_ZR = 162 * MiB;
constexpr size_t R_AA = 297 * MiB;
constexpr size_t R_Y = 369 * MiB;
constexpr size_t R_G = 513 * MiB;
constexpr size_t R_ZG = 549 * MiB;
constexpr size_t R_YG = 765 * MiB;
constexpr size_t R_QR = 909 * MiB;
constexpr size_t R_KR = 941 * MiB;
constexpr size_t R_LA = 949 * MiB;
constexpr size_t R_WDEC = 976 * MiB;
constexpr size_t R_GL = 1120 * MiB;
constexpr size_t R_GT = R_QR;
constexpr size_t R_MG = R_Y;
constexpr size_t R_PART = 600 * MiB;
constexpr size_t R_BS = 1192 * MiB;
constexpr size_t R_END = 1195 * MiB;
constexpr size_t WS_END = WS_R + R_END;
static_assert(R_GT + (size_t)MT * GT_W * 2 <= R_END, "GT overlay");
static_assert(WS_END <= (size_t)1408 * MiB, "workspace budget");
static_assert(R_H + (size_t)MT * FF * 2 <= R_END, "H fits");

#ifndef MK_EARLY_WB
#define MK_EARLY_WB 0
#endif
#define XB_TMO      128
#define XB_XCNT(j)  (256  + 64 * (j))
#define XB_XSUB(j)  (1280 + 64 * (j))
#define XB_XGEN(j)  (2304 + 64 * (j))
#define XB_TOP      3328
#define XB_TOPGEN   3392
#define XCD_BAR_WORDS 3456
#define XB_SPIN_CAP (1u << 18)
__device__ __forceinline__ unsigned xb_ld(unsigned* p)              { return __hip_atomic_load(p, __ATOMIC_RELAXED, __HIP_MEMORY_SCOPE_AGENT); }
__device__ __forceinline__ unsigned xb_add(unsigned* p, unsigned v) { return __hip_atomic_fetch_add(p, v, __ATOMIC_RELAXED, __HIP_MEMORY_SCOPE_AGENT); }
__device__ __forceinline__ unsigned xb_xcc_id() { return (unsigned)__builtin_amdgcn_s_getreg((3 << 11) | 20) & 0xFu; }
#define XB_SPIN(cond, bar) do { unsigned _sp = 0; while (cond) { __builtin_amdgcn_s_sleep(1); \
    if ((++_sp & 255u) == 0u) { if (xb_ld(&(bar)[XB_TMO])) break; if (_sp > XB_SPIN_CAP) { atomicAdd(&(bar)[XB_TMO], 1u); break; } } } } while (0)
struct XcdBarrier { unsigned* bar; unsigned x; volatile LAS unsigned* st; };
__device__ __forceinline__ XcdBarrier xcd_barrier_post(unsigned* bar, volatile LAS unsigned* st, int tid) {
    XcdBarrier b; b.bar = bar; b.x = xb_xcc_id(); b.st = st;
    if (tid == 0) (void)xb_add(&bar[XB_XCNT(b.x)], 1u);
    return b;
}
__device__ __forceinline__ void xcd_barrier_complete(unsigned* bar, unsigned x, unsigned& nloc, unsigned& nx) {
    const unsigned G = gridDim.x * gridDim.y * gridDim.z;
    unsigned sum, cnt, mine, sp = 0u;
    for (;;) {
        sum = 0u; cnt = 0u; mine = 0u;
#pragma unroll
        for (unsigned j = 0; j < 16; ++j) { const unsigned c = xb_ld(&bar[XB_XCNT(j)]); sum += c; cnt += (c > 0u) ? 1u : 0u; mine = (j == x) ? c : mine; }
        if (sum == G) break;
        __builtin_amdgcn_s_sleep(1);
        if ((++sp & 255u) == 0u) { if (xb_ld(&bar[XB_TMO])) break; if (sp > XB_SPIN_CAP) { atomicAdd(&bar[XB_TMO], 1u); break; } }
    }
    nloc = mine > 0u ? mine : 1u; nx = cnt > 0u ? cnt : 1u;
}
__device__ __forceinline__ void xcd_barrier(const XcdBarrier& b, int tid) {
    asm volatile("s_waitcnt vmcnt(0)" ::: "memory");
    __syncthreads();
    if (tid == 0) {
        unsigned* bar = b.bar; unsigned bx = b.x;
        asm volatile("" : "+s"(bar), "+s"(bx));
        __builtin_amdgcn_s_waitcnt(0);
        unsigned nloc = b.st[0], nx = b.st[1];
        if (nloc == 0u) { xcd_barrier_complete(bar, bx, nloc, nx); b.st[0] = nloc; b.st[1] = nx; }
#if MK_EARLY_WB
        __builtin_amdgcn_fence(__ATOMIC_RELEASE, "agent");
        asm volatile("s_waitcnt vmcnt(0)" ::: "memory");
#endif
        const unsigned old = xb_add(&bar[XB_XSUB(bx)], 1u);
        const unsigned gen = old / nloc;
        if (old + 1u == (gen + 1u) * nloc) {
            __builtin_amdgcn_fence(__ATOMIC_RELEASE, "agent");
            asm volatile("s_waitcnt vmcnt(0)" ::: "memory");
            const unsigned og = xb_add(&bar[XB_TOP], 1u);
            const unsigned tg = og / nx;
            if (og + 1u == (tg + 1u) * nx) xb_add(&bar[XB_TOPGEN], 1u);
            else XB_SPIN(xb_ld(&bar[XB_TOPGEN]) == tg, bar);
            __builtin_amdgcn_fence(__ATOMIC_ACQUIRE, "agent");
            xb_add(&bar[XB_XGEN(bx)], 1u);
            asm volatile("s_waitcnt vmcnt(0)" ::: "memory");
        } else {
            XB_SPIN(xb_ld(&bar[XB_XGEN(bx)]) == gen, bar);
            __builtin_amdgcn_fence(__ATOMIC_ACQUIRE, "agent");
            asm volatile("s_waitcnt vmcnt(0)" ::: "memory");
        }
    }
    __syncthreads();
}

constexpr int RING_BYTES = 143360;
constexpr int LDSCTL_OFF = RING_BYTES, MISC_OFF = LDSCTL_OFF + 320;
constexpr int LDS_BYTES = 147456;

struct Args { const float* in[30]; float* out; unsigned char* ws; int ph_lo, ph_hi; };
#define CAS __attribute__((address_space(4)))
typedef const CAS Args& ArgsRef;

struct Frame {
    LAS unsigned char* lds;
    int tid, lane, wave, G, bid;
    const float* const* in;
    GAS float* out; GAS unsigned char* ws;
};
#define AIN(i) ((const float*)(const GAS float*)A.in[i])
#define WSP(T, off) ((T*)(F.ws + (off)))
#define RGN(T, off) ((T*)(F.ws + WS_R + (off)))
__device__ __forceinline__ float* xrow(const Frame& F, int m) { return m < ML ? (float*)(F.out + (size_t)m * D) : WSP(float, WS_XC) + (size_t)(m - ML) * D; }

__device__ __forceinline__ void tr_item(const float* W, int N, bf16* WT, int ldk, int k0, int scol0, int drow0, LAS float* scr, int lane) {
    if (scol0 >= 0) {
#pragma unroll 8
        for (int i = 0; i < 32; ++i) { const int kk = 2 * i + (lane >> 5); scr[kk * 33 + (lane & 31)] = W[(size_t)(k0 + kk) * N + scol0 + (lane & 31)]; }
    } else {
#pragma unroll 8
        for (int i = 0; i < 32; ++i) { const int kk = 2 * i + (lane >> 5); scr[kk * 33 + (lane & 31)] = 0.f; }
    }
    asm volatile("s_waitcnt vmcnt(0) lgkmcnt(0)" ::: "memory");
    const int c = lane & 7;
#pragma unroll
    for (int j = 0; j < 4; ++j) { const int n = (lane >> 3) + 8 * j; const LAS float* s = scr + (8 * c) * 33 + n;
        v4u o; o.x = pk2(s[0 * 33], s[1 * 33]); o.y = pk2(s[2 * 33], s[3 * 33]); o.z = pk2(s[4 * 33], s[5 * 33]); o.w = pk2(s[6 * 33], s[7 * 33]);
        *(v4u*)(WT + (size_t)(drow0 + n) * ldk + k0 + 8 * c) = o; }
    asm volatile("s_waitcnt lgkmcnt(0)" ::: "memory");
}
struct MapIdent { __device__ __forceinline__ int operator()(int drow) const { return drow; } };
struct MapGU { __device__ __forceinline__ int operator()(int drow) const { const int pn = drow >> 8, bj = (drow >> 7) & 1, i = drow & 127; return bj * FF + pn * 128 + i; } };
struct MapWin { __device__ __forceinline__ int operator()(int drow) const {
    if (drow < 5248) return drow;
    if (drow < 5280) return 11392 + (drow - 5248);
    if (drow < 5376) return -1;
    if (drow < 11520) return 5248 + (drow - 5376);
    return 11424 + (drow - 11520);
} };
template <class MAP> __device__ __forceinline__ void conv_matrix(const Frame& F, const float* W, int K, int N, bf16* WT, int NT, const MAP& mp, int& item0, int gw, int NGW, int ldk = 0) {
    LAS float* scr = (LAS float*)(F.lds + F.wave * 16384);
    const int nblk = NT / 32, nitems = (K / 64) * nblk;
    int first = ((gw - item0) % NGW + NGW) % NGW;
    for (int it = first; it < nitems; it += NGW) { const int kb = it / nblk, nb = it % nblk; tr_item(W, N, WT, ldk ? ldk : K, kb * 64, mp(nb * 32), nb * 32, scr, F.lane); }
    item0 += nitems;
}

__device__ __forceinline__ int seq_row(int b, int dir, int p, int& idx, int& len) {
    if (p < CL) { idx = dir ? (CL - 1 - p) : p; len = CL; return ML + b * CL + idx; }
    const int q = p - CL; idx = dir ? (SEQ - 1 - q) : q; len = SEQ; return b * SEQ + idx;
}

__device__ __forceinline__ void phase_init(const Frame& F, ArgsRef A) {
    const float* c = AIN(1); const float* cctx = AIN(3); const float* ada_w = AIN(4); const float* ada_b = AIN(5);
    float* mods = WSP(float, WS_MODS);
    LAS float* sc = (LAS float*)F.lds;
    LAS float* red = sc + 9 * 2048;
    for (int i = F.tid; i < 9 * 2048; i += NTHR) { const int bs = i >> 11, k = i & 2047; const float v = bs < 8 ? c[bs * 2048 + k] : cctx[k]; sc[i] = fsilu(v); }
    __syncthreads();
    for (int item = F.bid; item < 2 * 144; item += F.G) {
        const int l = item / 144, cb = item % 144, col = cb * 128 + 2 * F.lane;
        float a0[9], a1[9];
#pragma unroll
        for (int bs = 0; bs < 9; ++bs) { a0[bs] = 0.f; a1[bs] = 0.f; }
        const float* wp = ada_w + ((size_t)l * 2048 + F.wave * 256) * 18432 + col;
        const LAS float* sp = sc + F.wave * 256;
#pragma unroll 8
        for (int k = 0; k < 256; ++k) { const f32x2 w = *(const f32x2*)(wp + (size_t)k * 18432);
#pragma unroll
            for (int bs = 0; bs < 9; ++bs) { const float s = sp[bs * 2048 + k]; a0[bs] += s * w.x; a1[bs] += s * w.y; } }
#pragma unroll
        for (int bs = 0; bs < 9; ++bs) { red[(F.wave * 9 + bs) * 128 + 2 * F.lane] = a0[bs]; red[(F.wave * 9 + bs) * 128 + 2 * F.lane + 1] = a1[bs]; }
        __syncthreads();
        for (int o = F.tid; o < 9 * 128; o += NTHR) { const int bs = o >> 7, cc = o & 127; float s = ada_b[l * 18432 + cb * 128 + cc];
#pragma unroll
            for (int w = 0; w < 8; ++w) s += red[(w * 9 + bs) * 128 + cc];
            mods[((size_t)l * 9 + bs) * 18432 + cb * 128 + cc] = s; }
        __syncthreads();
    }
}

template <bool POST, bool MODH, bool WX = false>
__device__ __forceinline__ void phase_ln(const Frame& F, int nrows, const float* g, const float* b, const float* mods_l, int kshift, int kscale, const bf16* part = nullptr, const float* pmod = nullptr, float pcoef = 0.f, const float* src_l = nullptr, const float* src_c = nullptr) {
    const int gw = F.bid * NWAVES + F.wave, NGW = F.G * NWAVES;
    bf16* HB = WSP(bf16, WS_HB);
    for (int m = gw; m < nrows; m += NGW) {
        float* xr = xrow(F, m);
        const float* xs = (m < ML) ? (src_l ? src_l + (size_t)m * D : xr) : (src_c ? src_c + (size_t)(m - ML) * D : xr);
        f32x4 v[8];
#pragma unroll
        for (int j = 0; j < 8; ++j) v[j] = ((const f32x4*)xs)[F.lane + 64 * j];
        if (POST && part != nullptr && m >= ML) {
            const v2u* pp = (const v2u*)(part + (size_t)(m - ML) * D);
#pragma unroll
            for (int j = 0; j < 8; ++j) { const int o = F.lane + 64 * j; const v2u p0 = pp[o], p1 = pp[o + (size_t)MC * D / 4], p2 = pp[o + 2 * ((size_t)MC * D / 4)], p3 = pp[o + 3 * ((size_t)MC * D / 4)];
                const f32x4 ps = ((f32x4){bflo(p0.x), bfhi(p0.x), bflo(p0.y), bfhi(p0.y)} + (f32x4){bflo(p1.x), bfhi(p1.x), bflo(p1.y), bfhi(p1.y)}) + ((f32x4){bflo(p2.x), bfhi(p2.x), bflo(p2.y), bfhi(p2.y)} + (f32x4){bflo(p3.x), bfhi(p3.x), bflo(p3.y), bfhi(p3.y)});
                v[j] = v[j] * ALPHA + ((const f32x4*)pmod)[o] * pcoef * ps; }
        }
        if (POST) {
            float s = 0.f;
#pragma unroll
            for (int j = 0; j < 8; ++j) s += (v[j].x + v[j].y) + (v[j].z + v[j].w);
            const float mean = wave_sum(s) * (1.f / D); float s2 = 0.f;
#pragma unroll
            for (int j = 0; j < 8; ++j) { v[j] = v[j] - mean; s2 += (v[j].x * v[j].x + v[j].y * v[j].y) + (v[j].z * v[j].z + v[j].w * v[j].w); }
            const float rstd = 1.f / sqrtf(wave_sum(s2) * (1.f / D) + LN_EPS);
#pragma unroll
            for (int j = 0; j < 8; ++j) { const f32x4 gg = ((const f32x4*)g)[F.lane + 64 * j], bb = ((const f32x4*)b)[F.lane + 64 * j]; v[j] = v[j] * rstd * gg + bb; if (WX || m >= ML) ((f32x4*)xr)[F.lane + 64 * j] = v[j]; }
            if (!WX && m < ML && F.lane == 0) *(v2f*)(WSP(float, WS_STATS) + 2 * m) = (v2f){mean, rstd};
        }
        if (MODH) {
            float s = 0.f;
#pragma unroll
            for (int j = 0; j < 8; ++j) s += (v[j].x + v[j].y) + (v[j].z + v[j].w);
            const float mean = wave_sum(s) * (1.f / D); float s2 = 0.f;
#pragma unroll
            for (int j = 0; j < 8; ++j) { v[j] = v[j] - mean; s2 += (v[j].x * v[j].x + v[j].y * v[j].y) + (v[j].z * v[j].z + v[j].w * v[j].w); }
            const float rstd = 1.f / sqrtf(wave_sum(s2) * (1.f / D) + LN_EPS);
            const int bsel = m < ML ? (m >> 11) : 8;
            const f32x4* shp = (const f32x4*)(mods_l + (size_t)bsel * 18432 + kshift * 2048);
            const f32x4* scp = (const f32x4*)(mods_l + (size_t)bsel * 18432 + kscale * 2048);
            v2u* hp = (v2u*)(HB + (size_t)m * D);
#pragma unroll
            for (int j = 0; j < 8; ++j) { const f32x4 sh = shp[F.lane + 64 * j], scl = scp[F.lane + 64 * j]; const f32x4 o = v[j] * rstd * (scl + 1.0f) + sh;
                v2u w; w.x = pk2(o.x, o.y); w.y = pk2(o.z, o.w); hp[F.lane + 64 * j] = w; }
        }
    }
}

__device__ __forceinline__ void phase_convert(const Frame& F, ArgsRef A, int l, int ffn_i, int which) {
    const int gw = F.bid * NWAVES + F.wave, NGW = F.G * NWAVES; int item0 = 0;
    if (which & 1) {
        conv_matrix(F, AIN(8) + ((size_t)l * 2 + ffn_i) * D * (2 * FF), D, 2 * FF, RGN(bf16, R_WGU), 2 * FF, MapGU(), item0, gw, NGW);
        conv_matrix(F, AIN(9) + ((size_t)l * 2 + ffn_i) * FF * D, FF, D, RGN(bf16, R_WDN), D, MapIdent(), item0, gw, NGW);
    }
    if (which & 2) {
        conv_matrix(F, AIN(10) + (size_t)l * D * NIN_SRC, D, NIN_SRC, WSP(bf16, WS_WM + WM_IN), NIN, MapWin(), item0, gw, NGW);
        conv_matrix(F, AIN(26) + (size_t)l * 1024 * D, 1024, D, WSP(bf16, WS_WM + WM_BA), D, MapIdent(), item0, gw, NGW, 4096);
        conv_matrix(F, AIN(27) + (size_t)l * 1024 * D, 1024, D, WSP(bf16, WS_WM + WM_BA) + 1024, D, MapIdent(), item0, gw, NGW, 4096);
        conv_matrix(F, AIN(28) + (size_t)l * D * D, D, D, WSP(bf16, WS_WM + WM_BA) + 2048, D, MapIdent(), item0, gw, NGW, 4096);
        conv_matrix(F, AIN(29) + (size_t)l * D * D, D, D, WSP(bf16, WS_WM + WM_OUT), D, MapIdent(), item0, gw, NGW);
        const float* w2 = AIN(14) + (size_t)l * 2 * 96 * 1024; const float* a2 = AIN(16) + (size_t)l * 2 * 96 * 1024; const float* g2 = AIN(17) + (size_t)l * 256 * 1024;
        bf16* LW = WSP(bf16, WS_WM + WM_LW); bf16* LAw = WSP(bf16, WS_WM + WM_LA); bf16* LG = WSP(bf16, WS_WM + WM_LG);
        for (int e = F.bid * NTHR + F.tid; e < 2048 * 256; e += F.G * NTHR) { const int n = e >> 8, k = e & 255, dir = n >> 10, cc = n & 1023;
            const int kk = k - dir * 96; const bool liv = kk >= 0 && kk < 96;
            LW[e] = liv ? (bf16)f2bf(w2[((size_t)dir * 96 + kk) * 1024 + cc]) : (bf16)0;
            LAw[e] = liv ? (bf16)f2bf(a2[((size_t)dir * 96 + kk) * 1024 + cc]) : (bf16)0;
            if (n < 1024) LG[e] = (bf16)f2bf(g2[(size_t)k * 1024 + n]); }
    }
    __syncthreads();
}

__device__ __forceinline__ float red16s(float v) { v += dppf<0xB1, 0xF>(v); v += dppf<0x4E, 0xF>(v); v += dppf<0x141, 0xF>(v); v += dppf<0x140, 0xF>(v); return v; }
__device__ __forceinline__ void phase_prep(const Frame& F, ArgsRef A, int l) {
    const int gw = F.bid * NWAVES + F.wave, NGW = F.G * NWAVES, lane = F.lane;
    const bf16* ZA = RGN(bf16, R_ZA); bf16* QR = RGN(bf16, R_QR); bf16* KR = RGN(bf16, R_KR);
    const bf16* ZR = RGN(bf16, R_ZR); bf16* LA = RGN(bf16, R_LA); unsigned* GL = RGN(unsigned, R_GL);
    {
        const int f2 = 2 * (lane & 15), axis = (lane >> 4) & 1, hs = lane >> 5;
        const float invf0 = exp2f(-(float)f2 * (13.287712379549449f / 32.0f)), invf1 = exp2f(-(float)(f2 + 1) * (13.287712379549449f / 32.0f));
        for (int m = gw; m < ML; m += NGW) {
            const int t = m & (SEQ - 1);
            const float pos = axis == 0 ? (float)(t >> 6) : (float)(t & 63);
            const float a0 = pos * invf0, a1 = pos * invf1; const float sn0 = __sinf(a0), cs0 = __cosf(a0), sn1 = __sinf(a1), cs1 = __cosf(a1);
            const bf16* zr = ZA + (size_t)m * ZA_LD + hs * 128 + axis * 64 + f2;
#pragma unroll
            for (int hp = 0; hp < 5; ++hp) {
                const unsigned w1 = *(const unsigned*)(zr + hp * 256), w2 = *(const unsigned*)(zr + hp * 256 + 32);
                const float x10 = bflo(w1), x11 = bfhi(w1), x20 = bflo(w2), x21 = bfhi(w2);
                const unsigned o1 = pk2(x10 * cs0 - x20 * sn0, x11 * cs1 - x21 * sn1), o2 = pk2(x20 * cs0 + x10 * sn0, x21 * cs1 + x11 * sn1);
                const int hh = 2 * hp + hs;
                bf16* dst = hh < 8 ? QR + (size_t)m * 1024 + hh * 128 + axis * 64 + f2 : KR + (size_t)m * 256 + (hh - 8) * 128 + axis * 64 + f2;
                *(unsigned*)dst = o1; *(unsigned*)(dst + 32) = o2;
            }
        }
    }
    {
        const float* cw = AIN(12) + (size_t)l * 3 * RW_COLS;
        float t0[6][2], t1[6][2], t2[6][2]; int scol[6];
#pragma unroll
        for (int it = 0; it < 6; ++it) { const int j = 2 * (lane + 64 * it), sec = j >> 8, jj = j & 255; const bool live = sec == 2 || jj < 192;
            scol[it] = live ? (sec == 0 ? 3072 : sec == 1 ? 3264 : 3456) + jj : -1;
#pragma unroll
            for (int e = 0; e < 2; ++e) { t0[it][e] = live ? cw[scol[it] + e] : 0.f; t1[it][e] = live ? cw[RW_COLS + scol[it] + e] : 0.f; t2[it][e] = live ? cw[2 * RW_COLS + scol[it] + e] : 0.f; } }
        for (int m = gw; m < MT; m += NGW) {
            int idx, len; if (m < ML) { idx = m & (SEQ - 1); len = SEQ; } else { idx = (m - ML) & (CL - 1); len = CL; }
            const float fl = idx > 0 ? 1.f : 0.f, fr = idx < len - 1 ? 1.f : 0.f;
            const bf16* z0 = ZR + (size_t)m * ZR_W; const bf16* zl = idx > 0 ? z0 - ZR_W : z0; const bf16* zrr = idx < len - 1 ? z0 + ZR_W : z0;
#pragma unroll
            for (int it = 0; it < 6; ++it) {
                unsigned o = 0u;
                if (scol[it] >= 0) {
                    const unsigned wc = *(const unsigned*)(z0 + scol[it]), wl = *(const unsigned*)(zl + scol[it]), wr = *(const unsigned*)(zrr + scol[it]);
                    float c0 = bflo(wc) * t1[it][0] + fl * bflo(wl) * t0[it][0] + fr * bflo(wr) * t2[it][0];
                    float c1 = bfhi(wc) * t1[it][1] + fl * bfhi(wl) * t0[it][1] + fr * bfhi(wr) * t2[it][1];
                    const int sec = it >> 1;
                    if (sec == 0) { c0 = ftanh(c0); c1 = ftanh(c1); } else if (sec == 2) { c0 = fsigmoid(c0); c1 = fsigmoid(c1); }
                    o = pk2(c0, c1);
                }
                *(unsigned*)(LA + (size_t)m * LA_W + 2 * (lane + 64 * it)) = o;
            }
        }
    }
    {
        __syncthreads();
        LAS unsigned short* TW = (LAS unsigned short*)F.lds;
        LAS float* TB = (LAS float*)(F.lds + 65536);
        const float* wa2 = AIN(23) + (size_t)l * 2 * 16 * 1024; const float* ba = AIN(24) + (size_t)l * 2 * 1024;
        for (int e = F.tid; e < 2 * 16 * 1024; e += NTHR) { const int dr = e >> 10, cc = e & 1023, dir = dr >> 4, r = dr & 15; TW[(dir * 1024 + cc) * 16 + r] = (unsigned short)f2bf(wa2[e]); }
        for (int e = F.tid; e < 2048; e += NTHR) TB[e] = ba[e];
        __syncthreads();
        const int l16 = lane & 15, g = lane >> 4;
        bf16* GLb = RGN(bf16, R_GL);
        const f32x4 zero4 = (f32x4){0.f, 0.f, 0.f, 0.f};
        for (int item = gw; item < (MT / 16) * 4; item += NGW) {
            const int rb = item >> 2, qq = item & 3, m = rb * 16 + l16;
            const bf16x8 af = *(const bf16x8*)(ZR + (size_t)m * ZR_W + 3712 + 8 * g);
            const int dir = qq >> 1;
            const bool live = (g >> 1) == dir;
            bf16* gp = GLb + ((size_t)dir * MT + m) * 1024 + ((512 * qq) & 1023) + 8 * g;
#pragma unroll 4
            for (int q = 0; q < 16; ++q) {
                const int ch0 = 512 * qq + 32 * q;
                const unsigned wa_ = (unsigned)((ch0 + 8 * (l16 >> 2) + (l16 & 3)) * 32 + (g & 1) * 16);
                bf16x8 w0 = *(const LAS bf16x8*)((LAS unsigned char*)TW + wa_), w1 = *(const LAS bf16x8*)((LAS unsigned char*)TW + wa_ + 4 * 32);
                if (!live) { w0 = (bf16x8){0, 0, 0, 0, 0, 0, 0, 0}; w1 = w0; }
                const f32x4 d0 = __builtin_amdgcn_mfma_f32_16x16x32_bf16(w0, af, zero4, 0, 0, 0), d1 = __builtin_amdgcn_mfma_f32_16x16x32_bf16(w1, af, zero4, 0, 0, 0);
                const f32x4 b0 = *(const LAS f32x4*)(TB + ch0 + 8 * g), b1 = *(const LAS f32x4*)(TB + ch0 + 8 * g + 4);
                float o[8];
#pragma unroll
                for (int r = 0; r < 4; ++r) { o[r] = -fsoftplus(-(d0[r] + b0[r])) * 0.0625f; o[4 + r] = -fsoftplus(-(d1[r] + b1[r])) * 0.0625f; }
                *(v4u*)(gp + 32 * q) = (v4u){pk2(o[0], o[1]), pk2(o[2], o[3]), pk2(o[4], o[5]), pk2(o[6], o[7])};
            }
        }
        __syncthreads();
    }
}

__device__ __forceinline__ unsigned opq(unsigned x) { asm volatile("" : "+v"(x)); return x; }
__device__ __forceinline__ bf16x8 pack8(const f32x4& a, const f32x4& b) {
    v4u w; w.x = pg8::cvt_pk_bf16(a[0], a[1]); w.y = pg8::cvt_pk_bf16(a[2], a[3]); w.z = pg8::cvt_pk_bf16(b[0], b[1]); w.w = pg8::cvt_pk_bf16(b[2], b[3]);
    return __builtin_bit_cast(bf16x8, w);
}
typedef short s16x4 __attribute__((ext_vector_type(4)));
__device__ __forceinline__ bf16x8 tr8(LAS unsigned char* L, unsigned a0, unsigned a1) {
    const s16x4 x = __builtin_amdgcn_ds_read_tr16_b64_v4i16((LAS s16x4*)(L + a0)), y = __builtin_amdgcn_ds_read_tr16_b64_v4i16((LAS s16x4*)(L + a1));
    return __builtin_shufflevector(x, y, 0, 1, 2, 3, 4, 5, 6, 7);
}
constexpr int RC_LD = 72;
constexpr int RC_QP = 0, RC_RT = 9216, RC_KD = 18432, RC_KA = 27648, RC_KDT = 36864, RC_KAT = 46080, RC_VT = 55296, RC_MKA = 64512, RC_MKD = 73728, RC_NKA = 82944, RC_NKD = 92160,
              RC_DG = 101376, RC_TB = 105472, RC_EB = 107520, RC_TQ = 107776, RC_BI = 109824, RC_END = 126208;
static_assert(RC_END <= RING_BYTES, "RWKV LDS map");
#define LD_(T, addr) (*(const LAS T*)(L + (addr)))
#define ST_(T, addr) (*(LAS T*)(L + (addr)))
__device__ __forceinline__ bf16x8 kperm(LAS unsigned char* L, unsigned addr) {
    const v2u a0 = LD_(v2u, addr), a1 = LD_(v2u, addr + 32); return __builtin_bit_cast(bf16x8, (v4u){a0.x, a0.y, a1.x, a1.y}); }
__device__ __forceinline__ void rwkv_chunk_item(const Frame& F, ArgsRef A, int l, int item, bool last) {
    const int b = item >> 5, h = (item >> 1) & 15, dir = item & 1, tid = F.tid, lane = F.lane, w = F.wave, sgn = dir ? -1 : 1, l16 = lane & 15, g = lane >> 4;
    LAS unsigned char* L = F.lds;
    const bf16* ZR = RGN(bf16, R_ZR); const unsigned short* WLD = RGN(unsigned short, R_WDEC) + (size_t)dir * MT * 1024;   const bf16* AA = RGN(bf16, R_AA) + (size_t)dir * MT * 1024;
    bf16* Y = RGN(bf16, R_Y) + (size_t)dir * MT * 1024;
    const float* cw = AIN(12) + (size_t)l * 3 * RW_COLS;
    const int j0 = 4 * l16, ch = h * 64 + j0;
    const int tA = dir ? 2 : 0, tB = dir ? 0 : 2;
    const f32x4 kkw = *(const f32x4*)(AIN(18) + l * 1024 + ch), kaw = *(const f32x4*)(AIN(19) + l * 1024 + ch);
    const int cj = tid & 63, ct8 = tid >> 6;
    const unsigned a_row = opq((unsigned)(((8 * w + g) * RC_LD + j0) * 2));
    const unsigned a_tr = opq((unsigned)((((lane & 15) >> 2) * RC_LD + 4 * (lane & 3)) * 2));
    const unsigned a_f8 = opq((unsigned)((l16 * RC_LD + 8 * g) * 2));
    const unsigned a_f4 = opq((unsigned)((l16 * RC_LD + 4 * g) * 2));

    f32x4 S[4];
#pragma unroll
    for (int t = 0; t < 4; ++t) S[t] = (f32x4){0.f, 0.f, 0.f, 0.f};
    v2u zz[2][3][3], za[2]; unsigned plw[8];
#define RC_ISSUE(chunk) do { int idx_, len_; const int c_ = (chunk); const int r0_ = seq_row(b, dir, c_ * 64, idx_, len_); \
        const int plo_ = c_ < 4 ? 0 : CL, phi_ = c_ < 4 ? CL : CL + SEQ; \
        _Pragma("unroll") for (int p = 0; p < 2; ++p) { const int t_ = 8 * w + 4 * p + g; \
            _Pragma("unroll") for (int x = 0; x < 3; ++x) { const int pp_ = c_ * 64 + t_ + x - 1; const bool ok_ = pp_ >= plo_ && pp_ < phi_; \
                const GAS bf16* zp_ = (const GAS bf16*)(ZR + (size_t)(ok_ ? r0_ + sgn * (t_ + x - 1) : r0_) * ZR_W + ch); asm volatile("" : "+v"(zp_)); \
                const v2u q0_ = *(const GAS v2u*)zp_, q1_ = *(const GAS v2u*)(zp_ + 1024), q2_ = *(const GAS v2u*)(zp_ + 2048); const v2u zero_ = (v2u){0u, 0u}; \
                zz[p][x][0] = ok_ ? q0_ : zero_; zz[p][x][1] = ok_ ? q1_ : zero_; zz[p][x][2] = ok_ ? q2_ : zero_; } \
            za[p] = *(const GAS v2u*)(const GAS bf16*)(AA + (size_t)(r0_ + sgn * t_) * 1024 + ch); } \
        { const GAS unsigned* wp_ = (const GAS unsigned*)(WLD + (size_t)(r0_ + sgn * 8 * ct8) * 1024 + h * 64 + (cj & ~1)); const long st_ = (long)sgn * 512;   \
          _Pragma("unroll") for (int q = 0; q < 8; ++q) { asm volatile("" : "+v"(wp_)); plw[q] = *wp_; wp_ += st_; } } } while (0)
    RC_ISSUE(0);
    for (int chunk = 0; chunk < 36; ++chunk) {
        int idx0, len0; const int r0 = seq_row(b, dir, chunk * 64, idx0, len0);
        const unsigned a_tqs = opq((unsigned)(RC_TQ + (ct8 * 64 + cj) * 4)), a_tqr = opq((unsigned)(RC_TQ + cj * 4)), a_bis = opq((unsigned)(RC_BI + (8 * ct8 * 64 + cj) * 4));
        float pl[8];
        { float s = 0.f;
#pragma unroll
          for (int q = 0; q < 8; ++q) { pl[q] = (float)__builtin_bit_cast(_Float16, (unsigned short)((cj & 1) ? (plw[q] >> 16) : (plw[q] & 0xffffu))); s += pl[q]; }
          ST_(float, a_tqs) = s; }
        __syncthreads();
        { float o = 0.f, tot = 0.f;
#pragma unroll
          for (int q = 0; q < 8; ++q) { const float tq = LD_(float, a_tqr + q * 256); if (q < ct8) o += tq; tot += tq; }
          if (ct8 == 0) ST_(float, RC_EB + cj * 4) = fexp(tot);
#pragma unroll
          for (int q = 0; q < 8; ++q) { o += pl[q]; ST_(float, a_bis + q * 256) = o; } }
        __syncthreads();
        f32x4 tp[3][3];
#pragma unroll
        for (int kind = 0; kind < 3; ++kind) { const GAS float* cp = (const GAS float*)(cw + kind * 1024 + ch); asm volatile("" : "+v"(cp));
            tp[0][kind] = *(const GAS f32x4*)(cp + tA * RW_COLS); tp[1][kind] = *(const GAS f32x4*)(cp + RW_COLS); tp[2][kind] = *(const GAS f32x4*)(cp + tB * RW_COLS); }
        const unsigned a_bir = opq((unsigned)(RC_BI + ((8 * w + g) * 64 + j0) * 4));
#pragma unroll
        for (int p = 0; p < 2; ++p) {
            const int t = 8 * w + 4 * p + g;
            f32x4 rkv[3];
#pragma unroll
            for (int kind = 0; kind < 3; ++kind) {
                const v2u wa = zz[p][0][kind], wc = zz[p][1][kind], wb = zz[p][2][kind];
                const f32x4 xa = (f32x4){bflo(wa.x), bfhi(wa.x), bflo(wa.y), bfhi(wa.y)}, xc = (f32x4){bflo(wc.x), bfhi(wc.x), bflo(wc.y), bfhi(wc.y)}, xb = (f32x4){bflo(wb.x), bfhi(wb.x), bflo(wb.y), bfhi(wb.y)};
                rkv[kind] = xa * tp[0][kind] + xc * tp[1][kind] + xb * tp[2][kind]; }
            const f32x4 r = rkv[0], k = rkv[1], v = rkv[2];
            const f32x4 kr = k * kkw;
            const float n2 = red16s((kr.x * kr.x + kr.y * kr.y) + (kr.z * kr.z + kr.w * kr.w));
            const f32x4 kk = kr * __builtin_amdgcn_rsqf(fmaxf(n2, 1e-24f));
            const f32x4 a = (f32x4){bflo(za[p].x), bfhi(za[p].x), bflo(za[p].y), bfhi(za[p].y)};
            const f32x4 kd = k * ((a - 1.0f) * kaw + 1.0f), kka = kk * a;
            {
              const GAS float* rp = (const GAS float*)(AIN(20) + l * 1024 + ch); asm volatile("" : "+v"(rp)); const f32x4 rkp = *(const GAS f32x4*)rp;
              const f32x4 pb = r * kd * rkp; const float bsum = red16s((pb.x + pb.y) + (pb.z + pb.w));
              if (l16 == 0) RGN(float, R_BS)[((size_t)dir * MT + (size_t)(r0 + sgn * t)) * 16 + h] = bsum; }
            const f32x4 bi = LD_(f32x4, a_bir + p * 1024);
            f32x4 bx = (f32x4){0.f, 0.f, 0.f, 0.f}; if (t > 0) bx = LD_(f32x4, a_bir + p * 1024 - 256);
            f32x4 ex, ei, en;
#pragma unroll
            for (int c = 0; c < 4; ++c) { ex[c] = fexp(bx[c]); ei[c] = fexp(bi[c]); en[c] = fexp(-bi[c]); }
            const f32x4 qp = kk * ex * -1.0f, rt = r * ei, kdn = kd * en, kan = kka * en;
            const unsigned ar = a_row + p * (4 * RC_LD * 2);
            ST_(v2u, RC_QP + ar) = (v2u){pg8::cvt_pk_bf16(qp.x, qp.y), pg8::cvt_pk_bf16(qp.z, qp.w)};
            ST_(v2u, RC_RT + ar) = (v2u){pg8::cvt_pk_bf16(rt.x, rt.y), pg8::cvt_pk_bf16(rt.z, rt.w)};
            const unsigned kd01 = pg8::cvt_pk_bf16(kdn.x, kdn.y), kd23 = pg8::cvt_pk_bf16(kdn.z, kdn.w), ka01 = pg8::cvt_pk_bf16(kan.x, kan.y), ka23 = pg8::cvt_pk_bf16(kan.z, kan.w);
            const unsigned v01 = pg8::cvt_pk_bf16(v.x, v.y), v23 = pg8::cvt_pk_bf16(v.z, v.w);
            ST_(v2u, RC_KD + ar) = (v2u){kd01, kd23}; ST_(v2u, RC_KA + ar) = (v2u){ka01, ka23};
            ST_(v2u, RC_VT + ar) = (v2u){v01, v23};
            asm volatile("" ::: "memory");
        }
        __syncthreads();
        if (chunk + 1 < 36) RC_ISSUE(chunk + 1);
        const unsigned a_dgs = opq((unsigned)(RC_DG + (l16 * 16 + 4 * g) * 4));
#pragma unroll
        for (int tt2 = 0; tt2 < 2; ++tt2) {
            const int id = 2 * w + tt2, st = id >> 2, tt = id & 3;
            f32x4 mka = (f32x4){0.f, 0.f, 0.f, 0.f}, mkd = mka, nka = mka, nkd = mka;
            if (st <= tt) {
                const unsigned as_ = a_f8 + st * (16 * RC_LD * 2), at_ = a_f8 + tt * (16 * RC_LD * 2);
#pragma unroll
                for (int ks = 0; ks < 2; ++ks) {
                    const bf16x8 fka = LD_(bf16x8, RC_KA + as_ + 64 * ks), fkd = LD_(bf16x8, RC_KD + as_ + 64 * ks), fqp = LD_(bf16x8, RC_QP + at_ + 64 * ks), frt = LD_(bf16x8, RC_RT + at_ + 64 * ks);
                    mka = __builtin_amdgcn_mfma_f32_16x16x32_bf16(fka, fqp, mka, 0, 0, 0); mkd = __builtin_amdgcn_mfma_f32_16x16x32_bf16(fkd, fqp, mkd, 0, 0, 0);
                    nka = __builtin_amdgcn_mfma_f32_16x16x32_bf16(fka, frt, nka, 0, 0, 0); nkd = __builtin_amdgcn_mfma_f32_16x16x32_bf16(fkd, frt, nkd, 0, 0, 0);
                }
            }
            const int t = 16 * tt + (int)opq((unsigned)l16), s0 = 16 * st + 4 * (int)opq((unsigned)g);
#pragma unroll
            for (int r = 0; r < 4; ++r) { const bool lt = (s0 + r) < t, le = (s0 + r) <= t; mka[r] = lt ? mka[r] : 0.f; mkd[r] = lt ? mkd[r] : 0.f; nka[r] = le ? nka[r] : 0.f; nkd[r] = le ? nkd[r] : 0.f; }
            const unsigned am = a_f4 + tt * (16 * RC_LD * 2) + st * 32;
            ST_(v2u, RC_MKA + am) = (v2u){pg8::cvt_pk_bf16(mka[0], mka[1]), pg8::cvt_pk_bf16(mka[2], mka[3])};
            ST_(v2u, RC_MKD + am) = (v2u){pg8::cvt_pk_bf16(mkd[0], mkd[1]), pg8::cvt_pk_bf16(mkd[2], mkd[3])};
            ST_(v2u, RC_NKA + am) = (v2u){pg8::cvt_pk_bf16(nka[0], nka[1]), pg8::cvt_pk_bf16(nka[2], nka[3])};
            ST_(v2u, RC_NKD + am) = (v2u){pg8::cvt_pk_bf16(nkd[0], nkd[1]), pg8::cvt_pk_bf16(nkd[2], nkd[3])};
            if (st == tt) ST_(f32x4, a_dgs + st * 1024) = mka;
        }
        __syncthreads();
        if (w == 4) {
            const unsigned a_dgb = opq((unsigned)(RC_DG + g * 1024)), a_tbs = opq((unsigned)(RC_TB + (g * 256 + l16) * 2));
            float tc[16]; const int lq = (int)opq((unsigned)l16);
#pragma unroll
            for (int t = 0; t < 16; ++t) {
                float acc = (t == lq) ? 1.f : 0.f;
                const f32x4 L0 = LD_(f32x4, a_dgb + t * 64), L1 = LD_(f32x4, a_dgb + t * 64 + 16), L2 = LD_(f32x4, a_dgb + t * 64 + 32), L3 = LD_(f32x4, a_dgb + t * 64 + 48);
                const float lr[16] = {L0[0], L0[1], L0[2], L0[3], L1[0], L1[1], L1[2], L1[3], L2[0], L2[1], L2[2], L2[3], L3[0], L3[1], L3[2], L3[3]};
#pragma unroll
                for (int s = 0; s < 16; ++s) if (s < t) acc += lr[s] * tc[s];
                tc[t] = acc;
                ST_(unsigned short, a_tbs + t * 32) = (unsigned short)f2bf(acc);
            }
        }
        f32x4 X[4], O[4], U[4];
        const f32x4 zero4 = (f32x4){0.f, 0.f, 0.f, 0.f};
        bf16x8 vb0, vb1;
        if (w < 4) {
            const bf16x8 sf0 = pack8(S[0], S[1]), sf1 = pack8(S[2], S[3]);
            { const unsigned av = RC_VT + a_tr + (8 * g) * (RC_LD * 2) + w * 32; vb0 = tr8(L, av, av + 4 * RC_LD * 2); vb1 = tr8(L, av + 32 * RC_LD * 2, av + 36 * RC_LD * 2); }
#pragma unroll
            for (int mt = 0; mt < 4; ++mt) {
                const unsigned o4 = a_f4 + mt * (16 * RC_LD * 2), o8 = a_f8 + mt * (16 * RC_LD * 2);
                X[mt] = __builtin_amdgcn_mfma_f32_16x16x32_bf16(kperm(L, RC_QP + o4), sf0, zero4, 0, 0, 0);
                X[mt] = __builtin_amdgcn_mfma_f32_16x16x32_bf16(kperm(L, RC_QP + o4 + 64), sf1, X[mt], 0, 0, 0);
                X[mt] = __builtin_amdgcn_mfma_f32_16x16x32_bf16(LD_(bf16x8, RC_MKD + o8), vb0, X[mt], 0, 0, 0);
                X[mt] = __builtin_amdgcn_mfma_f32_16x16x32_bf16(LD_(bf16x8, RC_MKD + o8 + 64), vb1, X[mt], 0, 0, 0);
                O[mt] = __builtin_amdgcn_mfma_f32_16x16x32_bf16(kperm(L, RC_RT + o4), sf0, zero4, 0, 0, 0);
                O[mt] = __builtin_amdgcn_mfma_f32_16x16x32_bf16(kperm(L, RC_RT + o4 + 64), sf1, O[mt], 0, 0, 0);
                O[mt] = __builtin_amdgcn_mfma_f32_16x16x32_bf16(LD_(bf16x8, RC_NKD + o8), vb0, O[mt], 0, 0, 0);
                O[mt] = __builtin_amdgcn_mfma_f32_16x16x32_bf16(LD_(bf16x8, RC_NKD + o8 + 64), vb1, O[mt], 0, 0, 0);
                asm volatile("" ::: "memory");
            }
#pragma unroll
            for (int jt = 0; jt < 4; ++jt) { const unsigned ak = RC_KD + a_tr + (8 * g) * (RC_LD * 2) + jt * 32;
                S[jt] = __builtin_amdgcn_mfma_f32_16x16x32_bf16(tr8(L, ak, ak + 4 * RC_LD * 2), vb0, S[jt], 0, 0, 0);
                S[jt] = __builtin_amdgcn_mfma_f32_16x16x32_bf16(tr8(L, ak + 32 * RC_LD * 2, ak + 36 * RC_LD * 2), vb1, S[jt], 0, 0, 0); }
        }
        __syncthreads();
        if (w < 4) {
            const unsigned a_tbf = opq((unsigned)(RC_TB + (l16 * 16 + 4 * g) * 2)), a_ebr = opq((unsigned)(RC_EB + 16 * g));
#define RC_TBF(tb) __builtin_bit_cast(bf16x8, (v4u){LD_(v2u, a_tbf + (tb) * 512).x, LD_(v2u, a_tbf + (tb) * 512).y, 0u, 0u})
            U[0] = __builtin_amdgcn_mfma_f32_16x16x32_bf16(RC_TBF(0), pack8(X[0], zero4), zero4, 0, 0, 0);
            X[1] = __builtin_amdgcn_mfma_f32_16x16x32_bf16(kperm(L, RC_MKA + a_f4 + 1 * (16 * RC_LD * 2)), pack8(U[0], zero4), X[1], 0, 0, 0);
            U[1] = __builtin_amdgcn_mfma_f32_16x16x32_bf16(RC_TBF(1), pack8(X[1], zero4), zero4, 0, 0, 0);
            const bf16x8 uf0 = pack8(U[0], U[1]);
            X[2] = __builtin_amdgcn_mfma_f32_16x16x32_bf16(kperm(L, RC_MKA + a_f4 + 2 * (16 * RC_LD * 2)), uf0, X[2], 0, 0, 0);
            U[2] = __builtin_amdgcn_mfma_f32_16x16x32_bf16(RC_TBF(2), pack8(X[2], zero4), zero4, 0, 0, 0);
            X[3] = __builtin_amdgcn_mfma_f32_16x16x32_bf16(kperm(L, RC_MKA + a_f4 + 3 * (16 * RC_LD * 2)), uf0, X[3], 0, 0, 0);
            X[3] = __builtin_amdgcn_mfma_f32_16x16x32_bf16(kperm(L, RC_MKA + a_f4 + 3 * (16 * RC_LD * 2) + 64), pack8(U[2], zero4), X[3], 0, 0, 0);
            U[3] = __builtin_amdgcn_mfma_f32_16x16x32_bf16(RC_TBF(3), pack8(X[3], zero4), zero4, 0, 0, 0);
            const bf16x8 uf1 = pack8(U[2], U[3]);
#undef RC_TBF
#pragma unroll
            for (int mt = 0; mt < 4; ++mt) { const unsigned o4 = a_f4 + mt * (16 * RC_LD * 2);
                O[mt] = __builtin_amdgcn_mfma_f32_16x16x32_bf16(kperm(L, RC_NKA + o4), uf0, O[mt], 0, 0, 0);
                O[mt] = __builtin_amdgcn_mfma_f32_16x16x32_bf16(kperm(L, RC_NKA + o4 + 64), uf1, O[mt], 0, 0, 0); }
#pragma unroll
            for (int jt = 0; jt < 4; ++jt) { const unsigned ak = RC_KA + a_tr + (4 * g) * (RC_LD * 2) + jt * 32;
                S[jt] = __builtin_amdgcn_mfma_f32_16x16x32_bf16(tr8(L, ak, ak + 16 * RC_LD * 2), uf0, S[jt], 0, 0, 0);
                S[jt] = __builtin_amdgcn_mfma_f32_16x16x32_bf16(tr8(L, ak + 32 * RC_LD * 2, ak + 48 * RC_LD * 2), uf1, S[jt], 0, 0, 0);
                S[jt] = S[jt] * LD_(f32x4, a_ebr + jt * 64); }
            if (!(last && chunk < 4)) {
                GAS bf16* yp = (GAS bf16*)(Y + (size_t)(r0 + sgn * 4 * g) * 1024 + h * 64 + 16 * w + l16);
                const long sy = (long)sgn * 1024;
#pragma unroll
                for (int mt = 0; mt < 4; ++mt) {
#pragma unroll
                    for (int r = 0; r < 4; ++r) { asm volatile("" : "+v"(yp)); yp[(long)r * sy] = (bf16)f2bf(O[mt][r]); }
                    yp += 16 * sy;
                }
            }
        }
        __syncthreads();
    }
#undef RC_ISSUE
}
#undef LD_
#undef ST_

constexpr int GQ_LD = 264, GT_LD = 72;
constexpr int GV_LD = 136;
constexpr int G_QD = 0, G_KI = G_QD + 64 * GQ_LD * 2, G_KT = G_KI + 64 * GQ_LD * 2, G_VT = G_KT + 256 * GT_LD * 2, G_AM = G_VT + 128 * GT_LD * 2, G_EBL = G_AM + 64 * GT_LD * 2, G_TQ = G_EBL + 1024, G_END = G_TQ + 4096;
static_assert(G_END <= RING_BYTES, "GLA LDS map");
#define LD_(T, addr) (*(const LAS T*)(L + (addr)))
#define ST_(T, addr) (*(LAS T*)(L + (addr)))
template <int VAR> __device__ __forceinline__ void gla_chunk_item(const Frame& F, int item, bool last) {
    const int b = item >> 5, h = (item >> 3) & 3, dir = (item >> 2) & 1, dvs = item & 3;
    LAS unsigned char* L = F.lds;
    const int tid = F.tid, lane = F.lane, w = F.wave, l16 = lane & 15, g = lane >> 4;
    const int dp = tid & 127, qt = tid >> 7;
    const int e8 = tid & 15, jj = tid >> 4;
    const bf16* ZG = RGN(bf16, R_ZG); const bf16* GL = RGN(bf16, R_GL) + (size_t)dir * MT * 1024;
    bf16* YG = RGN(bf16, R_YG) + (size_t)dir * MT * 2048;
    const int sgn = dir ? -1 : 1;
    f32x4 S[16];
#pragma unroll
    for (int t = 0; t < 16; ++t) S[t] = (f32x4){0.f, 0.f, 0.f, 0.f};
    unsigned rq[16], rk[16], rl[16]; v4u rv0, rv1;
#define GLA_ISSUE(chunk) do { int idx_, len_; const int r0_ = seq_row(b, dir, (chunk) * 64, idx_, len_); \
        const GAS bf16* pz_ = (const GAS bf16*)(ZG + (size_t)(r0_ + sgn * 16 * qt) * ZG_W + h * 256 + 2 * dp); const GAS bf16* pl_ = (const GAS bf16*)(GL + (size_t)(r0_ + sgn * 16 * qt) * 1024 + h * 256 + 2 * dp); \
        const long sz_ = (long)sgn * ZG_W, sl_ = (long)sgn * 1024; \
        _Pragma("unroll") for (int i = 0; i < 16; ++i) { asm volatile("" : "+v"(pz_), "+v"(pl_)); \
            rq[i] = *(const GAS unsigned*)pz_; rk[i] = *(const GAS unsigned*)(pz_ + 1024); rl[i] = *(const GAS unsigned*)pl_; pz_ += sz_; pl_ += sl_; } \
        const bf16* pv_ = ZG + (size_t)(r0_ + sgn * jj) * ZG_W + 2048 + h * 512 + dvs * 128 + 8 * e8; \
        rv0 = *(const v4u*)pv_; rv1 = *(const v4u*)(pv_ + sz_ * 32); } while (0)
    GLA_ISSUE(0);
    for (int chunk = 0; chunk < 36; ++chunk) {
        int idx0, len0; const int r0 = seq_row(b, dir, chunk * 64, idx0, len0);
        const unsigned a_ptq = opq(G_TQ + (2 * dp) * 4);
        {
            float s0 = 0.f, s1 = 0.f;
#pragma unroll
            for (int i = 0; i < 16; ++i) { s0 += bflo(rl[i]); s1 += bfhi(rl[i]); }
            ST_(f32x2, a_ptq + qt * 1024) = (f32x2){s0, s1};
        }
        __syncthreads();
        if (VAR != 2)
        {
            float o0 = 0.f, o1 = 0.f, t0 = 0.f, t1 = 0.f;
#pragma unroll
            for (int q = 0; q < 4; ++q) { const f32x2 tq = LD_(f32x2, a_ptq + q * 1024); if (q < qt) { o0 += tq.x; o1 += tq.y; } t0 += tq.x; t1 += tq.y; }
            if (qt == 0) ST_(f32x2, G_EBL + 2 * dp * 4) = (f32x2){fexp(t0), fexp(t1)};
            unsigned kt0[8], kt1[8];
            const unsigned a_pq = opq(G_QD + ((16 * qt) * GQ_LD + 2 * dp) * 2);
            const unsigned a_pkt = opq(G_KT + ((2 * dp) * GT_LD + 16 * qt) * 2);
        const unsigned a_pvt = opq(G_VT + (jj * GV_LD + 8 * e8) * 2);
#pragma unroll
            for (int i = 0; i < 16; ++i) {
                o0 += bflo(rl[i]); o1 += bfhi(rl[i]);
                const float e0 = fexp(o0), e1 = fexp(o1), n0 = fexp(-o0), n1 = fexp(-o1);
                const unsigned qd = pg8::cvt_pk_bf16(bflo(rq[i]) * 0.0625f * e0, bfhi(rq[i]) * 0.0625f * e1);
                const unsigned ki = pg8::cvt_pk_bf16(bflo(rk[i]) * n0, bfhi(rk[i]) * n1);
                ST_(unsigned, a_pq + i * GQ_LD * 2) = qd;
                ST_(unsigned, a_pq + (G_KI - G_QD) + i * GQ_LD * 2) = ki;
                if (i & 1) { kt0[i >> 1] |= (ki << 16); kt1[i >> 1] |= (ki & 0xffff0000u); }
                else { kt0[i >> 1] = ki & 0xffffu; kt1[i >> 1] = ki >> 16; }
                asm volatile("" ::: "memory");
            }
            ST_(v4u, a_pkt) = (v4u){kt0[0], kt0[1], kt0[2], kt0[3]};
            ST_(v4u, a_pkt + 16) = (v4u){kt0[4], kt0[5], kt0[6], kt0[7]};
            ST_(v4u, a_pkt + GT_LD * 2) = (v4u){kt1[0], kt1[1], kt1[2], kt1[3]};
            ST_(v4u, a_pkt + GT_LD * 2 + 16) = (v4u){kt1[4], kt1[5], kt1[6], kt1[7]};
            ST_(v4u, a_pvt) = rv0; ST_(v4u, a_pvt + 32 * GV_LD * 2) = rv1;
        }
        __syncthreads();
        if (chunk + 1 < 36 && VAR != 1) GLA_ISSUE(chunk + 1);
        const unsigned a_f8 = opq((l16 * GQ_LD + 8 * g) * 2);
#pragma unroll
        for (int tt = 0; tt < 2; ++tt) {
            const int t = 2 * w + tt, jt = t >> 2, it = t & 3;
            f32x4 acc = (f32x4){0.f, 0.f, 0.f, 0.f};
            if (jt <= it) {
                const unsigned ak = a_f8 + G_KI + jt * (16 * GQ_LD * 2), aq = a_f8 + G_QD + it * (16 * GQ_LD * 2);
#pragma unroll
                for (int s = 0; s < 8; ++s) {
                    const bf16x8 a = LD_(bf16x8, ak + 64 * s);
                    const bf16x8 bb = LD_(bf16x8, aq + 64 * s);
                    acc = __builtin_amdgcn_mfma_f32_16x16x32_bf16(a, bb, acc, 0, 0, 0);
                }
            }
            const int i = 16 * it + l16, j0 = 16 * jt + 4 * g;
            const float m0 = (j0 + 0 <= i) ? acc[0] : 0.f, m1 = (j0 + 1 <= i) ? acc[1] : 0.f, m2 = (j0 + 2 <= i) ? acc[2] : 0.f, m3 = (j0 + 3 <= i) ? acc[3] : 0.f;
            ST_(v2u, G_AM + (i * GT_LD + j0) * 2) = (v2u){pg8::cvt_pk_bf16(m0, m1), pg8::cvt_pk_bf16(m2, m3)};
        }
        __syncthreads();
        if (VAR != 3)
        {
            const unsigned a_f4 = opq(G_QD + (l16 * GQ_LD + 4 * g) * 2), a_t8 = opq((l16 * GT_LD + 8 * g) * 2), a_ebl = opq(G_EBL + 16 * g);
            const unsigned a_vtr = opq(G_VT + ((8 * g + (l16 >> 2)) * GV_LD + 16 * w + 4 * (l16 & 3)) * 2);
            const unsigned a_os = opq(G_KI + ((4 * g) * GV_LD + 16 * w + l16) * 2);
            f32x4 O[4];
#pragma unroll
            for (int mt = 0; mt < 4; ++mt) O[mt] = (f32x4){0.f, 0.f, 0.f, 0.f};
#pragma unroll
            for (int s = 0; s < 8; ++s) {
                const bf16x8 bs = pack8(S[2 * s], S[2 * s + 1]);
#pragma unroll
                for (int mt = 0; mt < 4; ++mt) {
                    const v2u a0 = LD_(v2u, a_f4 + (16 * mt * GQ_LD + 32 * s) * 2);
                    const v2u a1 = LD_(v2u, a_f4 + (16 * mt * GQ_LD + 32 * s + 16) * 2);
                    const bf16x8 a = __builtin_bit_cast(bf16x8, (v4u){a0.x, a0.y, a1.x, a1.y});
                    O[mt] = __builtin_amdgcn_mfma_f32_16x16x32_bf16(a, bs, O[mt], 0, 0, 0);
                }
                asm volatile("" ::: "memory");
            }
            const bf16x8 vb0 = tr8(L, a_vtr, a_vtr + 4 * GV_LD * 2);
            const bf16x8 vb1 = tr8(L, a_vtr + 32 * GV_LD * 2, a_vtr + 36 * GV_LD * 2);
#pragma unroll
            for (int mt = 0; mt < 4; ++mt) {
                const bf16x8 a0 = LD_(bf16x8, a_t8 + G_AM + mt * (16 * GT_LD * 2));
                O[mt] = __builtin_amdgcn_mfma_f32_16x16x32_bf16(a0, vb0, O[mt], 0, 0, 0);
                if (mt >= 2) { const bf16x8 a1 = LD_(bf16x8, a_t8 + G_AM + mt * (16 * GT_LD * 2) + 64);
                    O[mt] = __builtin_amdgcn_mfma_f32_16x16x32_bf16(a1, vb1, O[mt], 0, 0, 0); }
            }
            if (VAR == 0 && !(last && chunk < 4)) {
                const unsigned aos = a_os;
#pragma unroll
                for (int mt = 0; mt < 4; ++mt)
#pragma unroll
                    for (int r = 0; r < 4; ++r) ST_(unsigned short, aos + (16 * mt + r) * (GV_LD * 2)) = (unsigned short)f2bf(O[mt][r]);
            }
#pragma unroll
            for (int t = 0; t < 16; ++t) {
                const bf16x8 a0 = LD_(bf16x8, a_t8 + G_KT + t * (16 * GT_LD * 2));
                const bf16x8 a1 = LD_(bf16x8, a_t8 + G_KT + t * (16 * GT_LD * 2) + 64);
                S[t] = __builtin_amdgcn_mfma_f32_16x16x32_bf16(a0, vb0, S[t], 0, 0, 0);
                S[t] = __builtin_amdgcn_mfma_f32_16x16x32_bf16(a1, vb1, S[t], 0, 0, 0);
                const f32x4 eb = LD_(f32x4, a_ebl + 64 * t);
                S[t] = S[t] * eb;
                asm volatile("" ::: "memory");
            }
        }
        __syncthreads();
        if (VAR == 0 && !(last && chunk < 4)) {
            const unsigned a_or = opq(G_KI + ((tid >> 4) * GV_LD + 8 * (tid & 15)) * 2);
            const v4u o0 = LD_(v4u, a_or), o1 = LD_(v4u, a_or + 32 * GV_LD * 2);
            GAS bf16* yp = (GAS bf16*)(YG + (size_t)(r0 + sgn * (tid >> 4)) * 2048 + h * 512 + dvs * 128 + 8 * (tid & 15));
            *(GAS v4u*)yp = o0; *(GAS v4u*)(yp + (long)sgn * 32 * 2048) = o1;
        }
    }
#undef GLA_ISSUE
    if (VAR != 0) { float chk = 0.f;
#pragma unroll
        for (int t = 0; t < 16; ++t) chk += S[t][0] + S[t][1] + S[t][2] + S[t][3];
        chk += __uint_as_float(rq[0] ^ rk[3] ^ rl[7]);
        if (chk == 1.2345e-30f) YG[0] = (bf16)1; }
}
#undef LD_
#undef ST_

constexpr int AK_LD = 136, AV_LD = 136;
constexpr int A_K = 0, A_VT = A_K + 64 * AK_LD * 2, A_END = A_VT + 64 * AV_LD * 2;
static_assert(A_END <= RING_BYTES, "attention LDS map");
typedef float f32x16 __attribute__((ext_vector_type(16)));
#define LD_(T, addr) (*(const LAS T*)(L + (addr)))
#define ST_(T, addr) (*(LAS T*)(L + (addr)))
template <bool NOSTORE> __device__ __forceinline__ void attn_mfma_item(const Frame& F, ArgsRef A, int l, int item) {
    LAS unsigned char* L = F.lds;
    const int tid = F.tid, lane = F.lane, w = F.wave, l32 = lane & 31, g = lane >> 5;
    bf16* ZA = RGN(bf16, R_ZA); const bf16* QR = RGN(bf16, R_QR); const bf16* KR = RGN(bf16, R_KR);
    const bool isctx = item >= 512;
    int b, hk, t0;
    if (!isctx) { b = item >> 6; hk = (item >> 5) & 1; t0 = (item & 31) * 64; }
    else { const int it = item - 512; b = it >> 3; hk = (it >> 2) & 1; t0 = (it & 3) * 64; }
    const int hq = hk * 4 + (w >> 1), tq = t0 + 32 * (w & 1) + l32;
    const size_t qrow = isctx ? (size_t)(ML + b * CL + tq) : (size_t)(b * SEQ + tq);
    const float C2 = 0.08838834764831845f * 1.4426950408889634f;
    const int skey = tid >> 3, sc = tid & 7;
    const unsigned a_sk = opq(A_K + (skey * AK_LD + 8 * sc) * 2);
    const unsigned a_sv = opq(A_VT + (skey * AV_LD + 8 * sc) * 2);
    const unsigned a_kf = opq(A_K + (l32 * AK_LD + 8 * g) * 2);
    const unsigned a_vf = opq(A_VT + ((4 * g + ((lane & 15) >> 2)) * AV_LD + 16 * ((lane >> 4) & 1) + 4 * (lane & 3)) * 2);
    bf16x8 qf[8];
    {
        const bf16* qp = (isctx ? (const bf16*)ZA + qrow * ZA_LD : QR + qrow * 1024) + hq * 128 + 8 * g;
#pragma unroll
        for (int s = 0; s < 8; ++s) qf[s] = *(const bf16x8*)(qp + 16 * s);
    }
    float mrun = AIN(11)[l * 8 + hq] * 1.4426950408889634f, lsum = (g == 0) ? 1.f : 0.f;
    f32x16 O[4];
#pragma unroll
    for (int mt = 0; mt < 4; ++mt)
#pragma unroll
        for (int r = 0; r < 16; ++r) O[mt][r] = 0.f;
    int tfirst = isctx ? 5 : 0;
    if (!isctx) { while (t0 - 128 + 64 * tfirst < 0) ++tfirst; }
    v4u pk0, pk1, pv0, pv1;
#define ATT_PREFETCH(tile) do { const bf16 *kp_, *vp_; \
        if ((tile) < 5) { const size_t r_ = (size_t)(b * SEQ + t0 - 128 + 64 * (tile) + skey); kp_ = KR + r_ * 256 + hk * 128 + 8 * sc; vp_ = ZA + r_ * ZA_LD + 1280 + hk * 128 + 8 * sc; } \
        else { const size_t r_ = (size_t)(ML + b * CL + 64 * ((tile) - 5) + skey); kp_ = ZA + r_ * ZA_LD + 1024 + hk * 128 + 8 * sc; vp_ = kp_ + 256; } \
        pk0 = *(const v4u*)kp_; pk1 = *(const v4u*)(kp_ + 64); pv0 = *(const v4u*)vp_; pv1 = *(const v4u*)(vp_ + 64); } while (0)
    int tile = tfirst;
    ATT_PREFETCH(tile);
    bool plainq = isctx;
    while (tile < 9) {
        __syncthreads();
        ST_(v4u, a_sk) = pk0; ST_(v4u, a_sk + 128) = pk1;
        ST_(v4u, a_sv) = pv0; ST_(v4u, a_sv + 128) = pv1;
        __syncthreads();
        const int cur = tile;
        int nxt = cur + 1;
        if (nxt < 5 && t0 - 128 + 64 * nxt >= SEQ) nxt = 5;
        if (nxt < 9) ATT_PREFETCH(nxt);
        if (cur >= 5 && !plainq) {
            const bf16* qp = (const bf16*)ZA + qrow * ZA_LD + hq * 128 + 8 * g;
#pragma unroll
            for (int s = 0; s < 8; ++s) qf[s] = *(const bf16x8*)(qp + 16 * s);
            plainq = true;
        }
        f32x16 sc0, sc1;
#pragma unroll
        for (int r = 0; r < 16; ++r) { sc0[r] = 0.f; sc1[r] = 0.f; }
#pragma unroll
        for (int s = 0; s < 8; ++s) {
            const bf16x8 k0 = LD_(bf16x8, a_kf + 32 * s), k1 = LD_(bf16x8, a_kf + 32 * AK_LD * 2 + 32 * s);
            sc0 = __builtin_amdgcn_mfma_f32_32x32x16_bf16(k0, qf[s], sc0, 0, 0, 0);
            sc1 = __builtin_amdgcn_mfma_f32_32x32x16_bf16(k1, qf[s], sc1, 0, 0, 0);
        }
        float tmax = -3.0e38f;
        if (cur < 5) {
            const int kbase = t0 - 128 + 64 * cur - tq + 4 * g;
#pragma unroll
            for (int r = 0; r < 16; ++r) { const int d0 = kbase + 8 * (r >> 2) + (r & 3), d1 = d0 + 32;
                sc0[r] = (d0 >= -128 && d0 <= 128) ? sc0[r] * C2 : -1.0e30f; sc1[r] = (d1 >= -128 && d1 <= 128) ? sc1[r] * C2 : -1.0e30f; }
        } else {
#pragma unroll
            for (int r = 0; r < 16; ++r) { sc0[r] *= C2; sc1[r] *= C2; }
        }
#pragma unroll
        for (int r = 0; r < 16; ++r) tmax = fmaxf(tmax, fmaxf(sc0[r], sc1[r]));
        tmax = xhalf_max(tmax);
        const float mnew = fmaxf(mrun, tmax);
        const float corr = __builtin_amdgcn_exp2f(mrun - mnew);
        mrun = mnew;
        float ps = 0.f;
#pragma unroll
        for (int r = 0; r < 16; ++r) { sc0[r] = __builtin_amdgcn_exp2f(sc0[r] - mnew); sc1[r] = __builtin_amdgcn_exp2f(sc1[r] - mnew); ps += sc0[r] + sc1[r]; }
        lsum = lsum * corr + ps;
        if (__builtin_amdgcn_ballot_w64(corr != 1.0f) != 0ull) {
#pragma unroll
            for (int mt = 0; mt < 4; ++mt)
#pragma unroll
                for (int r = 0; r < 16; ++r) O[mt][r] *= corr;
        }
#pragma unroll
        for (int u = 0; u < 2; ++u)
#pragma unroll
            for (int s = 0; s < 2; ++s) {
                v4u pw;
                if (u == 0) { pw.x = pg8::cvt_pk_bf16(sc0[8 * s + 0], sc0[8 * s + 1]); pw.y = pg8::cvt_pk_bf16(sc0[8 * s + 2], sc0[8 * s + 3]); pw.z = pg8::cvt_pk_bf16(sc0[8 * s + 4], sc0[8 * s + 5]); pw.w = pg8::cvt_pk_bf16(sc0[8 * s + 6], sc0[8 * s + 7]); }
                else { pw.x = pg8::cvt_pk_bf16(sc1[8 * s + 0], sc1[8 * s + 1]); pw.y = pg8::cvt_pk_bf16(sc1[8 * s + 2], sc1[8 * s + 3]); pw.z = pg8::cvt_pk_bf16(sc1[8 * s + 4], sc1[8 * s + 5]); pw.w = pg8::cvt_pk_bf16(sc1[8 * s + 6], sc1[8 * s + 7]); }
                const bf16x8 pb = __builtin_bit_cast(bf16x8, pw);
#pragma unroll
                for (int mt = 0; mt < 4; ++mt) {
                    const bf16x8 av = tr8(L, a_vf + ((32 * u + 16 * s) * AV_LD + 32 * mt) * 2, a_vf + ((32 * u + 16 * s + 8) * AV_LD + 32 * mt) * 2);
                    O[mt] = __builtin_amdgcn_mfma_f32_32x32x16_bf16(av, pb, O[mt], 0, 0, 0);
                }
            }
        tile = nxt;
    }
#undef ATT_PREFETCH
    lsum = xhalf_sum(lsum);
    const float inv = 1.0f / lsum;
    bf16* op = ZA + qrow * ZA_LD + hq * 128 + 4 * g;
    if (NOSTORE) { float chk = inv;
#pragma unroll
        for (int mt = 0; mt < 4; ++mt) chk += O[mt][0] + O[mt][5] + O[mt][10] + O[mt][15];
        if (chk == 1.2345e-30f) op[0] = (bf16)1;
        return; }
#pragma unroll
    for (int mt = 0; mt < 4; ++mt)
#pragma unroll
        for (int i = 0; i < 4; ++i) {
            v2u o; o.x = pg8::cvt_pk_bf16(O[mt][4 * i] * inv, O[mt][4 * i + 1] * inv); o.y = pg8::cvt_pk_bf16(O[mt][4 * i + 2] * inv, O[mt][4 * i + 3] * inv);
            *(v2u*)(op + 32 * mt + 8 * i) = o;
        }
}
#undef LD_
#undef ST_

#ifndef MK_PROBE
#define MK_PROBE 0
#endif
#define PROBE_SPIN(bit, t0_) do { if ((MK_PROBE & (bit)) != 0) { asm volatile("s_waitcnt vmcnt(0) lgkmcnt(0)" ::: "memory"); const unsigned long long t1_ = __builtin_amdgcn_s_memrealtime(); \
        while (__builtin_amdgcn_s_memrealtime() - t1_ < t1_ - (t0_)) __builtin_amdgcn_s_sleep(8); } } while (0)
__device__ __forceinline__ void phase_mix(const Frame& F, ArgsRef A, int l, bool last) {
    unsigned long long tp = (MK_PROBE & 0x700) ? __builtin_amdgcn_s_memrealtime() : 0ull;
#if !defined(MIX_ONLY) || MIX_ONLY == 1
    for (int v = F.bid; v < 256; v += F.G) rwkv_chunk_item(F, A, l, ((v & 7) << 5) | (v >> 3), last);
#endif
    PROBE_SPIN(0x100, tp);
    if (MK_PROBE & 0x700) tp = __builtin_amdgcn_s_memrealtime();
#if !defined(MIX_ONLY) || MIX_ONLY == 2
    for (int v = F.bid; v < 256; v += F.G) { const int x = v & 7, y = v >> 3; gla_chunk_item<0>(F, ((x + 8 * (y >> 3)) << 3) | (y & 7), last); }

#endif
    PROBE_SPIN(0x200, tp);
    if (MK_PROBE & 0x700) tp = __builtin_amdgcn_s_memrealtime();
    {
        const int x = F.bid & 7; const unsigned nt = last ? 64u : 72u;
        unsigned* ctr = (unsigned*)(F.ws + WS_CTL) + 8192 + (l * 8 + x) * 64;
        volatile LAS unsigned* tk = (volatile LAS unsigned*)(F.lds + MISC_OFF) + 16;
        for (;;) {
            if (F.tid == 0) *tk = __hip_atomic_fetch_add(ctr, 1u, __ATOMIC_RELAXED, __HIP_MEMORY_SCOPE_AGENT);
            __syncthreads();
            const unsigned t = *tk;
            __syncthreads();
            if (t >= nt) break;
            const int item = t < 64u ? ((x << 6) | (int)t) : 512 + ((x << 3) | (int)(t - 64u));
#if !defined(MIX_ONLY) || MIX_ONLY == 3
            attn_mfma_item<false>(F, A, l, item);
#endif
        }
    }
    PROBE_SPIN(0x400, tp);
}

__device__ __forceinline__ void phase_mixout(const Frame& F, ArgsRef A, int l, int nrows) {
    const int gw = F.bid * NWAVES + F.wave, NGW = F.G * NWAVES, lane = F.lane;
    {
        const bf16* ZR = RGN(bf16, R_ZR); const bf16* Y = RGN(bf16, R_Y); const bf16* G = RGN(bf16, R_G); bf16* ORW = RGN(bf16, R_ZA) + OC_RW; const float* BS = RGN(float, R_BS);
        const float* cw = AIN(12) + (size_t)l * 3 * RW_COLS;
        const int cg = F.wave & 3, c0 = cg * 256 + lane * 4, hd = cg * 4 + (lane >> 4);
        f32x4 tpv[3];
#pragma unroll
        for (int tap = 0; tap < 3; ++tap) tpv[tap] = *(const f32x4*)(cw + tap * RW_COLS + 2 * 1024 + c0);
        const f32x4 lnw = *(const f32x4*)(AIN(21) + l * 1024 + c0), lnb = *(const f32x4*)(AIN(22) + l * 1024 + c0);
        for (int m = F.bid * 2 + (F.wave >> 2); m < nrows; m += 2 * F.G) {
            int idx, len; if (m < ML) { idx = m & (SEQ - 1); len = SEQ; } else { idx = (m - ML) & (CL - 1); len = CL; }
            const float fl = idx > 0 ? 1.f : 0.f, fr = idx < len - 1 ? 1.f : 0.f;
            const bf16* z0 = ZR + (size_t)m * ZR_W + 2 * 1024 + c0; const bf16* zl = idx > 0 ? z0 - ZR_W : z0; const bf16* zrr = idx < len - 1 ? z0 + ZR_W : z0;
            const v2u wc = *(const v2u*)z0, wl = *(const v2u*)zl, wr = *(const v2u*)zrr;
            const f32x4 xc = (f32x4){bflo(wc.x), bfhi(wc.x), bflo(wc.y), bfhi(wc.y)}, xl = (f32x4){bflo(wl.x), bfhi(wl.x), bflo(wl.y), bfhi(wl.y)}, xr = (f32x4){bflo(wr.x), bfhi(wr.x), bflo(wr.y), bfhi(wr.y)};
            const f32x4 v = xc * tpv[1] + xl * tpv[0] * fl + xr * tpv[2] * fr;
            const v2u yw0 = *(const v2u*)(Y + (size_t)m * 1024 + c0), yw1 = *(const v2u*)(Y + ((size_t)MT + m) * 1024 + c0);
            const f32x4 y0 = (f32x4){bflo(yw0.x), bfhi(yw0.x), bflo(yw0.y), bfhi(yw0.y)}, y1 = (f32x4){bflo(yw1.x), bfhi(yw1.x), bflo(yw1.y), bfhi(yw1.y)};
            const float bs = BS[(size_t)m * 16 + hd] + BS[((size_t)MT + m) * 16 + hd];
            const f32x4 o = y0 + y1;
            const float mean = red16s((o.x + o.y) + (o.z + o.w)) * (1.f / 64.f); const f32x4 dv = o - mean;
            const float var = red16s((dv.x * dv.x + dv.y * dv.y) + (dv.z * dv.z + dv.w * dv.w)) * (1.f / 64.f);
            const f32x4 on = dv * (1.f / sqrtf(var + 64e-5f)) * lnw + lnb;
            const v2u gw2 = *(const v2u*)(G + (size_t)m * 1024 + c0);
            const f32x4 gv = (f32x4){bflo(gw2.x), bfhi(gw2.x), bflo(gw2.y), bfhi(gw2.y)};
            const f32x4 res = (on + v * bs) * gv;
            *(v2u*)(ORW + (size_t)m * ZA_LD + c0) = (v2u){pk2(res.x, res.y), pk2(res.z, res.w)};
        }
    }
    {
        const bf16* YG = RGN(bf16, R_YG); const bf16* ZG = RGN(bf16, R_ZG); bf16* OGL = RGN(bf16, R_ZA) + OC_GL; const float* nw = AIN(25) + l * 512;
        const f32x4 nw0 = *(const f32x4*)(nw + lane * 8), nw1 = *(const f32x4*)(nw + lane * 8 + 4);
        for (int it = gw; it < nrows * 4; it += NGW) {
            const int m = it >> 2, h = it & 3;
            const v4u ya = *(const v4u*)(YG + (size_t)m * 2048 + h * 512 + lane * 8), yb = *(const v4u*)(YG + ((size_t)MT + m) * 2048 + h * 512 + lane * 8);
            f32x4 y0 = (f32x4){bflo(ya.x) + bflo(yb.x), bfhi(ya.x) + bfhi(yb.x), bflo(ya.y) + bflo(yb.y), bfhi(ya.y) + bfhi(yb.y)};
            f32x4 y1 = (f32x4){bflo(ya.z) + bflo(yb.z), bfhi(ya.z) + bfhi(yb.z), bflo(ya.w) + bflo(yb.w), bfhi(ya.w) + bfhi(yb.w)};
            const float ss = wave_sum((y0.x * y0.x + y0.y * y0.y) + (y0.z * y0.z + y0.w * y0.w) + (y1.x * y1.x + y1.y * y1.y) + (y1.z * y1.z + y1.w * y1.w));
            const float rs = 1.f / sqrtf(ss * (1.f / 512.f) + 1e-5f);
            const v4u gw4 = *(const v4u*)(ZG + (size_t)m * ZG_W + 4096 + h * 512 + lane * 8);
            const f32x4 g0 = (f32x4){bflo(gw4.x), bfhi(gw4.x), bflo(gw4.y), bfhi(gw4.y)}, g1 = (f32x4){bflo(gw4.z), bfhi(gw4.z), bflo(gw4.w), bfhi(gw4.w)};
            y0 = y0 * rs * nw0; y1 = y1 * rs * nw1;
            v4u w; w.x = pk2(y0.x * fsilu(g0.x), y0.y * fsilu(g0.y)); w.y = pk2(y0.z * fsilu(g0.z), y0.w * fsilu(g0.w));
            w.z = pk2(y1.x * fsilu(g1.x), y1.y * fsilu(g1.y)); w.w = pk2(y1.z * fsilu(g1.z), y1.w * fsilu(g1.w));
            *(v4u*)(OGL + (size_t)m * ZA_LD + h * 512 + lane * 8) = w;
        }
    }
}


#define NOPK
#ifndef MK_ONE_LAUNCH
#define MK_ONE_LAUNCH 1
#endif

template <int K> __device__ __forceinline__ void run_phase(const Frame& F, ArgsRef A, int l) {
    const float* mods = WSP(float, WS_MODS);
    bf16* HB = WSP(bf16, WS_HB);
    const bool last = (l == DEPTH - 1);
    const float* mods_l = mods + (size_t)l * 9 * 18432;
    const float* lng = AIN(6) + (size_t)l * 3 * D; const float* lnb = AIN(7) + (size_t)l * 3 * D;
    const int nrows = last ? ML : MT;
    if constexpr (K == -1) phase_init(F, A);
    if constexpr (K == 0) {
        if (l > 0) phase_ln<true, true>(F, MT, lng - D, lnb - D, mods_l, 0, 1, RGN(bf16, R_PART), mods_l - 9 * 18432 + 8 * 18432 + 8 * 2048, 0.5f);
        else phase_ln<false, true>(F, MT, nullptr, nullptr, mods_l, 0, 1, nullptr, nullptr, 0.f, AIN(0), AIN(2));
        phase_convert(F, A, l, 0, 3);
    }
    if constexpr (K == 1 || K == 12) { const int M = (K == 1) ? MT : nrows; pg8::Gemm g{HB, RGN(bf16, R_WGU), M, 2 * FF, D, D, D, 0}; pg8::StaticOrder S; S.init(M, 2 * FF, F.G, F.bid);
        pg8::EpiSwiglu E{RGN(bf16, R_H), FF}; pg8::gemm_phase<pg8::EpiSwiglu, pg8::StaticOrder, true, true>(F.lds, g, S, E, F.tid); }
    if constexpr (K == 2 || K == 13) { const int M = (K == 2) ? MT : nrows;
        { pg8::Gemm g{RGN(bf16, R_H), RGN(bf16, R_WDN), ML, D, FF, FF, FF, 0}; pg8::StaticOrder S; S.init(ML, D, F.G, F.bid);
          const bool first = (K == 2) && l == 0;
          const float* pg_ = (K == 2) ? (first ? lng : lng - D) : lng + D; const float* pb_ = (K == 2) ? (first ? lnb : lnb - D) : lnb + D;
          pg8::EpiResid<1> E{(float*)F.out, mods_l, first ? AIN(0) : (const float*)F.out, first ? nullptr : WSP(const float, WS_STATS), pg_, pb_, (K == 2) ? 2 : 8}; pg8::gemm_phase<pg8::EpiResid<1>, pg8::StaticOrder, true, true>(F.lds, g, S, E, F.tid); }
        if (M == MT) { pg8::Gemm g{RGN(bf16, R_H) + (size_t)ML * FF, RGN(bf16, R_WDN), MC, D, FF / 4, FF, FF, (FF / 4) * 2}; pg8::SplitKOrder S; S.init(MC, D, 4, F.G, F.bid);
          pg8::EpiPartial E{RGN(bf16, R_PART), D, (size_t)MC * D}; pg8::gemm_phase<pg8::EpiPartial, pg8::SplitKOrder, true, true>(F.lds, g, S, E, F.tid); }
    }
    if constexpr (K == 3) phase_ln<true, true>(F, MT, lng, lnb, mods_l, 3, 4, RGN(bf16, R_PART), mods_l + 8 * 18432 + 2 * 2048, 0.5f, nullptr, l == 0 ? AIN(2) : nullptr);
    if constexpr (K == 4) { pg8::Gemm g{HB, WSP(bf16, WS_WM + WM_IN), MT, NMIX, D, D, D, 0}; pg8::StaticOrder S; S.init(MT, NMIX, F.G, F.bid);
        typedef pg8::EpiBf16Seg<0, WS_R + R_ZA, WS_R + R_ZR, WS_R + R_ZG, 6, 21, ZA_LD, ZR_W, ZG_W> EpiWin; EpiWin E{(unsigned char*)F.ws};
        pg8::gemm_phase<EpiWin, pg8::StaticOrder, true, true>(F.lds, g, S, E, F.tid); }
    if constexpr (K == 5) { phase_prep(F, A, l);
#if (MK_PROBE & 0x100000)
        __syncthreads();
        for (int v = F.bid; v < 576; v += F.G) { const int item = v < 512 ? (((v & 7) << 6) | ((v >> 3) & 31) | ((v >> 8) << 5)) : 512 + ((((v - 512) & 7) << 3) | ((v - 512) >> 3)); attn_mfma_item<true>(F, A, l, item); }
#endif
#if (MK_PROBE & 0x200000)
        __syncthreads();
        for (int v = F.bid; v < 256; v += F.G) rwkv_chunk_item(F, A, l, ((v & 7) << 5) | (v >> 3), true);
#endif
#if (MK_PROBE & 0xF0000)
        __syncthreads();
        for (int v = F.bid; v < 256; v += F.G) { const int x = v & 7, y = v >> 3; gla_chunk_item<(MK_PROBE >> 16) & 15>(F, ((x + 8 * (y >> 3)) << 3) | (y & 7), true); }
#endif
    }
    if constexpr (K == 6) {
        { pg8::Gemm g{RGN(bf16, R_LA), WSP(bf16, WS_WM + WM_LW), MT, 2048, 256, LA_W, 256, 0}; pg8::StaticOrder S; S.init(MT, 2048, F.G, F.bid);
          pg8::EpiLora<0> E{RGN(float, R_WDEC), nullptr, AIN(13) + (size_t)l * 2048, (size_t)MT * 1024}; pg8::gemm_phase<pg8::EpiLora<0>, pg8::StaticOrder, true, true>(F.lds, g, S, E, F.tid); }
    }
    if constexpr (K == 15) {
        { pg8::Gemm g{RGN(bf16, R_LA) + 256, WSP(bf16, WS_WM + WM_LA), MT, 2048, 256, LA_W, 256, 0}; pg8::StaticOrder S; S.init(MT, 2048, F.G, F.bid);
          pg8::EpiLora<1> E{nullptr, RGN(bf16, R_AA), AIN(15) + (size_t)l * 2048, (size_t)MT * 1024}; pg8::gemm_phase<pg8::EpiLora<1>, pg8::StaticOrder, true, true>(F.lds, g, S, E, F.tid); }
    }
    if constexpr (K == 16) {
        { pg8::Gemm g{RGN(bf16, R_LA) + 512, WSP(bf16, WS_WM + WM_LG), MT, 1024, 256, LA_W, 256, 0}; pg8::StaticOrder S; S.init(MT, 1024, F.G, F.bid);
          pg8::EpiLora<2> E{nullptr, RGN(bf16, R_G), nullptr, 0}; pg8::gemm_phase<pg8::EpiLora<2>, pg8::StaticOrder, true, true>(F.lds, g, S, E, F.tid); }
    }
    if constexpr (K == 7) phase_mix(F, A, l, last);
    if constexpr (K == 8) {
        phase_mixout(F, A, l, nrows);
        __syncthreads();
        pg8::Gemm g{HB, WSP(bf16, WS_WM + WM_IN) + (size_t)NMIX * D, nrows, GT_W, D, D, D, 0}; pg8::StaticOrder S; S.init(nrows, GT_W, F.G, F.bid);
        typedef pg8::EpiBf16Seg<1, WS_R + R_GT, WS_R + R_GT, WS_R + R_GT, 1 << 20, 1 << 20, GT_W, GT_W, GT_W> EpiGate; EpiGate E{(unsigned char*)F.ws};
        pg8::gemm_phase<EpiGate, pg8::StaticOrder, true, true>(F.lds, g, S, E, F.tid);
    }
    if constexpr (K == 9) {
        pg8::Gemm g{RGN(bf16, R_ZA), WSP(bf16, WS_WM + WM_BA), nrows, D, 4096, ZA_LD, 4096, 0, 16, (OC_RW - 1024) * 2}; pg8::StaticOrder S; S.init(nrows, D, F.G, F.bid);
        pg8::EpiBranchFused E{RGN(bf16, R_GT), GT_W, RGN(bf16, R_MG)}; pg8::gemm_phase<pg8::EpiBranchFused, pg8::StaticOrder, true, true>(F.lds, g, S, E, F.tid);
    }
    if constexpr (K == 10) {
        { pg8::Gemm g{RGN(bf16, R_MG), WSP(bf16, WS_WM + WM_OUT), ML, D, D, D, D, 0}; pg8::StaticOrder S; S.init(ML, D, F.G, F.bid);
          pg8::EpiResid<2> E{(float*)F.out, mods_l, (const float*)F.out, WSP(const float, WS_STATS), lng, lnb, 5}; pg8::gemm_phase<pg8::EpiResid<2>, pg8::StaticOrder, true, true>(F.lds, g, S, E, F.tid); }
        if (nrows == MT) { pg8::Gemm g{RGN(bf16, R_MG) + (size_t)ML * D, WSP(bf16, WS_WM + WM_OUT), MC, D, D / 4, D, D, (D / 4) * 2}; pg8::SplitKOrder S; S.init(MC, D, 4, F.G, F.bid);
          pg8::EpiPartial E{RGN(bf16, R_PART), D, (size_t)MC * D}; pg8::gemm_phase<pg8::EpiPartial, pg8::SplitKOrder, true, true>(F.lds, g, S, E, F.tid); }
    }
    if constexpr (K == 11) { phase_ln<true, true>(F, nrows, lng + D, lnb + D, mods_l, 6, 7, RGN(bf16, R_PART), mods_l + 8 * 18432 + 5 * 2048, 1.0f); phase_convert(F, A, l, 1, 1); }
    if constexpr (K == 14) phase_ln<true, false, true>(F, ML, lng + 2 * D, lnb + 2 * D, nullptr, 0, 0);
}

__device__ __forceinline__ void frame_init(Frame& F, const Args& A, unsigned char* lds_raw) {
    F.lds = (LAS unsigned char*)lds_raw;
    F.tid = threadIdx.x; F.lane = F.tid & 63; F.wave = __builtin_amdgcn_readfirstlane(F.tid >> 6);
    F.G = gridDim.x; F.bid = blockIdx.x; F.out = (GAS float*)A.out; F.ws = (GAS unsigned char*)A.ws;
}

template <int K> __global__ void __launch_bounds__(NTHR, 2) NOPK fwd_phase(Args A) {
    extern __shared__ __attribute__((aligned(16))) unsigned char lds_raw[];
    Frame F; frame_init(F, A, lds_raw);
    const CAS Args* ap = (const CAS Args*)__builtin_amdgcn_kernarg_segment_ptr();
    run_phase<K>(F, *ap, A.ph_lo);
}


#ifndef MK_UNROLL_LAYERS
#define MK_UNROLL_LAYERS 0
#endif
__device__ __forceinline__ void launder(Frame& F, int& l) {
    asm volatile("" : "+s"(F.wave));
    { int ln; asm volatile("v_mbcnt_lo_u32_b32 %0, -1, 0\n\tv_mbcnt_hi_u32_b32 %0, -1, %0" : "=v"(ln)); F.lane = ln; }
    F.tid = F.wave * 64 + F.lane;
    asm volatile("" : "+s"(F.bid), "+s"(F.G), "+s"(l));
    asm volatile("" : "+s"(F.ws), "+s"(F.out));
}
template <int K> __device__ __forceinline__ constexpr int phase_group() { return (K == 1 || K == 2 || K == 4 || K == 6 || K == 15 || K == 16 || K == 9 || K == 10 || K == 12 || K == 13) ? 1 : (K == 7 ? 2 : (K == 8 ? 4 : (K == 5 ? 8 : (K == 0 || K == 11 ? 16 : (K == 3 || K == 14 ? 32 : 64))))); }
template <int K> __device__ __forceinline__ void run_phase_l(Frame F, int l) {
    if constexpr ((MK_PROBE & phase_group<K>()) != 0) {
        const unsigned long long t0 = __builtin_amdgcn_s_memrealtime();
        { Frame F2 = F; int l2 = l; launder(F2, l2); const CAS Args* ap = (const CAS Args*)__builtin_amdgcn_kernarg_segment_ptr(); asm volatile("" : "+s"(ap)); run_phase<K>(F2, *ap, l2); }
        asm volatile("s_waitcnt vmcnt(0) lgkmcnt(0)" ::: "memory");
        const unsigned long long t1 = __builtin_amdgcn_s_memrealtime();
        while (__builtin_amdgcn_s_memrealtime() - t1 < t1 - t0) __builtin_amdgcn_s_sleep(8);
        return;
    }
    launder(F, l); const CAS Args* ap = (const CAS Args*)__builtin_amdgcn_kernarg_segment_ptr(); asm volatile("" : "+s"(ap)); run_phase<K>(F, *ap, l); }
template <int L> __device__ __forceinline__ void run_layer(const Frame& F, int l, const XcdBarrier& bar) {
#if (MK_PROBE & 0x2000)
#define XBAR2(t_) do { const unsigned long long tb0_ = __builtin_amdgcn_s_memrealtime(); xcd_barrier(bar, (t_)); const unsigned long long tb1_ = __builtin_amdgcn_s_memrealtime(); \
    while (__builtin_amdgcn_s_memrealtime() - tb1_ < tb1_ - tb0_) __builtin_amdgcn_s_sleep(8); } while (0)
#elif (MK_PROBE & 0x1000)
#define XBAR2(t_) xcd_barrier(bar, (t_)); xcd_barrier(bar, (t_))
#else
#define XBAR2(t_) xcd_barrier(bar, (t_))
#endif
#define PB(K) run_phase_l<K>(F, l); { int ln_; asm volatile("v_mbcnt_lo_u32_b32 %0, -1, 0\n\tv_mbcnt_hi_u32_b32 %0, -1, %0" : "=v"(ln_)); XBAR2(F.wave * 64 + ln_); }
    PB(0) PB(1) PB(2) PB(3) PB(4) PB(5)
    run_phase_l<6>(F, l); run_phase_l<15>(F, l); run_phase_l<16>(F, l); { int ln_; asm volatile("v_mbcnt_lo_u32_b32 %0, -1, 0\n\tv_mbcnt_hi_u32_b32 %0, -1, %0" : "=v"(ln_)); XBAR2(F.wave * 64 + ln_); }
    PB(7) PB(8) PB(9) PB(10) PB(11) PB(12) PB(13)
#undef PB
}
__global__ void __launch_bounds__(NTHR, 2) NOPK fwd_all(Args A) {
    extern __shared__ __attribute__((aligned(16))) unsigned char lds_raw[];
    Frame F; frame_init(F, A, lds_raw);
    volatile LAS unsigned* MISC = (volatile LAS unsigned*)(F.lds + MISC_OFF);
    for (int u = F.tid; u < (LDS_BYTES - LDSCTL_OFF) / 4; u += NTHR) ((LAS unsigned*)(F.lds + LDSCTL_OFF))[u] = 0u;
    __syncthreads();
    const XcdBarrier bar = xcd_barrier_post((unsigned*)(F.ws + WS_CTL) + 4096, MISC + 8, F.tid);
    run_phase_l<-1>(F, 0); { int ln_; asm volatile("v_mbcnt_lo_u32_b32 %0, -1, 0\n\tv_mbcnt_hi_u32_b32 %0, -1, %0" : "=v"(ln_)); XBAR2(F.wave * 64 + ln_); }
#if MK_UNROLL_LAYERS
    run_layer<0>(F, 0, bar); run_layer<1>(F, 1, bar);
#else
    for (int l = 0; l < DEPTH; ++l) run_layer<0>(F, l, bar);
#endif
    run_phase_l<14>(F, DEPTH - 1);
}

template <int K> static void launch_phase(const Args& a, int l, int grid, hipStream_t stream) {
    static bool attr_done = false;
    if (!attr_done) { (void)hipFuncSetAttribute((const void*)fwd_phase<K>, hipFuncAttributeMaxDynamicSharedMemorySize, LDS_BYTES); attr_done = true; }
    Args b = a; b.ph_lo = l; b.ph_hi = 0;
    hipLaunchKernelGGL(fwd_phase<K>, dim3(grid), dim3(NTHR), LDS_BYTES, stream, b);
}

extern "C" void kernel_launch(void* const* d_in, const int* in_sizes, int n_in, void* d_out, int out_size, void* d_ws, size_t ws_size, hipStream_t stream) {
    static int grid = 0;
    if (grid == 0) {
        if (n_in != 30 || out_size != ML * D || ws_size < WS_END) { fprintf(stderr, "kernel_launch: unexpected shapes (n_in %d, out %d, ws %zu < %zu)\n", n_in, out_size, ws_size, (size_t)WS_END); grid = -1; return; }
        int dev = 0, cus = 0;
        if (hipGetDevice(&dev) != hipSuccess || hipDeviceGetAttribute(&cus, hipDeviceAttributeMultiprocessorCount, dev) != hipSuccess) { grid = -1; return; }
        grid = cus;
    }
    if (grid < 0) return;
    (void)hipMemsetAsync((char*)d_ws + WS_CTL, 0, CTL_ZERO_BYTES, stream);
    Args a{};
    for (int i = 0; i < 30; ++i) a.in[i] = (const float*)d_in[i];
    a.out = (float*)d_out; a.ws = (unsigned char*)d_ws;
#if MK_ONE_LAUNCH
    {
        static bool attr_done = false;
        if (!attr_done) { int per_cu = 0;
            if (hipFuncSetAttribute((const void*)fwd_all, hipFuncAttributeMaxDynamicSharedMemorySize, LDS_BYTES) != hipSuccess) { fprintf(stderr, "kernel_launch: hipFuncSetAttribute failed\n"); grid = -1; return; }
            if (hipOccupancyMaxActiveBlocksPerMultiprocessor(&per_cu, (const void*)fwd_all, NTHR, LDS_BYTES) != hipSuccess || per_cu < 1) { fprintf(stderr, "kernel_launch: occupancy query says %d blocks per CU; not launching\n", per_cu); (void)hipGetLastError(); grid = -1; return; }
            attr_done = true; }
        a.ph_lo = 0; a.ph_hi = 0;
        hipLaunchKernelGGL(fwd_all, dim3(grid), dim3(NTHR), LDS_BYTES, stream, a);
        return;
    }
#endif
    launch_phase<-1>(a, 0, grid, stream);
    for (int l = 0; l < DEPTH; ++l) {
        launch_phase<0>(a, l, grid, stream); launch_phase<1>(a, l, grid, stream); launch_phase<2>(a, l, grid, stream); launch_phase<3>(a, l, grid, stream);
        launch_phase<4>(a, l, grid, stream); launch_phase<5>(a, l, grid, stream); launch_phase<6>(a, l, grid, stream); launch_phase<15>(a, l, grid, stream); launch_phase<16>(a, l, grid, stream); launch_phase<7>(a, l, grid, stream);
        launch_phase<8>(a, l, grid, stream); launch_phase<9>(a, l, grid, stream); launch_phase<10>(a, l, grid, stream); launch_phase<11>(a, l, grid, stream);
        launch_phase<12>(a, l, grid, stream); launch_phase<13>(a, l, grid, stream);
    }
    launch_phase<14>(a, DEPTH - 1, grid, stream);
}
```
